# Optimizing an MI355X kernel written in HIP

```python
import math
import jax, jax.numpy as jnp
from jax import lax
import numpy as np

D_MODEL = 1024
BATCH = 4
SEQ = 4096
DEPTH = 1

MEM_LEN = 256
MLA_HEADS = 8
MLA_Q_RANK = 384
MLA_KV_RANK = 256
MLA_NOPE = 64
MLA_ROPE = 32
MLA_V = 64
Q_BLOCK = 128
RET_HEADS = 4
RET_DK = 128
RET_DV = 128
RET_CHUNK = 128
MIX_WIDTH = MLA_HEADS * MLA_V + RET_HEADS * RET_DV
IN_WIDTHS = (MLA_Q_RANK, MLA_KV_RANK, MLA_ROPE,
             RET_HEADS * RET_DK, RET_HEADS * RET_DK, RET_HEADS * RET_DV, RET_HEADS * RET_DV)
IN_WIDTH = sum(IN_WIDTHS)
IN_SPLITS = tuple(int(s) for s in np.cumsum(IN_WIDTHS)[:-1])
X_HEADS = 4
X_HEAD_DIM = D_MODEL // X_HEADS
PEER_KEYS = 128
PEER_EXPERTS = PEER_KEYS * PEER_KEYS
PEER_HEADS = 8
PEER_TOPK = 16
PEER_DKEY = 256
PEER_BLOCK = 128
ROPE_BASE = 10000.0
EPS = 1e-6
NEG = -1e30

kernel_name = "hymba_mla_retention_peer_block"


def rmsnorm(x, g):
    xf = x.astype(jnp.float32)
    y = xf * lax.rsqrt(jnp.mean(xf * xf, axis=-1, keepdims=True) + EPS)
    return (y * g.astype(jnp.float32)).astype(x.dtype)


def rope_tables(pos, dim):
    inv = 1.0 / (ROPE_BASE ** (jnp.arange(0, dim, 2, dtype=jnp.float32) / dim))
    ang = pos[:, None] * inv[None, :]
    return jnp.cos(ang), jnp.sin(ang)


def apply_rope(x, cos, sin):
    half = x.shape[-1] // 2
    c = cos[None, :, None, :].astype(x.dtype)
    s = sin[None, :, None, :].astype(x.dtype)
    x1, x2 = x[..., :half], x[..., half:]
    return jnp.concatenate([x1 * c - x2 * s, x1 * s + x2 * c], axis=-1)


def blocked_causal_attention(q, k, v, scale):
    B, S, H, dq = q.shape
    dv = v.shape[-1]
    nb = S // Q_BLOCK
    qb = q.reshape(B, nb, Q_BLOCK, H, dq).transpose(1, 0, 2, 3, 4)
    kpos = jnp.arange(S)

    def one_block(args):
        qblk, i = args
        s = jnp.einsum('bqhd,bkhd->bhqk', qblk, k).astype(jnp.float32) * scale
        qpos = i * Q_BLOCK + jnp.arange(Q_BLOCK)
        mask = kpos[None, :] <= qpos[:, None]
        s = jnp.where(mask[None, None], s, NEG)
        p = jax.nn.softmax(s, axis=-1)
        return jnp.einsum('bhqk,bkhd->bqhd', p.astype(v.dtype), v)

    out = lax.map(one_block, (qb, jnp.arange(nb)))
    return out.transpose(1, 0, 2, 3, 4).reshape(B, S, H, dv)


def chunkwise_retention(q, k, v):
    B, S, H, dk = q.shape
    dv = v.shape[-1]
    C = RET_CHUNK
    n = S // C
    log_g = jnp.log(1.0 - 2.0 ** (-5.0 - jnp.arange(H, dtype=jnp.float32)))
    idx = jnp.arange(C, dtype=jnp.float32)
    rel = idx[:, None] - idx[None, :]
    decay = jnp.where(rel[None] >= 0, jnp.exp(jnp.maximum(rel, 0.0)[None] * log_g[:, None, None]), 0.0)
    zeta = jnp.exp((C - 1 - idx)[None, :] * log_g[:, None])
    xi = jnp.exp((idx + 1)[None, :] * log_g[:, None])
    chunk_decay = jnp.exp(C * log_g)
    qc = q.reshape(B, n, C, H, dk)
    kc = k.reshape(B, n, C, H, dk)
    vc = v.reshape(B, n, C, H, dv)
    scores = jnp.einsum('bnihd,bnjhd->bnhij', qc, kc) * decay[None, None]
    inner = jnp.einsum('bnhij,bnjhe->bnihe', scores, vc)
    kz = kc * zeta.T[None, None, :, :, None]
    kv = jnp.einsum('bnjhd,bnjhe->bnhde', kz, vc)

    def step(R, kv_i):
        return R * chunk_decay[None, :, None, None] + kv_i, R

    _, R_prev = lax.scan(step, jnp.zeros((B, H, dk, dv), jnp.float32), kv.transpose(1, 0, 2, 3, 4))
    R_prev = R_prev.transpose(1, 0, 2, 3, 4)
    cross = jnp.einsum('bnihd,bnhde->bnihe', qc, R_prev) * xi.T[None, None, :, :, None]
    return (inner + cross).reshape(B, S, H, dv)


def hybrid_mixer(a, w_in, g_q_lora, w_uq, g_kv_lora, w_ukv, g_ret_gn, w_o, cos_m, sin_m, cos_r, sin_r):
    B, S, _ = a.shape
    proj = a @ w_in
    c_q, c_kv, k_pe, r_q, r_k, r_v, r_g = jnp.split(proj, IN_SPLITS, axis=-1)
    q = (rmsnorm(c_q, g_q_lora) @ w_uq).reshape(B, S, MLA_HEADS, MLA_NOPE + MLA_ROPE)
    q = jnp.concatenate([q[..., :MLA_NOPE], apply_rope(q[..., MLA_NOPE:], cos_m, sin_m)], axis=-1)
    kv = (rmsnorm(c_kv, g_kv_lora) @ w_ukv).reshape(B, S, MLA_HEADS, MLA_NOPE + MLA_V)
    k_pe = apply_rope(k_pe[:, :, None, :], cos_m, sin_m)
    k = jnp.concatenate([kv[..., :MLA_NOPE], jnp.broadcast_to(k_pe, (B, S, MLA_HEADS, MLA_ROPE))], axis=-1)
    v = kv[..., MLA_NOPE:]
    o_mla = blocked_causal_attention(q, k, v, (MLA_NOPE + MLA_ROPE) ** -0.5).reshape(B, S, MLA_HEADS * MLA_V)
    rq = apply_rope(r_q.reshape(B, S, RET_HEADS, RET_DK), cos_r, sin_r)
    rk = apply_rope(r_k.reshape(B, S, RET_HEADS, RET_DK), cos_r, sin_r) * (RET_DK ** -0.5)
    rv = r_v.reshape(B, S, RET_HEADS, RET_DV)
    o = chunkwise_retention(rq.astype(jnp.float32), rk.astype(jnp.float32), rv.astype(jnp.float32))
    mu = jnp.mean(o, axis=-1, keepdims=True)
    var = jnp.mean(jnp.square(o - mu), axis=-1, keepdims=True)
    o = ((o - mu) * lax.rsqrt(var + EPS)).reshape(B, S, RET_HEADS * RET_DV) * g_ret_gn.astype(jnp.float32)
    o_ret = (jax.nn.silu(r_g.astype(jnp.float32)) * o).astype(a.dtype)
    return jnp.concatenate([o_mla, o_ret], axis=-1) @ w_o


def memory_cross_attention(a, mem_n, w_xq, w_xkv, w_xo):
    B, S, D = a.shape
    M = mem_n.shape[1]
    q = (a @ w_xq).reshape(B, S, X_HEADS, X_HEAD_DIM)
    kv = (mem_n @ w_xkv).reshape(B, M, 2, X_HEADS, X_HEAD_DIM)
    k, v = kv[:, :, 0], kv[:, :, 1]
    s = jnp.einsum('bshd,bmhd->bhsm', q, k).astype(jnp.float32) * (X_HEAD_DIM ** -0.5)
    p = jax.nn.softmax(s, axis=-1)
    o = jnp.einsum('bhsm,bmhd->bshd', p.astype(v.dtype), v).reshape(B, S, D)
    return o @ w_xo


def peer_ffn(a, w_pq, sub_keys, u_experts, v_experts):
    B, S, D = a.shape
    T = B * S
    t = a.reshape(T, D)
    q = (t @ w_pq).reshape(T, PEER_HEADS, 2, PEER_DKEY // 2)
    s = jnp.einsum('thpd,pkd->thpk', q, sub_keys).astype(jnp.float32)
    top_s, top_i = lax.top_k(s, PEER_TOPK)
    cand = top_s[:, :, 0, :, None] + top_s[:, :, 1, None, :]
    best_s, best_c = lax.top_k(cand.reshape(T, PEER_HEADS, PEER_TOPK * PEER_TOPK), PEER_TOPK)
    i1 = jnp.take_along_axis(top_i[:, :, 0], best_c // PEER_TOPK, axis=-1)
    i2 = jnp.take_along_axis(top_i[:, :, 1], best_c % PEER_TOPK, axis=-1)
    expert = i1 * PEER_KEYS + i2
    gate = jax.nn.softmax(best_s, axis=-1)
    nb = T // PEER_BLOCK

    def one_block(args):
        tb, eb, gb = args
        u = u_experts[eb]
        act = jax.nn.gelu(jnp.einsum('thkd,td->thk', u, tb).astype(jnp.float32), approximate=False)
        w = (gb * act).astype(tb.dtype)
        return jnp.einsum('thk,thkd->td', w, v_experts[eb])

    out = lax.map(one_block, (t.reshape(nb, PEER_BLOCK, D),
                              expert.reshape(nb, PEER_BLOCK, PEER_HEADS, PEER_TOPK),
                              gate.reshape(nb, PEER_BLOCK, PEER_HEADS, PEER_TOPK)))
    return out.reshape(B, S, D)


def setup_inputs(seed: int = 0) -> dict:
    key = jax.random.key(seed)
    ks = jax.random.split(key, 24)
    f32 = jnp.float32

    def nrm(k, shape, scale):
        return jax.random.normal(k, shape, f32) * scale

    def gain(k, shape):
        return 1.0 + 0.02 * jax.random.normal(k, shape, f32)

    L = DEPTH
    return {
        "x": nrm(ks[0], (BATCH, SEQ, D_MODEL), 1.0),
        "mem": nrm(ks[1], (BATCH, MEM_LEN, D_MODEL), 1.0),
        "g_mix": gain(ks[2], (L, D_MODEL)),
        "w_in": nrm(ks[3], (L, D_MODEL, IN_WIDTH), D_MODEL ** -0.5),
        "g_q_lora": gain(ks[4], (L, MLA_Q_RANK)),
        "w_uq": nrm(ks[5], (L, MLA_Q_RANK, MLA_HEADS * (MLA_NOPE + MLA_ROPE)), MLA_Q_RANK ** -0.5),
        "g_kv_lora": gain(ks[6], (L, MLA_KV_RANK)),
        "w_ukv": nrm(ks[7], (L, MLA_KV_RANK, MLA_HEADS * (MLA_NOPE + MLA_V)), MLA_KV_RANK ** -0.5),
        "g_ret_gn": gain(ks[8], (L, RET_HEADS * RET_DV)),
        "w_o": nrm(ks[9], (L, MIX_WIDTH, D_MODEL), MIX_WIDTH ** -0.5),
        "g_xattn": gain(ks[10], (L, D_MODEL)),
        "g_mem": gain(ks[11], (L, D_MODEL)),
        "w_xq": nrm(ks[12], (L, D_MODEL, D_MODEL), D_MODEL ** -0.5),
        "w_xkv": nrm(ks[13], (L, D_MODEL, 2 * D_MODEL), D_MODEL ** -0.5),
        "w_xo": nrm(ks[14], (L, D_MODEL, D_MODEL), D_MODEL ** -0.5),
        "g_ffn": gain(ks[15], (L, D_MODEL)),
        "w_pq": nrm(ks[16], (L, D_MODEL, PEER_HEADS * PEER_DKEY), D_MODEL ** -0.5),
        "sub_keys": nrm(ks[17], (L, 2, PEER_KEYS, PEER_DKEY // 2), (PEER_DKEY // 2) ** -0.5),
        "u_experts": nrm(ks[18], (L, PEER_EXPERTS, D_MODEL), D_MODEL ** -0.5),
        "v_experts": nrm(ks[19], (L, PEER_EXPERTS, D_MODEL), PEER_HEADS ** -0.5),
        "g_final": gain(ks[20], (D_MODEL,)),
    }


def reference(x, mem, g_mix, w_in, g_q_lora, w_uq, g_kv_lora, w_ukv, g_ret_gn, w_o,
              g_xattn, g_mem, w_xq, w_xkv, w_xo, g_ffn, w_pq, sub_keys, u_experts, v_experts, g_final):
    S = x.shape[1]
    pos = jnp.arange(S, dtype=jnp.float32)
    cos_m, sin_m = rope_tables(pos, MLA_ROPE)
    cos_r, sin_r = rope_tables(pos, RET_DK)
    h = x
    for l in range(DEPTH):
        a = rmsnorm(h, g_mix[l])
        h = h + hybrid_mixer(a, w_in[l], g_q_lora[l], w_uq[l], g_kv_lora[l], w_ukv[l], g_ret_gn[l], w_o[l],
                             cos_m, sin_m, cos_r, sin_r)
        a = rmsnorm(h, g_xattn[l])
        h = h + memory_cross_attention(a, rmsnorm(mem, g_mem[l]), w_xq[l], w_xkv[l], w_xo[l])
        a = rmsnorm(h, g_ffn[l])
        h = h + peer_ffn(a, w_pq[l], sub_keys[l], u_experts[l], v_experts[l])
    return rmsnorm(h, g_final)
```

```cpp
#include <hip/hip_runtime.h>
#include <hip/hip_cooperative_groups.h>
#include <cstdio>
#include <cstdint>
namespace cg = cooperative_groups;

#define LAS __attribute__((address_space(3)))
#define GAS __attribute__((address_space(1)))
typedef unsigned short bf16_t;
typedef short bf16x8 __attribute__((ext_vector_type(8)));
typedef short s16x4 __attribute__((ext_vector_type(4)));
typedef float f32x4 __attribute__((ext_vector_type(4)));
typedef float f32x2 __attribute__((ext_vector_type(2)));
typedef float f32x16 __attribute__((ext_vector_type(16)));
typedef unsigned u32x4 __attribute__((ext_vector_type(4)));
typedef unsigned u32x2 __attribute__((ext_vector_type(2)));
typedef __bf16 bf16x2_t __attribute__((ext_vector_type(2)));

constexpr int T = 16384, D = 1024, SEQ = 4096;
constexpr int NPROJ = 2304;
constexpr int NWIN = 2816;
constexpr float EPS = 1e-6f;
constexpr float LOG2E = 1.4426950408889634f;
constexpr float C2_MLA = 0.10206207261596575f * LOG2E;
constexpr float C2_X = 0.0625f * LOG2E;
constexpr float U_SCALE = 512.f, V_SCALE = 64.f;

constexpr size_t MiB = 1u << 20;
constexpr size_t WS_CTL = 0, CTL_ZERO_BYTES = 1 * MiB;
constexpr size_t WS_SSQQ = 225 * MiB, WS_SSQKV = 226 * MiB, WS_SSQ1 = 227 * MiB, WS_SSQ2 = 228 * MiB;
constexpr size_t WS_CR = 1 * MiB, WS_SR = 2 * MiB, WS_CM = 3 * MiB, WS_SM = 3 * MiB + 256 * 1024;
constexpr size_t WS_WIN = 4 * MiB, WS_WUQ = 10 * MiB, WS_WUKV = 11 * MiB, WS_WO = 12 * MiB, WS_WXQ = 14 * MiB, WS_WXKV = 16 * MiB, WS_WXO = 20 * MiB, WS_WPQ = 22 * MiB, WS_SK = 26 * MiB;
constexpr size_t WS_MEMN = 27 * MiB, WS_KX = 29 * MiB, WS_VXT = 31 * MiB;
constexpr size_t WS_A0 = 33 * MiB, WS_MIX = 33 * MiB, WS_QX = 33 * MiB;
constexpr size_t WS_PROJ = 65 * MiB, WS_H1B = 65 * MiB, WS_U8 = 65 * MiB, WS_V8 = 81 * MiB;
constexpr size_t WS_OX = 97 * MiB, WS_H2B = 129 * MiB, WS_QP = 161 * MiB;
constexpr size_t WS_RVT = 137 * MiB, WS_QM = 153 * MiB, WS_KN = 177 * MiB, WS_VT = 193 * MiB, WS_RKVT = 209 * MiB;
constexpr size_t WS_END = 229 * MiB;
constexpr int CW_BAR = 4096;

constexpr int RING_BYTES = 131072;
constexpr int LDSCTL_OFF = 143360;
constexpr int LDS_BYTES = 147456;
constexpr int NWAVES = 8;

__device__ __forceinline__ unsigned cvtpk(float lo, float hi) { f32x2 v = {lo, hi}; bf16x2_t b = __builtin_convertvector(v, bf16x2_t); return __builtin_bit_cast(unsigned, b); }
__device__ __forceinline__ float bf2f(unsigned short b) { return __uint_as_float(((unsigned)b) << 16); }
__device__ __forceinline__ int crow(int r, int hi) { return (r & 3) + 8 * (r >> 2) + 4 * hi; }
__device__ __forceinline__ float wave_sum(float v) {
#pragma unroll
    for (int o = 1; o < 64; o <<= 1) v += __shfl_xor(v, o);
    return v;
}
__device__ __forceinline__ float xhalf_max(float m) { auto rr = __builtin_amdgcn_permlane32_swap(__float_as_uint(m), __float_as_uint(m), false, false); return fmaxf(__uint_as_float(rr[0]), __uint_as_float(rr[1])); }
__device__ __forceinline__ float xhalf_sum(float m) { auto rr = __builtin_amdgcn_permlane32_swap(__float_as_uint(m), __float_as_uint(m), false, false); return __uint_as_float(rr[0]) + __uint_as_float(rr[1]); }
__device__ __forceinline__ unsigned xhalf_other(unsigned m, int hi) { auto rr = __builtin_amdgcn_permlane32_swap(m, m, false, false); return hi ? rr[0] : rr[1]; }
#define LDS_WAIT() asm volatile("s_waitcnt lgkmcnt(0)" ::: "memory")
template <int NP> __device__ __forceinline__ float ssq_sum(const float* part) {
    float s = 0.f;
#pragma unroll
    for (int i = 0; i < NP / 4; ++i) { const f32x4 v = *(const f32x4*)(part + 4 * i); s += v[0]; s += v[1]; s += v[2]; s += v[3]; }
    return s;
}
__device__ __forceinline__ int opaque_tid() { int t = threadIdx.x; asm volatile("" : "+v"(t)); return t; }
#define MFMA32(a, b, c) __builtin_amdgcn_mfma_f32_32x32x16_bf16((a), (b), (c), 0, 0, 0)
__device__ __forceinline__ float gelu_f(float v) {
    const float av = fabsf(v), t = __builtin_amdgcn_rcpf(av * 0.2316418882f + 1.0f);
    float q = t * 0.5307027145f + (-0.7265760135f); q = q * t + 0.7107068705f; q = q * t + (-0.142248368f); q = q * t + 0.127414796f; q = q * t;
    const float e = __builtin_amdgcn_exp2f((v * v) * (-0.72134752044f));
    const float m = v * (q * e);
    return v < 0.f ? m : v - m;
}

namespace pg8 {
constexpr int BM = 256, BK = 64, HALF = 128, HTB = HALF * BK * 2, STAGE_BYTES = 8 * HTB, NXCD = 8, WGM = 8;
__host__ __device__ __forceinline__ int lds_byte(int r, int c) { const int st = (r >> 4) * 2 + (c >> 5), rr = r & 15, cc = c & 31, ob = rr * 64 + cc * 2; return st * 1024 + (ob ^ (((ob >> 9) & 1) << 5)); }
__host__ __device__ __forceinline__ void stage_rc(int b, int& R, int& C) { const int st = b / 1024, sb = b % 1024, swz = sb ^ (((sb >> 9) & 1) << 5); R = (st >> 1) * 16 + swz / 64; C = (st & 1) * 32 + (swz % 64) / 2; }
struct Unit { int pm, pn; };
struct Gemm { const bf16_t* A; const bf16_t* Bt; int M, N, K, lda, ldb; };
struct StaticOrder {
    int nM, nN, nwg, G, c;
    __device__ void init(int M, int N, int G_, int c_) { nM = M / BM; nN = N / BM; nwg = nM * nN; G = G_; c = c_; }
    __device__ bool next(int i, Unit& u) const {
        const long L = (long)i * G + c; if (L >= nwg) return false;
        int wgid = (int)L; { const int q = nwg / NXCD, r = nwg % NXCD, xcd = wgid % NXCD, off = wgid / NXCD; wgid = (xcd < r ? xcd * (q + 1) : r * (q + 1) + (xcd - r) * q) + off; }
        const int nig = WGM * nN, gid = wgid / nig, fm = gid * WGM, gsz = (nM - fm) < WGM ? (nM - fm) : WGM;
        u.pm = fm + ((wgid % nig) % gsz); u.pn = (wgid % nig) / gsz; return true;
    }
};

template <class Epi, class Sched, bool ALIGN_EPI>
__device__ __forceinline__ void gemm_phase(LAS unsigned char* lds, const Gemm g, const Sched& S, const Epi& E) {
    const int tid = opaque_tid(), wid = __builtin_amdgcn_readfirstlane(tid >> 6), lane = tid & 63, wr = wid >> 2, wc = wid & 3, fr = lane & 15, fq = lane >> 4;
    const int K = g.K, nt = K / BK;
    unsigned voffA[2], voffB[2];
#pragma unroll
    for (int i = 0; i < 2; ++i) { int R, C; stage_rc(tid * 16 + i * 8192, R, C); voffA[i] = (unsigned)(R * g.lda + C) * 2u; voffB[i] = (unsigned)(R * g.ldb + C) * 2u; }
    const size_t kstep = (size_t)(BK * 2);
    const size_t hstepA = (size_t)HALF * g.lda * 2, hstepB = (size_t)HALF * g.ldb * 2, tstepA = 2 * hstepA, tstepB = 2 * hstepB;
    const unsigned ldsw = (unsigned)wid * 1024u;
    const int aoff = lds_byte(wr * 64 + fr, fq * 8), boff = lds_byte(wc * 32 + fr, fq * 8);
#define PG8_SA(b, h) (((b) * 2 + (h)) * HTB)
#define PG8_SB(b, h) ((4 + (b) * 2 + (h)) * HTB)
#define PG8_STAGE(bufoff, gbase, voff) do { _Pragma("unroll") for (int _i = 0; _i < 2; ++_i) \
        __builtin_amdgcn_global_load_lds((const unsigned*)((const char*)(gbase) + (voff)[_i]), (LAS unsigned*)(lds + (bufoff) + ldsw + _i * 8192), 16, 0, 0); } while (0)
#define PG8_LDA(dst, b, h) do { _Pragma("unroll") for (int m = 0; m < 4; ++m) _Pragma("unroll") for (int k = 0; k < 2; ++k) dst[m][k] = *(const LAS bf16x8*)(lds + PG8_SA(b, h) + aoff + m * 2048 + k * 1024); } while (0)
#define PG8_LDB(dst, b, h) do { _Pragma("unroll") for (int n = 0; n < 2; ++n) _Pragma("unroll") for (int k = 0; k < 2; ++k) dst[n][k] = *(const LAS bf16x8*)(lds + PG8_SB(b, h) + boff + n * 2048 + k * 1024); } while (0)
#define PG8_MMA(ai, bj, At, Bt) do { __builtin_amdgcn_s_setprio(1); _Pragma("unroll") for (int m = 0; m < 4; ++m) _Pragma("unroll") for (int n = 0; n < 2; ++n) _Pragma("unroll") for (int k = 0; k < 2; ++k) \
        acc[ai][bj][m][n] = __builtin_amdgcn_mfma_f32_16x16x32_bf16(Bt[n][k], At[m][k], acc[ai][bj][m][n], 0, 0, 0); __builtin_amdgcn_s_setprio(0); } while (0)
#define PG8_WAIT_V(n) asm volatile("s_waitcnt vmcnt(" #n ")" ::: "memory")
#define PG8_WAIT_L(n) asm volatile("s_waitcnt lgkmcnt(" #n ")" ::: "memory")
#define PG8_BAR __builtin_amdgcn_s_barrier()
#define PG8_SCHED __builtin_amdgcn_sched_barrier(0)
    Unit cur, nxt; int ui = 0;
    if (!S.next(0, cur)) return;
    f32x4 acc[2][2][4][2];
#pragma unroll
    for (int a = 0; a < 2; ++a)
#pragma unroll
        for (int b = 0; b < 2; ++b)
#pragma unroll
            for (int m = 0; m < 4; ++m)
#pragma unroll
                for (int n = 0; n < 2; ++n) acc[a][b][m][n] = (f32x4){0.f, 0.f, 0.f, 0.f};
    bf16x8 At[4][2], B0[2][2], B1[2][2];
    const char* cA = (const char*)g.A + (size_t)cur.pm * tstepA; const char* cB = (const char*)g.Bt + (size_t)cur.pn * tstepB;
    PG8_STAGE(PG8_SB(0, 0), cB, voffB); PG8_STAGE(PG8_SB(0, 1), cB + hstepB, voffB); PG8_STAGE(PG8_SA(0, 0), cA, voffA); PG8_STAGE(PG8_SA(0, 1), cA + hstepA, voffA);
    if (wr == 1) PG8_BAR;
    PG8_WAIT_V(2); PG8_BAR;
    PG8_STAGE(PG8_SB(1, 0), cB + kstep, voffB); PG8_STAGE(PG8_SA(1, 0), cA + kstep, voffA); PG8_STAGE(PG8_SB(1, 1), cB + hstepB + kstep, voffB);
    PG8_WAIT_V(6); PG8_BAR;
    for (;;) {
        const bool has_next = S.next(ui + 1, nxt);
        const char* nA = has_next ? (const char*)g.A + (size_t)nxt.pm * tstepA : cA; const char* nB = has_next ? (const char*)g.Bt + (size_t)nxt.pn * tstepB : cB;
#pragma nounroll
        for (int t = 0; t < nt; t += 2) {
            const bool last = (t == nt - 2);
            const char* a1 = cA + (size_t)(t + 1) * kstep;
            const char* a2 = last ? nA : cA + (size_t)(t + 2) * kstep; const char* b2 = last ? nB : cB + (size_t)(t + 2) * kstep;
            const char* a3 = a2 + kstep; const char* b3 = b2 + kstep;
            PG8_LDB(B0, 0, 0); PG8_LDB(B1, 0, 1); PG8_SCHED; PG8_LDA(At, 0, 0); PG8_STAGE(PG8_SA(1, 1), a1 + hstepA, voffA);
            PG8_WAIT_V(8); PG8_WAIT_L(0); PG8_BAR; PG8_MMA(0, 0, At, B0); PG8_MMA(0, 1, At, B1); PG8_BAR; PG8_SCHED;
            PG8_LDA(At, 0, 1); PG8_STAGE(PG8_SB(0, 0), b2, voffB); PG8_STAGE(PG8_SB(0, 1), b2 + hstepB, voffB); PG8_STAGE(PG8_SA(0, 0), a2, voffA);
            PG8_WAIT_V(8); PG8_WAIT_L(0); PG8_BAR; PG8_MMA(1, 0, At, B0); PG8_MMA(1, 1, At, B1); PG8_BAR; PG8_SCHED;
            PG8_LDB(B0, 1, 0); PG8_LDB(B1, 1, 1); PG8_SCHED; PG8_LDA(At, 1, 0); PG8_STAGE(PG8_SA(0, 1), a2 + hstepA, voffA);
            PG8_WAIT_V(8); PG8_WAIT_L(0); PG8_BAR; PG8_MMA(0, 0, At, B0); PG8_MMA(0, 1, At, B1); PG8_BAR; PG8_SCHED;
            PG8_LDA(At, 1, 1); PG8_STAGE(PG8_SB(1, 0), b3, voffB); PG8_STAGE(PG8_SB(1, 1), b3 + hstepB, voffB); PG8_STAGE(PG8_SA(1, 0), a3, voffA);
            PG8_WAIT_V(8); PG8_WAIT_L(0); PG8_BAR; PG8_MMA(1, 0, At, B0); PG8_MMA(1, 1, At, B1); PG8_BAR; PG8_SCHED;
        }
        if constexpr (ALIGN_EPI) { if (wr == 0) PG8_BAR; }
        E(acc, cur, wr, wc, fr, fq);
        if (!has_next) break;
#pragma unroll
        for (int a = 0; a < 2; ++a)
#pragma unroll
            for (int b = 0; b < 2; ++b)
#pragma unroll
                for (int m = 0; m < 4; ++m)
#pragma unroll
                    for (int n = 0; n < 2; ++n) acc[a][b][m][n] = (f32x4){0.f, 0.f, 0.f, 0.f};
        cur = nxt; cA = nA; cB = nB; ++ui;
        if constexpr (ALIGN_EPI) { if (wr == 1) PG8_BAR; }
    }
    PG8_WAIT_V(0);
    if constexpr (!ALIGN_EPI) { if (wr == 0) PG8_BAR; }
    PG8_BAR;
#undef PG8_SA
#undef PG8_SB
#undef PG8_STAGE
#undef PG8_LDA
#undef PG8_LDB
#undef PG8_MMA
#undef PG8_WAIT_V
#undef PG8_WAIT_L
#undef PG8_BAR
#undef PG8_SCHED
}

__device__ __forceinline__ void st_bf16x4(bf16_t* p, f32x4 v) { u32x2 w; w.x = cvtpk(v[0], v[1]); w.y = cvtpk(v[2], v[3]); *(u32x2*)p = w; }
#define EPI_LOOP_AM _Pragma("unroll") for (int ai = 0; ai < 2; ++ai) _Pragma("unroll") for (int m = 0; m < 4; ++m)
#define EPI_LOOP_BN _Pragma("unroll") for (int bj = 0; bj < 2; ++bj) _Pragma("unroll") for (int n = 0; n < 2; ++n)

struct EpiPlain {
    bf16_t* O; int ldc;
    __device__ __forceinline__ void operator()(const f32x4 (&acc)[2][2][4][2], const Unit& u, int wr, int wc, int fr, int fq) const {
        const int row0 = u.pm * BM + wr * 64 + fr, col0 = u.pn * BM + wc * 32 + 4 * fq;
        EPI_LOOP_AM { bf16_t* rowp = O + (size_t)(row0 + ai * HALF + m * 16) * ldc + col0;
            EPI_LOOP_BN st_bf16x4(rowp + bj * HALF + n * 16, acc[ai][bj][m][n]); }
    }
};
template <int NP> struct EpiRowScale {
    bf16_t* O; int ldc; const float* ssq; float invn, mul;
    __device__ __forceinline__ void operator()(const f32x4 (&acc)[2][2][4][2], const Unit& u, int wr, int wc, int fr, int fq) const {
        const int row0 = u.pm * BM + wr * 64 + fr, col0 = u.pn * BM + wc * 32 + 4 * fq;
        EPI_LOOP_AM { const int row = row0 + ai * HALF + m * 16; const float rs = rsqrtf(ssq_sum<NP>(ssq + (size_t)row * 16) * invn + EPS) * mul; bf16_t* rowp = O + (size_t)row * ldc + col0;
            EPI_LOOP_BN st_bf16x4(rowp + bj * HALF + n * 16, acc[ai][bj][m][n] * rs);
            if (m & 1) asm volatile("" ::: "memory"); }
    }
};
struct EpiColScale {
    bf16_t* O; int ldc; const float* ssq; float invn;
    __device__ __forceinline__ void operator()(const f32x4 (&acc)[2][2][4][2], const Unit& u, int wr, int wc, int fr, int fq) const {
        const int row0 = u.pm * BM + wr * 64 + fr, col0 = u.pn * BM + wc * 32 + 4 * fq;
        EPI_LOOP_BN { const float* sp = ssq + (size_t)(col0 + bj * HALF + n * 16) * 16;
            const f32x4 rs = (f32x4){rsqrtf(ssq_sum<8>(sp) * invn + EPS), rsqrtf(ssq_sum<8>(sp + 16) * invn + EPS), rsqrtf(ssq_sum<8>(sp + 32) * invn + EPS), rsqrtf(ssq_sum<8>(sp + 48) * invn + EPS)};
            EPI_LOOP_AM st_bf16x4(O + (size_t)(row0 + ai * HALF + m * 16) * ldc + col0 + bj * HALF + n * 16, acc[ai][bj][m][n] * rs);
            asm volatile("" ::: "memory"); }
    }
};
struct EpiRes {
    const float* base; float* out; bf16_t* hb; float* ssq;
    __device__ __forceinline__ void operator()(const f32x4 (&acc)[2][2][4][2], const Unit& u, int wr, int wc, int fr, int fq) const {
        const int row0 = u.pm * BM + wr * 64 + fr, col0 = u.pn * BM + wc * 32 + 4 * fq;
        EPI_LOOP_AM { const int row = row0 + ai * HALF + m * 16; const size_t off = (size_t)row * D + col0; float ss = 0.f;
            EPI_LOOP_BN { const f32x4 b = *(const f32x4*)(base + off + bj * HALF + n * 16); const f32x4 h = b + acc[ai][bj][m][n];
                *(f32x4*)(out + off + bj * HALF + n * 16) = h; st_bf16x4(hb + off + bj * HALF + n * 16, h); ss += (h[0] * h[0] + h[1] * h[1]) + (h[2] * h[2] + h[3] * h[3]); }
            ss += __shfl_xor(ss, 16); ss += __shfl_xor(ss, 32);
            if (fq == 0) ssq[(size_t)row * 16 + u.pn * 4 + wc] = ss;
            asm volatile("" ::: "memory"); }
    }
};
struct EpiProj {
    bf16_t* P; float* ssq_q; float* ssq_kv; const float* cr; const float* sr; const float* cm; const float* sm;
    __device__ __forceinline__ void operator()(const f32x4 (&acc)[2][2][4][2], const Unit& u, int wr, int wc, int fr, int fq) const {
        const int row0 = u.pm * BM + wr * 64 + fr;
#pragma unroll
        for (int bj = 0; bj < 2; ++bj) {
            const int hb = 2 * u.pn + bj;
            if (hb == 17 && wc != 0) continue;
            const int kind = hb < 3 ? 0 : hb < 5 ? 1 : hb < 9 ? 2 : hb < 13 ? 3 : hb < 17 ? 4 : 5;
            const int col = hb * HALF + wc * 32 + 4 * fq;
            EPI_LOOP_AM { const int row = row0 + ai * HALF + m * 16; const int s = row & (SEQ - 1);
                f32x4 v0 = acc[ai][bj][m][0], v1 = acc[ai][bj][m][1];
                if (kind <= 1) {
                    float ss = (v0[0] * v0[0] + v0[1] * v0[1]) + (v0[2] * v0[2] + v0[3] * v0[3]) + (v1[0] * v1[0] + v1[1] * v1[1]) + (v1[2] * v1[2] + v1[3] * v1[3]);
                    ss += __shfl_xor(ss, 16); ss += __shfl_xor(ss, 32);
                    if (fq == 0) { if (kind == 0) ssq_q[(size_t)row * 16 + hb * 4 + wc] = ss; else ssq_kv[(size_t)row * 16 + (hb - 3) * 4 + wc] = ss; }
                } else if (kind == 2 || kind == 3) {
                    const f32x4 c = *(const f32x4*)(cr + (size_t)s * 64 + wc * 16 + 4 * fq), sn = *(const f32x4*)(sr + (size_t)s * 64 + wc * 16 + 4 * fq);
                    f32x4 y0 = v0 * c - v1 * sn, y1 = v0 * sn + v1 * c;
                    if (kind == 3) { y0 = y0 * 0.08838834764831845f; y1 = y1 * 0.08838834764831845f; }
                    v0 = y0; v1 = y1;
                } else if (kind == 5) {
                    const f32x4 c = *(const f32x4*)(cm + (size_t)s * 16 + 4 * fq), sn = *(const f32x4*)(sm + (size_t)s * 16 + 4 * fq);
                    const f32x4 y0 = v0 * c - v1 * sn, y1 = v0 * sn + v1 * c; v0 = y0; v1 = y1;
                }
                bf16_t* rowp = P + (size_t)row * NPROJ + col;
                st_bf16x4(rowp, v0); st_bf16x4(rowp + 16, v1);
                if (m & 1) asm volatile("" ::: "memory"); }
        }
    }
};
struct EpiQ {
    bf16_t* O; const float* ssq; const float* cm; const float* sm;
    __device__ __forceinline__ void operator()(const f32x4 (&acc)[2][2][4][2], const Unit& u, int wr, int wc, int fr, int fq) const {
        const int row0 = u.pm * BM + wr * 64 + fr, col0 = u.pn * BM + wc * 32 + 4 * fq;
        EPI_LOOP_AM { const int row = row0 + ai * HALF + m * 16; const int s = row & (SEQ - 1); const float rs = rsqrtf(ssq_sum<12>(ssq + (size_t)row * 16) * (1.f / 384.f) + EPS) * C2_MLA;
            bf16_t* rowp = O + (size_t)row * 768 + col0;
            f32x4 c = (f32x4){1.f, 1.f, 1.f, 1.f}, sn = (f32x4){0.f, 0.f, 0.f, 0.f};
            if (u.pn == 2) { c = *(const f32x4*)(cm + (size_t)s * 16 + 4 * fq); sn = *(const f32x4*)(sm + (size_t)s * 16 + 4 * fq); }
#pragma unroll
            for (int bj = 0; bj < 2; ++bj) { const f32x4 v0 = acc[ai][bj][m][0] * rs, v1 = acc[ai][bj][m][1] * rs;
                st_bf16x4(rowp + bj * HALF, v0 * c - v1 * sn); st_bf16x4(rowp + bj * HALF + 16, v0 * sn + v1 * c); }
            asm volatile("" ::: "memory"); }
    }
};
}

#define XB_TMO      128
#define XB_XCNT(j)  (256  + 64 * (j))
#define XB_XSUB(j)  (1280 + 64 * (j))
#define XB_XGEN(j)  (2304 + 64 * (j))
#define XB_TOP      3328
#define XB_TOPGEN   3392
#define XCD_BAR_WORDS 3456
#define XB_SPIN_CAP (1u << 21)
__device__ __forceinline__ unsigned xb_ld(unsigned* p)              { return __hip_atomic_load(p, __ATOMIC_RELAXED, __HIP_MEMORY_SCOPE_AGENT); }
__device__ __forceinline__ unsigned xb_add(unsigned* p, unsigned v) { return __hip_atomic_fetch_add(p, v, __ATOMIC_RELAXED, __HIP_MEMORY_SCOPE_AGENT); }
__device__ __forceinline__ unsigned xb_xcc_id() { return (unsigned)__builtin_amdgcn_s_getreg((3 << 11) | 20) & 0xFu; }
#define XB_SPIN(cond, bar) do { unsigned _sp = 0; while (cond) { __builtin_amdgcn_s_sleep(1); \
    if ((++_sp & 255u) == 0u) { if (xb_ld(&(bar)[XB_TMO])) break; if (_sp > XB_SPIN_CAP) { atomicAdd(&(bar)[XB_TMO], 1u); break; } } } } while (0)
struct XcdBarrier { unsigned* bar; unsigned x; volatile LAS unsigned* st; };
__device__ __forceinline__ XcdBarrier xcd_barrier_post(unsigned* bar, volatile LAS unsigned* st) {
    XcdBarrier b; b.bar = bar; b.x = xb_xcc_id(); b.st = st;
    if (threadIdx.x == 0) (void)xb_add(&bar[XB_XCNT(b.x)], 1u);
    return b;
}
__device__ __forceinline__ void xcd_barrier_complete(unsigned* bar, unsigned x, unsigned& nloc, unsigned& nx) {
    const unsigned G = gridDim.x * gridDim.y * gridDim.z;
    unsigned sum, cnt, mine, sp = 0u;
    for (;;) {
        sum = 0u; cnt = 0u; mine = 0u;
#pragma unroll
        for (unsigned j = 0; j < 16; ++j) { const unsigned c = xb_ld(&bar[XB_XCNT(j)]); sum += c; cnt += (c > 0u) ? 1u : 0u; mine = (j == x) ? c : mine; }
        if (sum == G) break;
        __builtin_amdgcn_s_sleep(1);
        if ((++sp & 255u) == 0u) { if (xb_ld(&bar[XB_TMO])) break; if (sp > XB_SPIN_CAP) { atomicAdd(&bar[XB_TMO], 1u); break; } }
    }
    nloc = mine > 0u ? mine : 1u; nx = cnt > 0u ? cnt : 1u;
}
__device__ __forceinline__ void xcd_barrier(const XcdBarrier& b) {
    asm volatile("s_waitcnt vmcnt(0)" ::: "memory");
    __syncthreads();
    if (threadIdx.x == 0) {
        unsigned* bar = b.bar;
        __builtin_amdgcn_s_waitcnt(0);
        unsigned nloc = b.st[0], nx = b.st[1];
        if (nloc == 0u) { xcd_barrier_complete(bar, b.x, nloc, nx); b.st[0] = nloc; b.st[1] = nx; }
        const unsigned old = xb_add(&bar[XB_XSUB(b.x)], 1u);
        const unsigned gen = old / nloc;
        if (old + 1u == (gen + 1u) * nloc) {
            __builtin_amdgcn_fence(__ATOMIC_RELEASE, "agent");
            asm volatile("s_waitcnt vmcnt(0)" ::: "memory");
            const unsigned og = xb_add(&bar[XB_TOP], 1u);
            const unsigned tg = og / nx;
            if (og + 1u == (tg + 1u) * nx) xb_add(&bar[XB_TOPGEN], 1u);
            else XB_SPIN(xb_ld(&bar[XB_TOPGEN]) == tg, bar);
            __builtin_amdgcn_fence(__ATOMIC_ACQUIRE, "agent");
            xb_add(&bar[XB_XGEN(b.x)], 1u);
            asm volatile("s_waitcnt vmcnt(0)" ::: "memory");
        } else {
            XB_SPIN(xb_ld(&bar[XB_XGEN(b.x)]) == gen, bar);
            __builtin_amdgcn_fence(__ATOMIC_ACQUIRE, "agent");
            asm volatile("s_waitcnt vmcnt(0)" ::: "memory");
        }
    }
    __syncthreads();
}

struct Params {
    const float *x, *mem, *g_mix, *w_in, *g_q_lora, *w_uq, *g_kv_lora, *w_ukv, *g_ret_gn, *w_o, *g_xattn, *g_mem, *w_xq, *w_xkv, *w_xo, *g_ffn, *w_pq, *sub_keys, *u_exp, *v_exp, *g_final;
    float* out; unsigned char* ws; int never; int pad;
};

__device__ __forceinline__ int permret(int i) { return i < 64 ? ((i >> 4) * 32 + (i & 15)) : (((i - 64) >> 4) * 32 + 16 + ((i - 64) & 15)); }
template <int MODE> __device__ __forceinline__ int dst_row(int c) {
    if (MODE == 1) {
        if (c < 640) return c;
        if (c < 672) return 2176 + (c - 640);
        if (c < 1184) { const int cc = c - 672; return 640 + (cc & ~127) + permret(cc & 127); }
        if (c < 1696) { const int cc = c - 1184; return 1152 + (cc & ~127) + permret(cc & 127); }
        if (c < 2208) return 2304 + (c - 1696);
        return 1664 + (c - 2208);
    } else if (MODE == 2) {
        const int h = c / 96, i = c - h * 96; return i < 64 ? h * 64 + i : 512 + h * 32 + (i - 64);
    } else if (MODE == 3) {
        const int h = c >> 7, i = c & 127; return i < 64 ? h * 64 + i : 512 + h * 64 + (i - 64);
    }
    return c;
}
template <int MODE> __device__ __forceinline__ void p0_transpose_item(const float* W, int K, int N, bf16_t* WT, const float* gain, LAS float* scr, int item, int lane) {
    const int nblk = N / 32, kb = item / nblk, nb = item % nblk, k0 = 64 * kb, n0 = 32 * nb;
#pragma unroll 8
    for (int i = 0; i < 32; ++i) { const int kk = 2 * i + (lane >> 5); float v = W[(size_t)(k0 + kk) * N + n0 + (lane & 31)]; if (gain) v *= gain[k0 + kk]; scr[kk * 33 + (lane & 31)] = v; }
    LDS_WAIT(); asm volatile("" ::: "memory");
    const int c = lane & 7;
#pragma unroll
    for (int j = 0; j < 4; ++j) { const int n = (lane >> 3) + 8 * j; const LAS float* s = scr + (8 * c) * 33 + n;
        u32x4 o; o.x = cvtpk(s[0 * 33], s[1 * 33]); o.y = cvtpk(s[2 * 33], s[3 * 33]); o.z = cvtpk(s[4 * 33], s[5 * 33]); o.w = cvtpk(s[6 * 33], s[7 * 33]);
        *(u32x4*)(WT + (size_t)dst_row<MODE>(n0 + n) * K + k0 + 8 * c) = o; }
    LDS_WAIT(); asm volatile("" ::: "memory");
}
__device__ __forceinline__ void rms_row_to_bf16(const float* xrow, const float* g, bf16_t* orow, int lane) {
    const f32x4* xr = (const f32x4*)xrow + lane; const f32x4* gr = (const f32x4*)g + lane;
    f32x4 v[4]; float s = 0.f;
#pragma unroll
    for (int j = 0; j < 4; ++j) { v[j] = xr[64 * j]; s += (v[j][0] * v[j][0] + v[j][1] * v[j][1]) + (v[j][2] * v[j][2] + v[j][3] * v[j][3]); }
    const float rstd = rsqrtf(wave_sum(s) * (1.f / D) + EPS);
    u32x2* o8 = (u32x2*)orow + lane;
#pragma unroll
    for (int j = 0; j < 4; ++j) { const f32x4 y = v[j] * rstd * gr[64 * j]; u32x2 w; w.x = cvtpk(y[0], y[1]); w.y = cvtpk(y[2], y[3]); o8[64 * j] = w; }
}

struct NoMid { __device__ __forceinline__ void operator()() const {} };
template <int NS, int NT, class Mid>
__device__ __forceinline__ void flash_tile(const LAS unsigned char* Ks, int kpitch, const LAS unsigned char* Vs, int vpitch, const bf16x8 (&qf)[NS], f32x16 (&o)[NT],
                                           float& mrun, float& lrun, int r32, int hi, bool domask, int qrel, int krel, const Mid& mid) {
    f32x16 p0, p1;
#pragma unroll
    for (int r = 0; r < 16; ++r) { p0[r] = 0.f; p1[r] = 0.f; }
    const LAS unsigned char* k0 = Ks + r32 * kpitch + hi * 16; const LAS unsigned char* k1 = k0 + 32 * kpitch;
#pragma unroll
    for (int s = 0; s < NS; ++s) {
        const bf16x8 a0 = *(const LAS bf16x8*)(k0 + s * 32), a1 = *(const LAS bf16x8*)(k1 + s * 32);
        p0 = MFMA32(a0, qf[s], p0); p1 = MFMA32(a1, qf[s], p1);
    }
    if (domask) {
#pragma unroll
        for (int r = 0; r < 16; ++r) { const int kv = krel + crow(r, hi); if (kv > qrel) p0[r] = -1e30f; if (kv + 32 > qrel) p1[r] = -1e30f; }
    }
    float mx = fmaxf(p0[0], p1[0]);
#pragma unroll
    for (int r = 1; r < 16; ++r) mx = fmaxf(mx, fmaxf(p0[r], p1[r]));
    mx = xhalf_max(mx);
    const float mnew = fmaxf(mrun, mx), alpha = __builtin_amdgcn_exp2f(mrun - mnew);
    mrun = mnew;
    float rs = 0.f;
#pragma unroll
    for (int r = 0; r < 16; ++r) { p0[r] = __builtin_amdgcn_exp2f(p0[r] - mnew); p1[r] = __builtin_amdgcn_exp2f(p1[r] - mnew); rs += p0[r] + p1[r]; }
    lrun = lrun * alpha + rs;
#pragma unroll
    for (int t = 0; t < NT; ++t)
#pragma unroll
        for (int r = 0; r < 16; ++r) o[t][r] *= alpha;
    bf16x8 pb[4];
#pragma unroll
    for (int ks = 0; ks < 2; ++ks) {
        u32x4 w0, w1;
        w0.x = cvtpk(p0[8 * ks + 0], p0[8 * ks + 1]); w0.y = cvtpk(p0[8 * ks + 2], p0[8 * ks + 3]); w0.z = cvtpk(p0[8 * ks + 4], p0[8 * ks + 5]); w0.w = cvtpk(p0[8 * ks + 6], p0[8 * ks + 7]);
        w1.x = cvtpk(p1[8 * ks + 0], p1[8 * ks + 1]); w1.y = cvtpk(p1[8 * ks + 2], p1[8 * ks + 3]); w1.z = cvtpk(p1[8 * ks + 4], p1[8 * ks + 5]); w1.w = cvtpk(p1[8 * ks + 6], p1[8 * ks + 7]);
        pb[ks] = __builtin_bit_cast(bf16x8, w0); pb[2 + ks] = __builtin_bit_cast(bf16x8, w1);
    }
    mid();
    const LAS unsigned char* vb = Vs + r32 * vpitch + hi * 8;
#pragma unroll
    for (int t = 0; t < NT; ++t)
#pragma unroll
        for (int ks = 0; ks < 4; ++ks) {
            const s16x4 lo = *(const LAS s16x4*)(vb + t * 32 * vpitch + ks * 32), hh = *(const LAS s16x4*)(vb + t * 32 * vpitch + ks * 32 + 16);
            const bf16x8 a = (bf16x8){lo[0], lo[1], lo[2], lo[3], hh[0], hh[1], hh[2], hh[3]};
            o[t] = MFMA32(a, pb[ks], o[t]);
        }
}

constexpr int MLA_KP = 208, MLA_VP = 136;
constexpr int MLA_KT = 64 * MLA_KP, MLA_VTB = 64 * MLA_VP;
__device__ __forceinline__ void mla_unit(LAS unsigned char* lds, int b, int h, int qb, const bf16_t* QM, const bf16_t* KN, const bf16_t* PROJ, const bf16_t* VT, bf16_t* MIX) {
    const int tid = opaque_tid(), lane = tid & 63, r32 = lane & 31, hi = lane >> 5, wid = __builtin_amdgcn_readfirstlane(tid >> 6);
    const size_t tb = (size_t)b * SEQ;
    const int q0 = qb * 256 + wid * 32;
    bf16x8 qf[6];
    { const bf16_t* qr = QM + (tb + q0 + r32) * 768;
#pragma unroll
      for (int s = 0; s < 4; ++s) qf[s] = *(const bf16x8*)(qr + h * 64 + s * 16 + hi * 8);
#pragma unroll
      for (int s = 0; s < 2; ++s) qf[4 + s] = *(const bf16x8*)(qr + 512 + h * 32 + s * 16 + hi * 8); }
    f32x16 o[2];
#pragma unroll
    for (int t = 0; t < 2; ++t)
#pragma unroll
        for (int r = 0; r < 16; ++r) o[t][r] = 0.f;
    float mrun = -1e30f, lrun = 0.f;
    const int NTL = 4 * qb + 4;
    const int kr = tid >> 3, kc = tid & 7;
    const int pr = (tid & 255) >> 2, pc = tid & 3;
    const int vr = tid >> 3, vc = tid & 7;
    const bf16_t* ksrc = KN + (tb + kr) * 512 + h * 64 + kc * 8;
    const bf16_t* psrc = PROJ + (tb + pr) * NPROJ + 2176 + pc * 8;
    const bf16_t* vsrc = VT + (size_t)(h * 64 + vr) * T + tb + vc * 8;
    u32x4 kreg, preg, vreg;
    kreg = *(const u32x4*)ksrc; preg = (u32x4){0u, 0u, 0u, 0u}; if (tid < 256) preg = *(const u32x4*)psrc; vreg = *(const u32x4*)vsrc;
    auto stage_write = [&](int buf) {
        LAS unsigned char* kb = lds + buf * (MLA_KT + MLA_VTB); LAS unsigned char* vbp = kb + MLA_KT;
        *(LAS u32x4*)(kb + kr * MLA_KP + kc * 16) = kreg;
        if (tid < 256) *(LAS u32x4*)(kb + pr * MLA_KP + 128 + pc * 16) = preg;
        *(LAS u32x2*)(vbp + vr * MLA_VP + vc * 16) = (u32x2){vreg.x, vreg.y}; *(LAS u32x2*)(vbp + vr * MLA_VP + vc * 16 + 8) = (u32x2){vreg.z, vreg.w};
    };
    stage_write(0);
    __syncthreads();
    for (int kt = 0; kt < NTL; ++kt) {
        const int buf = kt & 1;
        if (kt + 1 < NTL) { const size_t ko = (size_t)(kt + 1) * 64;
            kreg = *(const u32x4*)(ksrc + ko * 512); if (tid < 256) preg = *(const u32x4*)(psrc + ko * NPROJ); vreg = *(const u32x4*)(vsrc + ko); }
        const int krel = kt * 64 - qb * 256;
        const int qrel = wid * 32 + r32;
        const bool skip = krel > wid * 32 + 31;
        if (!skip) {
            const LAS unsigned char* kb = lds + buf * (MLA_KT + MLA_VTB);
            flash_tile<6, 2>(kb, MLA_KP, kb + MLA_KT, MLA_VP, qf, o, mrun, lrun, r32, hi, krel + 63 > wid * 32, qrel, krel, NoMid());
        }
        if (kt + 1 < NTL) stage_write(buf ^ 1);
        __syncthreads();
    }
    const float inv = 1.f / xhalf_sum(lrun);
    bf16_t* orow = MIX + (tb + q0 + r32) * D + h * 64;
#pragma unroll
    for (int t = 0; t < 2; ++t)
#pragma unroll
        for (int g = 0; g < 4; ++g) { u32x2 w; w.x = cvtpk(o[t][4 * g] * inv, o[t][4 * g + 1] * inv); w.y = cvtpk(o[t][4 * g + 2] * inv, o[t][4 * g + 3] * inv);
            *(u32x2*)(orow + 32 * t + 8 * g + 4 * hi) = w; }
}

constexpr int XA_KP = 528, XA_VP = 136;
constexpr int XA_KT = 64 * XA_KP, XA_VTB = 128 * XA_VP;
__device__ __forceinline__ void xattn_unit(LAS unsigned char* lds, int b, int h, int qb, int dvh, const bf16_t* QX, const bf16_t* KX, const bf16_t* VXT, bf16_t* OX) {
    const int tid = opaque_tid(), lane = tid & 63, r32 = lane & 31, hi = lane >> 5, wid = __builtin_amdgcn_readfirstlane(tid >> 6);
    const size_t tb = (size_t)b * SEQ;
    const int q0 = qb * 256 + wid * 32;
    bf16x8 qf[16];
    { const bf16_t* qr = QX + (tb + q0 + r32) * D + h * 256 + hi * 8;
#pragma unroll
      for (int s = 0; s < 16; ++s) qf[s] = *(const bf16x8*)(qr + s * 16); }
    f32x16 o[4];
#pragma unroll
    for (int t = 0; t < 4; ++t)
#pragma unroll
        for (int r = 0; r < 16; ++r) o[t][r] = 0.f;
    float mrun = -1e30f, lrun = 0.f;
    const bf16_t* kbase = KX + (size_t)(b * 256) * D + h * 256;
    const bf16_t* vbase = VXT + (size_t)(h * 256 + dvh * 128) * D + b * 256;
    u32x4 kreg[4], vreg[2];
    auto stage_load = [&](int kt) {
#pragma unroll
        for (int i = 0; i < 4; ++i) { const int idx = tid + 512 * i, row = idx >> 5, c = idx & 31; kreg[i] = *(const u32x4*)(kbase + (size_t)(kt * 64 + row) * D + c * 8); }
#pragma unroll
        for (int i = 0; i < 2; ++i) { const int idx = tid + 512 * i, dv = idx >> 3, c = idx & 7; vreg[i] = *(const u32x4*)(vbase + (size_t)dv * D + kt * 64 + c * 8); }
    };
    auto stage_write = [&](int buf) {
        LAS unsigned char* kb = lds + buf * (XA_KT + XA_VTB); LAS unsigned char* vbp = kb + XA_KT;
#pragma unroll
        for (int i = 0; i < 4; ++i) { const int idx = tid + 512 * i, row = idx >> 5, c = idx & 31; *(LAS u32x4*)(kb + row * XA_KP + c * 16) = kreg[i]; }
#pragma unroll
        for (int i = 0; i < 2; ++i) { const int idx = tid + 512 * i, dv = idx >> 3, c = idx & 7;
            *(LAS u32x2*)(vbp + dv * XA_VP + c * 16) = (u32x2){vreg[i].x, vreg[i].y}; *(LAS u32x2*)(vbp + dv * XA_VP + c * 16 + 8) = (u32x2){vreg[i].z, vreg[i].w}; }
    };
    stage_load(0); stage_write(0);
    __syncthreads();
    for (int kt = 0; kt < 4; ++kt) {
        const int buf = kt & 1;
        const LAS unsigned char* kb = lds + buf * (XA_KT + XA_VTB);
        auto mid = [&]() { if (kt + 1 < 4) stage_load(kt + 1); };
        flash_tile<16, 4>(kb, XA_KP, kb + XA_KT, XA_VP, qf, o, mrun, lrun, r32, hi, false, 0, 0, mid);
        if (kt + 1 < 4) stage_write(buf ^ 1);
        __syncthreads();
    }
    const float inv = 1.f / xhalf_sum(lrun);
    bf16_t* orow = OX + (tb + q0 + r32) * D + h * 256 + dvh * 128;
#pragma unroll
    for (int t = 0; t < 4; ++t)
#pragma unroll
        for (int g = 0; g < 4; ++g) { u32x2 w; w.x = cvtpk(o[t][4 * g] * inv, o[t][4 * g + 1] * inv); w.y = cvtpk(o[t][4 * g + 2] * inv, o[t][4 * g + 3] * inv);
            *(u32x2*)(orow + 32 * t + 8 * g + 4 * hi) = w; }
}

constexpr int RT_P = 272;
constexpr int RT_PV = 264;
__device__ __forceinline__ float ret_log2g(int h) { return log2f(1.0f - exp2f(-5.0f - (float)h)); }
__device__ __forceinline__ void ret_state_unit(LAS unsigned char* lds, int unit, const bf16_t* PROJ, const bf16_t* RVT, bf16_t* RKVT) {
    const int tid = opaque_tid(), lane = tid & 63, r32 = lane & 31, hi = lane >> 5, wid = __builtin_amdgcn_readfirstlane(tid >> 6);
    const int n = unit & 31, h = (unit >> 5) & 3, b = unit >> 7;
    const size_t t0 = (size_t)b * SEQ + n * 128;
    const float l2g = ret_log2g(h);
    LAS unsigned char* Vs = lds;
    LAS unsigned char* Ks = lds + 128 * RT_P;
#pragma unroll
    for (int i = 0; i < 4; ++i) { const int idx = tid + 512 * i, e = idx >> 4, c = idx & 15;
        *(LAS u32x4*)(Vs + e * RT_P + c * 16) = *(const u32x4*)(RVT + (size_t)(h * 128 + e) * T + t0 + c * 8); }
#pragma unroll
    for (int i = 0; i < 4; ++i) { const int idx = tid + 512 * i, j = idx >> 4, c = idx & 15;
        const u32x4 v = *(const u32x4*)(PROJ + (t0 + j) * NPROJ + 1152 + h * 128 + c * 8);
        const float z = exp2f((float)(127 - j) * l2g);
        const unsigned w[4] = {v.x, v.y, v.z, v.w};
#pragma unroll
        for (int q = 0; q < 4; ++q) { const float lo = bf2f((unsigned short)(w[q] & 0xffffu)) * z, hh = bf2f((unsigned short)(w[q] >> 16)) * z; const unsigned pk = cvtpk(lo, hh);
            *(LAS unsigned short*)(Ks + (c * 8 + 2 * q) * RT_P + j * 2) = (unsigned short)(pk & 0xffffu); *(LAS unsigned short*)(Ks + (c * 8 + 2 * q + 1) * RT_P + j * 2) = (unsigned short)(pk >> 16); } }
    __syncthreads();
    const int eb = (wid & 3) * 32, db = (wid >> 2) * 64;
    f32x16 acc[2];
#pragma unroll
    for (int t = 0; t < 2; ++t)
#pragma unroll
        for (int r = 0; r < 16; ++r) acc[t][r] = 0.f;
#pragma unroll
    for (int ks = 0; ks < 8; ++ks) {
        const bf16x8 a = *(const LAS bf16x8*)(Vs + (eb + r32) * RT_P + ks * 32 + hi * 16);
#pragma unroll
        for (int t = 0; t < 2; ++t) { const bf16x8 bb = *(const LAS bf16x8*)(Ks + (db + 32 * t + r32) * RT_P + ks * 32 + hi * 16); acc[t] = MFMA32(a, bb, acc[t]); }
    }
    bf16_t* O = RKVT + (size_t)unit * 16384;
#pragma unroll
    for (int t = 0; t < 2; ++t)
#pragma unroll
        for (int r = 0; r < 16; ++r) { const unsigned pk = cvtpk(acc[t][r], 0.f); O[(size_t)(eb + crow(r, hi)) * 128 + db + 32 * t + r32] = (unsigned short)(pk & 0xffffu); }
    __syncthreads();
}
__device__ __forceinline__ void ret_out_unit(LAS unsigned char* lds, int unit, const bf16_t* PROJ, const bf16_t* RVT, const bf16_t* RKVT, const float* g_gn, bf16_t* MIX) {
    const int tid = opaque_tid(), lane = tid & 63, r32 = lane & 31, hi = lane >> 5, wid = __builtin_amdgcn_readfirstlane(tid >> 6);
    const int n = unit & 31, h = (unit >> 5) & 3, b = unit >> 7;
    const size_t t0 = (size_t)b * SEQ + n * 128;
    const float l2g = ret_log2g(h);
    LAS unsigned char* Ks = lds;
    LAS unsigned char* Vs = lds + 128 * RT_P;
    LAS unsigned char* Rs = Vs + 128 * RT_PV;
    LAS float* Xs = (LAS float*)(Rs + 128 * RT_P);
#pragma unroll
    for (int i = 0; i < 4; ++i) { const int idx = tid + 512 * i, j = idx >> 4, c = idx & 15;
        *(LAS u32x4*)(Ks + j * RT_P + c * 16) = *(const u32x4*)(PROJ + (t0 + j) * NPROJ + 1152 + h * 128 + c * 8); }
#pragma unroll
    for (int i = 0; i < 4; ++i) { const int idx = tid + 512 * i, e = idx >> 4, c = idx & 15;
        const u32x4 v = *(const u32x4*)(RVT + (size_t)(h * 128 + e) * T + t0 + c * 8);
        *(LAS u32x2*)(Vs + e * RT_PV + c * 16) = (u32x2){v.x, v.y}; *(LAS u32x2*)(Vs + e * RT_PV + c * 16 + 8) = (u32x2){v.z, v.w}; }
    {
        const float cd = exp2f(128.f * l2g);
        float ra[4][8];
#pragma unroll
        for (int i = 0; i < 4; ++i)
#pragma unroll
            for (int q = 0; q < 8; ++q) ra[i][q] = 0.f;
        const bf16_t* src = RKVT + (size_t)(unit - n) * 16384;
        for (int mm = 0; mm < n; ++mm) {
#pragma unroll
            for (int i = 0; i < 4; ++i) { const int idx = tid + 512 * i; const u32x4 v = *(const u32x4*)(src + (size_t)mm * 16384 + idx * 8);
                const unsigned w[4] = {v.x, v.y, v.z, v.w};
#pragma unroll
                for (int q = 0; q < 4; ++q) { ra[i][2 * q] = ra[i][2 * q] * cd + bf2f((unsigned short)(w[q] & 0xffffu)); ra[i][2 * q + 1] = ra[i][2 * q + 1] * cd + bf2f((unsigned short)(w[q] >> 16)); } }
        }
#pragma unroll
        for (int i = 0; i < 4; ++i) { const int idx = tid + 512 * i, e = idx >> 4, c = idx & 15;
            u32x4 w; w.x = cvtpk(ra[i][0], ra[i][1]); w.y = cvtpk(ra[i][2], ra[i][3]); w.z = cvtpk(ra[i][4], ra[i][5]); w.w = cvtpk(ra[i][6], ra[i][7]);
            *(LAS u32x4*)(Rs + e * RT_P + c * 16) = w; }
    }
    const int ib = wid & 3, eh = wid >> 2;
    bf16x8 qf[8];
    { const bf16_t* qr = PROJ + (t0 + ib * 32 + r32) * NPROJ + 640 + h * 128 + hi * 8;
#pragma unroll
      for (int s = 0; s < 8; ++s) qf[s] = *(const bf16x8*)(qr + s * 16); }
    __syncthreads();
    f32x16 oi[2], oc[2];
#pragma unroll
    for (int t = 0; t < 2; ++t)
#pragma unroll
        for (int r = 0; r < 16; ++r) { oi[t][r] = 0.f; oc[t][r] = 0.f; }
#pragma unroll
    for (int s = 0; s < 8; ++s)
#pragma unroll
        for (int t = 0; t < 2; ++t) { const bf16x8 a = *(const LAS bf16x8*)(Rs + (eh * 64 + t * 32 + r32) * RT_P + s * 32 + hi * 16); oc[t] = MFMA32(a, qf[s], oc[t]); }
    for (int jt = 0; jt <= ib; ++jt) {
        f32x16 p;
#pragma unroll
        for (int r = 0; r < 16; ++r) p[r] = 0.f;
#pragma unroll
        for (int s = 0; s < 8; ++s) { const bf16x8 a = *(const LAS bf16x8*)(Ks + (jt * 32 + r32) * RT_P + s * 32 + hi * 16); p = MFMA32(a, qf[s], p); }
        const int dbase = (ib - jt) * 32 + r32;
#pragma unroll
        for (int r = 0; r < 16; ++r) { const int dd = dbase - crow(r, hi); p[r] = dd >= 0 ? p[r] * exp2f((float)dd * l2g) : 0.f; }
        bf16x8 pb[2];
#pragma unroll
        for (int ks = 0; ks < 2; ++ks) { u32x4 w; w.x = cvtpk(p[8 * ks + 0], p[8 * ks + 1]); w.y = cvtpk(p[8 * ks + 2], p[8 * ks + 3]); w.z = cvtpk(p[8 * ks + 4], p[8 * ks + 5]); w.w = cvtpk(p[8 * ks + 6], p[8 * ks + 7]); pb[ks] = __builtin_bit_cast(bf16x8, w); }
#pragma unroll
        for (int t = 0; t < 2; ++t)
#pragma unroll
            for (int ks = 0; ks < 2; ++ks) { const LAS unsigned char* vp = Vs + (eh * 64 + t * 32 + r32) * RT_PV + (jt * 32 + ks * 16) * 2 + hi * 8;
                const s16x4 lo = *(const LAS s16x4*)vp, hh = *(const LAS s16x4*)(vp + 16);
                const bf16x8 a = (bf16x8){lo[0], lo[1], lo[2], lo[3], hh[0], hh[1], hh[2], hh[3]}; oi[t] = MFMA32(a, pb[ks], oi[t]); }
    }
    const float xi = exp2f((float)(ib * 32 + r32 + 1) * l2g);
    float s1 = 0.f, s2 = 0.f;
#pragma unroll
    for (int t = 0; t < 2; ++t)
#pragma unroll
        for (int r = 0; r < 16; ++r) { const float v = oi[t][r] + oc[t][r] * xi; oi[t][r] = v; s1 += v; s2 += v * v; }
    s1 = xhalf_sum(s1); s2 = xhalf_sum(s2);
    if (hi == 0) { Xs[(wid * 32 + r32) * 2] = s1; Xs[(wid * 32 + r32) * 2 + 1] = s2; }
    __syncthreads();
    { const int ow = wid ^ 4; s1 += Xs[(ow * 32 + r32) * 2]; s2 += Xs[(ow * 32 + r32) * 2 + 1]; }
    const float mean = s1 * (1.f / 128.f), var = fmaxf(s2 * (1.f / 128.f) - mean * mean, 0.f), rstd = rsqrtf(var + EPS);
    const size_t trow = t0 + ib * 32 + r32;
    const bf16_t* grow = PROJ + trow * NPROJ + 1664 + h * 128;
    bf16_t* orow = MIX + trow * D + 512 + h * 128;
#pragma unroll
    for (int t = 0; t < 2; ++t)
#pragma unroll
        for (int g = 0; g < 4; ++g) { const int e = eh * 64 + t * 32 + 8 * g + 4 * hi;
            const u32x2 gg = *(const u32x2*)(grow + e); const f32x4 gn = *(const f32x4*)(g_gn + h * 128 + e);
            const float rg[4] = {bf2f((unsigned short)(gg.x & 0xffffu)), bf2f((unsigned short)(gg.x >> 16)), bf2f((unsigned short)(gg.y & 0xffffu)), bf2f((unsigned short)(gg.y >> 16))};
            float y[4];
#pragma unroll
            for (int q = 0; q < 4; ++q) { const float sil = rg[q] / (1.f + __expf(-rg[q])); y[q] = (oi[t][4 * g + q] - mean) * rstd * gn[q] * sil; }
            u32x2 w; w.x = cvtpk(y[0], y[1]); w.y = cvtpk(y[2], y[3]); *(u32x2*)(orow + e) = w; }
    __syncthreads();
}

constexpr int PK_P = 272;
constexpr int PEER_SK = 0, PEER_LST = 2 * 128 * PK_P;
constexpr int PEER_ENT = PEER_LST + NWAVES * 4096;
__device__ __forceinline__ unsigned f_ord(float f) { const unsigned u = __float_as_uint(f); return u ^ ((unsigned)((int)u >> 31) | 0x80000000u); }
__device__ __forceinline__ float f_unord(unsigned k) { return __uint_as_float((k & 0x80000000u) ? (k ^ 0x80000000u) : ~k); }
#define TK_INS(L, x) do { unsigned _x = (x); _Pragma("unroll") for (int _j = 0; _j < 16; ++_j) { const unsigned _h = max(_x, L[_j]); _x = min(_x, L[_j]); L[_j] = _h; } } while (0)
__device__ __forceinline__ void tk_merge_partner(unsigned (&L)[16], int hi) {
    unsigned M[16];
#pragma unroll
    for (int i = 0; i < 16; ++i) { const unsigned o = xhalf_other(L[15 - i], hi); M[i] = max(L[i], o); }
#pragma unroll
    for (int st = 8; st >= 1; st >>= 1)
#pragma unroll
        for (int i = 0; i < 16; ++i) if ((i & st) == 0) { const unsigned a = max(M[i], M[i + st]), bq = min(M[i], M[i + st]); M[i] = a; M[i + st] = bq; }
#pragma unroll
    for (int i = 0; i < 16; ++i) L[i] = M[i];
}

__device__ __forceinline__ void peer_phase(LAS unsigned char* lds, const Params& p, int vcu, int G) {
    const int tid = opaque_tid(), lane = tid & 63, r32 = lane & 31, hi = lane >> 5, wid = __builtin_amdgcn_readfirstlane(tid >> 6);
    const bf16_t* SK = (const bf16_t*)(p.ws + WS_SK); const bf16_t* QP = (const bf16_t*)(p.ws + WS_QP);
    const unsigned char* U8 = p.ws + WS_U8; const unsigned char* V8 = p.ws + WS_V8; const float* ssq2 = (const float*)(p.ws + WS_SSQ2);
    for (int idx = tid; idx < 2 * 128 * 16; idx += 512) { const int row = idx >> 4, c = idx & 15; *(LAS u32x4*)(lds + PEER_SK + row * PK_P + c * 16) = *(const u32x4*)(SK + row * 128 + c * 8); }
    __syncthreads();
    LAS unsigned* LST = (LAS unsigned*)(lds + PEER_LST + wid * 4096);
    LAS u32x2* ENT = (LAS u32x2*)(lds + PEER_ENT + wid * 4096);
    for (int grp = vcu * NWAVES + wid; grp < T / 4; grp += G * NWAVES) {
        const int tok0 = grp * 4;
        unsigned hi4 = (unsigned)hi << 2; asm volatile("" : "+v"(hi4));
        {
            const bf16_t* qrow = QP + (size_t)(tok0 + (r32 >> 3)) * 2048 + (r32 & 7) * 256 + hi * 8;
            unsigned LA[16], LB[16];
#pragma unroll
            for (int pp = 0; pp < 2; ++pp) {
                bf16x8 qf[8];
#pragma unroll
                for (int s = 0; s < 8; ++s) qf[s] = *(const bf16x8*)(qrow + pp * 128 + s * 16);
                unsigned L[16];
#pragma unroll
                for (int i = 0; i < 16; ++i) L[i] = 0u;
#pragma unroll
                for (int kt = 0; kt < 4; ++kt) {
                    f32x16 sc;
#pragma unroll
                    for (int r = 0; r < 16; ++r) sc[r] = 0.f;
#pragma unroll
                    for (int s = 0; s < 8; ++s) { const bf16x8 a = *(const LAS bf16x8*)(lds + PEER_SK + (pp * 128 + kt * 32 + r32) * PK_P + s * 32 + hi * 16); sc = MFMA32(a, qf[s], sc); }
#pragma unroll
                    for (int r = 0; r < 16; ++r) { const unsigned code = 127u - (unsigned)(32 * kt + (r & 3) + 8 * (r >> 2)); TK_INS(L, ((f_ord(sc[r]) & ~0x7Fu) | code) ^ hi4); }
                }
                tk_merge_partner(L, hi);
#pragma unroll
                for (int i = 0; i < 16; ++i) { if (pp == 0) LA[i] = L[i]; else LB[i] = L[i]; }
            }
#pragma unroll
            for (int i = 0; i < 16; ++i) { LST[i * 32 + r32] = LA[i]; LST[(16 + i) * 32 + r32] = LB[i]; }
            float va[16], vb[16];
#pragma unroll
            for (int i = 0; i < 16; ++i) { va[i] = f_unord(LA[i] & ~0x7Fu); vb[i] = f_unord(LB[i] & ~0x7Fu); }
            unsigned C[16];
#pragma unroll
            for (int i = 0; i < 16; ++i) C[i] = 0u;
#pragma unroll
            for (int i = 0; i < 16; ++i)
#pragma unroll
                for (int j = 0; j < 16; ++j) if ((i + 1) * (j + 1) <= 16) { const unsigned code = 255u - (unsigned)(16 * i + j); TK_INS(C, (f_ord(va[i] + vb[j]) & ~0xFFu) | code); }
            LDS_WAIT();
            float bs[16]; unsigned ex[16]; float mx = -1e30f;
#pragma unroll
            for (int k = 0; k < 16; ++k) { const unsigned code = 255u - (C[k] & 0xFFu); const unsigned i = code >> 4, j = code & 15u;
                const unsigned ka = LST[i * 32 + r32], kbq = LST[(16 + j) * 32 + r32];
                bs[k] = f_unord(ka & ~0x7Fu) + f_unord(kbq & ~0x7Fu); ex[k] = (127u - (ka & 0x7Fu)) * 128u + (127u - (kbq & 0x7Fu)); mx = fmaxf(mx, bs[k]); }
            float sum = 0.f;
#pragma unroll
            for (int k = 0; k < 16; ++k) { bs[k] = __expf(bs[k] - mx); sum += bs[k]; }
            const float rinv = 1.f / sum;
            if (hi == 0) {
#pragma unroll
                for (int k = 0; k < 16; ++k) ENT[(r32 >> 3) * 128 + (r32 & 7) * 16 + k] = (u32x2){ex[k], __float_as_uint(bs[k] * rinv)};
            }
            LDS_WAIT();
        }
        for (int tk = 0; tk < 4; ++tk) {
            const int t = tok0 + tk;
            float* hrow = p.out + (size_t)t * D + lane * 16;
            f32x4 hv[4];
#pragma unroll
            for (int i = 0; i < 4; ++i) hv[i] = *(const f32x4*)(hrow + 4 * i);
            const float rstd2 = rsqrtf(ssq_sum<16>(ssq2 + (size_t)t * 16) * (1.f / D) + EPS);
            float ov[16];
#pragma unroll
            for (int i = 0; i < 16; ++i) ov[i] = 0.f;
            for (int hd = 0; hd < 8; ++hd) {
                const u32x2 ent = ENT[tk * 128 + hd * 16 + (lane & 15)];
                const u32x2 entk = ENT[tk * 128 + hd * 16 + ((lane >> 2) & 15)];
                u32x4 up[16];
#pragma unroll
                for (int k = 0; k < 16; ++k) { const unsigned e = (unsigned)__builtin_amdgcn_readlane((int)ent.x, k); up[k] = *(const u32x4*)(U8 + (size_t)e * D + lane * 16); }
                float dt[16];
#pragma unroll
                for (int k = 0; k < 16; ++k) { float a = 0.f; const unsigned w[4] = {up[k].x, up[k].y, up[k].z, up[k].w};
#pragma unroll
                    for (int q = 0; q < 4; ++q) { const f32x2 lo = __builtin_amdgcn_cvt_pk_f32_fp8((int)w[q], false), h2 = __builtin_amdgcn_cvt_pk_f32_fp8((int)w[q], true);
                        a += lo[0] * hv[q][0] + lo[1] * hv[q][1] + h2[0] * hv[q][2] + h2[1] * hv[q][3]; }
                    dt[k] = a; }
                asm volatile("" ::: "memory");
#pragma unroll
                for (int k = 0; k < 16; ++k) { const unsigned e = (unsigned)__builtin_amdgcn_readlane((int)ent.x, k); up[k] = *(const u32x4*)(V8 + (size_t)e * D + lane * 16); }
                float y8[8], y4[4], y2[2], y1;
                { const bool bsel = hi != 0;
#pragma unroll
                  for (int k = 0; k < 8; ++k) { const float snd = bsel ? dt[k] : dt[k + 8], kp = bsel ? dt[k + 8] : dt[k]; y8[k] = kp + __shfl_xor(snd, 32); } }
                { const bool bsel = (lane & 16) != 0;
#pragma unroll
                  for (int k = 0; k < 4; ++k) { const float snd = bsel ? y8[k] : y8[k + 4], kp = bsel ? y8[k + 4] : y8[k]; y4[k] = kp + __shfl_xor(snd, 16); } }
                { const bool bsel = (lane & 8) != 0;
#pragma unroll
                  for (int k = 0; k < 2; ++k) { const float snd = bsel ? y4[k] : y4[k + 2], kp = bsel ? y4[k + 2] : y4[k]; y2[k] = kp + __shfl_xor(snd, 8); } }
                { const bool bsel = (lane & 4) != 0; const float snd = bsel ? y2[0] : y2[1], kp = bsel ? y2[1] : y2[0]; y1 = kp + __shfl_xor(snd, 4); }
                y1 += __shfl_xor(y1, 2); y1 += __shfl_xor(y1, 1);
                const float act = y1 * rstd2 * (1.f / U_SCALE);
                const float wgt = __uint_as_float(entk.y) * gelu_f(act) * (1.f / V_SCALE);
#pragma unroll
                for (int k = 0; k < 16; ++k) { const float wk = __uint_as_float((unsigned)__builtin_amdgcn_readlane((int)__float_as_uint(wgt), 4 * k));
                    const unsigned w[4] = {up[k].x, up[k].y, up[k].z, up[k].w};
#pragma unroll
                    for (int q = 0; q < 4; ++q) { const f32x2 lo = __builtin_amdgcn_cvt_pk_f32_fp8((int)w[q], false), h2 = __builtin_amdgcn_cvt_pk_f32_fp8((int)w[q], true);
                        ov[4 * q + 0] += wk * lo[0]; ov[4 * q + 1] += wk * lo[1]; ov[4 * q + 2] += wk * h2[0]; ov[4 * q + 3] += wk * h2[1]; } }
            }
            float ss = 0.f;
#pragma unroll
            for (int i = 0; i < 4; ++i)
#pragma unroll
                for (int q = 0; q < 4; ++q) { const float v = hv[i][q] + ov[4 * i + q]; hv[i][q] = v; ss += v * v; }
            const float rstd3 = rsqrtf(wave_sum(ss) * (1.f / D) + EPS);
#pragma unroll
            for (int i = 0; i < 4; ++i) { const f32x4 gf = *(const f32x4*)(p.g_final + lane * 16 + 4 * i); *(f32x4*)(hrow + 4 * i) = hv[i] * rstd3 * gf; }
        }
    }
}

#ifndef PH_MASK
#define PH_MASK 0xFFFF
#endif
#define PH(k) ((PH_MASK >> (k)) & 1)
__global__ void __launch_bounds__(NWAVES * 64, 2) fwd_megakernel(Params p) {
    extern __shared__ __attribute__((aligned(16))) unsigned char lds_raw[];
    LAS unsigned char* lds = (LAS unsigned char*)lds_raw;
    const int tid = threadIdx.x, lane = tid & 63, wave = __builtin_amdgcn_readfirstlane(tid >> 6);
    const int G = gridDim.x; const int bx = blockIdx.x;
    const int vcu = (G % 8 == 0) ? (bx % 8) * (G / 8) + bx / 8 : bx;
    if (p.never) { cg::this_grid().sync(); }
    unsigned char* const ws = p.ws;
    volatile LAS unsigned* MISC = (volatile LAS unsigned*)(lds + LDSCTL_OFF);
    for (int u = tid; u < (LDS_BYTES - LDSCTL_OFF) / 4; u += NWAVES * 64) ((LAS unsigned*)(lds + LDSCTL_OFF))[u] = 0u;
    __syncthreads();
    XcdBarrier bar = xcd_barrier_post((unsigned*)(ws + WS_CTL) + CW_BAR, MISC + 8);
    const int gw = vcu * NWAVES + wave, NGW = G * NWAVES;

#define WSB(off) ((bf16_t*)(p.ws + (off)))
#define WSF(off) ((float*)(p.ws + (off)))
    if (PH(0))
    {
        LAS float* scr = (LAS float*)(lds + wave * 16384);
        constexpr int I_IN = 16 * 85, I_UQ = 6 * 24, I_UKV = 4 * 32, I_SQ = 16 * 32, I_XKV = 16 * 64, I_PQ = 16 * 64;
        constexpr int NITEMS = I_IN + I_UQ + I_UKV + 3 * I_SQ + I_XKV + I_PQ;
        for (int it = gw; it < NITEMS; it += NGW) {
            int r = it;
            if (r < I_IN) { p0_transpose_item<1>(p.w_in, 1024, 2720, WSB(WS_WIN), nullptr, scr, r, lane); continue; } r -= I_IN;
            if (r < I_UQ) { p0_transpose_item<2>(p.w_uq, 384, 768, WSB(WS_WUQ), p.g_q_lora, scr, r, lane); continue; } r -= I_UQ;
            if (r < I_UKV) { p0_transpose_item<3>(p.w_ukv, 256, 1024, WSB(WS_WUKV), p.g_kv_lora, scr, r, lane); continue; } r -= I_UKV;
            if (r < I_SQ) { p0_transpose_item<0>(p.w_o, 1024, 1024, WSB(WS_WO), nullptr, scr, r, lane); continue; } r -= I_SQ;
            if (r < I_SQ) { p0_transpose_item<0>(p.w_xq, 1024, 1024, WSB(WS_WXQ), p.g_xattn, scr, r, lane); continue; } r -= I_SQ;
            if (r < I_SQ) { p0_transpose_item<0>(p.w_xo, 1024, 1024, WSB(WS_WXO), nullptr, scr, r, lane); continue; } r -= I_SQ;
            if (r < I_XKV) { p0_transpose_item<0>(p.w_xkv, 1024, 2048, WSB(WS_WXKV), nullptr, scr, r, lane); continue; } r -= I_XKV;
            p0_transpose_item<0>(p.w_pq, 1024, 2048, WSB(WS_WPQ), p.g_ffn, scr, r, lane);
        }
        for (int m = gw; m < T; m += NGW) rms_row_to_bf16(p.x + (size_t)m * D, p.g_mix, WSB(WS_A0) + (size_t)m * D, lane);
        for (int m = gw; m < 1024; m += NGW) rms_row_to_bf16(p.mem + (size_t)m * D, p.g_mem, WSB(WS_MEMN) + (size_t)m * D, lane);
        const int gt = vcu * 512 + tid, NGT = G * 512;
        for (int i = gt; i < 2 * 128 * 128 / 2; i += NGT) { const f32x2 v = *(const f32x2*)(p.sub_keys + 2 * i); ((unsigned*)WSB(WS_SK))[i] = cvtpk(v[0], v[1]); }
        for (int i = gt; i < 96 * 1024 / 8; i += NGT) ((u32x4*)(WSB(WS_WIN) + (size_t)2208 * 1024))[i] = (u32x4){0u, 0u, 0u, 0u};
        for (int i = gt; i < SEQ * 64; i += NGT) { const int s = i >> 6, f = i & 63; const float inv = exp2f(-(float)f * (13.287712379549449f / 64.f)); const float ang = (float)s * inv;
            const double rev = (double)ang * 0.15915494309189535; const float fr = (float)(rev - floor(rev)); WSF(WS_CR)[i] = __builtin_amdgcn_cosf(fr); WSF(WS_SR)[i] = __builtin_amdgcn_sinf(fr); }
        for (int i = gt; i < SEQ * 16; i += NGT) { const int s = i >> 4, f = i & 15; const float inv = exp2f(-(float)f * (13.287712379549449f / 16.f)); const float ang = (float)s * inv;
            const double rev = (double)ang * 0.15915494309189535; const float fr = (float)(rev - floor(rev)); WSF(WS_CM)[i] = __builtin_amdgcn_cosf(fr); WSF(WS_SM)[i] = __builtin_amdgcn_sinf(fr); }
    }
    xcd_barrier(bar);

    if (PH(1))
    {
        { pg8::Gemm g{WSB(WS_A0), WSB(WS_WIN), T, NPROJ, 1024, 1024, 1024}; pg8::StaticOrder S; S.init(T, NPROJ, G, bx);
          pg8::EpiProj E{WSB(WS_PROJ), WSF(WS_SSQQ), WSF(WS_SSQKV), WSF(WS_CR), WSF(WS_SR), WSF(WS_CM), WSF(WS_SM)}; pg8::gemm_phase<pg8::EpiProj, pg8::StaticOrder, true>(lds, g, S, E); }
        { pg8::Gemm g{WSB(WS_WIN) + (size_t)2304 * 1024, WSB(WS_A0), 512, T, 1024, 1024, 1024}; pg8::StaticOrder S; S.init(512, T, G, (bx - 64 + G) % G);
          pg8::EpiPlain E{WSB(WS_RVT), T}; pg8::gemm_phase<pg8::EpiPlain, pg8::StaticOrder, true>(lds, g, S, E); }
        { pg8::Gemm g{WSB(WS_MEMN), WSB(WS_WXKV), 1024, 1024, 1024, 1024, 1024}; pg8::StaticOrder S; S.init(1024, 1024, G, (bx - 192 + G) % G);
          pg8::EpiPlain E{WSB(WS_KX), 1024}; pg8::gemm_phase<pg8::EpiPlain, pg8::StaticOrder, true>(lds, g, S, E); }
        { pg8::Gemm g{WSB(WS_WXKV) + (size_t)1024 * 1024, WSB(WS_MEMN), 1024, 1024, 1024, 1024, 1024}; pg8::StaticOrder S; S.init(1024, 1024, G, (bx - 208 + G) % G);
          pg8::EpiPlain E{WSB(WS_VXT), 1024}; pg8::gemm_phase<pg8::EpiPlain, pg8::StaticOrder, true>(lds, g, S, E); }
    }
    xcd_barrier(bar);

    if (PH(2))
    {
        { pg8::Gemm g{WSB(WS_PROJ), WSB(WS_WUQ), T, 768, 384, NPROJ, 384}; pg8::StaticOrder S; S.init(T, 768, G, bx);
          pg8::EpiQ E{WSB(WS_QM), WSF(WS_SSQQ), WSF(WS_CM), WSF(WS_SM)}; pg8::gemm_phase<pg8::EpiQ, pg8::StaticOrder, true>(lds, g, S, E); }
        { pg8::Gemm g{WSB(WS_PROJ) + 384, WSB(WS_WUKV), T, 512, 256, NPROJ, 256}; pg8::StaticOrder S; S.init(T, 512, G, (bx - 192 + G) % G);
          pg8::EpiRowScale<8> E{WSB(WS_KN), 512, WSF(WS_SSQKV), 1.f / 256.f, 1.f}; pg8::gemm_phase<pg8::EpiRowScale<8>, pg8::StaticOrder, true>(lds, g, S, E); }
        { pg8::Gemm g{WSB(WS_WUKV) + (size_t)512 * 256, WSB(WS_PROJ) + 384, 512, T, 256, 256, NPROJ}; pg8::StaticOrder S; S.init(512, T, G, (bx - 64 + G) % G);
          pg8::EpiColScale E{WSB(WS_VT), T, WSF(WS_SSQKV), 1.f / 256.f}; pg8::gemm_phase<pg8::EpiColScale, pg8::StaticOrder, true>(lds, g, S, E); }
        for (int u = vcu; u < 512; u += G) ret_state_unit(lds, u, WSB(WS_PROJ), WSB(WS_RVT), WSB(WS_RKVT));
    }
    xcd_barrier(bar);

    if (PH(3))
    {
        for (int u = vcu; u < 512; u += G) ret_out_unit(lds, u, WSB(WS_PROJ), WSB(WS_RVT), WSB(WS_RKVT), p.g_ret_gn, WSB(WS_MIX));
        for (int v = vcu; v < 256; v += G) { const int bh = v >> 3, s = v & 7;
            mla_unit(lds, bh >> 3, bh & 7, 15 - s, WSB(WS_QM), WSB(WS_KN), WSB(WS_PROJ), WSB(WS_VT), WSB(WS_MIX));
            mla_unit(lds, bh >> 3, bh & 7, s, WSB(WS_QM), WSB(WS_KN), WSB(WS_PROJ), WSB(WS_VT), WSB(WS_MIX)); }
    }
    xcd_barrier(bar);

    if (PH(4))
    { pg8::Gemm g{WSB(WS_MIX), WSB(WS_WO), T, 1024, 1024, 1024, 1024}; pg8::StaticOrder S; S.init(T, 1024, G, bx);
      pg8::EpiRes E{p.x, p.out, WSB(WS_H1B), WSF(WS_SSQ1)}; pg8::gemm_phase<pg8::EpiRes, pg8::StaticOrder, true>(lds, g, S, E); }
    xcd_barrier(bar);

    if (PH(5))
    { pg8::Gemm g{WSB(WS_H1B), WSB(WS_WXQ), T, 1024, 1024, 1024, 1024}; pg8::StaticOrder S; S.init(T, 1024, G, bx);
      pg8::EpiRowScale<16> E{WSB(WS_QX), 1024, WSF(WS_SSQ1), 1.f / 1024.f, C2_X}; pg8::gemm_phase<pg8::EpiRowScale<16>, pg8::StaticOrder, true>(lds, g, S, E); }
    xcd_barrier(bar);

    if (PH(6))
    {
        for (int u = vcu; u < 512; u += G) { const int dvh = u & 1, qb = (u >> 1) & 15, h = (u >> 5) & 3, b = u >> 7; xattn_unit(lds, b, h, qb, dvh, WSB(WS_QX), WSB(WS_KX), WSB(WS_VXT), WSB(WS_OX)); }
        unsigned char* U8 = ws + WS_U8; unsigned char* V8 = ws + WS_V8;
        const f32x4* gf = (const f32x4*)p.g_ffn + lane * 4;
        f32x4 gs[4];
#pragma unroll
        for (int i = 0; i < 4; ++i) gs[i] = gf[i] * U_SCALE;
        for (int e = gw; e < 2 * 16384; e += NGW) {
            const bool isv = e >= 16384; const int row = isv ? e - 16384 : e;
            const f32x4* src = (const f32x4*)((isv ? p.v_exp : p.u_exp) + (size_t)row * D) + lane * 4;
            u32x4 o; unsigned ow[4];
#pragma unroll
            for (int i = 0; i < 4; ++i) { f32x4 v = src[i]; v = isv ? v * V_SCALE : v * gs[i]; int pk = 0; pk = __builtin_amdgcn_cvt_pk_fp8_f32(v[0], v[1], pk, false); pk = __builtin_amdgcn_cvt_pk_fp8_f32(v[2], v[3], pk, true); ow[i] = (unsigned)pk; }
            o.x = ow[0]; o.y = ow[1]; o.z = ow[2]; o.w = ow[3];
            *(u32x4*)((isv ? V8 : U8) + (size_t)row * D + lane * 16) = o;
        }
    }
    xcd_barrier(bar);

    if (PH(7))
    { pg8::Gemm g{WSB(WS_OX), WSB(WS_WXO), T, 1024, 1024, 1024, 1024}; pg8::StaticOrder S; S.init(T, 1024, G, bx);
      pg8::EpiRes E{p.out, p.out, WSB(WS_H2B), WSF(WS_SSQ2)}; pg8::gemm_phase<pg8::EpiRes, pg8::StaticOrder, true>(lds, g, S, E); }
    xcd_barrier(bar);

    if (PH(8))
    { pg8::Gemm g{WSB(WS_H2B), WSB(WS_WPQ), T, 2048, 1024, 1024, 1024}; pg8::StaticOrder S; S.init(T, 2048, G, bx);
      pg8::EpiRowScale<16> E{WSB(WS_QP), 2048, WSF(WS_SSQ2), 1.f / 1024.f, 1.f}; pg8::gemm_phase<pg8::EpiRowScale<16>, pg8::StaticOrder, true>(lds, g, S, E); }
    xcd_barrier(bar);

    if (PH(9))
    peer_phase(lds, p, vcu, G);
}

extern "C" void kernel_launch(void* const* d_in, const int* in_sizes, int n_in, void* d_out, int out_size, void* d_ws, size_t ws_size, hipStream_t stream) {
    static int grid = 0;
    if (grid == 0) {
        if (n_in != 21 || out_size != T * D || ws_size < WS_END) { fprintf(stderr, "kernel_launch: unexpected shapes (n_in %d out %d ws %zu)\n", n_in, out_size, ws_size); grid = -1; return; }
        int dev = 0, cus = 0, per_cu = 0;
        if (hipGetDevice(&dev) != hipSuccess || hipDeviceGetAttribute(&cus, hipDeviceAttributeMultiprocessorCount, dev) != hipSuccess) { grid = -1; return; }
        if (hipFuncSetAttribute((const void*)fwd_megakernel, hipFuncAttributeMaxDynamicSharedMemorySize, LDS_BYTES) != hipSuccess) { fprintf(stderr, "kernel_launch: hipFuncSetAttribute failed\n"); grid = -1; return; }
        if (hipOccupancyMaxActiveBlocksPerMultiprocessor(&per_cu, (const void*)fwd_megakernel, NWAVES * 64, LDS_BYTES) != hipSuccess || per_cu < 1) { fprintf(stderr, "kernel_launch: occupancy query says %d\n", per_cu); grid = -1; return; }
        (void)hipGetLastError();
        grid = cus;
    }
    if (grid < 0) return;
    (void)hipMemsetAsync((char*)d_ws + WS_CTL, 0, CTL_ZERO_BYTES, stream);
    Params p{};
    const float** pp = (const float**)&p;
    for (int i = 0; i < 21; ++i) pp[i] = (const float*)d_in[i];
    p.out = (float*)d_out; p.ws = (unsigned char*)d_ws; p.never = 0; p.pad = 0;
    void* args[] = {&p};
    hipError_t e = hipLaunchCooperativeKernel((const void*)fwd_megakernel, dim3(grid), dim3(NWAVES * 64), args, LDS_BYTES, stream);
    if (e != hipSuccess) fprintf(stderr, "cooperative launch failed: %s (grid %d)\n", hipGetErrorString(e), grid);
}
```

```cpp
#include <hip/hip_runtime.h>
#include <hip/hip_cooperative_groups.h>
#include <cstdio>
#include <cstdint>
namespace cg = cooperative_groups;

#define LAS __attribute__((address_space(3)))
#define GAS __attribute__((address_space(1)))
typedef unsigned short bf16_t;
typedef short bf16x8 __attribute__((ext_vector_type(8)));
typedef short s16x4 __attribute__((ext_vector_type(4)));
typedef float f32x4 __attribute__((ext_vector_type(4)));
typedef float f32x2 __attribute__((ext_vector_type(2)));
typedef float f32x16 __attribute__((ext_vector_type(16)));
typedef unsigned u32x4 __attribute__((ext_vector_type(4)));
typedef unsigned u32x2 __attribute__((ext_vector_type(2)));
typedef __bf16 bf16x2_t __attribute__((ext_vector_type(2)));

constexpr int T = 16384, D = 1024, SEQ = 4096;
constexpr int NPROJ = 2304;
constexpr int NWIN = 2816;
constexpr float EPS = 1e-6f;
constexpr float LOG2E = 1.4426950408889634f;
constexpr float C2_MLA = 0.10206207261596575f * LOG2E;
constexpr float C2_X = 0.0625f * LOG2E;
constexpr float U_SCALE = 512.f, V_SCALE = 64.f;

constexpr size_t MiB = 1u << 20;
constexpr size_t WS_CTL = 0, CTL_ZERO_BYTES = 1 * MiB;
constexpr size_t WS_SSQQ = 227 * MiB, WS_SSQKV = 228 * MiB, WS_SSQ1 = 229 * MiB, WS_SSQ2 = 230 * MiB;
constexpr size_t WS_CR = 1 * MiB, WS_SR = 2 * MiB, WS_CM = 3 * MiB, WS_SM = 3 * MiB + 256 * 1024;
constexpr size_t WS_WIN = 4 * MiB, WS_WUQ = 10 * MiB, WS_WUKV = 11 * MiB, WS_WO = 12 * MiB, WS_WXQ = 14 * MiB, WS_WXKV = 16 * MiB, WS_WXO = 20 * MiB, WS_WPQ = 22 * MiB, WS_SK = 26 * MiB;
constexpr size_t WS_MEMN = 27 * MiB, WS_KX = 29 * MiB, WS_VXT = 31 * MiB;
constexpr size_t WS_A0 = 33 * MiB, WS_MIX = 33 * MiB, WS_QX = 33 * MiB;
constexpr size_t WS_EG = 33 * MiB, WS_WG = 41 * MiB;
constexpr size_t WS_PROJ = 65 * MiB, WS_H1B = 65 * MiB, WS_U8 = 137 * MiB, WS_V8 = 153 * MiB;
constexpr size_t WS_OX = 97 * MiB, WS_H2B = 169 * MiB, WS_QP = 65 * MiB;
constexpr size_t WS_RVT = 137 * MiB, WS_QM = 154 * MiB, WS_KN = 178 * MiB, WS_VT = 194 * MiB, WS_RKVT = 211 * MiB;
constexpr int TP = T + 64;
constexpr size_t WS_END = 231 * MiB;
constexpr int CW_BAR = 4096;
constexpr int CW_QUEUE = 16384, Q3_SLOT = 0;

constexpr int RING_BYTES = 131072;
constexpr int LDSCTL_OFF = 143360;
constexpr int LDS_BYTES = 147456;
constexpr int NWAVES = 8;

__device__ __forceinline__ unsigned cvtpk(float lo, float hi) { f32x2 v = {lo, hi}; bf16x2_t b = __builtin_convertvector(v, bf16x2_t); return __builtin_bit_cast(unsigned, b); }
__device__ __forceinline__ float bf2f(unsigned short b) { return __uint_as_float(((unsigned)b) << 16); }
__device__ __forceinline__ int crow(int r, int hi) { return (r & 3) + 8 * (r >> 2) + 4 * hi; }
__device__ __forceinline__ float wave_sum(float v) {
#pragma unroll
    for (int o = 1; o < 64; o <<= 1) v += __shfl_xor(v, o);
    return v;
}
__device__ __forceinline__ float xhalf_max(float m) { auto rr = __builtin_amdgcn_permlane32_swap(__float_as_uint(m), __float_as_uint(m), false, false); return fmaxf(__uint_as_float(rr[0]), __uint_as_float(rr[1])); }
__device__ __forceinline__ float xhalf_sum(float m) { auto rr = __builtin_amdgcn_permlane32_swap(__float_as_uint(m), __float_as_uint(m), false, false); return __uint_as_float(rr[0]) + __uint_as_float(rr[1]); }
__device__ __forceinline__ unsigned xhalf_other(unsigned m, int hi) { auto rr = __builtin_amdgcn_permlane32_swap(m, m, false, false); return hi ? rr[0] : rr[1]; }
#define LDS_WAIT() asm volatile("s_waitcnt lgkmcnt(0)" ::: "memory")
template <int NP> __device__ __forceinline__ float ssq_sum(const float* part) {
    float s = 0.f;
#pragma unroll
    for (int i = 0; i < NP / 4; ++i) { const f32x4 v = *(const f32x4*)(part + 4 * i); s += v[0]; s += v[1]; s += v[2]; s += v[3]; }
    return s;
}
__device__ __forceinline__ int opaque_tid() { int t = threadIdx.x; asm volatile("" : "+v"(t)); return t; }
#define MFMA32(a, b, c) __builtin_amdgcn_mfma_f32_32x32x16_bf16((a), (b), (c), 0, 0, 0)
__device__ __forceinline__ float gelu_f(float v) {
    const float av = fabsf(v), t = __builtin_amdgcn_rcpf(av * 0.2316418882f + 1.0f);
    float q = t * 0.5307027145f + (-0.7265760135f); q = q * t + 0.7107068705f; q = q * t + (-0.142248368f); q = q * t + 0.127414796f; q = q * t;
    const float e = __builtin_amdgcn_exp2f((v * v) * (-0.72134752044f));
    const float m = v * (q * e);
    return v < 0.f ? m : v - m;
}

namespace pg8 {
constexpr int BM = 256, BK = 64, HALF = 128, HTB = HALF * BK * 2, STAGE_BYTES = 8 * HTB, NXCD = 8, WGM = 8;
__host__ __device__ __forceinline__ int lds_byte(int r, int c) { const int st = (r >> 4) * 2 + (c >> 5), rr = r & 15, cc = c & 31, ob = rr * 64 + cc * 2; return st * 1024 + (ob ^ (((ob >> 9) & 1) << 5)); }
__host__ __device__ __forceinline__ void stage_rc(int b, int& R, int& C) { const int st = b / 1024, sb = b % 1024, swz = sb ^ (((sb >> 9) & 1) << 5); R = (st >> 1) * 16 + swz / 64; C = (st & 1) * 32 + (swz % 64) / 2; }
struct Unit { int pm, pn; };
struct Gemm { const bf16_t* A; const bf16_t* Bt; int M, N, K, lda, ldb; };
struct StaticOrder {
    int nM, nN, nwg, G, c;
    __device__ void init(int M, int N, int G_, int c_) { nM = M / BM; nN = N / BM; nwg = nM * nN; G = G_; c = c_; }
    __device__ bool next(int i, Unit& u) const {
        const long L = (long)i * G + c; if (L >= nwg) return false;
        int wgid = (int)L; { const int q = nwg / NXCD, r = nwg % NXCD, xcd = wgid % NXCD, off = wgid / NXCD; wgid = (xcd < r ? xcd * (q + 1) : r * (q + 1) + (xcd - r) * q) + off; }
        const int nig = WGM * nN, gid = wgid / nig, fm = gid * WGM, gsz = (nM - fm) < WGM ? (nM - fm) : WGM;
        u.pm = fm + ((wgid % nig) % gsz); u.pn = (wgid % nig) / gsz; return true;
    }
};

template <class Epi, class Sched, bool ALIGN_EPI>
__device__ __forceinline__ void gemm_phase(LAS unsigned char* lds, const Gemm g, const Sched& S, const Epi& E) {
    const int tid = opaque_tid(), wid = __builtin_amdgcn_readfirstlane(tid >> 6), lane = tid & 63, wr = wid >> 2, wc = wid & 3, fr = lane & 15, fq = lane >> 4;
    const int K = g.K, nt = K / BK;
    unsigned voffA[2], voffB[2];
#pragma unroll
    for (int i = 0; i < 2; ++i) { int R, C; stage_rc(tid * 16 + i * 8192, R, C); voffA[i] = (unsigned)(R * g.lda + C) * 2u; voffB[i] = (unsigned)(R * g.ldb + C) * 2u; }
    const size_t kstep = (size_t)(BK * 2);
    const size_t hstepA = (size_t)HALF * g.lda * 2, hstepB = (size_t)HALF * g.ldb * 2, tstepA = 2 * hstepA, tstepB = 2 * hstepB;
    const unsigned ldsw = (unsigned)wid * 1024u;
    const int aoff = lds_byte(wr * 64 + fr, fq * 8), boff = lds_byte(wc * 32 + fr, fq * 8);
#define PG8_SA(b, h) (((b) * 2 + (h)) * HTB)
#define PG8_SB(b, h) ((4 + (b) * 2 + (h)) * HTB)
#define PG8_STAGE(bufoff, gbase, voff) do { _Pragma("unroll") for (int _i = 0; _i < 2; ++_i) \
        __builtin_amdgcn_global_load_lds((const unsigned*)((const char*)(gbase) + (voff)[_i]), (LAS unsigned*)(lds + (bufoff) + ldsw + _i * 8192), 16, 0, 0); } while (0)
#define PG8_LDA(dst, b, h) do { _Pragma("unroll") for (int m = 0; m < 4; ++m) _Pragma("unroll") for (int k = 0; k < 2; ++k) dst[m][k] = *(const LAS bf16x8*)(lds + PG8_SA(b, h) + aoff + m * 2048 + k * 1024); } while (0)
#define PG8_LDB(dst, b, h) do { _Pragma("unroll") for (int n = 0; n < 2; ++n) _Pragma("unroll") for (int k = 0; k < 2; ++k) dst[n][k] = *(const LAS bf16x8*)(lds + PG8_SB(b, h) + boff + n * 2048 + k * 1024); } while (0)
#define PG8_MMA(ai, bj, At, Bt) do { __builtin_amdgcn_s_setprio(1); _Pragma("unroll") for (int m = 0; m < 4; ++m) _Pragma("unroll") for (int n = 0; n < 2; ++n) _Pragma("unroll") for (int k = 0; k < 2; ++k) \
        acc[ai][bj][m][n] = __builtin_amdgcn_mfma_f32_16x16x32_bf16(Bt[n][k], At[m][k], acc[ai][bj][m][n], 0, 0, 0); __builtin_amdgcn_s_setprio(0); } while (0)
#define PG8_WAIT_V(n) asm volatile("s_waitcnt vmcnt(" #n ")" ::: "memory")
#define PG8_WAIT_L(n) asm volatile("s_waitcnt lgkmcnt(" #n ")" ::: "memory")
#define PG8_BAR __builtin_amdgcn_s_barrier()
#define PG8_SCHED __builtin_amdgcn_sched_barrier(0)
    Unit cur, nxt; int ui = 0;
    if (!S.next(0, cur)) return;
    f32x4 acc[2][2][4][2];
#pragma unroll
    for (int a = 0; a < 2; ++a)
#pragma unroll
        for (int b = 0; b < 2; ++b)
#pragma unroll
            for (int m = 0; m < 4; ++m)
#pragma unroll
                for (int n = 0; n < 2; ++n) acc[a][b][m][n] = (f32x4){0.f, 0.f, 0.f, 0.f};
    bf16x8 At[4][2], B0[2][2], B1[2][2];
    const char* cA = (const char*)g.A + (size_t)cur.pm * tstepA; const char* cB = (const char*)g.Bt + (size_t)cur.pn * tstepB;
    PG8_STAGE(PG8_SB(0, 0), cB, voffB); PG8_STAGE(PG8_SB(0, 1), cB + hstepB, voffB); PG8_STAGE(PG8_SA(0, 0), cA, voffA); PG8_STAGE(PG8_SA(0, 1), cA + hstepA, voffA);
    if (wr == 1) PG8_BAR;
    PG8_WAIT_V(2); PG8_BAR;
    PG8_STAGE(PG8_SB(1, 0), cB + kstep, voffB); PG8_STAGE(PG8_SA(1, 0), cA + kstep, voffA); PG8_STAGE(PG8_SB(1, 1), cB + hstepB + kstep, voffB);
    PG8_WAIT_V(6); PG8_BAR;
    for (;;) {
        const bool has_next = S.next(ui + 1, nxt);
        const char* nA = has_next ? (const char*)g.A + (size_t)nxt.pm * tstepA : cA; const char* nB = has_next ? (const char*)g.Bt + (size_t)nxt.pn * tstepB : cB;
#pragma nounroll
        for (int t = 0; t < nt; t += 2) {
            const bool last = (t == nt - 2);
            const char* a1 = cA + (size_t)(t + 1) * kstep;
            const char* a2 = last ? nA : cA + (size_t)(t + 2) * kstep; const char* b2 = last ? nB : cB + (size_t)(t + 2) * kstep;
            const char* a3 = a2 + kstep; const char* b3 = b2 + kstep;
            PG8_LDB(B0, 0, 0); PG8_LDB(B1, 0, 1); PG8_SCHED; PG8_LDA(At, 0, 0); PG8_STAGE(PG8_SA(1, 1), a1 + hstepA, voffA);
            PG8_WAIT_V(8); PG8_WAIT_L(0); PG8_BAR; PG8_MMA(0, 0, At, B0); PG8_MMA(0, 1, At, B1); PG8_BAR; PG8_SCHED;
            PG8_LDA(At, 0, 1); PG8_STAGE(PG8_SB(0, 0), b2, voffB); PG8_STAGE(PG8_SB(0, 1), b2 + hstepB, voffB); PG8_STAGE(PG8_SA(0, 0), a2, voffA);
            PG8_WAIT_V(8); PG8_WAIT_L(0); PG8_BAR; PG8_MMA(1, 0, At, B0); PG8_MMA(1, 1, At, B1); PG8_BAR; PG8_SCHED;
            PG8_LDB(B0, 1, 0); PG8_LDB(B1, 1, 1); PG8_SCHED; PG8_LDA(At, 1, 0); PG8_STAGE(PG8_SA(0, 1), a2 + hstepA, voffA);
            PG8_WAIT_V(8); PG8_WAIT_L(0); PG8_BAR; PG8_MMA(0, 0, At, B0); PG8_MMA(0, 1, At, B1); PG8_BAR; PG8_SCHED;
            PG8_LDA(At, 1, 1); PG8_STAGE(PG8_SB(1, 0), b3, voffB); PG8_STAGE(PG8_SB(1, 1), b3 + hstepB, voffB); PG8_STAGE(PG8_SA(1, 0), a3, voffA);
            PG8_WAIT_V(8); PG8_WAIT_L(0); PG8_BAR; PG8_MMA(1, 0, At, B0); PG8_MMA(1, 1, At, B1); PG8_BAR; PG8_SCHED;
        }
        if constexpr (ALIGN_EPI) { if (wr == 0) PG8_BAR; }
        E(acc, cur, wr, wc, fr, fq);
        if (!has_next) break;
#pragma unroll
        for (int a = 0; a < 2; ++a)
#pragma unroll
            for (int b = 0; b < 2; ++b)
#pragma unroll
                for (int m = 0; m < 4; ++m)
#pragma unroll
                    for (int n = 0; n < 2; ++n) acc[a][b][m][n] = (f32x4){0.f, 0.f, 0.f, 0.f};
        cur = nxt; cA = nA; cB = nB; ++ui;
        if constexpr (ALIGN_EPI) { if (wr == 1) PG8_BAR; }
    }
    PG8_WAIT_V(0);
    if constexpr (!ALIGN_EPI) { if (wr == 0) PG8_BAR; }
    PG8_BAR;
#undef PG8_SA
#undef PG8_SB
#undef PG8_STAGE
#undef PG8_LDA
#undef PG8_LDB
#undef PG8_MMA
#undef PG8_WAIT_V
#undef PG8_WAIT_L
#undef PG8_BAR
#undef PG8_SCHED
}

__device__ __forceinline__ void st_bf16x4(bf16_t* p, f32x4 v) { u32x2 w; w.x = cvtpk(v[0], v[1]); w.y = cvtpk(v[2], v[3]); *(u32x2*)p = w; }
#define EPI_LOOP_AM _Pragma("unroll") for (int ai = 0; ai < 2; ++ai) _Pragma("unroll") for (int m = 0; m < 4; ++m)
#define EPI_LOOP_BN _Pragma("unroll") for (int bj = 0; bj < 2; ++bj) _Pragma("unroll") for (int n = 0; n < 2; ++n)

struct EpiPlain {
    bf16_t* O; int ldc;
    __device__ __forceinline__ void operator()(const f32x4 (&acc)[2][2][4][2], const Unit& u, int wr, int wc, int fr, int fq) const {
        const int row0 = u.pm * BM + wr * 64 + fr, col0 = u.pn * BM + wc * 32 + 4 * fq;
        EPI_LOOP_AM { bf16_t* rowp = O + (size_t)(row0 + ai * HALF + m * 16) * ldc + col0;
            EPI_LOOP_BN st_bf16x4(rowp + bj * HALF + n * 16, acc[ai][bj][m][n]); }
    }
};
template <int NP> struct EpiRowScale {
    bf16_t* O; int ldc; const float* ssq; float invn, mul;
    __device__ __forceinline__ void operator()(const f32x4 (&acc)[2][2][4][2], const Unit& u, int wr, int wc, int fr, int fq) const {
        const int row0 = u.pm * BM + wr * 64 + fr, col0 = u.pn * BM + wc * 32 + 4 * fq;
        EPI_LOOP_AM { const int row = row0 + ai * HALF + m * 16; const float rs = rsqrtf(ssq_sum<NP>(ssq + (size_t)row * 16) * invn + EPS) * mul; bf16_t* rowp = O + (size_t)row * ldc + col0;
            EPI_LOOP_BN st_bf16x4(rowp + bj * HALF + n * 16, acc[ai][bj][m][n] * rs);
            if (m & 1) asm volatile("" ::: "memory"); }
    }
};
struct EpiColScale {
    bf16_t* O; int ldc; const float* ssq; float invn;
    __device__ __forceinline__ void operator()(const f32x4 (&acc)[2][2][4][2], const Unit& u, int wr, int wc, int fr, int fq) const {
        const int row0 = u.pm * BM + wr * 64 + fr, col0 = u.pn * BM + wc * 32 + 4 * fq;
        EPI_LOOP_BN { const float* sp = ssq + (size_t)(col0 + bj * HALF + n * 16) * 16;
            const f32x4 rs = (f32x4){rsqrtf(ssq_sum<8>(sp) * invn + EPS), rsqrtf(ssq_sum<8>(sp + 16) * invn + EPS), rsqrtf(ssq_sum<8>(sp + 32) * invn + EPS), rsqrtf(ssq_sum<8>(sp + 48) * invn + EPS)};
            EPI_LOOP_AM st_bf16x4(O + (size_t)(row0 + ai * HALF + m * 16) * ldc + col0 + bj * HALF + n * 16, acc[ai][bj][m][n] * rs);
            asm volatile("" ::: "memory"); }
    }
};
struct EpiRes {
    const float* basef; const bf16_t* baseb; bf16_t* hb; float* ssq;
    __device__ __forceinline__ void operator()(const f32x4 (&acc)[2][2][4][2], const Unit& u, int wr, int wc, int fr, int fq) const {
        const int row0 = u.pm * BM + wr * 64 + fr, col0 = u.pn * BM + wc * 32 + 4 * fq;
        EPI_LOOP_AM { const int row = row0 + ai * HALF + m * 16; const size_t off = (size_t)row * D + col0; float ss = 0.f;
            EPI_LOOP_BN { f32x4 b;
                if (basef) b = *(const f32x4*)(basef + off + bj * HALF + n * 16);
                else { const u32x2 r = *(const u32x2*)(baseb + off + bj * HALF + n * 16); b = (f32x4){bf2f((unsigned short)(r.x & 0xffffu)), bf2f((unsigned short)(r.x >> 16)), bf2f((unsigned short)(r.y & 0xffffu)), bf2f((unsigned short)(r.y >> 16))}; }
                const f32x4 h = b + acc[ai][bj][m][n];
                st_bf16x4(hb + off + bj * HALF + n * 16, h); ss += (h[0] * h[0] + h[1] * h[1]) + (h[2] * h[2] + h[3] * h[3]); }
            ss += __shfl_xor(ss, 16); ss += __shfl_xor(ss, 32);
            if (fq == 0) ssq[(size_t)row * 16 + u.pn * 4 + wc] = ss;
            asm volatile("" ::: "memory"); }
    }
};
struct EpiProj {
    bf16_t* P; float* ssq_q; float* ssq_kv; const float* cr; const float* sr; const float* cm; const float* sm;
    __device__ __forceinline__ void operator()(const f32x4 (&acc)[2][2][4][2], const Unit& u, int wr, int wc, int fr, int fq) const {
        const int row0 = u.pm * BM + wr * 64 + fr;
#pragma unroll
        for (int bj = 0; bj < 2; ++bj) {
            const int hb = 2 * u.pn + bj;
            if (hb == 17 && wc != 0) continue;
            const int kind = hb < 3 ? 0 : hb < 5 ? 1 : hb < 9 ? 2 : hb < 13 ? 3 : hb < 17 ? 4 : 5;
            const int col = hb * HALF + wc * 32 + 4 * fq;
            EPI_LOOP_AM { const int row = row0 + ai * HALF + m * 16; const int s = row & (SEQ - 1);
                f32x4 v0 = acc[ai][bj][m][0], v1 = acc[ai][bj][m][1];
                if (kind <= 1) {
                    float ss = (v0[0] * v0[0] + v0[1] * v0[1]) + (v0[2] * v0[2] + v0[3] * v0[3]) + (v1[0] * v1[0] + v1[1] * v1[1]) + (v1[2] * v1[2] + v1[3] * v1[3]);
                    ss += __shfl_xor(ss, 16); ss += __shfl_xor(ss, 32);
                    if (fq == 0) { if (kind == 0) ssq_q[(size_t)row * 16 + hb * 4 + wc] = ss; else ssq_kv[(size_t)row * 16 + (hb - 3) * 4 + wc] = ss; }
                } else if (kind == 2 || kind == 3) {
                    const f32x4 c = *(const f32x4*)(cr + (size_t)s * 64 + wc * 16 + 4 * fq), sn = *(const f32x4*)(sr + (size_t)s * 64 + wc * 16 + 4 * fq);
                    f32x4 y0 = v0 * c - v1 * sn, y1 = v0 * sn + v1 * c;
                    if (kind == 3) { y0 = y0 * 0.08838834764831845f; y1 = y1 * 0.08838834764831845f; }
                    v0 = y0; v1 = y1;
                } else if (kind == 5) {
                    const f32x4 c = *(const f32x4*)(cm + (size_t)s * 16 + 4 * fq), sn = *(const f32x4*)(sm + (size_t)s * 16 + 4 * fq);
                    const f32x4 y0 = v0 * c - v1 * sn, y1 = v0 * sn + v1 * c; v0 = y0; v1 = y1;
                }
                bf16_t* rowp = P + (size_t)row * NPROJ + col;
                st_bf16x4(rowp, v0); st_bf16x4(rowp + 16, v1);
                if (m & 1) asm volatile("" ::: "memory"); }
        }
    }
};
struct EpiQ {
    bf16_t* O; const float* ssq; const float* cm; const float* sm;
    __device__ __forceinline__ void operator()(const f32x4 (&acc)[2][2][4][2], const Unit& u, int wr, int wc, int fr, int fq) const {
        const int row0 = u.pm * BM + wr * 64 + fr, col0 = u.pn * BM + wc * 32 + 4 * fq;
        EPI_LOOP_AM { const int row = row0 + ai * HALF + m * 16; const int s = row & (SEQ - 1); const float rs = rsqrtf(ssq_sum<12>(ssq + (size_t)row * 16) * (1.f / 384.f) + EPS) * C2_MLA;
            bf16_t* rowp = O + (size_t)row * 768 + col0;
            f32x4 c = (f32x4){1.f, 1.f, 1.f, 1.f}, sn = (f32x4){0.f, 0.f, 0.f, 0.f};
            if (u.pn == 2) { c = *(const f32x4*)(cm + (size_t)s * 16 + 4 * fq); sn = *(const f32x4*)(sm + (size_t)s * 16 + 4 * fq); }
#pragma unroll
            for (int bj = 0; bj < 2; ++bj) { const f32x4 v0 = acc[ai][bj][m][0] * rs, v1 = acc[ai][bj][m][1] * rs;
                st_bf16x4(rowp + bj * HALF, v0 * c - v1 * sn); st_bf16x4(rowp + bj * HALF + 16, v0 * sn + v1 * c); }
            asm volatile("" ::: "memory"); }
    }
};
}

#define XB_TMO      128
#define XB_XCNT(j)  (256  + 64 * (j))
#define XB_XSUB(j)  (1280 + 64 * (j))
#define XB_XGEN(j)  (2304 + 64 * (j))
#define XB_TOP      3328
#define XB_TOPGEN   3392
#define XCD_BAR_WORDS 3456
#define XB_SPIN_CAP (1u << 21)
__device__ __forceinline__ unsigned xb_ld(unsigned* p)              { return __hip_atomic_load(p, __ATOMIC_RELAXED, __HIP_MEMORY_SCOPE_AGENT); }
__device__ __forceinline__ unsigned xb_add(unsigned* p, unsigned v) { return __hip_atomic_fetch_add(p, v, __ATOMIC_RELAXED, __HIP_MEMORY_SCOPE_AGENT); }
__device__ __forceinline__ unsigned xb_xcc_id() { return (unsigned)__builtin_amdgcn_s_getreg((3 << 11) | 20) & 0xFu; }
#define XB_SPIN(cond, bar) do { unsigned _sp = 0; while (cond) { __builtin_amdgcn_s_sleep(1); \
    if ((++_sp & 255u) == 0u) { if (xb_ld(&(bar)[XB_TMO])) break; if (_sp > XB_SPIN_CAP) { atomicAdd(&(bar)[XB_TMO], 1u); break; } } } } while (0)
struct XcdBarrier { unsigned* bar; unsigned x; volatile LAS unsigned* st; };
__device__ __forceinline__ XcdBarrier xcd_barrier_post(unsigned* bar, volatile LAS unsigned* st) {
    XcdBarrier b; b.bar = bar; b.x = xb_xcc_id(); b.st = st;
    if (threadIdx.x == 0) (void)xb_add(&bar[XB_XCNT(b.x)], 1u);
    return b;
}
__device__ __forceinline__ void xcd_barrier_complete(unsigned* bar, unsigned x, unsigned& nloc, unsigned& nx) {
    const unsigned G = gridDim.x * gridDim.y * gridDim.z;
    unsigned sum, cnt, mine, sp = 0u;
    for (;;) {
        sum = 0u; cnt = 0u; mine = 0u;
#pragma unroll
        for (unsigned j = 0; j < 16; ++j) { const unsigned c = xb_ld(&bar[XB_XCNT(j)]); sum += c; cnt += (c > 0u) ? 1u : 0u; mine = (j == x) ? c : mine; }
        if (sum == G) break;
        __builtin_amdgcn_s_sleep(1);
        if ((++sp & 255u) == 0u) { if (xb_ld(&bar[XB_TMO])) break; if (sp > XB_SPIN_CAP) { atomicAdd(&bar[XB_TMO], 1u); break; } }
    }
    nloc = mine > 0u ? mine : 1u; nx = cnt > 0u ? cnt : 1u;
}
__device__ __forceinline__ void xcd_barrier(const XcdBarrier& b) {
    asm volatile("s_waitcnt vmcnt(0)" ::: "memory");
    __syncthreads();
    if (threadIdx.x == 0) {
        unsigned* bar = b.bar;
        __builtin_amdgcn_s_waitcnt(0);
        unsigned nloc = b.st[0], nx = b.st[1];
        if (nloc == 0u) { xcd_barrier_complete(bar, b.x, nloc, nx); b.st[0] = nloc; b.st[1] = nx; }
        const unsigned old = xb_add(&bar[XB_XSUB(b.x)], 1u);
        const unsigned gen = old / nloc;
        if (old + 1u == (gen + 1u) * nloc) {
            __builtin_amdgcn_fence(__ATOMIC_RELEASE, "agent");
            asm volatile("s_waitcnt vmcnt(0)" ::: "memory");
            const unsigned og = xb_add(&bar[XB_TOP], 1u);
            const unsigned tg = og / nx;
            if (og + 1u == (tg + 1u) * nx) xb_add(&bar[XB_TOPGEN], 1u);
            else XB_SPIN(xb_ld(&bar[XB_TOPGEN]) == tg, bar);
            __builtin_amdgcn_fence(__ATOMIC_ACQUIRE, "agent");
            xb_add(&bar[XB_XGEN(b.x)], 1u);
            asm volatile("s_waitcnt vmcnt(0)" ::: "memory");
        } else {
            XB_SPIN(xb_ld(&bar[XB_XGEN(b.x)]) == gen, bar);
            __builtin_amdgcn_fence(__ATOMIC_ACQUIRE, "agent");
            asm volatile("s_waitcnt vmcnt(0)" ::: "memory");
        }
    }
    __syncthreads();
}

struct Params {
    const float *x, *mem, *g_mix, *w_in, *g_q_lora, *w_uq, *g_kv_lora, *w_ukv, *g_ret_gn, *w_o, *g_xattn, *g_mem, *w_xq, *w_xkv, *w_xo, *g_ffn, *w_pq, *sub_keys, *u_exp, *v_exp, *g_final;
    float* out; unsigned char* ws; int never; int pad;
};

__device__ __forceinline__ int permret(int i) { return i < 64 ? ((i >> 4) * 32 + (i & 15)) : (((i - 64) >> 4) * 32 + 16 + ((i - 64) & 15)); }
template <int MODE> __device__ __forceinline__ int dst_row(int c) {
    if (MODE == 1) {
        if (c < 640) return c;
        if (c < 672) return 2176 + (c - 640);
        if (c < 1184) { const int cc = c - 672; return 640 + (cc & ~127) + permret(cc & 127); }
        if (c < 1696) { const int cc = c - 1184; return 1152 + (cc & ~127) + permret(cc & 127); }
        if (c < 2208) return 2304 + (c - 1696);
        return 1664 + (c - 2208);
    } else if (MODE == 2) {
        const int h = c / 96, i = c - h * 96; return i < 64 ? h * 64 + i : 512 + h * 32 + (i - 64);
    } else if (MODE == 3) {
        const int h = c >> 7, i = c & 127; return i < 64 ? h * 64 + i : 512 + h * 64 + (i - 64);
    }
    return c;
}
template <int MODE> __device__ __forceinline__ void p0_transpose_item(const float* W, int K, int N, bf16_t* WT, const float* gain, LAS float* scr, int item, int lane) {
    const int nblk = N / 32, kb = item / nblk, nb = item % nblk, k0 = 64 * kb, n0 = 32 * nb;
    float v[32];
#pragma unroll
    for (int i = 0; i < 32; ++i) { const int kk = 2 * i + (lane >> 5); v[i] = W[(size_t)(k0 + kk) * N + n0 + (lane & 31)]; }
    if (gain) {
#pragma unroll
        for (int i = 0; i < 32; ++i) { const int kk = 2 * i + (lane >> 5); v[i] *= gain[k0 + kk]; }
    }
#pragma unroll
    for (int i = 0; i < 32; ++i) { const int kk = 2 * i + (lane >> 5); scr[kk * 33 + (lane & 31)] = v[i]; }
    LDS_WAIT(); asm volatile("" ::: "memory");
    const int c = lane & 7;
#pragma unroll
    for (int j = 0; j < 4; ++j) { const int n = (lane >> 3) + 8 * j; const LAS float* s = scr + (8 * c) * 33 + n;
        u32x4 o; o.x = cvtpk(s[0 * 33], s[1 * 33]); o.y = cvtpk(s[2 * 33], s[3 * 33]); o.z = cvtpk(s[4 * 33], s[5 * 33]); o.w = cvtpk(s[6 * 33], s[7 * 33]);
        *(u32x4*)(WT + (size_t)dst_row<MODE>(n0 + n) * K + k0 + 8 * c) = o; }
    LDS_WAIT(); asm volatile("" ::: "memory");
}
template <int NR> __device__ __forceinline__ void rms_rows_to_bf16(const float* xrow, const float* g, bf16_t* orow, size_t rstride, int lane) {
    f32x4 v[NR][4];
#pragma unroll
    for (int r = 0; r < NR; ++r)
#pragma unroll
        for (int j = 0; j < 4; ++j) v[r][j] = ((const f32x4*)(xrow + r * rstride) + lane)[64 * j];
    const f32x4* gr = (const f32x4*)g + lane;
    f32x4 gv[4];
#pragma unroll
    for (int j = 0; j < 4; ++j) gv[j] = gr[64 * j];
#pragma unroll
    for (int r = 0; r < NR; ++r) {
        float s = 0.f;
#pragma unroll
        for (int j = 0; j < 4; ++j) s += (v[r][j][0] * v[r][j][0] + v[r][j][1] * v[r][j][1]) + (v[r][j][2] * v[r][j][2] + v[r][j][3] * v[r][j][3]);
        const float rstd = rsqrtf(wave_sum(s) * (1.f / D) + EPS);
        u32x2* o8 = (u32x2*)(orow + r * rstride) + lane;
#pragma unroll
        for (int j = 0; j < 4; ++j) { const f32x4 y = v[r][j] * rstd * gv[j]; u32x2 w; w.x = cvtpk(y[0], y[1]); w.y = cvtpk(y[2], y[3]); o8[64 * j] = w; }
    }
}

struct NoMid { __device__ __forceinline__ void operator()() const {} };
__device__ __forceinline__ float max3f(float a, float b, float c) { return fmaxf(fmaxf(a, b), c); }
template <int NS, int NT, int KG, bool CINIT, class Mid>
__device__ __forceinline__ void flash_tile(const LAS unsigned char* Ks, int kpitch, const LAS unsigned char* Vs, int vpitch, const bf16x8 (&qf)[NS], f32x16 (&o)[NT],
                                           f32x16& negm, float& mref, float& lrun, bool first, int r32, int hi, bool domask, int qrel, int krel, const Mid& mid) {
    f32x16 p0, p1;
    const LAS unsigned char* k0 = Ks + r32 * kpitch + hi * 16; const LAS unsigned char* k1 = k0 + 32 * kpitch;
    if (CINIT) { p0 = negm; p1 = negm; }
    else {
#pragma unroll
        for (int r = 0; r < 16; ++r) { p0[r] = 0.f; p1[r] = 0.f; }
    }
#pragma unroll
    for (int g0 = 0; g0 < NS; g0 += KG) {
        bf16x8 ka[KG], kb2[KG];
#pragma unroll
        for (int s = 0; s < KG; ++s) { ka[s] = *(const LAS bf16x8*)(k0 + (g0 + s) * 32); kb2[s] = *(const LAS bf16x8*)(k1 + (g0 + s) * 32); }
        __builtin_amdgcn_sched_barrier(0);
#pragma unroll
        for (int s = 0; s < KG; ++s) { p0 = MFMA32(ka[s], qf[g0 + s], p0); p1 = MFMA32(kb2[s], qf[g0 + s], p1); }
        __builtin_amdgcn_sched_barrier(0);
    }
    if (!CINIT) {
#pragma unroll
        for (int r = 0; r < 16; ++r) { p0[r] -= mref; p1[r] -= mref; }
    }
    if (domask) {
#pragma unroll
        for (int r = 0; r < 16; ++r) { const int kv = krel + crow(r, hi); if (kv > qrel) p0[r] = -1e30f; if (kv + 32 > qrel) p1[r] = -1e30f; }
    }
    float ma = max3f(p0[0], p0[1], p1[0]), mb = max3f(p0[2], p0[3], p1[1]); ma = max3f(ma, p1[2], p1[3]);
#pragma unroll
    for (int r = 4; r < 16; r += 4) { ma = max3f(ma, p0[r], p0[r + 1]); mb = max3f(mb, p0[r + 2], p0[r + 3]); ma = max3f(ma, p1[r], p1[r + 1]); mb = max3f(mb, p1[r + 2], p1[r + 3]); }
    const float mx = xhalf_max(fmaxf(ma, mb));
    if (first || __any(mx > 8.0f)) {
        const float dl = first ? mx : fmaxf(mx, 0.f);
        mref += dl;
#pragma unroll
        for (int r = 0; r < 16; ++r) { p0[r] -= dl; p1[r] -= dl; if (CINIT) negm[r] = -mref; }
        const float alpha = __builtin_amdgcn_exp2f(-dl);
        lrun *= alpha;
        if (!first) {
#pragma unroll
            for (int t = 0; t < NT; ++t)
#pragma unroll
                for (int r = 0; r < 16; ++r) o[t][r] *= alpha;
        }
    }
    float rs0 = 0.f, rs1 = 0.f;
#pragma unroll
    for (int r = 0; r < 16; ++r) { p0[r] = __builtin_amdgcn_exp2f(p0[r]); p1[r] = __builtin_amdgcn_exp2f(p1[r]); rs0 += p0[r]; rs1 += p1[r]; }
    lrun += rs0 + rs1;
    bf16x8 pb[4];
#pragma unroll
    for (int ks = 0; ks < 2; ++ks) {
        u32x4 w0, w1;
        w0.x = cvtpk(p0[8 * ks + 0], p0[8 * ks + 1]); w0.y = cvtpk(p0[8 * ks + 2], p0[8 * ks + 3]); w0.z = cvtpk(p0[8 * ks + 4], p0[8 * ks + 5]); w0.w = cvtpk(p0[8 * ks + 6], p0[8 * ks + 7]);
        w1.x = cvtpk(p1[8 * ks + 0], p1[8 * ks + 1]); w1.y = cvtpk(p1[8 * ks + 2], p1[8 * ks + 3]); w1.z = cvtpk(p1[8 * ks + 4], p1[8 * ks + 5]); w1.w = cvtpk(p1[8 * ks + 6], p1[8 * ks + 7]);
        pb[ks] = __builtin_bit_cast(bf16x8, w0); pb[2 + ks] = __builtin_bit_cast(bf16x8, w1);
    }
    mid();
    const LAS unsigned char* vb = Vs + r32 * vpitch + hi * 8;
#pragma unroll
    for (int t = 0; t < NT; ++t) {
        s16x4 lo[4], hh[4];
#pragma unroll
        for (int ks = 0; ks < 4; ++ks) { lo[ks] = *(const LAS s16x4*)(vb + t * 32 * vpitch + ks * 32); hh[ks] = *(const LAS s16x4*)(vb + t * 32 * vpitch + ks * 32 + 16); }
        __builtin_amdgcn_sched_barrier(0);
#pragma unroll
        for (int ks = 0; ks < 4; ++ks) { const bf16x8 a = (bf16x8){lo[ks][0], lo[ks][1], lo[ks][2], lo[ks][3], hh[ks][0], hh[ks][1], hh[ks][2], hh[ks][3]}; o[t] = MFMA32(a, pb[ks], o[t]); }
        __builtin_amdgcn_sched_barrier(0);
    }
}

constexpr int MLA_KP = 208, MLA_VP = 264;
constexpr int MLA_KT = 128 * MLA_KP, MLA_VTB = 64 * MLA_VP, MLA_BUF = MLA_KT + MLA_VTB;
__device__ __forceinline__ void mla_unit(LAS unsigned char* lds, int b, int h, int qb, const bf16_t* QM, const bf16_t* KN, const bf16_t* PROJ, const bf16_t* VT, bf16_t* MIX) {
    const int tid = opaque_tid(), lane = tid & 63, r32 = lane & 31, hi = lane >> 5, wid = __builtin_amdgcn_readfirstlane(tid >> 6);
    const size_t tb = (size_t)b * SEQ;
    const int q0 = qb * 256 + wid * 32;
    bf16x8 qf[6];
    { const bf16_t* qr = QM + (tb + q0 + r32) * 768;
#pragma unroll
      for (int s = 0; s < 4; ++s) qf[s] = *(const bf16x8*)(qr + h * 64 + s * 16 + hi * 8);
#pragma unroll
      for (int s = 0; s < 2; ++s) qf[4 + s] = *(const bf16x8*)(qr + 512 + h * 32 + s * 16 + hi * 8); }
    f32x16 o[2], negm;
#pragma unroll
    for (int r = 0; r < 16; ++r) { o[0][r] = 0.f; o[1][r] = 0.f; negm[r] = 0.f; }
    float mref = 0.f, lrun = 0.f;
    const int NCH = 2 * qb + 2;
    const int kr = tid >> 3, kc = tid & 7;
    const int pr = tid >> 2, pc = tid & 3;
    const int vr = tid >> 4, vc = tid & 15;
    const bf16_t* ksrc = KN + (tb + kr) * 512 + h * 64 + kc * 8;
    const bf16_t* psrc = PROJ + (tb + pr) * NPROJ + 2176 + pc * 8;
    const bf16_t* vsrc = VT + (size_t)(h * 64 + vr) * TP + tb + vc * 8;
    struct Stg { u32x4 k0, k1, pe, v0, v1; };
    Stg sa, sb;
    auto stage_load = [&](Stg& s, int ch) { const size_t ko = (size_t)ch * 128;
        s.k0 = *(const u32x4*)(ksrc + ko * 512); s.k1 = *(const u32x4*)(ksrc + (ko + 64) * 512); s.pe = *(const u32x4*)(psrc + ko * NPROJ);
        s.v0 = *(const u32x4*)(vsrc + ko); s.v1 = *(const u32x4*)(vsrc + (size_t)32 * TP + ko); };
    auto stage_write = [&](const Stg& s, int buf) {
        LAS unsigned char* kb = lds + buf * MLA_BUF; LAS unsigned char* vbp = kb + MLA_KT;
        *(LAS u32x4*)(kb + kr * MLA_KP + kc * 16) = s.k0; *(LAS u32x4*)(kb + (kr + 64) * MLA_KP + kc * 16) = s.k1;
        *(LAS u32x4*)(kb + pr * MLA_KP + 128 + pc * 16) = s.pe;
        { LAS unsigned char* d = vbp + vr * MLA_VP + vc * 16; *(LAS u32x2*)d = (u32x2){s.v0.x, s.v0.y}; *(LAS u32x2*)(d + 8) = (u32x2){s.v0.z, s.v0.w}; }
        { LAS unsigned char* d = vbp + (vr + 32) * MLA_VP + vc * 16; *(LAS u32x2*)d = (u32x2){s.v1.x, s.v1.y}; *(LAS u32x2*)(d + 8) = (u32x2){s.v1.z, s.v1.w}; }
    };
    const int qrel = wid * 32 + r32;
    auto compute = [&](int buf, int ch) {
        const LAS unsigned char* kb = lds + buf * MLA_BUF;
#pragma unroll
        for (int j = 0; j < 2; ++j) {
            const int krel = ch * 128 + j * 64 - qb * 256;
            if (krel <= wid * 32 + 31)
                flash_tile<6, 2, 6, true>(kb + j * 64 * MLA_KP, MLA_KP, kb + MLA_KT + j * 128, MLA_VP, qf, o, negm, mref, lrun, ch == 0 && j == 0, r32, hi, krel + 63 > wid * 32, qrel, krel, NoMid());
        }
    };
    stage_load(sa, 0); stage_write(sa, 0);
    stage_load(sa, 1);
    __syncthreads();
    for (int ch = 0; ch < NCH; ch += 2) {
        if (ch + 2 < NCH) stage_load(sb, ch + 2);
        compute(0, ch);
        stage_write(sa, 1);
        __syncthreads();
        if (ch + 3 < NCH) stage_load(sa, ch + 3);
        compute(1, ch + 1);
        if (ch + 2 < NCH) stage_write(sb, 0);
        __syncthreads();
    }
    const float inv = 1.f / xhalf_sum(lrun);
    bf16_t* orow = MIX + (tb + q0 + r32) * D + h * 64;
#pragma unroll
    for (int t = 0; t < 2; ++t)
#pragma unroll
        for (int g = 0; g < 4; ++g) { u32x2 w; w.x = cvtpk(o[t][4 * g] * inv, o[t][4 * g + 1] * inv); w.y = cvtpk(o[t][4 * g + 2] * inv, o[t][4 * g + 3] * inv);
            *(u32x2*)(orow + 32 * t + 8 * g + 4 * hi) = w; }
}

constexpr int XA_KP = 528, XA_VP = 136;
constexpr int XA_KT = 64 * XA_KP, XA_VTB = 128 * XA_VP;
__device__ __forceinline__ void xattn_unit(LAS unsigned char* lds, int b, int h, int qb, int dvh, const bf16_t* QX, const bf16_t* KX, const bf16_t* VXT, bf16_t* OX) {
    const int tid = opaque_tid(), lane = tid & 63, r32 = lane & 31, hi = lane >> 5, wid = __builtin_amdgcn_readfirstlane(tid >> 6);
    const size_t tb = (size_t)b * SEQ;
    const int q0 = qb * 256 + wid * 32;
    bf16x8 qf[16];
    { const bf16_t* qr = QX + (tb + q0 + r32) * D + h * 256 + hi * 8;
#pragma unroll
      for (int s = 0; s < 16; ++s) qf[s] = *(const bf16x8*)(qr + s * 16); }
    f32x16 o[4], negm;
#pragma unroll
    for (int t = 0; t < 4; ++t)
#pragma unroll
        for (int r = 0; r < 16; ++r) o[t][r] = 0.f;
#pragma unroll
    for (int r = 0; r < 16; ++r) negm[r] = 0.f;
    float mref = 0.f, lrun = 0.f;
    const bf16_t* kbase = KX + (size_t)(b * 256) * D + h * 256;
    const bf16_t* vbase = VXT + (size_t)(h * 256 + dvh * 128) * D + b * 256;
    u32x4 kreg[4], vreg[2];
    auto stage_load = [&](int kt) {
#pragma unroll
        for (int i = 0; i < 4; ++i) { const int idx = tid + 512 * i, row = idx >> 5, c = idx & 31; kreg[i] = *(const u32x4*)(kbase + (size_t)(kt * 64 + row) * D + c * 8); }
#pragma unroll
        for (int i = 0; i < 2; ++i) { const int idx = tid + 512 * i, dv = idx >> 3, c = idx & 7; vreg[i] = *(const u32x4*)(vbase + (size_t)dv * D + kt * 64 + c * 8); }
    };
    auto stage_write = [&](int buf) {
        LAS unsigned char* kb = lds + buf * (XA_KT + XA_VTB); LAS unsigned char* vbp = kb + XA_KT;
#pragma unroll
        for (int i = 0; i < 4; ++i) { const int idx = tid + 512 * i, row = idx >> 5, c = idx & 31; *(LAS u32x4*)(kb + row * XA_KP + c * 16) = kreg[i]; }
#pragma unroll
        for (int i = 0; i < 2; ++i) { const int idx = tid + 512 * i, dv = idx >> 3, c = idx & 7;
            *(LAS u32x2*)(vbp + dv * XA_VP + c * 16) = (u32x2){vreg[i].x, vreg[i].y}; *(LAS u32x2*)(vbp + dv * XA_VP + c * 16 + 8) = (u32x2){vreg[i].z, vreg[i].w}; }
    };
    stage_load(0); stage_write(0);
    __syncthreads();
    for (int kt = 0; kt < 4; ++kt) {
        const int buf = kt & 1;
        const LAS unsigned char* kb = lds + buf * (XA_KT + XA_VTB);
        auto mid = [&]() { if (kt + 1 < 4) stage_load(kt + 1); };
        flash_tile<16, 4, 4, false>(kb, XA_KP, kb + XA_KT, XA_VP, qf, o, negm, mref, lrun, kt == 0, r32, hi, false, 0, 0, mid);
        if (kt + 1 < 4) stage_write(buf ^ 1);
        __syncthreads();
    }
    const float inv = 1.f / xhalf_sum(lrun);
    bf16_t* orow = OX + (tb + q0 + r32) * D + h * 256 + dvh * 128;
#pragma unroll
    for (int t = 0; t < 4; ++t)
#pragma unroll
        for (int g = 0; g < 4; ++g) { u32x2 w; w.x = cvtpk(o[t][4 * g] * inv, o[t][4 * g + 1] * inv); w.y = cvtpk(o[t][4 * g + 2] * inv, o[t][4 * g + 3] * inv);
            *(u32x2*)(orow + 32 * t + 8 * g + 4 * hi) = w; }
}

constexpr int RT_P = 272;
constexpr int RT_PV = 264;
__device__ __forceinline__ float ret_log2g(int h) { return log2f(1.0f - exp2f(-5.0f - (float)h)); }
__device__ __forceinline__ void ret_state_unit(LAS unsigned char* lds, int unit, const bf16_t* PROJ, const bf16_t* RVT, bf16_t* RKVT) {
    const int tid = opaque_tid(), lane = tid & 63, r32 = lane & 31, hi = lane >> 5, wid = __builtin_amdgcn_readfirstlane(tid >> 6);
    const int n = unit & 31, h = (unit >> 5) & 3, b = unit >> 7;
    const size_t t0 = (size_t)b * SEQ + n * 128;
    const float l2g = ret_log2g(h);
    LAS unsigned char* Vs = lds;
    LAS unsigned char* Ks = lds + 128 * RT_P;
#pragma unroll
    for (int i = 0; i < 4; ++i) { const int idx = tid + 512 * i, e = idx >> 4, c = idx & 15;
        *(LAS u32x4*)(Vs + e * RT_P + c * 16) = *(const u32x4*)(RVT + (size_t)(h * 128 + e) * TP + t0 + c * 8); }
#pragma unroll
    for (int i = 0; i < 4; ++i) { const int idx = tid + 512 * i, j = idx >> 4, c = idx & 15;
        const u32x4 v = *(const u32x4*)(PROJ + (t0 + j) * NPROJ + 1152 + h * 128 + c * 8);
        const float z = exp2f((float)(127 - j) * l2g);
        const unsigned w[4] = {v.x, v.y, v.z, v.w};
#pragma unroll
        for (int q = 0; q < 4; ++q) { const float lo = bf2f((unsigned short)(w[q] & 0xffffu)) * z, hh = bf2f((unsigned short)(w[q] >> 16)) * z; const unsigned pk = cvtpk(lo, hh);
            *(LAS unsigned short*)(Ks + (c * 8 + 2 * q) * RT_P + j * 2) = (unsigned short)(pk & 0xffffu); *(LAS unsigned short*)(Ks + (c * 8 + 2 * q + 1) * RT_P + j * 2) = (unsigned short)(pk >> 16); } }
    __syncthreads();
    const int eb = (wid & 3) * 32, db = (wid >> 2) * 64;
    f32x16 acc[2];
#pragma unroll
    for (int t = 0; t < 2; ++t)
#pragma unroll
        for (int r = 0; r < 16; ++r) acc[t][r] = 0.f;
#pragma unroll
    for (int ks = 0; ks < 8; ++ks) {
        const bf16x8 a = *(const LAS bf16x8*)(Vs + (eb + r32) * RT_P + ks * 32 + hi * 16);
#pragma unroll
        for (int t = 0; t < 2; ++t) { const bf16x8 bb = *(const LAS bf16x8*)(Ks + (db + 32 * t + r32) * RT_P + ks * 32 + hi * 16); acc[t] = MFMA32(a, bb, acc[t]); }
    }
    bf16_t* O = RKVT + (size_t)unit * 16384;
#pragma unroll
    for (int t = 0; t < 2; ++t)
#pragma unroll
        for (int r = 0; r < 16; ++r) { const unsigned pk = cvtpk(acc[t][r], 0.f); O[(size_t)(eb + crow(r, hi)) * 128 + db + 32 * t + r32] = (unsigned short)(pk & 0xffffu); }
    __syncthreads();
}
__device__ __forceinline__ void ret_out_unit(LAS unsigned char* lds, int unit, const bf16_t* PROJ, const bf16_t* RVT, const bf16_t* RKVT, const float* g_gn, bf16_t* MIX) {
    const int tid = opaque_tid(), lane = tid & 63, r32 = lane & 31, hi = lane >> 5, wid = __builtin_amdgcn_readfirstlane(tid >> 6);
    const int n = unit & 31, h = (unit >> 5) & 3, b = unit >> 7;
    const size_t t0 = (size_t)b * SEQ + n * 128;
    const float l2g = ret_log2g(h);
    LAS unsigned char* Ks = lds;
    LAS unsigned char* Vs = lds + 128 * RT_P;
    LAS unsigned char* Rs = Vs + 128 * RT_PV;
    LAS float* Xs = (LAS float*)(Rs + 128 * RT_P);
#pragma unroll
    for (int i = 0; i < 4; ++i) { const int idx = tid + 512 * i, j = idx >> 4, c = idx & 15;
        *(LAS u32x4*)(Ks + j * RT_P + c * 16) = *(const u32x4*)(PROJ + (t0 + j) * NPROJ + 1152 + h * 128 + c * 8); }
#pragma unroll
    for (int i = 0; i < 4; ++i) { const int idx = tid + 512 * i, e = idx >> 4, c = idx & 15;
        const u32x4 v = *(const u32x4*)(RVT + (size_t)(h * 128 + e) * TP + t0 + c * 8);
        *(LAS u32x2*)(Vs + e * RT_PV + c * 16) = (u32x2){v.x, v.y}; *(LAS u32x2*)(Vs + e * RT_PV + c * 16 + 8) = (u32x2){v.z, v.w}; }
    {
        const bf16_t* src = RKVT + (size_t)unit * 16384;
#pragma unroll
        for (int i = 0; i < 4; ++i) { const int idx = tid + 512 * i, e = idx >> 4, c = idx & 15; *(LAS u32x4*)(Rs + e * RT_P + c * 16) = *(const u32x4*)(src + idx * 8); }
    }
    const int ib = wid & 3, eh = wid >> 2;
    bf16x8 qf[8];
    { const bf16_t* qr = PROJ + (t0 + ib * 32 + r32) * NPROJ + 640 + h * 128 + hi * 8;
#pragma unroll
      for (int s = 0; s < 8; ++s) qf[s] = *(const bf16x8*)(qr + s * 16); }
    __syncthreads();
    f32x16 oi[2], oc[2];
#pragma unroll
    for (int t = 0; t < 2; ++t)
#pragma unroll
        for (int r = 0; r < 16; ++r) { oi[t][r] = 0.f; oc[t][r] = 0.f; }
#pragma unroll
    for (int s = 0; s < 8; ++s)
#pragma unroll
        for (int t = 0; t < 2; ++t) { const bf16x8 a = *(const LAS bf16x8*)(Rs + (eh * 64 + t * 32 + r32) * RT_P + s * 32 + hi * 16); oc[t] = MFMA32(a, qf[s], oc[t]); }
    for (int jt = 0; jt <= ib; ++jt) {
        f32x16 p;
#pragma unroll
        for (int r = 0; r < 16; ++r) p[r] = 0.f;
#pragma unroll
        for (int s = 0; s < 8; ++s) { const bf16x8 a = *(const LAS bf16x8*)(Ks + (jt * 32 + r32) * RT_P + s * 32 + hi * 16); p = MFMA32(a, qf[s], p); }
        const int dbase = (ib - jt) * 32 + r32;
#pragma unroll
        for (int r = 0; r < 16; ++r) { const int dd = dbase - crow(r, hi); p[r] = dd >= 0 ? p[r] * exp2f((float)dd * l2g) : 0.f; }
        bf16x8 pb[2];
#pragma unroll
        for (int ks = 0; ks < 2; ++ks) { u32x4 w; w.x = cvtpk(p[8 * ks + 0], p[8 * ks + 1]); w.y = cvtpk(p[8 * ks + 2], p[8 * ks + 3]); w.z = cvtpk(p[8 * ks + 4], p[8 * ks + 5]); w.w = cvtpk(p[8 * ks + 6], p[8 * ks + 7]); pb[ks] = __builtin_bit_cast(bf16x8, w); }
#pragma unroll
        for (int t = 0; t < 2; ++t)
#pragma unroll
            for (int ks = 0; ks < 2; ++ks) { const LAS unsigned char* vp = Vs + (eh * 64 + t * 32 + r32) * RT_PV + (jt * 32 + ks * 16) * 2 + hi * 8;
                const s16x4 lo = *(const LAS s16x4*)vp, hh = *(const LAS s16x4*)(vp + 16);
                const bf16x8 a = (bf16x8){lo[0], lo[1], lo[2], lo[3], hh[0], hh[1], hh[2], hh[3]}; oi[t] = MFMA32(a, pb[ks], oi[t]); }
    }
    const float xi = exp2f((float)(ib * 32 + r32 + 1) * l2g);
    float s1 = 0.f, s2 = 0.f;
#pragma unroll
    for (int t = 0; t < 2; ++t)
#pragma unroll
        for (int r = 0; r < 16; ++r) { const float v = oi[t][r] + oc[t][r] * xi; oi[t][r] = v; s1 += v; s2 += v * v; }
    s1 = xhalf_sum(s1); s2 = xhalf_sum(s2);
    if (hi == 0) { Xs[(wid * 32 + r32) * 2] = s1; Xs[(wid * 32 + r32) * 2 + 1] = s2; }
    __syncthreads();
    { const int ow = wid ^ 4; s1 += Xs[(ow * 32 + r32) * 2]; s2 += Xs[(ow * 32 + r32) * 2 + 1]; }
    const float mean = s1 * (1.f / 128.f), var = fmaxf(s2 * (1.f / 128.f) - mean * mean, 0.f), rstd = rsqrtf(var + EPS);
    const size_t trow = t0 + ib * 32 + r32;
    const bf16_t* grow = PROJ + trow * NPROJ + 1664 + h * 128;
    bf16_t* orow = MIX + trow * D + 512 + h * 128;
#pragma unroll
    for (int t = 0; t < 2; ++t)
#pragma unroll
        for (int g = 0; g < 4; ++g) { const int e = eh * 64 + t * 32 + 8 * g + 4 * hi;
            const u32x2 gg = *(const u32x2*)(grow + e); const f32x4 gn = *(const f32x4*)(g_gn + h * 128 + e);
            const float rg[4] = {bf2f((unsigned short)(gg.x & 0xffffu)), bf2f((unsigned short)(gg.x >> 16)), bf2f((unsigned short)(gg.y & 0xffffu)), bf2f((unsigned short)(gg.y >> 16))};
            float y[4];
#pragma unroll
            for (int q = 0; q < 4; ++q) { const float sil = rg[q] / (1.f + __expf(-rg[q])); y[q] = (oi[t][4 * g + q] - mean) * rstd * gn[q] * sil; }
            u32x2 w; w.x = cvtpk(y[0], y[1]); w.y = cvtpk(y[2], y[3]); *(u32x2*)(orow + e) = w; }
    __syncthreads();
}

constexpr int PK_P = 272;
constexpr int PEER_SK = 0, PEER_LST = 2 * 128 * PK_P;
constexpr int PEER_ENT = PEER_LST + NWAVES * 4096;
__device__ __forceinline__ unsigned f_ord(float f) { const unsigned u = __float_as_uint(f); return u ^ ((unsigned)((int)u >> 31) | 0x80000000u); }
__device__ __forceinline__ float f_unord(unsigned k) { return __uint_as_float((k & 0x80000000u) ? (k ^ 0x80000000u) : ~k); }
#define TK_INS(L, x) do { unsigned _x = (x); _Pragma("unroll") for (int _j = 0; _j < 16; ++_j) { const unsigned _h = max(_x, L[_j]); _x = min(_x, L[_j]); L[_j] = _h; } } while (0)
__device__ __forceinline__ void tk_merge_partner(unsigned (&L)[16], int hi) {
    unsigned M[16];
#pragma unroll
    for (int i = 0; i < 16; ++i) { const unsigned o = xhalf_other(L[15 - i], hi); M[i] = max(L[i], o); }
#pragma unroll
    for (int st = 8; st >= 1; st >>= 1)
#pragma unroll
        for (int i = 0; i < 16; ++i) if ((i & st) == 0) { const unsigned a = max(M[i], M[i + st]), bq = min(M[i], M[i + st]); M[i] = a; M[i + st] = bq; }
#pragma unroll
    for (int i = 0; i < 16; ++i) L[i] = M[i];
}

__device__ __forceinline__ void peer_phase(LAS unsigned char* lds, const Params& p, int vcu, int G) {
    const int tid = opaque_tid(), lane = tid & 63, r32 = lane & 31, hi = lane >> 5, wid = __builtin_amdgcn_readfirstlane(tid >> 6);
    const bf16_t* SK = (const bf16_t*)(p.ws + WS_SK); const bf16_t* QP = (const bf16_t*)(p.ws + WS_QP);
    const unsigned char* U8 = p.ws + WS_U8; const float* ssq2 = (const float*)(p.ws + WS_SSQ2); unsigned* EG = (unsigned*)(p.ws + WS_EG); float* WG = (float*)(p.ws + WS_WG);
    for (int idx = tid; idx < 2 * 128 * 16; idx += 512) { const int row = idx >> 4, c = idx & 15; *(LAS u32x4*)(lds + PEER_SK + row * PK_P + c * 16) = *(const u32x4*)(SK + row * 128 + c * 8); }
    __syncthreads();
    LAS unsigned* LST = (LAS unsigned*)(lds + PEER_LST + wid * 4096);
    LAS u32x2* ENT = (LAS u32x2*)(lds + PEER_ENT + wid * 4096);
    for (int grp = vcu * NWAVES + wid; grp < T / 4; grp += G * NWAVES) {
        const int tok0 = grp * 4;
        int lg = lane; asm volatile("" : "+v"(lg));
        const int r32 = lg & 31, hi = lg >> 5;
        const unsigned hi4 = (unsigned)hi << 2;
        {
            const bf16_t* qrow = QP + (size_t)(tok0 + (r32 >> 3)) * 2048 + (r32 & 7) * 256 + hi * 8;
            unsigned LA[16], LB[16];
#pragma unroll
            for (int pp = 0; pp < 2; ++pp) {
                bf16x8 qf[8];
#pragma unroll
                for (int s = 0; s < 8; ++s) qf[s] = *(const bf16x8*)(qrow + pp * 128 + s * 16);
                unsigned L[16];
#pragma unroll
                for (int i = 0; i < 16; ++i) L[i] = 0u;
#pragma unroll
                for (int kt = 0; kt < 4; ++kt) {
                    f32x16 sc;
#pragma unroll
                    for (int r = 0; r < 16; ++r) sc[r] = 0.f;
#pragma unroll
                    for (int s = 0; s < 8; ++s) { const bf16x8 a = *(const LAS bf16x8*)(lds + PEER_SK + (pp * 128 + kt * 32 + r32) * PK_P + s * 32 + hi * 16); sc = MFMA32(a, qf[s], sc); }
#pragma unroll
                    for (int r = 0; r < 16; ++r) { const unsigned code = 127u - (unsigned)(32 * kt + (r & 3) + 8 * (r >> 2)); TK_INS(L, ((f_ord(sc[r]) & ~0x7Fu) | code) ^ hi4); }
                }
                tk_merge_partner(L, hi);
#pragma unroll
                for (int i = 0; i < 16; ++i) { if (pp == 0) LA[i] = L[i]; else LB[i] = L[i]; }
            }
#pragma unroll
            for (int i = 0; i < 16; ++i) { LST[i * 32 + r32] = LA[i]; LST[(16 + i) * 32 + r32] = LB[i]; }
            float va[16], vb[16];
#pragma unroll
            for (int i = 0; i < 16; ++i) { va[i] = f_unord(LA[i] & ~0x7Fu); vb[i] = f_unord(LB[i] & ~0x7Fu); }
            unsigned C[16];
#pragma unroll
            for (int i = 0; i < 16; ++i) C[i] = 0u;
#pragma unroll
            for (int i = 0; i < 16; ++i)
#pragma unroll
                for (int j = 0; j < 16; ++j) if ((i + 1) * (j + 1) <= 16) { const unsigned code = 255u - (unsigned)(16 * i + j); TK_INS(C, (f_ord(va[i] + vb[j]) & ~0xFFu) | code); }
            LDS_WAIT();
            float bs[16]; unsigned ex[16]; float mx = -1e30f;
#pragma unroll
            for (int k = 0; k < 16; ++k) { const unsigned code = 255u - (C[k] & 0xFFu); const unsigned i = code >> 4, j = code & 15u;
                const unsigned ka = LST[i * 32 + r32], kbq = LST[(16 + j) * 32 + r32];
                bs[k] = f_unord(ka & ~0x7Fu) + f_unord(kbq & ~0x7Fu); ex[k] = (127u - (ka & 0x7Fu)) * 128u + (127u - (kbq & 0x7Fu)); mx = fmaxf(mx, bs[k]); }
            float sum = 0.f;
#pragma unroll
            for (int k = 0; k < 16; ++k) { bs[k] = __expf(bs[k] - mx); sum += bs[k]; }
            const float rinv = 1.f / sum;
            if (hi == 0) {
#pragma unroll
                for (int k = 0; k < 16; ++k) ENT[(r32 >> 3) * 128 + (r32 & 7) * 16 + k] = (u32x2){ex[k], __float_as_uint(bs[k] * rinv)};
            }
            LDS_WAIT();
        }
        for (int tk = 0; tk < 4; ++tk) {
            const int t = tok0 + tk;
            int ln = lane; asm volatile("" : "+v"(ln));
            const bf16_t* hrow = (const bf16_t*)(p.ws + WS_H2B) + (size_t)t * D + ln * 16;
            f32x2 hv[8];
#pragma unroll
            for (int i = 0; i < 2; ++i) { const u32x4 v = *(const u32x4*)(hrow + 8 * i); const unsigned w[4] = {v.x, v.y, v.z, v.w};
#pragma unroll
                for (int q = 0; q < 4; ++q) hv[4 * i + q] = (f32x2){bf2f((unsigned short)(w[q] & 0xffffu)), bf2f((unsigned short)(w[q] >> 16))}; }
            const float rstd2 = rsqrtf(ssq_sum<16>(ssq2 + (size_t)t * 16) * (1.f / D) + EPS);
            EG[(size_t)t * 128 + ln] = ENT[tk * 128 + ln].x; EG[(size_t)t * 128 + 64 + ln] = ENT[tk * 128 + 64 + ln].x;
            u32x4 ua[16], ub[16];
            { const unsigned ex = ENT[tk * 128 + (ln & 15)].x;
#pragma unroll
              for (int k = 0; k < 16; ++k) { const unsigned e = (unsigned)__builtin_amdgcn_readlane((int)ex, k); ua[k] = *(const u32x4*)(U8 + (size_t)e * D + ln * 16); } }
            auto head = [&](u32x4 (&cur)[16], u32x4 (&nxt)[16], int hd) {
                if (hd < 7) { const unsigned ex = ENT[tk * 128 + (hd + 1) * 16 + (ln & 15)].x;
#pragma unroll
                    for (int k = 0; k < 16; ++k) { const unsigned e = (unsigned)__builtin_amdgcn_readlane((int)ex, k); nxt[k] = *(const u32x4*)(U8 + (size_t)e * D + ln * 16); } }
                const float gate = __uint_as_float(ENT[tk * 128 + hd * 16 + ((ln >> 2) & 15)].y);
                float dt[16];
#pragma unroll
                for (int k = 0; k < 16; ++k) { f32x2 a0 = (f32x2){0.f, 0.f}, a1 = (f32x2){0.f, 0.f}; const unsigned w[4] = {cur[k].x, cur[k].y, cur[k].z, cur[k].w};
#pragma unroll
                    for (int q = 0; q < 4; ++q) { const f32x2 lo = __builtin_amdgcn_cvt_pk_f32_fp8((int)w[q], false), h2 = __builtin_amdgcn_cvt_pk_f32_fp8((int)w[q], true);
                        a0 += lo * hv[2 * q]; a1 += h2 * hv[2 * q + 1]; }
                    const f32x2 a = a0 + a1; dt[k] = a[0] + a[1]; if (k & 1) __builtin_amdgcn_sched_barrier(0); }
                float y8[8], y4[4], y2[2], y1;
                { const bool bsel = (ln & 32) != 0;
#pragma unroll
                  for (int k = 0; k < 8; ++k) { const float snd = bsel ? dt[k] : dt[k + 8], kp = bsel ? dt[k + 8] : dt[k]; y8[k] = kp + __shfl_xor(snd, 32); } }
                { const bool bsel = (ln & 16) != 0;
#pragma unroll
                  for (int k = 0; k < 4; ++k) { const float snd = bsel ? y8[k] : y8[k + 4], kp = bsel ? y8[k + 4] : y8[k]; y4[k] = kp + __shfl_xor(snd, 16); } }
                { const bool bsel = (ln & 8) != 0;
#pragma unroll
                  for (int k = 0; k < 2; ++k) { const float snd = bsel ? y4[k] : y4[k + 2], kp = bsel ? y4[k + 2] : y4[k]; y2[k] = kp + __shfl_xor(snd, 8); } }
                { const bool bsel = (ln & 4) != 0; const float snd = bsel ? y2[0] : y2[1], kp = bsel ? y2[1] : y2[0]; y1 = kp + __shfl_xor(snd, 4); }
                y1 += __shfl_xor(y1, 2); y1 += __shfl_xor(y1, 1);
                const float act = y1 * rstd2 * (1.f / U_SCALE);
                const float wgt = gate * gelu_f(act) * (1.f / V_SCALE);
                if ((ln & 3) == 0) WG[(size_t)t * 128 + hd * 16 + ((ln >> 2) & 15)] = wgt;
            };
            for (int hd = 0; hd < 8; hd += 2) { head(ua, ub, hd); head(ub, ua, hd + 1); }
        }
    }
}

__device__ __forceinline__ void peer_v_phase(const Params& p, int vcu, int G) {
    const int tid = opaque_tid(), lane = tid & 63, wid = __builtin_amdgcn_readfirstlane(tid >> 6);
    const unsigned char* V8 = p.ws + WS_V8; const unsigned* EG = (const unsigned*)(p.ws + WS_EG); const float* WG = (const float*)(p.ws + WS_WG);
    const int g0 = vcu * NWAVES + wid, gs = G * NWAVES;
    const int ngrp = (T / 4 - g0 + gs - 1) / gs, NT = 4 * ngrp;
    if (NT <= 0) return;
    int ln = lane; asm volatile("" : "+v"(ln));
    auto tok = [&](int i) { return (g0 + (i >> 2) * gs) * 4 + (i & 3); };
    unsigned e0, e1, ne0 = 0u, ne1 = 0u; float w0, w1, nw0 = 0.f, nw1 = 0.f;
    { const int t = tok(0); e0 = EG[(size_t)t * 128 + ln]; e1 = EG[(size_t)t * 128 + 64 + ln]; w0 = WG[(size_t)t * 128 + ln]; w1 = WG[(size_t)t * 128 + 64 + ln]; }
    u32x4 va[16], vb[16];
#pragma unroll
    for (int k = 0; k < 16; ++k) { const unsigned e = (unsigned)__builtin_amdgcn_readlane((int)e0, k); va[k] = *(const u32x4*)(V8 + (size_t)e * D + ln * 16); }
    for (int i = 0; i < NT; ++i) {
        const int t = tok(i); const bool more = i + 1 < NT;
        if (more) { const int tn = tok(i + 1); ne0 = EG[(size_t)tn * 128 + ln]; ne1 = EG[(size_t)tn * 128 + 64 + ln]; nw0 = WG[(size_t)tn * 128 + ln]; nw1 = WG[(size_t)tn * 128 + 64 + ln]; }
        float* hrow = p.out + (size_t)t * D + ln * 16;
        f32x4 h3[4];
        f32x2 ov[8];
#pragma unroll
        for (int q = 0; q < 8; ++q) ov[q] = (f32x2){0.f, 0.f};
        auto head = [&](u32x4 (&cur)[16], u32x4 (&nxt)[16], int hd) {
            if (hd < 7) { const int h1 = hd + 1; const unsigned er = (h1 & 4) ? e1 : e0; const int lb = (h1 & 3) * 16;
#pragma unroll
                for (int k = 0; k < 16; ++k) { const unsigned e = (unsigned)__builtin_amdgcn_readlane((int)er, lb + k); nxt[k] = *(const u32x4*)(V8 + (size_t)e * D + ln * 16); } }
            else if (more) {
#pragma unroll
                for (int k = 0; k < 16; ++k) { const unsigned e = (unsigned)__builtin_amdgcn_readlane((int)ne0, k); nxt[k] = *(const u32x4*)(V8 + (size_t)e * D + ln * 16); } }
            const float wr = (hd & 4) ? w1 : w0; const int lb0 = (hd & 3) * 16;
#pragma unroll
            for (int k = 0; k < 16; ++k) { const float wk = __uint_as_float((unsigned)__builtin_amdgcn_readlane((int)__float_as_uint(wr), lb0 + k)); const f32x2 wk2 = (f32x2){wk, wk};
                const unsigned w[4] = {cur[k].x, cur[k].y, cur[k].z, cur[k].w};
#pragma unroll
                for (int q = 0; q < 4; ++q) { const f32x2 lo = __builtin_amdgcn_cvt_pk_f32_fp8((int)w[q], false), h2 = __builtin_amdgcn_cvt_pk_f32_fp8((int)w[q], true);
                    ov[2 * q] += wk2 * lo; ov[2 * q + 1] += wk2 * h2; }
                if (k & 1) __builtin_amdgcn_sched_barrier(0); }
        };
        for (int hd = 0; hd < 6; hd += 2) { head(va, vb, hd); head(vb, va, hd + 1); }
        { const bf16_t* hb = (const bf16_t*)(p.ws + WS_H2B) + (size_t)t * D + ln * 16;
#pragma unroll
          for (int q2 = 0; q2 < 2; ++q2) { const u32x4 v = *(const u32x4*)(hb + 8 * q2);
              h3[2 * q2] = (f32x4){bf2f((unsigned short)(v.x & 0xffffu)), bf2f((unsigned short)(v.x >> 16)), bf2f((unsigned short)(v.y & 0xffffu)), bf2f((unsigned short)(v.y >> 16))};
              h3[2 * q2 + 1] = (f32x4){bf2f((unsigned short)(v.z & 0xffffu)), bf2f((unsigned short)(v.z >> 16)), bf2f((unsigned short)(v.w & 0xffffu)), bf2f((unsigned short)(v.w >> 16))}; } }
        head(va, vb, 6); head(vb, va, 7);
        float ss = 0.f;
#pragma unroll
        for (int q = 0; q < 4; ++q) { h3[q] = h3[q] + (f32x4){ov[2 * q][0], ov[2 * q][1], ov[2 * q + 1][0], ov[2 * q + 1][1]};
            ss += (h3[q][0] * h3[q][0] + h3[q][1] * h3[q][1]) + (h3[q][2] * h3[q][2] + h3[q][3] * h3[q][3]); }
        const float rstd3 = rsqrtf(wave_sum(ss) * (1.f / D) + EPS);
#pragma unroll
        for (int q = 0; q < 4; ++q) { const f32x4 gf = *(const f32x4*)(p.g_final + ln * 16 + 4 * q); *(f32x4*)(hrow + 4 * q) = h3[q] * rstd3 * gf; }
        e0 = ne0; e1 = ne1; w0 = nw0; w1 = nw1;
    }
}

#ifndef PH_MASK
#define PH_MASK 0xFFFF
#endif
#define PH(k) ((PH_MASK >> (k)) & 1)
#ifndef GEMM_ALIGN
#define GEMM_ALIGN true
#endif
#ifndef REP_MASK
#define REP_MASK 0
#endif
#if (REP_MASK >> 0) & 1
#define REP_0 for (int rep_ = 0; rep_ < 2; ++rep_)
#else
#define REP_0
#endif
#if (REP_MASK >> 1) & 1
#define REP_1 for (int rep_ = 0; rep_ < 2; ++rep_)
#else
#define REP_1
#endif
#if (REP_MASK >> 2) & 1
#define REP_2 for (int rep_ = 0; rep_ < 2; ++rep_)
#else
#define REP_2
#endif
#if (REP_MASK >> 3) & 1
#define REP_3 for (int rep_ = 0; rep_ < 2; ++rep_)
#else
#define REP_3
#endif
#if (REP_MASK >> 4) & 1
#define REP_4 for (int rep_ = 0; rep_ < 2; ++rep_)
#else
#define REP_4
#endif
#if (REP_MASK >> 5) & 1
#define REP_5 for (int rep_ = 0; rep_ < 2; ++rep_)
#else
#define REP_5
#endif
#if (REP_MASK >> 6) & 1
#define REP_6 for (int rep_ = 0; rep_ < 2; ++rep_)
#else
#define REP_6
#endif
#if (REP_MASK >> 7) & 1
#define REP_7 for (int rep_ = 0; rep_ < 2; ++rep_)
#else
#define REP_7
#endif
#if (REP_MASK >> 8) & 1
#define REP_8 for (int rep_ = 0; rep_ < 2; ++rep_)
#else
#define REP_8
#endif
#define REP(k) REP_##k
__global__ void __launch_bounds__(NWAVES * 64, 2) fwd_megakernel(Params p) {
    extern __shared__ __attribute__((aligned(16))) unsigned char lds_raw[];
    LAS unsigned char* lds = (LAS unsigned char*)lds_raw;
    const int tid = threadIdx.x, lane = tid & 63, wave = __builtin_amdgcn_readfirstlane(tid >> 6);
    const int G = gridDim.x; const int bx = blockIdx.x;
    const int vcu = (G % 8 == 0) ? (bx % 8) * (G / 8) + bx / 8 : bx;
    if (p.never) { cg::this_grid().sync(); }
    unsigned char* const ws = p.ws;
    volatile LAS unsigned* MISC = (volatile LAS unsigned*)(lds + LDSCTL_OFF);
    for (int u = tid; u < (LDS_BYTES - LDSCTL_OFF) / 4; u += NWAVES * 64) ((LAS unsigned*)(lds + LDSCTL_OFF))[u] = 0u;
    __syncthreads();
    XcdBarrier bar = xcd_barrier_post((unsigned*)(ws + WS_CTL) + CW_BAR, MISC + 8);
    const int gw = vcu * NWAVES + wave, NGW = G * NWAVES;

#define WSB(off) ((bf16_t*)(p.ws + (off)))
#define WSF(off) ((float*)(p.ws + (off)))
    REP(0) {
    if (PH(0))
    {
        LAS float* scr = (LAS float*)(lds + wave * 16384);
        constexpr int I_IN = 16 * 85, I_XKV = 16 * 64;
        constexpr int NITEMS = I_IN + I_XKV;
        for (int it = gw; it < NITEMS; it += NGW) {
            int r = it;
            if (r < I_IN) { p0_transpose_item<1>(p.w_in, 1024, 2720, WSB(WS_WIN), nullptr, scr, r, lane); continue; } r -= I_IN;
            p0_transpose_item<0>(p.w_xkv, 1024, 2048, WSB(WS_WXKV), nullptr, scr, r, lane);
        }
        for (int m = gw; m < T / 4; m += NGW) rms_rows_to_bf16<4>(p.x + (size_t)m * D, p.g_mix, WSB(WS_A0) + (size_t)m * D, (size_t)(T / 4) * D, lane);
        for (int m = gw; m < 1024; m += NGW) rms_rows_to_bf16<1>(p.mem + (size_t)m * D, p.g_mem, WSB(WS_MEMN) + (size_t)m * D, 0, lane);
        const int gt = vcu * 512 + tid, NGT = G * 512;
        for (int i = gt; i < 2 * 128 * 128 / 2; i += NGT) { const f32x2 v = *(const f32x2*)(p.sub_keys + 2 * i); ((unsigned*)WSB(WS_SK))[i] = cvtpk(v[0], v[1]); }
        for (int i = gt; i < 96 * 1024 / 8; i += NGT) ((u32x4*)(WSB(WS_WIN) + (size_t)2208 * 1024))[i] = (u32x4){0u, 0u, 0u, 0u};
        for (int i = gt; i < SEQ * 64; i += NGT) { const int s = i >> 6, f = i & 63; const float inv = exp2f(-(float)f * (13.287712379549449f / 64.f)); const float ang = (float)s * inv;
            const double rev = (double)ang * 0.15915494309189535; const float fr = (float)(rev - floor(rev)); WSF(WS_CR)[i] = __builtin_amdgcn_cosf(fr); WSF(WS_SR)[i] = __builtin_amdgcn_sinf(fr); }
        for (int i = gt; i < SEQ * 16; i += NGT) { const int s = i >> 4, f = i & 15; const float inv = exp2f(-(float)f * (13.287712379549449f / 16.f)); const float ang = (float)s * inv;
            const double rev = (double)ang * 0.15915494309189535; const float fr = (float)(rev - floor(rev)); WSF(WS_CM)[i] = __builtin_amdgcn_cosf(fr); WSF(WS_SM)[i] = __builtin_amdgcn_sinf(fr); }
    }
    xcd_barrier(bar);
#ifdef DBL_BAR
    xcd_barrier(bar);
#endif
    }

    REP(1) {
    if (PH(1))
    {
        { pg8::Gemm g{WSB(WS_A0), WSB(WS_WIN), T, NPROJ, 1024, 1024, 1024}; pg8::StaticOrder S; S.init(T, NPROJ, G, bx);
          pg8::EpiProj E{WSB(WS_PROJ), WSF(WS_SSQQ), WSF(WS_SSQKV), WSF(WS_CR), WSF(WS_SR), WSF(WS_CM), WSF(WS_SM)}; pg8::gemm_phase<pg8::EpiProj, pg8::StaticOrder, GEMM_ALIGN>(lds, g, S, E); }
        { pg8::Gemm g{WSB(WS_WIN) + (size_t)2304 * 1024, WSB(WS_A0), 512, T, 1024, 1024, 1024}; pg8::StaticOrder S; S.init(512, T, G, (bx - 64 + G) % G);
          pg8::EpiPlain E{WSB(WS_RVT), TP}; pg8::gemm_phase<pg8::EpiPlain, pg8::StaticOrder, GEMM_ALIGN>(lds, g, S, E); }
        { pg8::Gemm g{WSB(WS_MEMN), WSB(WS_WXKV), 1024, 1024, 1024, 1024, 1024}; pg8::StaticOrder S; S.init(1024, 1024, G, (bx - 192 + G) % G);
          pg8::EpiPlain E{WSB(WS_KX), 1024}; pg8::gemm_phase<pg8::EpiPlain, pg8::StaticOrder, GEMM_ALIGN>(lds, g, S, E); }
        { pg8::Gemm g{WSB(WS_WXKV) + (size_t)1024 * 1024, WSB(WS_MEMN), 1024, 1024, 1024, 1024, 1024}; pg8::StaticOrder S; S.init(1024, 1024, G, (bx - 208 + G) % G);
          pg8::EpiPlain E{WSB(WS_VXT), 1024}; pg8::gemm_phase<pg8::EpiPlain, pg8::StaticOrder, GEMM_ALIGN>(lds, g, S, E); }
        {
            const int nd = G >= 64 ? 32 : G, d0 = G - nd;
            if (bx >= d0) {
                LAS float* scr = (LAS float*)(lds + wave * 16384);
                constexpr int I_UQ = 6 * 24, I_UKV = 4 * 32, I_SQ = 16 * 32, I_PQ = 16 * 64;
                constexpr int NITEMS = I_UQ + I_UKV + 3 * I_SQ + I_PQ;
                for (int it = (bx - d0) * NWAVES + wave; it < NITEMS; it += nd * NWAVES) {
                    int r = it;
                    if (r < I_UQ) { p0_transpose_item<2>(p.w_uq, 384, 768, WSB(WS_WUQ), p.g_q_lora, scr, r, lane); continue; } r -= I_UQ;
                    if (r < I_UKV) { p0_transpose_item<3>(p.w_ukv, 256, 1024, WSB(WS_WUKV), p.g_kv_lora, scr, r, lane); continue; } r -= I_UKV;
                    if (r < I_SQ) { p0_transpose_item<0>(p.w_o, 1024, 1024, WSB(WS_WO), nullptr, scr, r, lane); continue; } r -= I_SQ;
                    if (r < I_SQ) { p0_transpose_item<0>(p.w_xq, 1024, 1024, WSB(WS_WXQ), p.g_xattn, scr, r, lane); continue; } r -= I_SQ;
                    if (r < I_SQ) { p0_transpose_item<0>(p.w_xo, 1024, 1024, WSB(WS_WXO), nullptr, scr, r, lane); continue; } r -= I_SQ;
                    p0_transpose_item<0>(p.w_pq, 1024, 2048, WSB(WS_WPQ), p.g_ffn, scr, r, lane);
                }
            }
        }
    }
    xcd_barrier(bar);
#ifdef DBL_BAR
    xcd_barrier(bar);
#endif
    }

    REP(2) {
    if (PH(2))
    {
        { pg8::Gemm g{WSB(WS_PROJ), WSB(WS_WUQ), T, 768, 384, NPROJ, 384}; pg8::StaticOrder S; S.init(T, 768, G, bx);
          pg8::EpiQ E{WSB(WS_QM), WSF(WS_SSQQ), WSF(WS_CM), WSF(WS_SM)}; pg8::gemm_phase<pg8::EpiQ, pg8::StaticOrder, GEMM_ALIGN>(lds, g, S, E); }
        { pg8::Gemm g{WSB(WS_PROJ) + 384, WSB(WS_WUKV), T, 512, 256, NPROJ, 256}; pg8::StaticOrder S; S.init(T, 512, G, (bx - 192 + G) % G);
          pg8::EpiRowScale<8> E{WSB(WS_KN), 512, WSF(WS_SSQKV), 1.f / 256.f, 1.f}; pg8::gemm_phase<pg8::EpiRowScale<8>, pg8::StaticOrder, GEMM_ALIGN>(lds, g, S, E); }
        { pg8::Gemm g{WSB(WS_WUKV) + (size_t)512 * 256, WSB(WS_PROJ) + 384, 512, T, 256, 256, NPROJ}; pg8::StaticOrder S; S.init(512, T, G, (bx - 64 + G) % G);
          pg8::EpiColScale E{WSB(WS_VT), TP, WSF(WS_SSQKV), 1.f / 256.f}; pg8::gemm_phase<pg8::EpiColScale, pg8::StaticOrder, GEMM_ALIGN>(lds, g, S, E); }
        for (int u = vcu; u < 512; u += G) ret_state_unit(lds, u, WSB(WS_PROJ), WSB(WS_RVT), WSB(WS_RKVT));
    }
    xcd_barrier(bar);
#ifdef DBL_BAR
    xcd_barrier(bar);
#endif
    }

    REP(3) {
    if (PH(3))
    {
        unsigned* scan_cnt = (unsigned*)(p.ws + WS_CTL) + CW_QUEUE + 64 * Q3_SLOT;
#if (REP_MASK >> 3) & 1
        if (rep_ == 0)
#endif
        {
            bf16_t* RK = WSB(WS_RKVT);
            for (int e2 = vcu * 512 + tid; e2 < 16 * 8192; e2 += G * 512) {
                const int bh = e2 >> 13, off = e2 & 8191; const float cd = exp2f(128.f * ret_log2g(bh & 3));
                unsigned* base = (unsigned*)(RK + (size_t)bh * 32 * 16384) + off;
                unsigned x[32];
#pragma unroll
                for (int n = 0; n < 32; ++n) x[n] = base[(size_t)n * 8192];
                float r0 = 0.f, r1 = 0.f;
#pragma unroll
                for (int n = 0; n < 32; ++n) { const unsigned o = cvtpk(r0, r1); r0 = r0 * cd + bf2f((unsigned short)(x[n] & 0xffffu)); r1 = r1 * cd + bf2f((unsigned short)(x[n] >> 16)); base[(size_t)n * 8192] = o; }
            }
            asm volatile("s_waitcnt vmcnt(0)" ::: "memory");
            __syncthreads();
            if (tid == 0) { __builtin_amdgcn_fence(__ATOMIC_RELEASE, "agent"); asm volatile("s_waitcnt vmcnt(0)" ::: "memory"); __hip_atomic_fetch_add(scan_cnt, 1u, __ATOMIC_RELAXED, __HIP_MEMORY_SCOPE_AGENT); }
        }
#ifdef REP_MLA
        for (int rr_ = 0; rr_ < REP_MLA; ++rr_)
#endif
        for (int v2 = 2 * vcu; v2 < 512; v2 += (v2 & 1) ? 2 * G - 1 : 1) { const int v = v2 >> 1, bh = v >> 3, s = v & 7;
            mla_unit(lds, bh >> 3, bh & 7, (v2 & 1) ? s : 15 - s, WSB(WS_QM), WSB(WS_KN), WSB(WS_PROJ), WSB(WS_VT), WSB(WS_MIX)); }
        if (tid == 0) { unsigned sp = 0; while (__hip_atomic_load(scan_cnt, __ATOMIC_RELAXED, __HIP_MEMORY_SCOPE_AGENT) < (unsigned)G) { __builtin_amdgcn_s_sleep(2); if (++sp > XB_SPIN_CAP) break; }
            __builtin_amdgcn_fence(__ATOMIC_ACQUIRE, "agent"); asm volatile("s_waitcnt vmcnt(0)" ::: "memory"); }
        __syncthreads();
#ifdef REP_RET
        for (int rr_ = 0; rr_ < 2; ++rr_)
#endif
        for (int u = vcu; u < 512; u += G) ret_out_unit(lds, u, WSB(WS_PROJ), WSB(WS_RVT), WSB(WS_RKVT), p.g_ret_gn, WSB(WS_MIX));
    }
    xcd_barrier(bar);
#ifdef DBL_BAR
    xcd_barrier(bar);
#endif
    }

    REP(4) {
    if (PH(4))
#ifdef REP_P4NB
    for (int nb_ = 0; nb_ < 2; ++nb_)
#endif
    { pg8::Gemm g{WSB(WS_MIX), WSB(WS_WO), T, 1024, 1024, 1024, 1024}; pg8::StaticOrder S; S.init(T, 1024, G, bx);
      pg8::EpiRes E{p.x, nullptr, WSB(WS_H1B), WSF(WS_SSQ1)}; pg8::gemm_phase<pg8::EpiRes, pg8::StaticOrder, GEMM_ALIGN>(lds, g, S, E); }
    xcd_barrier(bar);
#ifdef DBL_BAR
    xcd_barrier(bar);
#endif
    }

    REP(5) {
    if (PH(5))
    { pg8::Gemm g{WSB(WS_H1B), WSB(WS_WXQ), T, 1024, 1024, 1024, 1024}; pg8::StaticOrder S; S.init(T, 1024, G, bx);
      pg8::EpiRowScale<16> E{WSB(WS_QX), 1024, WSF(WS_SSQ1), 1.f / 1024.f, C2_X}; pg8::gemm_phase<pg8::EpiRowScale<16>, pg8::StaticOrder, GEMM_ALIGN>(lds, g, S, E); }
    xcd_barrier(bar);
#ifdef DBL_BAR
    xcd_barrier(bar);
#endif
    }

    REP(6) {
    if (PH(6))
    {
        for (int u = vcu; u < 512; u += G) { const int dvh = u & 1, qb = (u >> 1) & 15, h = (u >> 5) & 3, b = u >> 7; xattn_unit(lds, b, h, qb, dvh, WSB(WS_QX), WSB(WS_KX), WSB(WS_VXT), WSB(WS_OX)); }
        unsigned char* U8 = ws + WS_U8; unsigned char* V8 = ws + WS_V8;
        const f32x4* gf = (const f32x4*)p.g_ffn + lane * 4;
        f32x4 gs[4];
#pragma unroll
        for (int i = 0; i < 4; ++i) gs[i] = gf[i] * U_SCALE;
        for (int e = gw; e < 2 * 16384; e += NGW) {
            const bool isv = e >= 16384; const int row = isv ? e - 16384 : e;
            const f32x4* src = (const f32x4*)((isv ? p.v_exp : p.u_exp) + (size_t)row * D) + lane * 4;
            u32x4 o; unsigned ow[4];
#pragma unroll
            for (int i = 0; i < 4; ++i) { f32x4 v = src[i]; v = isv ? v * V_SCALE : v * gs[i]; int pk = 0; pk = __builtin_amdgcn_cvt_pk_fp8_f32(v[0], v[1], pk, false); pk = __builtin_amdgcn_cvt_pk_fp8_f32(v[2], v[3], pk, true); ow[i] = (unsigned)pk; }
            o.x = ow[0]; o.y = ow[1]; o.z = ow[2]; o.w = ow[3];
            *(u32x4*)((isv ? V8 : U8) + (size_t)row * D + lane * 16) = o;
        }
    }
    xcd_barrier(bar);
#ifdef DBL_BAR
    xcd_barrier(bar);
#endif
    }

    REP(7) {
    if (PH(7))
    { pg8::Gemm g{WSB(WS_OX), WSB(WS_WXO), T, 1024, 1024, 1024, 1024}; pg8::StaticOrder S; S.init(T, 1024, G, bx);
      pg8::EpiRes E{nullptr, WSB(WS_H1B), WSB(WS_H2B), WSF(WS_SSQ2)}; pg8::gemm_phase<pg8::EpiRes, pg8::StaticOrder, GEMM_ALIGN>(lds, g, S, E); }
    xcd_barrier(bar);
#ifdef DBL_BAR
    xcd_barrier(bar);
#endif
    }

    REP(8) {
    if (PH(8))
    { pg8::Gemm g{WSB(WS_H2B), WSB(WS_WPQ), T, 2048, 1024, 1024, 1024}; pg8::StaticOrder S; S.init(T, 2048, G, bx);
      pg8::EpiRowScale<16> E{WSB(WS_QP), 2048, WSF(WS_SSQ2), 1.f / 1024.f, 1.f}; pg8::gemm_phase<pg8::EpiRowScale<16>, pg8::StaticOrder, GEMM_ALIGN>(lds, g, S, E); }
    xcd_barrier(bar);
#ifdef DBL_BAR
    xcd_barrier(bar);
#endif
    }

    if (PH(9))
    { peer_phase(lds, p, vcu, G);
      xcd_barrier(bar);
      peer_v_phase(p, vcu, G); }
}

extern "C" void kernel_launch(void* const* d_in, const int* in_sizes, int n_in, void* d_out, int out_size, void* d_ws, size_t ws_size, hipStream_t stream) {
    static int grid = 0;
    if (grid == 0) {
        if (n_in != 21 || out_size != T * D || ws_size < WS_END) { fprintf(stderr, "kernel_launch: unexpected shapes (n_in %d out %d ws %zu)\n", n_in, out_size, ws_size); grid = -1; return; }
        int dev = 0, cus = 0, per_cu = 0;
        if (hipGetDevice(&dev) != hipSuccess || hipDeviceGetAttribute(&cus, hipDeviceAttributeMultiprocessorCount, dev) != hipSuccess) { grid = -1; return; }
        if (hipFuncSetAttribute((const void*)fwd_megakernel, hipFuncAttributeMaxDynamicSharedMemorySize, LDS_BYTES) != hipSuccess) { fprintf(stderr, "kernel_launch: hipFuncSetAttribute failed\n"); grid = -1; return; }
        if (hipOccupancyMaxActiveBlocksPerMultiprocessor(&per_cu, (const void*)fwd_megakernel, NWAVES * 64, LDS_BYTES) != hipSuccess || per_cu < 1) { fprintf(stderr, "kernel_launch: occupancy query says %d\n", per_cu); grid = -1; return; }
        (void)hipGetLastError();
        grid = cus;
    }
    if (grid < 0) return;
    (void)hipMemsetAsync((char*)d_ws + WS_CTL, 0, CTL_ZERO_BYTES, stream);
    Params p{};
    const float** pp = (const float**)&p;
    for (int i = 0; i < 21; ++i) pp[i] = (const float*)d_in[i];
    p.out = (float*)d_out; p.ws = (unsigned char*)d_ws; p.never = 0; p.pad = 0;
    void* args[] = {&p};
    hipError_t e = hipLaunchCooperativeKernel((const void*)fwd_megakernel, dim3(grid), dim3(NWAVES * 64), args, LDS_BYTES, stream);
    if (e != hipSuccess) fprintf(stderr, "cooperative launch failed: %s (grid %d)\n", hipGetErrorString(e), grid);
}
```

```cpp
#include <hip/hip_runtime.h>
#include <hip/hip_cooperative_groups.h>
#include <cstdio>
#include <cstdint>
namespace cg = cooperative_groups;

#define LAS __attribute__((address_space(3)))
#define GAS __attribute__((address_space(1)))
typedef unsigned short bf16_t;
typedef short bf16x8 __attribute__((ext_vector_type(8)));
typedef short s16x4 __attribute__((ext_vector_type(4)));
typedef float f32x4 __attribute__((ext_vector_type(4)));
typedef float f32x2 __attribute__((ext_vector_type(2)));
typedef float f32x16 __attribute__((ext_vector_type(16)));
typedef unsigned u32x4 __attribute__((ext_vector_type(4)));
typedef unsigned u32x2 __attribute__((ext_vector_type(2)));
typedef __bf16 bf16x2_t __attribute__((ext_vector_type(2)));

constexpr int T = 16384, D = 1024, SEQ = 4096;
constexpr int NPROJ = 2304;
constexpr int NWIN = 2816;
constexpr float EPS = 1e-6f;
constexpr float LOG2E = 1.4426950408889634f;
constexpr float C2_MLA = 0.10206207261596575f * LOG2E;
constexpr float C2_X = 0.0625f * LOG2E;
constexpr float U_SCALE = 512.f, V_SCALE = 64.f;

constexpr size_t MiB = 1u << 20;
constexpr size_t WS_CTL = 0, CTL_ZERO_BYTES = 1 * MiB;
constexpr size_t WS_SSQQ = 227 * MiB, WS_SSQKV = 228 * MiB, WS_SSQ1 = 229 * MiB, WS_SSQ2 = 230 * MiB;
constexpr size_t WS_CR = 1 * MiB, WS_SR = 2 * MiB, WS_CM = 3 * MiB, WS_SM = 3 * MiB + 256 * 1024;
constexpr size_t WS_WIN = 4 * MiB, WS_WUQ = 10 * MiB, WS_WUKV = 11 * MiB, WS_WO = 12 * MiB, WS_WXQ = 14 * MiB, WS_WXKV = 16 * MiB, WS_WXO = 20 * MiB, WS_WPQ = 22 * MiB, WS_SK = 26 * MiB;
constexpr size_t WS_MEMN = 27 * MiB, WS_KX = 29 * MiB, WS_VXT = 31 * MiB;
constexpr size_t WS_A0 = 33 * MiB, WS_MIX = 33 * MiB, WS_QX = 33 * MiB;
constexpr size_t WS_EG = 33 * MiB, WS_WG = 41 * MiB, WS_SSQ3 = 49 * MiB, WS_PART = 65 * MiB;
constexpr size_t WS_PROJ = 65 * MiB, WS_H1B = 65 * MiB, WS_U8 = 137 * MiB, WS_V8 = 153 * MiB;
constexpr size_t WS_OX = 97 * MiB, WS_H2B = 169 * MiB, WS_QP = 65 * MiB;
constexpr size_t WS_RVT = 137 * MiB, WS_QM = 154 * MiB, WS_KN = 178 * MiB, WS_VT = 194 * MiB, WS_RKVT = 211 * MiB;
constexpr int TP = T + 64;
constexpr size_t WS_END = 231 * MiB;
constexpr int CW_BAR = 4096;
constexpr int CW_XRANK = 20480;
constexpr int CW_QUEUE = 16384, Q3_SLOT = 0;

constexpr int RING_BYTES = 131072;
constexpr int LDSCTL_OFF = 143360;
constexpr int LDS_BYTES = 147456;
constexpr int NWAVES = 8;

__device__ __forceinline__ unsigned cvtpk(float lo, float hi) { f32x2 v = {lo, hi}; bf16x2_t b = __builtin_convertvector(v, bf16x2_t); return __builtin_bit_cast(unsigned, b); }
__device__ __forceinline__ float bf2f(unsigned short b) { return __uint_as_float(((unsigned)b) << 16); }
__device__ __forceinline__ int crow(int r, int hi) { return (r & 3) + 8 * (r >> 2) + 4 * hi; }
__device__ __forceinline__ float wave_sum(float v) {
#pragma unroll
    for (int o = 1; o < 64; o <<= 1) v += __shfl_xor(v, o);
    return v;
}
__device__ __forceinline__ float xhalf_max(float m) { auto rr = __builtin_amdgcn_permlane32_swap(__float_as_uint(m), __float_as_uint(m), false, false); return fmaxf(__uint_as_float(rr[0]), __uint_as_float(rr[1])); }
__device__ __forceinline__ float xhalf_sum(float m) { auto rr = __builtin_amdgcn_permlane32_swap(__float_as_uint(m), __float_as_uint(m), false, false); return __uint_as_float(rr[0]) + __uint_as_float(rr[1]); }
__device__ __forceinline__ unsigned xhalf_other(unsigned m, int hi) { auto rr = __builtin_amdgcn_permlane32_swap(m, m, false, false); return hi ? rr[0] : rr[1]; }
#define LDS_WAIT() asm volatile("s_waitcnt lgkmcnt(0)" ::: "memory")
template <int NP> __device__ __forceinline__ float ssq_sum(const float* part) {
    float s = 0.f;
#pragma unroll
    for (int i = 0; i < NP / 4; ++i) { const f32x4 v = *(const f32x4*)(part + 4 * i); s += v[0]; s += v[1]; s += v[2]; s += v[3]; }
    return s;
}
__device__ __forceinline__ int opaque_tid() { int t = threadIdx.x; asm volatile("" : "+v"(t)); return t; }
#define MFMA32(a, b, c) __builtin_amdgcn_mfma_f32_32x32x16_bf16((a), (b), (c), 0, 0, 0)
__device__ __forceinline__ float gelu_f(float v) {
    const float av = fabsf(v), t = __builtin_amdgcn_rcpf(av * 0.2316418882f + 1.0f);
    float q = t * 0.5307027145f + (-0.7265760135f); q = q * t + 0.7107068705f; q = q * t + (-0.142248368f); q = q * t + 0.127414796f; q = q * t;
    const float e = __builtin_amdgcn_exp2f((v * v) * (-0.72134752044f));
    const float m = v * (q * e);
    return v < 0.f ? m : v - m;
}

namespace pg8 {
constexpr int BM = 256, BK = 64, HALF = 128, HTB = HALF * BK * 2, STAGE_BYTES = 8 * HTB, NXCD = 8, WGM = 8;
__host__ __device__ __forceinline__ int lds_byte(int r, int c) { const int st = (r >> 4) * 2 + (c >> 5), rr = r & 15, cc = c & 31, ob = rr * 64 + cc * 2; return st * 1024 + (ob ^ (((ob >> 9) & 1) << 5)); }
__host__ __device__ __forceinline__ void stage_rc(int b, int& R, int& C) { const int st = b / 1024, sb = b % 1024, swz = sb ^ (((sb >> 9) & 1) << 5); R = (st >> 1) * 16 + swz / 64; C = (st & 1) * 32 + (swz % 64) / 2; }
struct Unit { int pm, pn; };
struct Gemm { const bf16_t* A; const bf16_t* Bt; int M, N, K, lda, ldb; };
struct StaticOrder {
    int nM, nN, nwg, G, c;
    __device__ void init(int M, int N, int G_, int c_) { nM = M / BM; nN = N / BM; nwg = nM * nN; G = G_; c = c_; }
    __device__ bool next(int i, Unit& u) const {
        const long L = (long)i * G + c; if (L >= nwg) return false;
        int wgid = (int)L; { const int q = nwg / NXCD, r = nwg % NXCD, xcd = wgid % NXCD, off = wgid / NXCD; wgid = (xcd < r ? xcd * (q + 1) : r * (q + 1) + (xcd - r) * q) + off; }
        const int nig = WGM * nN, gid = wgid / nig, fm = gid * WGM, gsz = (nM - fm) < WGM ? (nM - fm) : WGM;
        u.pm = fm + ((wgid % nig) % gsz); u.pn = (wgid % nig) / gsz; return true;
    }
};

template <class Epi, class Sched, bool ALIGN_EPI>
__device__ __forceinline__ void gemm_phase(LAS unsigned char* lds, const Gemm g, const Sched& S, const Epi& E) {
    const int tid = opaque_tid(), wid = __builtin_amdgcn_readfirstlane(tid >> 6), lane = tid & 63, wr = wid >> 2, wc = wid & 3, fr = lane & 15, fq = lane >> 4;
    const int K = g.K, nt = K / BK;
    unsigned voffA[2], voffB[2];
#pragma unroll
    for (int i = 0; i < 2; ++i) { int R, C; stage_rc(tid * 16 + i * 8192, R, C); voffA[i] = (unsigned)(R * g.lda + C) * 2u; voffB[i] = (unsigned)(R * g.ldb + C) * 2u; }
    const size_t kstep = (size_t)(BK * 2);
    const size_t hstepA = (size_t)HALF * g.lda * 2, hstepB = (size_t)HALF * g.ldb * 2, tstepA = 2 * hstepA, tstepB = 2 * hstepB;
    const unsigned ldsw = (unsigned)wid * 1024u;
    const int aoff = lds_byte(wr * 64 + fr, fq * 8), boff = lds_byte(wc * 32 + fr, fq * 8);
#define PG8_SA(b, h) (((b) * 2 + (h)) * HTB)
#define PG8_SB(b, h) ((4 + (b) * 2 + (h)) * HTB)
#define PG8_STAGE(bufoff, gbase, voff) do { _Pragma("unroll") for (int _i = 0; _i < 2; ++_i) \
        __builtin_amdgcn_global_load_lds((const unsigned*)((const char*)(gbase) + (voff)[_i]), (LAS unsigned*)(lds + (bufoff) + ldsw + _i * 8192), 16, 0, 0); } while (0)
#define PG8_LDA(dst, b, h) do { _Pragma("unroll") for (int m = 0; m < 4; ++m) _Pragma("unroll") for (int k = 0; k < 2; ++k) dst[m][k] = *(const LAS bf16x8*)(lds + PG8_SA(b, h) + aoff + m * 2048 + k * 1024); } while (0)
#define PG8_LDB(dst, b, h) do { _Pragma("unroll") for (int n = 0; n < 2; ++n) _Pragma("unroll") for (int k = 0; k < 2; ++k) dst[n][k] = *(const LAS bf16x8*)(lds + PG8_SB(b, h) + boff + n * 2048 + k * 1024); } while (0)
#define PG8_MMA(ai, bj, At, Bt) do { __builtin_amdgcn_s_setprio(1); _Pragma("unroll") for (int m = 0; m < 4; ++m) _Pragma("unroll") for (int n = 0; n < 2; ++n) _Pragma("unroll") for (int k = 0; k < 2; ++k) \
        acc[ai][bj][m][n] = __builtin_amdgcn_mfma_f32_16x16x32_bf16(Bt[n][k], At[m][k], acc[ai][bj][m][n], 0, 0, 0); __builtin_amdgcn_s_setprio(0); } while (0)
#define PG8_WAIT_V(n) asm volatile("s_waitcnt vmcnt(" #n ")" ::: "memory")
#define PG8_WAIT_L(n) asm volatile("s_waitcnt lgkmcnt(" #n ")" ::: "memory")
#define PG8_BAR __builtin_amdgcn_s_barrier()
#define PG8_SCHED __builtin_amdgcn_sched_barrier(0)
    Unit cur, nxt; int ui = 0;
    if (!S.next(0, cur)) return;
    f32x4 acc[2][2][4][2];
#pragma unroll
    for (int a = 0; a < 2; ++a)
#pragma unroll
        for (int b = 0; b < 2; ++b)
#pragma unroll
            for (int m = 0; m < 4; ++m)
#pragma unroll
                for (int n = 0; n < 2; ++n) acc[a][b][m][n] = (f32x4){0.f, 0.f, 0.f, 0.f};
    bf16x8 At[4][2], B0[2][2], B1[2][2];
    const char* cA = (const char*)g.A + (size_t)cur.pm * tstepA; const char* cB = (const char*)g.Bt + (size_t)cur.pn * tstepB;
    PG8_STAGE(PG8_SB(0, 0), cB, voffB); PG8_STAGE(PG8_SB(0, 1), cB + hstepB, voffB); PG8_STAGE(PG8_SA(0, 0), cA, voffA); PG8_STAGE(PG8_SA(0, 1), cA + hstepA, voffA);
    if (wr == 1) PG8_BAR;
    PG8_WAIT_V(2); PG8_BAR;
    PG8_STAGE(PG8_SB(1, 0), cB + kstep, voffB); PG8_STAGE(PG8_SA(1, 0), cA + kstep, voffA); PG8_STAGE(PG8_SB(1, 1), cB + hstepB + kstep, voffB);
    PG8_WAIT_V(6); PG8_BAR;
    for (;;) {
        const bool has_next = S.next(ui + 1, nxt);
        const char* nA = has_next ? (const char*)g.A + (size_t)nxt.pm * tstepA : cA; const char* nB = has_next ? (const char*)g.Bt + (size_t)nxt.pn * tstepB : cB;
#pragma nounroll
        for (int t = 0; t < nt; t += 2) {
            const bool last = (t == nt - 2);
            const char* a1 = cA + (size_t)(t + 1) * kstep;
            const char* a2 = last ? nA : cA + (size_t)(t + 2) * kstep; const char* b2 = last ? nB : cB + (size_t)(t + 2) * kstep;
            const char* a3 = a2 + kstep; const char* b3 = b2 + kstep;
            PG8_LDB(B0, 0, 0); PG8_LDB(B1, 0, 1); PG8_SCHED; PG8_LDA(At, 0, 0); PG8_STAGE(PG8_SA(1, 1), a1 + hstepA, voffA);
            PG8_WAIT_V(8); PG8_WAIT_L(0); PG8_BAR; PG8_MMA(0, 0, At, B0); PG8_MMA(0, 1, At, B1); PG8_BAR; PG8_SCHED;
            PG8_LDA(At, 0, 1); PG8_STAGE(PG8_SB(0, 0), b2, voffB); PG8_STAGE(PG8_SB(0, 1), b2 + hstepB, voffB); PG8_STAGE(PG8_SA(0, 0), a2, voffA);
            PG8_WAIT_V(8); PG8_WAIT_L(0); PG8_BAR; PG8_MMA(1, 0, At, B0); PG8_MMA(1, 1, At, B1); PG8_BAR; PG8_SCHED;
            PG8_LDB(B0, 1, 0); PG8_LDB(B1, 1, 1); PG8_SCHED; PG8_LDA(At, 1, 0); PG8_STAGE(PG8_SA(0, 1), a2 + hstepA, voffA);
            PG8_WAIT_V(8); PG8_WAIT_L(0); PG8_BAR; PG8_MMA(0, 0, At, B0); PG8_MMA(0, 1, At, B1); PG8_BAR; PG8_SCHED;
            PG8_LDA(At, 1, 1); PG8_STAGE(PG8_SB(1, 0), b3, voffB); PG8_STAGE(PG8_SB(1, 1), b3 + hstepB, voffB); PG8_STAGE(PG8_SA(1, 0), a3, voffA);
            PG8_WAIT_V(8); PG8_WAIT_L(0); PG8_BAR; PG8_MMA(1, 0, At, B0); PG8_MMA(1, 1, At, B1); PG8_BAR; PG8_SCHED;
        }
        if constexpr (ALIGN_EPI) { if (wr == 0) PG8_BAR; }
        E(acc, cur, wr, wc, fr, fq);
        if (!has_next) break;
#pragma unroll
        for (int a = 0; a < 2; ++a)
#pragma unroll
            for (int b = 0; b < 2; ++b)
#pragma unroll
                for (int m = 0; m < 4; ++m)
#pragma unroll
                    for (int n = 0; n < 2; ++n) acc[a][b][m][n] = (f32x4){0.f, 0.f, 0.f, 0.f};
        cur = nxt; cA = nA; cB = nB; ++ui;
        if constexpr (ALIGN_EPI) { if (wr == 1) PG8_BAR; }
    }
    PG8_WAIT_V(0);
    if constexpr (!ALIGN_EPI) { if (wr == 0) PG8_BAR; }
    PG8_BAR;
#undef PG8_SA
#undef PG8_SB
#undef PG8_STAGE
#undef PG8_LDA
#undef PG8_LDB
#undef PG8_MMA
#undef PG8_WAIT_V
#undef PG8_WAIT_L
#undef PG8_BAR
#undef PG8_SCHED
}

__device__ __forceinline__ void st_bf16x4(bf16_t* p, f32x4 v) { u32x2 w; w.x = cvtpk(v[0], v[1]); w.y = cvtpk(v[2], v[3]); *(u32x2*)p = w; }
#define EPI_LOOP_AM _Pragma("unroll") for (int ai = 0; ai < 2; ++ai) _Pragma("unroll") for (int m = 0; m < 4; ++m)
#define EPI_LOOP_BN _Pragma("unroll") for (int bj = 0; bj < 2; ++bj) _Pragma("unroll") for (int n = 0; n < 2; ++n)

struct EpiPlain {
    bf16_t* O; int ldc;
    __device__ __forceinline__ void operator()(const f32x4 (&acc)[2][2][4][2], const Unit& u, int wr, int wc, int fr, int fq) const {
        const int row0 = u.pm * BM + wr * 64 + fr, col0 = u.pn * BM + wc * 32 + 4 * fq;
        EPI_LOOP_AM { bf16_t* rowp = O + (size_t)(row0 + ai * HALF + m * 16) * ldc + col0;
            EPI_LOOP_BN st_bf16x4(rowp + bj * HALF + n * 16, acc[ai][bj][m][n]); }
    }
};
template <int NP> struct EpiRowScale {
    bf16_t* O; int ldc; const float* ssq; float invn, mul;
    __device__ __forceinline__ void operator()(const f32x4 (&acc)[2][2][4][2], const Unit& u, int wr, int wc, int fr, int fq) const {
        const int row0 = u.pm * BM + wr * 64 + fr, col0 = u.pn * BM + wc * 32 + 4 * fq;
        EPI_LOOP_AM { const int row = row0 + ai * HALF + m * 16; const float rs = rsqrtf(ssq_sum<NP>(ssq + (size_t)row * 16) * invn + EPS) * mul; bf16_t* rowp = O + (size_t)row * ldc + col0;
            EPI_LOOP_BN st_bf16x4(rowp + bj * HALF + n * 16, acc[ai][bj][m][n] * rs);
            if (m & 1) asm volatile("" ::: "memory"); }
    }
};
struct EpiColScale {
    bf16_t* O; int ldc; const float* ssq; float invn;
    __device__ __forceinline__ void operator()(const f32x4 (&acc)[2][2][4][2], const Unit& u, int wr, int wc, int fr, int fq) const {
        const int row0 = u.pm * BM + wr * 64 + fr, col0 = u.pn * BM + wc * 32 + 4 * fq;
        EPI_LOOP_BN { const float* sp = ssq + (size_t)(col0 + bj * HALF + n * 16) * 16;
            const f32x4 rs = (f32x4){rsqrtf(ssq_sum<8>(sp) * invn + EPS), rsqrtf(ssq_sum<8>(sp + 16) * invn + EPS), rsqrtf(ssq_sum<8>(sp + 32) * invn + EPS), rsqrtf(ssq_sum<8>(sp + 48) * invn + EPS)};
            EPI_LOOP_AM st_bf16x4(O + (size_t)(row0 + ai * HALF + m * 16) * ldc + col0 + bj * HALF + n * 16, acc[ai][bj][m][n] * rs);
            asm volatile("" ::: "memory"); }
    }
};
struct EpiRes {
    const float* basef; const bf16_t* baseb; bf16_t* hb; float* ssq;
    __device__ __forceinline__ void operator()(const f32x4 (&acc)[2][2][4][2], const Unit& u, int wr, int wc, int fr, int fq) const {
        const int row0 = u.pm * BM + wr * 64 + fr, col0 = u.pn * BM + wc * 32 + 4 * fq;
        EPI_LOOP_AM { const int row = row0 + ai * HALF + m * 16; const size_t off = (size_t)row * D + col0; float ss = 0.f;
            EPI_LOOP_BN { f32x4 b;
                if (basef) b = *(const f32x4*)(basef + off + bj * HALF + n * 16);
                else { const u32x2 r = *(const u32x2*)(baseb + off + bj * HALF + n * 16); b = (f32x4){bf2f((unsigned short)(r.x & 0xffffu)), bf2f((unsigned short)(r.x >> 16)), bf2f((unsigned short)(r.y & 0xffffu)), bf2f((unsigned short)(r.y >> 16))}; }
                const f32x4 h = b + acc[ai][bj][m][n];
                st_bf16x4(hb + off + bj * HALF + n * 16, h); ss += (h[0] * h[0] + h[1] * h[1]) + (h[2] * h[2] + h[3] * h[3]); }
            ss += __shfl_xor(ss, 16); ss += __shfl_xor(ss, 32);
            if (fq == 0) ssq[(size_t)row * 16 + u.pn * 4 + wc] = ss;
            asm volatile("" ::: "memory"); }
    }
};
struct EpiProj {
    bf16_t* P; float* ssq_q; float* ssq_kv; const float* cr; const float* sr; const float* cm; const float* sm;
    __device__ __forceinline__ void operator()(const f32x4 (&acc)[2][2][4][2], const Unit& u, int wr, int wc, int fr, int fq) const {
        const int row0 = u.pm * BM + wr * 64 + fr;
#pragma unroll
        for (int bj = 0; bj < 2; ++bj) {
            const int hb = 2 * u.pn + bj;
            if (hb == 17 && wc != 0) continue;
            const int kind = hb < 3 ? 0 : hb < 5 ? 1 : hb < 9 ? 2 : hb < 13 ? 3 : hb < 17 ? 4 : 5;
            const int col = hb * HALF + wc * 32 + 4 * fq;
            EPI_LOOP_AM { const int row = row0 + ai * HALF + m * 16; const int s = row & (SEQ - 1);
                f32x4 v0 = acc[ai][bj][m][0], v1 = acc[ai][bj][m][1];
                if (kind <= 1) {
                    float ss = (v0[0] * v0[0] + v0[1] * v0[1]) + (v0[2] * v0[2] + v0[3] * v0[3]) + (v1[0] * v1[0] + v1[1] * v1[1]) + (v1[2] * v1[2] + v1[3] * v1[3]);
                    ss += __shfl_xor(ss, 16); ss += __shfl_xor(ss, 32);
                    if (fq == 0) { if (kind == 0) ssq_q[(size_t)row * 16 + hb * 4 + wc] = ss; else ssq_kv[(size_t)row * 16 + (hb - 3) * 4 + wc] = ss; }
                } else if (kind == 2 || kind == 3) {
                    const f32x4 c = *(const f32x4*)(cr + (size_t)s * 64 + wc * 16 + 4 * fq), sn = *(const f32x4*)(sr + (size_t)s * 64 + wc * 16 + 4 * fq);
                    f32x4 y0 = v0 * c - v1 * sn, y1 = v0 * sn + v1 * c;
                    if (kind == 3) { y0 = y0 * 0.08838834764831845f; y1 = y1 * 0.08838834764831845f; }
                    v0 = y0; v1 = y1;
                } else if (kind == 5) {
                    const f32x4 c = *(const f32x4*)(cm + (size_t)s * 16 + 4 * fq), sn = *(const f32x4*)(sm + (size_t)s * 16 + 4 * fq);
                    const f32x4 y0 = v0 * c - v1 * sn, y1 = v0 * sn + v1 * c; v0 = y0; v1 = y1;
                }
                bf16_t* rowp = P + (size_t)row * NPROJ + col;
                st_bf16x4(rowp, v0); st_bf16x4(rowp + 16, v1);
                if (m & 1) asm volatile("" ::: "memory"); }
        }
    }
};
struct EpiQ {
    bf16_t* O; const float* ssq; const float* cm; const float* sm;
    __device__ __forceinline__ void operator()(const f32x4 (&acc)[2][2][4][2], const Unit& u, int wr, int wc, int fr, int fq) const {
        const int row0 = u.pm * BM + wr * 64 + fr, col0 = u.pn * BM + wc * 32 + 4 * fq;
        EPI_LOOP_AM { const int row = row0 + ai * HALF + m * 16; const int s = row & (SEQ - 1); const float rs = rsqrtf(ssq_sum<12>(ssq + (size_t)row * 16) * (1.f / 384.f) + EPS) * C2_MLA;
            bf16_t* rowp = O + (size_t)row * 768 + col0;
            f32x4 c = (f32x4){1.f, 1.f, 1.f, 1.f}, sn = (f32x4){0.f, 0.f, 0.f, 0.f};
            if (u.pn == 2) { c = *(const f32x4*)(cm + (size_t)s * 16 + 4 * fq); sn = *(const f32x4*)(sm + (size_t)s * 16 + 4 * fq); }
#pragma unroll
            for (int bj = 0; bj < 2; ++bj) { const f32x4 v0 = acc[ai][bj][m][0] * rs, v1 = acc[ai][bj][m][1] * rs;
                st_bf16x4(rowp + bj * HALF, v0 * c - v1 * sn); st_bf16x4(rowp + bj * HALF + 16, v0 * sn + v1 * c); }
            asm volatile("" ::: "memory"); }
    }
};
}

#define XB_TMO      128
#define XB_XCNT(j)  (256  + 64 * (j))
#define XB_XSUB(j)  (1280 + 64 * (j))
#define XB_XGEN(j)  (2304 + 64 * (j))
#define XB_TOP      3328
#define XB_TOPGEN   3392
#define XCD_BAR_WORDS 3456
#define XB_SPIN_CAP (1u << 21)
__device__ __forceinline__ unsigned xb_ld(unsigned* p)              { return __hip_atomic_load(p, __ATOMIC_RELAXED, __HIP_MEMORY_SCOPE_AGENT); }
__device__ __forceinline__ unsigned xb_add(unsigned* p, unsigned v) { return __hip_atomic_fetch_add(p, v, __ATOMIC_RELAXED, __HIP_MEMORY_SCOPE_AGENT); }
__device__ __forceinline__ unsigned xb_xcc_id() { return (unsigned)__builtin_amdgcn_s_getreg((3 << 11) | 20) & 0xFu; }
#define XB_SPIN(cond, bar) do { unsigned _sp = 0; while (cond) { __builtin_amdgcn_s_sleep(1); \
    if ((++_sp & 255u) == 0u) { if (xb_ld(&(bar)[XB_TMO])) break; if (_sp > XB_SPIN_CAP) { atomicAdd(&(bar)[XB_TMO], 1u); break; } } } } while (0)
struct XcdBarrier { unsigned* bar; unsigned x; volatile LAS unsigned* st; };
__device__ __forceinline__ XcdBarrier xcd_barrier_post(unsigned* bar, volatile LAS unsigned* st) {
    XcdBarrier b; b.bar = bar; b.x = xb_xcc_id(); b.st = st;
    if (threadIdx.x == 0) (void)xb_add(&bar[XB_XCNT(b.x)], 1u);
    return b;
}
__device__ __forceinline__ void xcd_barrier_complete(unsigned* bar, unsigned x, unsigned& nloc, unsigned& nx) {
    const unsigned G = gridDim.x * gridDim.y * gridDim.z;
    unsigned sum, cnt, mine, sp = 0u;
    for (;;) {
        sum = 0u; cnt = 0u; mine = 0u;
#pragma unroll
        for (unsigned j = 0; j < 16; ++j) { const unsigned c = xb_ld(&bar[XB_XCNT(j)]); sum += c; cnt += (c > 0u) ? 1u : 0u; mine = (j == x) ? c : mine; }
        if (sum == G) break;
        __builtin_amdgcn_s_sleep(1);
        if ((++sp & 255u) == 0u) { if (xb_ld(&bar[XB_TMO])) break; if (sp > XB_SPIN_CAP) { atomicAdd(&bar[XB_TMO], 1u); break; } }
    }
    nloc = mine > 0u ? mine : 1u; nx = cnt > 0u ? cnt : 1u;
}
__device__ __forceinline__ void xcd_barrier(const XcdBarrier& b) {
    asm volatile("s_waitcnt vmcnt(0)" ::: "memory");
    __syncthreads();
    if (threadIdx.x == 0) {
        unsigned* bar = b.bar;
        __builtin_amdgcn_s_waitcnt(0);
        unsigned nloc = b.st[0], nx = b.st[1];
        if (nloc == 0u) { xcd_barrier_complete(bar, b.x, nloc, nx); b.st[0] = nloc; b.st[1] = nx; }
        const unsigned old = xb_add(&bar[XB_XSUB(b.x)], 1u);
        const unsigned gen = old / nloc;
        if (old + 1u == (gen + 1u) * nloc) {
            __builtin_amdgcn_fence(__ATOMIC_RELEASE, "agent");
            asm volatile("s_waitcnt vmcnt(0)" ::: "memory");
            const unsigned og = xb_add(&bar[XB_TOP], 1u);
            const unsigned tg = og / nx;
            if (og + 1u == (tg + 1u) * nx) xb_add(&bar[XB_TOPGEN], 1u);
            else XB_SPIN(xb_ld(&bar[XB_TOPGEN]) == tg, bar);
            __builtin_amdgcn_fence(__ATOMIC_ACQUIRE, "agent");
            xb_add(&bar[XB_XGEN(b.x)], 1u);
            asm volatile("s_waitcnt vmcnt(0)" ::: "memory");
        } else {
            XB_SPIN(xb_ld(&bar[XB_XGEN(b.x)]) == gen, bar);
            __builtin_amdgcn_fence(__ATOMIC_ACQUIRE, "agent");
            asm volatile("s_waitcnt vmcnt(0)" ::: "memory");
        }
    }
    __syncthreads();
}

struct Params {
    const float *x, *mem, *g_mix, *w_in, *g_q_lora, *w_uq, *g_kv_lora, *w_ukv, *g_ret_gn, *w_o, *g_xattn, *g_mem, *w_xq, *w_xkv, *w_xo, *g_ffn, *w_pq, *sub_keys, *u_exp, *v_exp, *g_final;
    float* out; unsigned char* ws; int never; int pad;
};

__device__ __forceinline__ int permret(int i) { return i < 64 ? ((i >> 4) * 32 + (i & 15)) : (((i - 64) >> 4) * 32 + 16 + ((i - 64) & 15)); }
template <int MODE> __device__ __forceinline__ int dst_row(int c) {
    if (MODE == 1) {
        if (c < 640) return c;
        if (c < 672) return 2176 + (c - 640);
        if (c < 1184) { const int cc = c - 672; return 640 + (cc & ~127) + permret(cc & 127); }
        if (c < 1696) { const int cc = c - 1184; return 1152 + (cc & ~127) + permret(cc & 127); }
        if (c < 2208) return 2304 + (c - 1696);
        return 1664 + (c - 2208);
    } else if (MODE == 2) {
        const int h = c / 96, i = c - h * 96; return i < 64 ? h * 64 + i : 512 + h * 32 + (i - 64);
    } else if (MODE == 3) {
        const int h = c >> 7, i = c & 127; return i < 64 ? h * 64 + i : 512 + h * 64 + (i - 64);
    }
    return c;
}
template <int MODE> __device__ __forceinline__ void p0_transpose_item(const float* W, int K, int N, bf16_t* WT, const float* gain, LAS float* scr, int item, int lane) {
    const int nblk = N / 32, kb = item / nblk, nb = item % nblk, k0 = 64 * kb, n0 = 32 * nb;
    float v[32];
#pragma unroll
    for (int i = 0; i < 32; ++i) { const int kk = 2 * i + (lane >> 5); v[i] = W[(size_t)(k0 + kk) * N + n0 + (lane & 31)]; }
    if (gain) {
#pragma unroll
        for (int i = 0; i < 32; ++i) { const int kk = 2 * i + (lane >> 5); v[i] *= gain[k0 + kk]; }
    }
#pragma unroll
    for (int i = 0; i < 32; ++i) { const int kk = 2 * i + (lane >> 5); scr[kk * 33 + (lane & 31)] = v[i]; }
    LDS_WAIT(); asm volatile("" ::: "memory");
    const int c = lane & 7;
#pragma unroll
    for (int j = 0; j < 4; ++j) { const int n = (lane >> 3) + 8 * j; const LAS float* s = scr + (8 * c) * 33 + n;
        u32x4 o; o.x = cvtpk(s[0 * 33], s[1 * 33]); o.y = cvtpk(s[2 * 33], s[3 * 33]); o.z = cvtpk(s[4 * 33], s[5 * 33]); o.w = cvtpk(s[6 * 33], s[7 * 33]);
        *(u32x4*)(WT + (size_t)dst_row<MODE>(n0 + n) * K + k0 + 8 * c) = o; }
    LDS_WAIT(); asm volatile("" ::: "memory");
}
template <int NR> __device__ __forceinline__ void rms_rows_to_bf16(const float* xrow, const float* g, bf16_t* orow, size_t rstride, int lane) {
    f32x4 v[NR][4];
#pragma unroll
    for (int r = 0; r < NR; ++r)
#pragma unroll
        for (int j = 0; j < 4; ++j) v[r][j] = ((const f32x4*)(xrow + r * rstride) + lane)[64 * j];
    const f32x4* gr = (const f32x4*)g + lane;
    f32x4 gv[4];
#pragma unroll
    for (int j = 0; j < 4; ++j) gv[j] = gr[64 * j];
#pragma unroll
    for (int r = 0; r < NR; ++r) {
        float s = 0.f;
#pragma unroll
        for (int j = 0; j < 4; ++j) s += (v[r][j][0] * v[r][j][0] + v[r][j][1] * v[r][j][1]) + (v[r][j][2] * v[r][j][2] + v[r][j][3] * v[r][j][3]);
        const float rstd = rsqrtf(wave_sum(s) * (1.f / D) + EPS);
        u32x2* o8 = (u32x2*)(orow + r * rstride) + lane;
#pragma unroll
        for (int j = 0; j < 4; ++j) { const f32x4 y = v[r][j] * rstd * gv[j]; u32x2 w; w.x = cvtpk(y[0], y[1]); w.y = cvtpk(y[2], y[3]); o8[64 * j] = w; }
    }
}

struct NoMid { __device__ __forceinline__ void operator()() const {} };
__device__ __forceinline__ float max3f(float a, float b, float c) { return fmaxf(fmaxf(a, b), c); }
template <int NS, int NT, int KG, bool CINIT, class Mid>
__device__ __forceinline__ void flash_tile(const LAS unsigned char* Ks, int kpitch, const LAS unsigned char* Vs, int vpitch, const bf16x8 (&qf)[NS], f32x16 (&o)[NT],
                                           f32x16& negm, float& mref, float& lrun, bool first, int r32, int hi, bool domask, int qrel, int krel, const Mid& mid) {
    f32x16 p0, p1;
    const LAS unsigned char* k0 = Ks + r32 * kpitch + hi * 16; const LAS unsigned char* k1 = k0 + 32 * kpitch;
    if (CINIT) { p0 = negm; p1 = negm; }
    else {
#pragma unroll
        for (int r = 0; r < 16; ++r) { p0[r] = 0.f; p1[r] = 0.f; }
    }
#pragma unroll
    for (int g0 = 0; g0 < NS; g0 += KG) {
        bf16x8 ka[KG], kb2[KG];
#pragma unroll
        for (int s = 0; s < KG; ++s) { ka[s] = *(const LAS bf16x8*)(k0 + (g0 + s) * 32); kb2[s] = *(const LAS bf16x8*)(k1 + (g0 + s) * 32); }
        __builtin_amdgcn_sched_barrier(0);
#pragma unroll
        for (int s = 0; s < KG; ++s) { p0 = MFMA32(ka[s], qf[g0 + s], p0); p1 = MFMA32(kb2[s], qf[g0 + s], p1); }
        __builtin_amdgcn_sched_barrier(0);
    }
    if (!CINIT) {
#pragma unroll
        for (int r = 0; r < 16; ++r) { p0[r] -= mref; p1[r] -= mref; }
    }
    if (domask) {
#pragma unroll
        for (int r = 0; r < 16; ++r) { const int kv = krel + crow(r, hi); if (kv > qrel) p0[r] = -1e30f; if (kv + 32 > qrel) p1[r] = -1e30f; }
    }
    float ma = max3f(p0[0], p0[1], p1[0]), mb = max3f(p0[2], p0[3], p1[1]); ma = max3f(ma, p1[2], p1[3]);
#pragma unroll
    for (int r = 4; r < 16; r += 4) { ma = max3f(ma, p0[r], p0[r + 1]); mb = max3f(mb, p0[r + 2], p0[r + 3]); ma = max3f(ma, p1[r], p1[r + 1]); mb = max3f(mb, p1[r + 2], p1[r + 3]); }
    const float mx = xhalf_max(fmaxf(ma, mb));
    if (first || __any(mx > 8.0f)) {
        const float dl = first ? mx : fmaxf(mx, 0.f);
        mref += dl;
#pragma unroll
        for (int r = 0; r < 16; ++r) { p0[r] -= dl; p1[r] -= dl; if (CINIT) negm[r] = -mref; }
        const float alpha = __builtin_amdgcn_exp2f(-dl);
        lrun *= alpha;
        if (!first) {
#pragma unroll
            for (int t = 0; t < NT; ++t)
#pragma unroll
                for (int r = 0; r < 16; ++r) o[t][r] *= alpha;
        }
    }
    float rs0 = 0.f, rs1 = 0.f;
#pragma unroll
    for (int r = 0; r < 16; ++r) { p0[r] = __builtin_amdgcn_exp2f(p0[r]); p1[r] = __builtin_amdgcn_exp2f(p1[r]); rs0 += p0[r]; rs1 += p1[r]; }
    lrun += rs0 + rs1;
    bf16x8 pb[4];
#pragma unroll
    for (int ks = 0; ks < 2; ++ks) {
        u32x4 w0, w1;
        w0.x = cvtpk(p0[8 * ks + 0], p0[8 * ks + 1]); w0.y = cvtpk(p0[8 * ks + 2], p0[8 * ks + 3]); w0.z = cvtpk(p0[8 * ks + 4], p0[8 * ks + 5]); w0.w = cvtpk(p0[8 * ks + 6], p0[8 * ks + 7]);
        w1.x = cvtpk(p1[8 * ks + 0], p1[8 * ks + 1]); w1.y = cvtpk(p1[8 * ks + 2], p1[8 * ks + 3]); w1.z = cvtpk(p1[8 * ks + 4], p1[8 * ks + 5]); w1.w = cvtpk(p1[8 * ks + 6], p1[8 * ks + 7]);
        pb[ks] = __builtin_bit_cast(bf16x8, w0); pb[2 + ks] = __builtin_bit_cast(bf16x8, w1);
    }
    mid();
    const LAS unsigned char* vb = Vs + r32 * vpitch + hi * 8;
#pragma unroll
    for (int t = 0; t < NT; ++t) {
        s16x4 lo[4], hh[4];
#pragma unroll
        for (int ks = 0; ks < 4; ++ks) { lo[ks] = *(const LAS s16x4*)(vb + t * 32 * vpitch + ks * 32); hh[ks] = *(const LAS s16x4*)(vb + t * 32 * vpitch + ks * 32 + 16); }
        __builtin_amdgcn_sched_barrier(0);
#pragma unroll
        for (int ks = 0; ks < 4; ++ks) { const bf16x8 a = (bf16x8){lo[ks][0], lo[ks][1], lo[ks][2], lo[ks][3], hh[ks][0], hh[ks][1], hh[ks][2], hh[ks][3]}; o[t] = MFMA32(a, pb[ks], o[t]); }
        __builtin_amdgcn_sched_barrier(0);
    }
}

constexpr int MLA_KP = 208, MLA_VP = 264;
constexpr int MLA_KT = 128 * MLA_KP, MLA_VTB = 64 * MLA_VP, MLA_BUF = MLA_KT + MLA_VTB;
__device__ __forceinline__ void mla_unit(LAS unsigned char* lds, int b, int h, int qb, const bf16_t* QM, const bf16_t* KN, const bf16_t* PROJ, const bf16_t* VT, bf16_t* MIX) {
    const int tid = opaque_tid(), lane = tid & 63, r32 = lane & 31, hi = lane >> 5, wid = __builtin_amdgcn_readfirstlane(tid >> 6);
    const size_t tb = (size_t)b * SEQ;
    const int q0 = qb * 256 + wid * 32;
    bf16x8 qf[6];
    { const bf16_t* qr = QM + (tb + q0 + r32) * 768;
#pragma unroll
      for (int s = 0; s < 4; ++s) qf[s] = *(const bf16x8*)(qr + h * 64 + s * 16 + hi * 8);
#pragma unroll
      for (int s = 0; s < 2; ++s) qf[4 + s] = *(const bf16x8*)(qr + 512 + h * 32 + s * 16 + hi * 8); }
    f32x16 o[2], negm;
#pragma unroll
    for (int r = 0; r < 16; ++r) { o[0][r] = 0.f; o[1][r] = 0.f; negm[r] = 0.f; }
    float mref = 0.f, lrun = 0.f;
    const int NCH = 2 * qb + 2;
    const int kr = tid >> 3, kc = tid & 7;
    const int pr = tid >> 2, pc = tid & 3;
    const int vr = tid >> 4, vc = tid & 15;
    const bf16_t* ksrc = KN + (tb + kr) * 512 + h * 64 + kc * 8;
    const bf16_t* psrc = PROJ + (tb + pr) * NPROJ + 2176 + pc * 8;
    const bf16_t* vsrc = VT + (size_t)(h * 64 + vr) * TP + tb + vc * 8;
    struct Stg { u32x4 k0, k1, pe, v0, v1; };
    Stg sa, sb;
    auto stage_load = [&](Stg& s, int ch) { const size_t ko = (size_t)ch * 128;
        s.k0 = *(const u32x4*)(ksrc + ko * 512); s.k1 = *(const u32x4*)(ksrc + (ko + 64) * 512); s.pe = *(const u32x4*)(psrc + ko * NPROJ);
        s.v0 = *(const u32x4*)(vsrc + ko); s.v1 = *(const u32x4*)(vsrc + (size_t)32 * TP + ko); };
    auto stage_write = [&](const Stg& s, int buf) {
        LAS unsigned char* kb = lds + buf * MLA_BUF; LAS unsigned char* vbp = kb + MLA_KT;
        *(LAS u32x4*)(kb + kr * MLA_KP + kc * 16) = s.k0; *(LAS u32x4*)(kb + (kr + 64) * MLA_KP + kc * 16) = s.k1;
        *(LAS u32x4*)(kb + pr * MLA_KP + 128 + pc * 16) = s.pe;
        { LAS unsigned char* d = vbp + vr * MLA_VP + vc * 16; *(LAS u32x2*)d = (u32x2){s.v0.x, s.v0.y}; *(LAS u32x2*)(d + 8) = (u32x2){s.v0.z, s.v0.w}; }
        { LAS unsigned char* d = vbp + (vr + 32) * MLA_VP + vc * 16; *(LAS u32x2*)d = (u32x2){s.v1.x, s.v1.y}; *(LAS u32x2*)(d + 8) = (u32x2){s.v1.z, s.v1.w}; }
    };
    const int qrel = wid * 32 + r32;
    auto compute = [&](int buf, int ch) {
        const LAS unsigned char* kb = lds + buf * MLA_BUF;
#pragma unroll
        for (int j = 0; j < 2; ++j) {
            const int krel = ch * 128 + j * 64 - qb * 256;
            if (krel <= wid * 32 + 31)
                flash_tile<6, 2, 6, true>(kb + j * 64 * MLA_KP, MLA_KP, kb + MLA_KT + j * 128, MLA_VP, qf, o, negm, mref, lrun, ch == 0 && j == 0, r32, hi, krel + 63 > wid * 32, qrel, krel, NoMid());
        }
    };
    stage_load(sa, 0); stage_write(sa, 0);
    stage_load(sa, 1);
    __syncthreads();
    for (int ch = 0; ch < NCH; ch += 2) {
        if (ch + 2 < NCH) stage_load(sb, ch + 2);
        compute(0, ch);
        stage_write(sa, 1);
        __syncthreads();
        if (ch + 3 < NCH) stage_load(sa, ch + 3);
        compute(1, ch + 1);
        if (ch + 2 < NCH) stage_write(sb, 0);
        __syncthreads();
    }
    const float inv = 1.f / xhalf_sum(lrun);
    bf16_t* orow = MIX + (tb + q0 + r32) * D + h * 64;
#pragma unroll
    for (int t = 0; t < 2; ++t)
#pragma unroll
        for (int g = 0; g < 4; ++g) { u32x2 w; w.x = cvtpk(o[t][4 * g] * inv, o[t][4 * g + 1] * inv); w.y = cvtpk(o[t][4 * g + 2] * inv, o[t][4 * g + 3] * inv);
            *(u32x2*)(orow + 32 * t + 8 * g + 4 * hi) = w; }
}

constexpr int XA_KP = 528, XA_VP = 136;
constexpr int XA_KT = 64 * XA_KP, XA_VTB = 128 * XA_VP;
__device__ __forceinline__ void xattn_unit(LAS unsigned char* lds, int b, int h, int qb, int dvh, const bf16_t* QX, const bf16_t* KX, const bf16_t* VXT, bf16_t* OX) {
    const int tid = opaque_tid(), lane = tid & 63, r32 = lane & 31, hi = lane >> 5, wid = __builtin_amdgcn_readfirstlane(tid >> 6);
    const size_t tb = (size_t)b * SEQ;
    const int q0 = qb * 256 + wid * 32;
    bf16x8 qf[16];
    { const bf16_t* qr = QX + (tb + q0 + r32) * D + h * 256 + hi * 8;
#pragma unroll
      for (int s = 0; s < 16; ++s) qf[s] = *(const bf16x8*)(qr + s * 16); }
    f32x16 o[4], negm;
#pragma unroll
    for (int t = 0; t < 4; ++t)
#pragma unroll
        for (int r = 0; r < 16; ++r) o[t][r] = 0.f;
#pragma unroll
    for (int r = 0; r < 16; ++r) negm[r] = 0.f;
    float mref = 0.f, lrun = 0.f;
    const bf16_t* kbase = KX + (size_t)(b * 256) * D + h * 256;
    const bf16_t* vbase = VXT + (size_t)(h * 256 + dvh * 128) * D + b * 256;
    u32x4 kreg[4], vreg[2];
    auto stage_load = [&](int kt) {
#pragma unroll
        for (int i = 0; i < 4; ++i) { const int idx = tid + 512 * i, row = idx >> 5, c = idx & 31; kreg[i] = *(const u32x4*)(kbase + (size_t)(kt * 64 + row) * D + c * 8); }
#pragma unroll
        for (int i = 0; i < 2; ++i) { const int idx = tid + 512 * i, dv = idx >> 3, c = idx & 7; vreg[i] = *(const u32x4*)(vbase + (size_t)dv * D + kt * 64 + c * 8); }
    };
    auto stage_write = [&](int buf) {
        LAS unsigned char* kb = lds + buf * (XA_KT + XA_VTB); LAS unsigned char* vbp = kb + XA_KT;
#pragma unroll
        for (int i = 0; i < 4; ++i) { const int idx = tid + 512 * i, row = idx >> 5, c = idx & 31; *(LAS u32x4*)(kb + row * XA_KP + c * 16) = kreg[i]; }
#pragma unroll
        for (int i = 0; i < 2; ++i) { const int idx = tid + 512 * i, dv = idx >> 3, c = idx & 7;
            *(LAS u32x2*)(vbp + dv * XA_VP + c * 16) = (u32x2){vreg[i].x, vreg[i].y}; *(LAS u32x2*)(vbp + dv * XA_VP + c * 16 + 8) = (u32x2){vreg[i].z, vreg[i].w}; }
    };
    stage_load(0); stage_write(0);
    __syncthreads();
    for (int kt = 0; kt < 4; ++kt) {
        const int buf = kt & 1;
        const LAS unsigned char* kb = lds + buf * (XA_KT + XA_VTB);
        auto mid = [&]() { if (kt + 1 < 4) stage_load(kt + 1); };
        flash_tile<16, 4, 4, false>(kb, XA_KP, kb + XA_KT, XA_VP, qf, o, negm, mref, lrun, kt == 0, r32, hi, false, 0, 0, mid);
        if (kt + 1 < 4) stage_write(buf ^ 1);
        __syncthreads();
    }
    const float inv = 1.f / xhalf_sum(lrun);
    bf16_t* orow = OX + (tb + q0 + r32) * D + h * 256 + dvh * 128;
#pragma unroll
    for (int t = 0; t < 4; ++t)
#pragma unroll
        for (int g = 0; g < 4; ++g) { u32x2 w; w.x = cvtpk(o[t][4 * g] * inv, o[t][4 * g + 1] * inv); w.y = cvtpk(o[t][4 * g + 2] * inv, o[t][4 * g + 3] * inv);
            *(u32x2*)(orow + 32 * t + 8 * g + 4 * hi) = w; }
}

constexpr int RT_P = 272;
constexpr int RT_PV = 264;
__device__ __forceinline__ float ret_log2g(int h) { return log2f(1.0f - exp2f(-5.0f - (float)h)); }
__device__ __forceinline__ void ret_state_unit(LAS unsigned char* lds, int unit, const bf16_t* PROJ, const bf16_t* RVT, bf16_t* RKVT) {
    const int tid = opaque_tid(), lane = tid & 63, r32 = lane & 31, hi = lane >> 5, wid = __builtin_amdgcn_readfirstlane(tid >> 6);
    const int n = unit & 31, h = (unit >> 5) & 3, b = unit >> 7;
    const size_t t0 = (size_t)b * SEQ + n * 128;
    const float l2g = ret_log2g(h);
    LAS unsigned char* Vs = lds;
    LAS unsigned char* Ks = lds + 128 * RT_P;
#pragma unroll
    for (int i = 0; i < 4; ++i) { const int idx = tid + 512 * i, e = idx >> 4, c = idx & 15;
        *(LAS u32x4*)(Vs + e * RT_P + c * 16) = *(const u32x4*)(RVT + (size_t)(h * 128 + e) * TP + t0 + c * 8); }
#pragma unroll
    for (int i = 0; i < 4; ++i) { const int idx = tid + 512 * i, j = idx >> 4, c = idx & 15;
        const u32x4 v = *(const u32x4*)(PROJ + (t0 + j) * NPROJ + 1152 + h * 128 + c * 8);
        const float z = exp2f((float)(127 - j) * l2g);
        const unsigned w[4] = {v.x, v.y, v.z, v.w};
#pragma unroll
        for (int q = 0; q < 4; ++q) { const float lo = bf2f((unsigned short)(w[q] & 0xffffu)) * z, hh = bf2f((unsigned short)(w[q] >> 16)) * z; const unsigned pk = cvtpk(lo, hh);
            *(LAS unsigned short*)(Ks + (c * 8 + 2 * q) * RT_P + j * 2) = (unsigned short)(pk & 0xffffu); *(LAS unsigned short*)(Ks + (c * 8 + 2 * q + 1) * RT_P + j * 2) = (unsigned short)(pk >> 16); } }
    __syncthreads();
    const int eb = (wid & 3) * 32, db = (wid >> 2) * 64;
    f32x16 acc[2];
#pragma unroll
    for (int t = 0; t < 2; ++t)
#pragma unroll
        for (int r = 0; r < 16; ++r) acc[t][r] = 0.f;
#pragma unroll
    for (int ks = 0; ks < 8; ++ks) {
        const bf16x8 a = *(const LAS bf16x8*)(Vs + (eb + r32) * RT_P + ks * 32 + hi * 16);
#pragma unroll
        for (int t = 0; t < 2; ++t) { const bf16x8 bb = *(const LAS bf16x8*)(Ks + (db + 32 * t + r32) * RT_P + ks * 32 + hi * 16); acc[t] = MFMA32(a, bb, acc[t]); }
    }
    bf16_t* O = RKVT + (size_t)unit * 16384;
#pragma unroll
    for (int t = 0; t < 2; ++t)
#pragma unroll
        for (int r = 0; r < 16; ++r) { const unsigned pk = cvtpk(acc[t][r], 0.f); O[(size_t)(eb + crow(r, hi)) * 128 + db + 32 * t + r32] = (unsigned short)(pk & 0xffffu); }
    __syncthreads();
}
__device__ __forceinline__ void ret_out_unit(LAS unsigned char* lds, int unit, const bf16_t* PROJ, const bf16_t* RVT, const bf16_t* RKVT, const float* g_gn, bf16_t* MIX) {
    const int tid = opaque_tid(), lane = tid & 63, r32 = lane & 31, hi = lane >> 5, wid = __builtin_amdgcn_readfirstlane(tid >> 6);
    const int n = unit & 31, h = (unit >> 5) & 3, b = unit >> 7;
    const size_t t0 = (size_t)b * SEQ + n * 128;
    const float l2g = ret_log2g(h);
    LAS unsigned char* Ks = lds;
    LAS unsigned char* Vs = lds + 128 * RT_P;
    LAS unsigned char* Rs = Vs + 128 * RT_PV;
    LAS float* Xs = (LAS float*)(Rs + 128 * RT_P);
#pragma unroll
    for (int i = 0; i < 4; ++i) { const int idx = tid + 512 * i, j = idx >> 4, c = idx & 15;
        *(LAS u32x4*)(Ks + j * RT_P + c * 16) = *(const u32x4*)(PROJ + (t0 + j) * NPROJ + 1152 + h * 128 + c * 8); }
#pragma unroll
    for (int i = 0; i < 4; ++i) { const int idx = tid + 512 * i, e = idx >> 4, c = idx & 15;
        const u32x4 v = *(const u32x4*)(RVT + (size_t)(h * 128 + e) * TP + t0 + c * 8);
        *(LAS u32x2*)(Vs + e * RT_PV + c * 16) = (u32x2){v.x, v.y}; *(LAS u32x2*)(Vs + e * RT_PV + c * 16 + 8) = (u32x2){v.z, v.w}; }
    {
        const bf16_t* src = RKVT + (size_t)unit * 16384;
#pragma unroll
        for (int i = 0; i < 4; ++i) { const int idx = tid + 512 * i, e = idx >> 4, c = idx & 15; *(LAS u32x4*)(Rs + e * RT_P + c * 16) = *(const u32x4*)(src + idx * 8); }
    }
    const int ib = wid & 3, eh = wid >> 2;
    bf16x8 qf[8];
    { const bf16_t* qr = PROJ + (t0 + ib * 32 + r32) * NPROJ + 640 + h * 128 + hi * 8;
#pragma unroll
      for (int s = 0; s < 8; ++s) qf[s] = *(const bf16x8*)(qr + s * 16); }
    __syncthreads();
    f32x16 oi[2], oc[2];
#pragma unroll
    for (int t = 0; t < 2; ++t)
#pragma unroll
        for (int r = 0; r < 16; ++r) { oi[t][r] = 0.f; oc[t][r] = 0.f; }
#pragma unroll
    for (int s = 0; s < 8; ++s)
#pragma unroll
        for (int t = 0; t < 2; ++t) { const bf16x8 a = *(const LAS bf16x8*)(Rs + (eh * 64 + t * 32 + r32) * RT_P + s * 32 + hi * 16); oc[t] = MFMA32(a, qf[s], oc[t]); }
    for (int jt = 0; jt <= ib; ++jt) {
        f32x16 p;
#pragma unroll
        for (int r = 0; r < 16; ++r) p[r] = 0.f;
#pragma unroll
        for (int s = 0; s < 8; ++s) { const bf16x8 a = *(const LAS bf16x8*)(Ks + (jt * 32 + r32) * RT_P + s * 32 + hi * 16); p = MFMA32(a, qf[s], p); }
        const int dbase = (ib - jt) * 32 + r32;
#pragma unroll
        for (int r = 0; r < 16; ++r) { const int dd = dbase - crow(r, hi); p[r] = dd >= 0 ? p[r] * exp2f((float)dd * l2g) : 0.f; }
        bf16x8 pb[2];
#pragma unroll
        for (int ks = 0; ks < 2; ++ks) { u32x4 w; w.x = cvtpk(p[8 * ks + 0], p[8 * ks + 1]); w.y = cvtpk(p[8 * ks + 2], p[8 * ks + 3]); w.z = cvtpk(p[8 * ks + 4], p[8 * ks + 5]); w.w = cvtpk(p[8 * ks + 6], p[8 * ks + 7]); pb[ks] = __builtin_bit_cast(bf16x8, w); }
#pragma unroll
        for (int t = 0; t < 2; ++t)
#pragma unroll
            for (int ks = 0; ks < 2; ++ks) { const LAS unsigned char* vp = Vs + (eh * 64 + t * 32 + r32) * RT_PV + (jt * 32 + ks * 16) * 2 + hi * 8;
                const s16x4 lo = *(const LAS s16x4*)vp, hh = *(const LAS s16x4*)(vp + 16);
                const bf16x8 a = (bf16x8){lo[0], lo[1], lo[2], lo[3], hh[0], hh[1], hh[2], hh[3]}; oi[t] = MFMA32(a, pb[ks], oi[t]); }
    }
    const float xi = exp2f((float)(ib * 32 + r32 + 1) * l2g);
    float s1 = 0.f, s2 = 0.f;
#pragma unroll
    for (int t = 0; t < 2; ++t)
#pragma unroll
        for (int r = 0; r < 16; ++r) { const float v = oi[t][r] + oc[t][r] * xi; oi[t][r] = v; s1 += v; s2 += v * v; }
    s1 = xhalf_sum(s1); s2 = xhalf_sum(s2);
    if (hi == 0) { Xs[(wid * 32 + r32) * 2] = s1; Xs[(wid * 32 + r32) * 2 + 1] = s2; }
    __syncthreads();
    { const int ow = wid ^ 4; s1 += Xs[(ow * 32 + r32) * 2]; s2 += Xs[(ow * 32 + r32) * 2 + 1]; }
    const float mean = s1 * (1.f / 128.f), var = fmaxf(s2 * (1.f / 128.f) - mean * mean, 0.f), rstd = rsqrtf(var + EPS);
    const size_t trow = t0 + ib * 32 + r32;
    const bf16_t* grow = PROJ + trow * NPROJ + 1664 + h * 128;
    bf16_t* orow = MIX + trow * D + 512 + h * 128;
#pragma unroll
    for (int t = 0; t < 2; ++t)
#pragma unroll
        for (int g = 0; g < 4; ++g) { const int e = eh * 64 + t * 32 + 8 * g + 4 * hi;
            const u32x2 gg = *(const u32x2*)(grow + e); const f32x4 gn = *(const f32x4*)(g_gn + h * 128 + e);
            const float rg[4] = {bf2f((unsigned short)(gg.x & 0xffffu)), bf2f((unsigned short)(gg.x >> 16)), bf2f((unsigned short)(gg.y & 0xffffu)), bf2f((unsigned short)(gg.y >> 16))};
            float y[4];
#pragma unroll
            for (int q = 0; q < 4; ++q) { const float sil = rg[q] / (1.f + __expf(-rg[q])); y[q] = (oi[t][4 * g + q] - mean) * rstd * gn[q] * sil; }
            u32x2 w; w.x = cvtpk(y[0], y[1]); w.y = cvtpk(y[2], y[3]); *(u32x2*)(orow + e) = w; }
    __syncthreads();
}

constexpr int PK_P = 272;
constexpr int PEER_SK = 0, PEER_LST = 2 * 128 * PK_P;
constexpr int PEER_ENT = PEER_LST + NWAVES * 4096;
__device__ __forceinline__ unsigned f_ord(float f) { const unsigned u = __float_as_uint(f); return u ^ ((unsigned)((int)u >> 31) | 0x80000000u); }
__device__ __forceinline__ float f_unord(unsigned k) { return __uint_as_float((k & 0x80000000u) ? (k ^ 0x80000000u) : ~k); }
#define TK_INS(L, x) do { unsigned _x = (x); _Pragma("unroll") for (int _j = 0; _j < 16; ++_j) { const unsigned _h = max(_x, L[_j]); _x = min(_x, L[_j]); L[_j] = _h; } } while (0)
__device__ __forceinline__ void tk_merge_partner(unsigned (&L)[16], int hi) {
    unsigned M[16];
#pragma unroll
    for (int i = 0; i < 16; ++i) { const unsigned o = xhalf_other(L[15 - i], hi); M[i] = max(L[i], o); }
#pragma unroll
    for (int st = 8; st >= 1; st >>= 1)
#pragma unroll
        for (int i = 0; i < 16; ++i) if ((i & st) == 0) { const unsigned a = max(M[i], M[i + st]), bq = min(M[i], M[i + st]); M[i] = a; M[i + st] = bq; }
#pragma unroll
    for (int i = 0; i < 16; ++i) L[i] = M[i];
}

template <bool RETR_ONLY>
__device__ __forceinline__ void peer_phase(LAS unsigned char* lds, const Params& p, int vcu, int G) {
    const int tid = opaque_tid(), lane = tid & 63, r32 = lane & 31, hi = lane >> 5, wid = __builtin_amdgcn_readfirstlane(tid >> 6);
    const bf16_t* SK = (const bf16_t*)(p.ws + WS_SK); const bf16_t* QP = (const bf16_t*)(p.ws + WS_QP);
    const unsigned char* U8 = p.ws + WS_U8; const float* ssq2 = (const float*)(p.ws + WS_SSQ2); unsigned* EG = (unsigned*)(p.ws + WS_EG); float* WG = (float*)(p.ws + WS_WG);
    for (int idx = tid; idx < 2 * 128 * 16; idx += 512) { const int row = idx >> 4, c = idx & 15; *(LAS u32x4*)(lds + PEER_SK + row * PK_P + c * 16) = *(const u32x4*)(SK + row * 128 + c * 8); }
    __syncthreads();
    LAS unsigned* LST = (LAS unsigned*)(lds + PEER_LST + wid * 4096);
    LAS u32x2* ENT = (LAS u32x2*)(lds + PEER_ENT + wid * 4096);
    for (int grp = vcu * NWAVES + wid; grp < T / 4; grp += G * NWAVES) {
        const int tok0 = grp * 4;
        int lg = lane; asm volatile("" : "+v"(lg));
        const int r32 = lg & 31, hi = lg >> 5;
        const unsigned hi4 = (unsigned)hi << 2;
        {
            const bf16_t* qrow = QP + (size_t)(tok0 + (r32 >> 3)) * 2048 + (r32 & 7) * 256 + hi * 8;
            unsigned LA[16], LB[16];
#pragma unroll
            for (int pp = 0; pp < 2; ++pp) {
                bf16x8 qf[8];
#pragma unroll
                for (int s = 0; s < 8; ++s) qf[s] = *(const bf16x8*)(qrow + pp * 128 + s * 16);
                unsigned L[16];
#pragma unroll
                for (int i = 0; i < 16; ++i) L[i] = 0u;
#pragma unroll
                for (int kt = 0; kt < 4; ++kt) {
                    f32x16 sc;
#pragma unroll
                    for (int r = 0; r < 16; ++r) sc[r] = 0.f;
#pragma unroll
                    for (int s = 0; s < 8; ++s) { const bf16x8 a = *(const LAS bf16x8*)(lds + PEER_SK + (pp * 128 + kt * 32 + r32) * PK_P + s * 32 + hi * 16); sc = MFMA32(a, qf[s], sc); }
#pragma unroll
                    for (int r = 0; r < 16; ++r) { const unsigned code = 127u - (unsigned)(32 * kt + (r & 3) + 8 * (r >> 2)); TK_INS(L, ((f_ord(sc[r]) & ~0x7Fu) | code) ^ hi4); }
                }
                tk_merge_partner(L, hi);
#pragma unroll
                for (int i = 0; i < 16; ++i) { if (pp == 0) LA[i] = L[i]; else LB[i] = L[i]; }
            }
#pragma unroll
            for (int i = 0; i < 16; ++i) { LST[i * 32 + r32] = LA[i]; LST[(16 + i) * 32 + r32] = LB[i]; }
            float va[16], vb[16];
#pragma unroll
            for (int i = 0; i < 16; ++i) { va[i] = f_unord(LA[i] & ~0x7Fu); vb[i] = f_unord(LB[i] & ~0x7Fu); }
            unsigned C[16];
#pragma unroll
            for (int i = 0; i < 16; ++i) C[i] = 0u;
#pragma unroll
            for (int i = 0; i < 16; ++i)
#pragma unroll
                for (int j = 0; j < 16; ++j) if ((i + 1) * (j + 1) <= 16) { const unsigned code = 255u - (unsigned)(16 * i + j); TK_INS(C, (f_ord(va[i] + vb[j]) & ~0xFFu) | code); }
            LDS_WAIT();
            float bs[16]; unsigned ex[16]; float mx = -1e30f;
#pragma unroll
            for (int k = 0; k < 16; ++k) { const unsigned code = 255u - (C[k] & 0xFFu); const unsigned i = code >> 4, j = code & 15u;
                const unsigned ka = LST[i * 32 + r32], kbq = LST[(16 + j) * 32 + r32];
                bs[k] = f_unord(ka & ~0x7Fu) + f_unord(kbq & ~0x7Fu); ex[k] = (127u - (ka & 0x7Fu)) * 128u + (127u - (kbq & 0x7Fu)); mx = fmaxf(mx, bs[k]); }
            float sum = 0.f;
#pragma unroll
            for (int k = 0; k < 16; ++k) { bs[k] = __expf(bs[k] - mx); sum += bs[k]; }
            const float rinv = 1.f / sum;
            if (hi == 0) {
#pragma unroll
                for (int k = 0; k < 16; ++k) ENT[(r32 >> 3) * 128 + (r32 & 7) * 16 + k] = (u32x2){ex[k], __float_as_uint(bs[k] * rinv)};
            }
            LDS_WAIT();
        }
        if (RETR_ONLY) {
            for (int tk = 0; tk < 4; ++tk) { const int t = tok0 + tk;
                int ln = lane; asm volatile("" : "+v"(ln));
                const u32x2 a0 = ENT[tk * 128 + ln], a1 = ENT[tk * 128 + 64 + ln];
                const int j0 = 16 * (ln & 7) + (ln >> 3), j1 = j0 + 8;
                EG[(size_t)t * 128 + j0] = a0.x; WG[(size_t)t * 128 + j0] = __uint_as_float(a0.y);
                EG[(size_t)t * 128 + j1] = a1.x; WG[(size_t)t * 128 + j1] = __uint_as_float(a1.y); }
            continue;
        }
        for (int tk = 0; tk < 4; ++tk) {
            const int t = tok0 + tk;
            int ln = lane; asm volatile("" : "+v"(ln));
            const bf16_t* hrow = (const bf16_t*)(p.ws + WS_H2B) + (size_t)t * D + ln * 16;
            f32x2 hv[8];
#pragma unroll
            for (int i = 0; i < 2; ++i) { const u32x4 v = *(const u32x4*)(hrow + 8 * i); const unsigned w[4] = {v.x, v.y, v.z, v.w};
#pragma unroll
                for (int q = 0; q < 4; ++q) hv[4 * i + q] = (f32x2){bf2f((unsigned short)(w[q] & 0xffffu)), bf2f((unsigned short)(w[q] >> 16))}; }
            const float rstd2 = rsqrtf(ssq_sum<16>(ssq2 + (size_t)t * 16) * (1.f / D) + EPS);
            EG[(size_t)t * 128 + ln] = ENT[tk * 128 + ln].x; EG[(size_t)t * 128 + 64 + ln] = ENT[tk * 128 + 64 + ln].x;
            u32x4 ua[16], ub[16];
            { const unsigned ex = ENT[tk * 128 + (ln & 15)].x;
#pragma unroll
              for (int k = 0; k < 16; ++k) { const unsigned e = (unsigned)__builtin_amdgcn_readlane((int)ex, k); ua[k] = *(const u32x4*)(U8 + (size_t)e * D + ln * 16); } }
            auto head = [&](u32x4 (&cur)[16], u32x4 (&nxt)[16], int hd) {
                if (hd < 7) { const unsigned ex = ENT[tk * 128 + (hd + 1) * 16 + (ln & 15)].x;
#pragma unroll
                    for (int k = 0; k < 16; ++k) { const unsigned e = (unsigned)__builtin_amdgcn_readlane((int)ex, k); nxt[k] = *(const u32x4*)(U8 + (size_t)e * D + ln * 16); } }
                const float gate = __uint_as_float(ENT[tk * 128 + hd * 16 + ((ln >> 2) & 15)].y);
                float dt[16];
#pragma unroll
                for (int k = 0; k < 16; ++k) { f32x2 a0 = (f32x2){0.f, 0.f}, a1 = (f32x2){0.f, 0.f}; const unsigned w[4] = {cur[k].x, cur[k].y, cur[k].z, cur[k].w};
#pragma unroll
                    for (int q = 0; q < 4; ++q) { const f32x2 lo = __builtin_amdgcn_cvt_pk_f32_fp8((int)w[q], false), h2 = __builtin_amdgcn_cvt_pk_f32_fp8((int)w[q], true);
                        a0 += lo * hv[2 * q]; a1 += h2 * hv[2 * q + 1]; }
                    const f32x2 a = a0 + a1; dt[k] = a[0] + a[1]; if (k & 1) __builtin_amdgcn_sched_barrier(0); }
                float y8[8], y4[4], y2[2], y1;
                { const bool bsel = (ln & 32) != 0;
#pragma unroll
                  for (int k = 0; k < 8; ++k) { const float snd = bsel ? dt[k] : dt[k + 8], kp = bsel ? dt[k + 8] : dt[k]; y8[k] = kp + __shfl_xor(snd, 32); } }
                { const bool bsel = (ln & 16) != 0;
#pragma unroll
                  for (int k = 0; k < 4; ++k) { const float snd = bsel ? y8[k] : y8[k + 4], kp = bsel ? y8[k + 4] : y8[k]; y4[k] = kp + __shfl_xor(snd, 16); } }
                { const bool bsel = (ln & 8) != 0;
#pragma unroll
                  for (int k = 0; k < 2; ++k) { const float snd = bsel ? y4[k] : y4[k + 2], kp = bsel ? y4[k + 2] : y4[k]; y2[k] = kp + __shfl_xor(snd, 8); } }
                { const bool bsel = (ln & 4) != 0; const float snd = bsel ? y2[0] : y2[1], kp = bsel ? y2[1] : y2[0]; y1 = kp + __shfl_xor(snd, 4); }
                y1 += __shfl_xor(y1, 2); y1 += __shfl_xor(y1, 1);
                const float act = y1 * rstd2 * (1.f / U_SCALE);
                const float wgt = gate * gelu_f(act) * (1.f / V_SCALE);
                if ((ln & 3) == 0) WG[(size_t)t * 128 + hd * 16 + ((ln >> 2) & 15)] = wgt;
            };
            for (int hd = 0; hd < 8; hd += 2) { head(ua, ub, hd); head(ub, ua, hd + 1); }
        }
    }
}

__device__ __forceinline__ void peer_v_phase(const Params& p, int vcu, int G) {
    const int tid = opaque_tid(), lane = tid & 63, wid = __builtin_amdgcn_readfirstlane(tid >> 6);
    const unsigned char* V8 = p.ws + WS_V8; const unsigned* EG = (const unsigned*)(p.ws + WS_EG); const float* WG = (const float*)(p.ws + WS_WG);
    for (int grp = vcu * NWAVES + wid; grp < T / 4; grp += G * NWAVES) {
        for (int tk = 0; tk < 4; ++tk) {
            const int t = grp * 4 + tk;
            int ln = lane; asm volatile("" : "+v"(ln));
            const unsigned e0 = EG[(size_t)t * 128 + ln], e1 = EG[(size_t)t * 128 + 64 + ln];
            const float w0 = WG[(size_t)t * 128 + ln], w1 = WG[(size_t)t * 128 + 64 + ln];
            f32x2 ov[8];
#pragma unroll
            for (int i = 0; i < 8; ++i) ov[i] = (f32x2){0.f, 0.f};
            u32x4 va[16], vb[16];
#pragma unroll
            for (int k = 0; k < 16; ++k) { const unsigned e = (unsigned)__builtin_amdgcn_readlane((int)e0, k); va[k] = *(const u32x4*)(V8 + (size_t)e * D + ln * 16); }
            auto head = [&](u32x4 (&cur)[16], u32x4 (&nxt)[16], int hd) {
                if (hd < 7) { const int h1 = hd + 1; const unsigned er = (h1 & 4) ? e1 : e0; const int lb = (h1 & 3) * 16;
#pragma unroll
                    for (int k = 0; k < 16; ++k) { const unsigned e = (unsigned)__builtin_amdgcn_readlane((int)er, lb + k); nxt[k] = *(const u32x4*)(V8 + (size_t)e * D + ln * 16); } }
                const float wr = (hd & 4) ? w1 : w0; const int lb0 = (hd & 3) * 16;
#pragma unroll
                for (int k = 0; k < 16; ++k) { const float wk = __uint_as_float((unsigned)__builtin_amdgcn_readlane((int)__float_as_uint(wr), lb0 + k)); const f32x2 wk2 = (f32x2){wk, wk};
                    const unsigned w[4] = {cur[k].x, cur[k].y, cur[k].z, cur[k].w};
#pragma unroll
                    for (int q = 0; q < 4; ++q) { const f32x2 lo = __builtin_amdgcn_cvt_pk_f32_fp8((int)w[q], false), h2 = __builtin_amdgcn_cvt_pk_f32_fp8((int)w[q], true);
                        ov[2 * q] += wk2 * lo; ov[2 * q + 1] += wk2 * h2; }
                    if (k & 1) __builtin_amdgcn_sched_barrier(0); }
            };
            for (int hd = 0; hd < 8; hd += 2) { head(va, vb, hd); head(vb, va, hd + 1); }
            float* hrow = p.out + (size_t)t * D + ln * 16;
            const bf16_t* hb = (const bf16_t*)(p.ws + WS_H2B) + (size_t)t * D + ln * 16;
            float ss = 0.f; f32x4 h3[4];
#pragma unroll
            for (int q2 = 0; q2 < 2; ++q2) { const u32x4 v = *(const u32x4*)(hb + 8 * q2);
                h3[2 * q2] = (f32x4){bf2f((unsigned short)(v.x & 0xffffu)), bf2f((unsigned short)(v.x >> 16)), bf2f((unsigned short)(v.y & 0xffffu)), bf2f((unsigned short)(v.y >> 16))};
                h3[2 * q2 + 1] = (f32x4){bf2f((unsigned short)(v.z & 0xffffu)), bf2f((unsigned short)(v.z >> 16)), bf2f((unsigned short)(v.w & 0xffffu)), bf2f((unsigned short)(v.w >> 16))}; }
#pragma unroll
            for (int q = 0; q < 4; ++q) { h3[q] = h3[q] + (f32x4){ov[2 * q][0], ov[2 * q][1], ov[2 * q + 1][0], ov[2 * q + 1][1]};
                ss += (h3[q][0] * h3[q][0] + h3[q][1] * h3[q][1]) + (h3[q][2] * h3[q][2] + h3[q][3] * h3[q][3]); }
            const float rstd3 = rsqrtf(wave_sum(ss) * (1.f / D) + EPS);
#pragma unroll
            for (int q = 0; q < 4; ++q) { const f32x4 gf = *(const f32x4*)(p.g_final + ln * 16 + 4 * q); *(f32x4*)(hrow + 4 * q) = h3[q] * rstd3 * gf; }
        }
    }
}

template <bool VSIDE>
__device__ __forceinline__ void peer_slice_tokens(const Params& p, int x, int w0, int nwv, int lane) {
    const unsigned char* TB = p.ws + (VSIDE ? WS_V8 : WS_U8) + 128 * x;
    const unsigned* EG = (const unsigned*)(p.ws + WS_EG); const float* WG = (const float*)(p.ws + WS_WG);
    const bf16_t* H2 = (const bf16_t*)(p.ws + WS_H2B) + 128 * x;
    float* PART = (float*)(p.ws + WS_PART) + (size_t)x * T * 128; float* SSQ3 = (float*)(p.ws + WS_SSQ3);
    int ln = lane; asm volatile("" : "+v"(ln));
    const int r = ln >> 3, c = ln & 7;
    if (w0 >= T) return;
    u32x4 idn[4];
    f32x4 wn[4], wc[4];
    u32x4 hn[2], hc[2];
    u32x4 ra[16], rb[16];
    auto load_meta = [&](int t) {
#pragma unroll
        for (int q = 0; q < 4; ++q) idn[q] = *(const u32x4*)(EG + (size_t)t * 128 + 16 * r + 4 * q);
        if (VSIDE) {
#pragma unroll
            for (int q = 0; q < 4; ++q) wn[q] = *(const f32x4*)(WG + (size_t)t * 128 + 16 * r + 4 * q);
        } else { hn[0] = *(const u32x4*)(H2 + (size_t)t * D + 16 * c); hn[1] = *(const u32x4*)(H2 + (size_t)t * D + 16 * c + 8); }
    };
    auto issue = [&](u32x4 (&buf)[16]) {
#pragma unroll
        for (int q = 0; q < 4; ++q) { const unsigned e4[4] = {idn[q].x, idn[q].y, idn[q].z, idn[q].w};
#pragma unroll
            for (int j = 0; j < 4; ++j) buf[4 * q + j] = *(const u32x4*)(TB + (size_t)e4[j] * D + 16 * c); }
    };
    auto compute = [&](u32x4 (&cur)[16], int t) {
        if (!VSIDE) {
            f32x2 hv[8];
#pragma unroll
            for (int i2 = 0; i2 < 2; ++i2) { const unsigned w[4] = {hc[i2].x, hc[i2].y, hc[i2].z, hc[i2].w};
#pragma unroll
                for (int q = 0; q < 4; ++q) hv[4 * i2 + q] = (f32x2){bf2f((unsigned short)(w[q] & 0xffffu)), bf2f((unsigned short)(w[q] >> 16))}; }
            float dt[16];
#pragma unroll
            for (int i = 0; i < 16; ++i) { f32x2 a0 = (f32x2){0.f, 0.f}, a1 = (f32x2){0.f, 0.f}; const unsigned w[4] = {cur[i].x, cur[i].y, cur[i].z, cur[i].w};
#pragma unroll
                for (int q = 0; q < 4; ++q) { const f32x2 lo = __builtin_amdgcn_cvt_pk_f32_fp8((int)w[q], false), h2 = __builtin_amdgcn_cvt_pk_f32_fp8((int)w[q], true);
                    a0 += lo * hv[2 * q]; a1 += h2 * hv[2 * q + 1]; }
                const f32x2 a = a0 + a1; dt[i] = a[0] + a[1]; if (i & 1) __builtin_amdgcn_sched_barrier(0); }
            float y8[8], y4[4], y2[2];
            { const bool bs = (ln & 4) != 0;
#pragma unroll
              for (int k = 0; k < 8; ++k) { const float snd = bs ? dt[k] : dt[k + 8], kp = bs ? dt[k + 8] : dt[k]; y8[k] = kp + __shfl_xor(snd, 4); } }
            { const bool bs = (ln & 2) != 0;
#pragma unroll
              for (int k = 0; k < 4; ++k) { const float snd = bs ? y8[k] : y8[k + 4], kp = bs ? y8[k + 4] : y8[k]; y4[k] = kp + __shfl_xor(snd, 2); } }
            { const bool bs = (ln & 1) != 0;
#pragma unroll
              for (int k = 0; k < 2; ++k) { const float snd = bs ? y4[k] : y4[k + 2], kp = bs ? y4[k + 2] : y4[k]; y2[k] = kp + __shfl_xor(snd, 1); } }
            *(f32x2*)(PART + (size_t)t * 128 + 2 * ln) = (f32x2){y2[0], y2[1]};
        } else {
            f32x2 ov[8];
#pragma unroll
            for (int q = 0; q < 8; ++q) ov[q] = (f32x2){0.f, 0.f};
#pragma unroll
            for (int i = 0; i < 16; ++i) { const float wk = wc[i >> 2][i & 3]; const f32x2 wk2 = (f32x2){wk, wk}; const unsigned w[4] = {cur[i].x, cur[i].y, cur[i].z, cur[i].w};
#pragma unroll
                for (int q = 0; q < 4; ++q) { const f32x2 lo = __builtin_amdgcn_cvt_pk_f32_fp8((int)w[q], false), h2 = __builtin_amdgcn_cvt_pk_f32_fp8((int)w[q], true);
                    ov[2 * q] += wk2 * lo; ov[2 * q + 1] += wk2 * h2; }
                if (i & 1) __builtin_amdgcn_sched_barrier(0); }
            f32x2 z4[4], z2[2], z1;
            { const bool bs = (ln & 32) != 0;
#pragma unroll
              for (int k = 0; k < 4; ++k) { const f32x2 snd = bs ? ov[k] : ov[k + 4], kp = bs ? ov[k + 4] : ov[k]; z4[k] = kp + (f32x2){__shfl_xor(snd[0], 32), __shfl_xor(snd[1], 32)}; } }
            { const bool bs = (ln & 16) != 0;
#pragma unroll
              for (int k = 0; k < 2; ++k) { const f32x2 snd = bs ? z4[k] : z4[k + 2], kp = bs ? z4[k + 2] : z4[k]; z2[k] = kp + (f32x2){__shfl_xor(snd[0], 16), __shfl_xor(snd[1], 16)}; } }
            { const bool bs = (ln & 8) != 0; const f32x2 snd = bs ? z2[0] : z2[1], kp = bs ? z2[1] : z2[0]; z1 = kp + (f32x2){__shfl_xor(snd[0], 8), __shfl_xor(snd[1], 8)}; }
            const int dd = 16 * c + ((ln >> 5) & 1) * 8 + ((ln >> 4) & 1) * 4 + ((ln >> 3) & 1) * 2;
            const unsigned hb = *(const unsigned*)(H2 + (size_t)t * D + dd);
            const f32x2 h3 = (f32x2){bf2f((unsigned short)(hb & 0xffffu)) + z1[0], bf2f((unsigned short)(hb >> 16)) + z1[1]};
            *(f32x2*)(p.out + (size_t)t * D + 128 * x + dd) = h3;
            const float ss = wave_sum(h3[0] * h3[0] + h3[1] * h3[1]);
            if (ln == 0) SSQ3[(size_t)t * 8 + x] = ss;
        }
    };
    load_meta(w0);
    issue(ra);
    if (VSIDE) {
#pragma unroll
        for (int q = 0; q < 4; ++q) wc[q] = wn[q];
    } else { hc[0] = hn[0]; hc[1] = hn[1]; }
    if (w0 + nwv < T) load_meta(w0 + nwv);
    for (int t = w0; t < T; t += 2 * nwv) {
        const bool m1 = t + nwv < T, m2 = t + 2 * nwv < T, m3 = t + 3 * nwv < T;
        f32x4 w1[4]; u32x4 h1[2];
        if (m1) { issue(rb);
            if (VSIDE) {
#pragma unroll
                for (int q = 0; q < 4; ++q) w1[q] = wn[q];
            } else { h1[0] = hn[0]; h1[1] = hn[1]; }
            if (m2) load_meta(t + 2 * nwv); }
        compute(ra, t);
        if (!m1) break;
        if (VSIDE) {
#pragma unroll
            for (int q = 0; q < 4; ++q) wc[q] = w1[q];
        } else { hc[0] = h1[0]; hc[1] = h1[1]; }
        if (m2) { issue(ra); }
        f32x4 w2[4]; u32x4 h2x[2];
        if (m2) {
            if (VSIDE) {
#pragma unroll
                for (int q = 0; q < 4; ++q) w2[q] = wn[q];
            } else { h2x[0] = hn[0]; h2x[1] = hn[1]; }
            if (m3) load_meta(t + 3 * nwv); }
        compute(rb, t + nwv);
        if (!m2) break;
        if (VSIDE) {
#pragma unroll
            for (int q = 0; q < 4; ++q) wc[q] = w2[q];
        } else { hc[0] = h2x[0]; hc[1] = h2x[1]; }
    }
}
template <bool VSIDE>
__device__ __forceinline__ void peer_slice_phase(const Params& p, unsigned xcc, int rank, int G, int bx, int wave, int lane) {
    unsigned* ctl = (unsigned*)(p.ws + WS_CTL);
    for (int x = 0; x < 8; ++x) {
        const int cx = (int)__builtin_amdgcn_readfirstlane((int)__hip_atomic_load(ctl + CW_BAR + XB_XCNT(x), __ATOMIC_RELAXED, __HIP_MEMORY_SCOPE_AGENT));
        if (cx != 0 && (int)xcc != x) continue;
        const int nwv = (cx == 0 ? G : cx) * NWAVES, w0 = (cx == 0 ? bx : rank) * NWAVES + wave;
        peer_slice_tokens<VSIDE>(p, x, w0, nwv, lane);
    }
}
__device__ __forceinline__ void peer_combine_phase(const Params& p, int gw, int NGW, int lane) {
    const float* PART = (const float*)(p.ws + WS_PART); float* WG = (float*)(p.ws + WS_WG); const float* ssq2 = (const float*)(p.ws + WS_SSQ2);
    for (int t = gw; t < T; t += NGW) {
        f32x2 s = (f32x2){0.f, 0.f};
#pragma unroll
        for (int x = 0; x < 8; ++x) s += *(const f32x2*)(PART + ((size_t)x * T + t) * 128 + 2 * lane);
        const float rs = rsqrtf(ssq_sum<16>(ssq2 + (size_t)t * 16) * (1.f / D) + EPS) * (1.f / U_SCALE);
        f32x2* wp = (f32x2*)(WG + (size_t)t * 128 + 2 * lane);
        const f32x2 g = *wp;
        *wp = (f32x2){g[0] * gelu_f(s[0] * rs) * (1.f / V_SCALE), g[1] * gelu_f(s[1] * rs) * (1.f / V_SCALE)};
    }
}
__device__ __forceinline__ void peer_final_phase(const Params& p, int gw, int NGW, int lane) {
    const float* SSQ3 = (const float*)(p.ws + WS_SSQ3);
    for (int t = gw; t < T; t += NGW) {
        float* row = p.out + (size_t)t * D + lane * 16;
        f32x4 v[4];
#pragma unroll
        for (int q = 0; q < 4; ++q) v[q] = *(const f32x4*)(row + 4 * q);
        const float rstd3 = rsqrtf(ssq_sum<8>(SSQ3 + (size_t)t * 8) * (1.f / D) + EPS);
#pragma unroll
        for (int q = 0; q < 4; ++q) { const f32x4 gf = *(const f32x4*)(p.g_final + lane * 16 + 4 * q); *(f32x4*)(row + 4 * q) = v[q] * rstd3 * gf; }
    }
}

#ifndef PH_MASK
#define PH_MASK 0xFFFF
#endif
#define PH(k) ((PH_MASK >> (k)) & 1)
#ifndef PEER_DSLICE
#define PEER_DSLICE 1
#endif
#ifndef GEMM_ALIGN
#define GEMM_ALIGN true
#endif
#ifndef REP_MASK
#define REP_MASK 0
#endif
#if (REP_MASK >> 0) & 1
#define REP_0 for (int rep_ = 0; rep_ < 2; ++rep_)
#else
#define REP_0
#endif
#if (REP_MASK >> 1) & 1
#define REP_1 for (int rep_ = 0; rep_ < 2; ++rep_)
#else
#define REP_1
#endif
#if (REP_MASK >> 2) & 1
#define REP_2 for (int rep_ = 0; rep_ < 2; ++rep_)
#else
#define REP_2
#endif
#if (REP_MASK >> 3) & 1
#define REP_3 for (int rep_ = 0; rep_ < 2; ++rep_)
#else
#define REP_3
#endif
#if (REP_MASK >> 4) & 1
#define REP_4 for (int rep_ = 0; rep_ < 2; ++rep_)
#else
#define REP_4
#endif
#if (REP_MASK >> 5) & 1
#define REP_5 for (int rep_ = 0; rep_ < 2; ++rep_)
#else
#define REP_5
#endif
#if (REP_MASK >> 6) & 1
#define REP_6 for (int rep_ = 0; rep_ < 2; ++rep_)
#else
#define REP_6
#endif
#if (REP_MASK >> 7) & 1
#define REP_7 for (int rep_ = 0; rep_ < 2; ++rep_)
#else
#define REP_7
#endif
#if (REP_MASK >> 8) & 1
#define REP_8 for (int rep_ = 0; rep_ < 2; ++rep_)
#else
#define REP_8
#endif
#if (REP_MASK >> 9) & 1
#define REP_9 for (int rep_ = 0; rep_ < 2; ++rep_)
#else
#define REP_9
#endif
#define REP(k) REP_##k
__global__ void __launch_bounds__(NWAVES * 64, 2) fwd_megakernel(Params p) {
    extern __shared__ __attribute__((aligned(16))) unsigned char lds_raw[];
    LAS unsigned char* lds = (LAS unsigned char*)lds_raw;
    const int tid = threadIdx.x, lane = tid & 63, wave = __builtin_amdgcn_readfirstlane(tid >> 6);
    const int G = gridDim.x; const int bx = blockIdx.x;
    const int vcu = (G % 8 == 0) ? (bx % 8) * (G / 8) + bx / 8 : bx;
    if (p.never) { cg::this_grid().sync(); }
    unsigned char* const ws = p.ws;
    volatile LAS unsigned* MISC = (volatile LAS unsigned*)(lds + LDSCTL_OFF);
    for (int u = tid; u < (LDS_BYTES - LDSCTL_OFF) / 4; u += NWAVES * 64) ((LAS unsigned*)(lds + LDSCTL_OFF))[u] = 0u;
    __syncthreads();
    XcdBarrier bar = xcd_barrier_post((unsigned*)(ws + WS_CTL) + CW_BAR, MISC + 8);
    if (tid == 0) MISC[20] = __hip_atomic_fetch_add((unsigned*)(ws + WS_CTL) + CW_XRANK + 64 * bar.x, 1u, __ATOMIC_RELAXED, __HIP_MEMORY_SCOPE_AGENT);
    const int gw = vcu * NWAVES + wave, NGW = G * NWAVES;

#define WSB(off) ((bf16_t*)(p.ws + (off)))
#define WSF(off) ((float*)(p.ws + (off)))
    REP(0) {
    if (PH(0))
    {
        LAS float* scr = (LAS float*)(lds + wave * 16384);
        constexpr int I_IN = 16 * 85, I_XKV = 16 * 64;
        constexpr int NITEMS = I_IN + I_XKV;
        for (int it = gw; it < NITEMS; it += NGW) {
            int r = it;
            if (r < I_IN) { p0_transpose_item<1>(p.w_in, 1024, 2720, WSB(WS_WIN), nullptr, scr, r, lane); continue; } r -= I_IN;
            p0_transpose_item<0>(p.w_xkv, 1024, 2048, WSB(WS_WXKV), nullptr, scr, r, lane);
        }
        for (int m = gw; m < T / 4; m += NGW) rms_rows_to_bf16<4>(p.x + (size_t)m * D, p.g_mix, WSB(WS_A0) + (size_t)m * D, (size_t)(T / 4) * D, lane);
        for (int m = gw; m < 1024; m += NGW) rms_rows_to_bf16<1>(p.mem + (size_t)m * D, p.g_mem, WSB(WS_MEMN) + (size_t)m * D, 0, lane);
        const int gt = vcu * 512 + tid, NGT = G * 512;
        for (int i = gt; i < 2 * 128 * 128 / 2; i += NGT) { const f32x2 v = *(const f32x2*)(p.sub_keys + 2 * i); ((unsigned*)WSB(WS_SK))[i] = cvtpk(v[0], v[1]); }
        for (int i = gt; i < 96 * 1024 / 8; i += NGT) ((u32x4*)(WSB(WS_WIN) + (size_t)2208 * 1024))[i] = (u32x4){0u, 0u, 0u, 0u};
        for (int i = gt; i < SEQ * 64; i += NGT) { const int s = i >> 6, f = i & 63; const float inv = exp2f(-(float)f * (13.287712379549449f / 64.f)); const float ang = (float)s * inv;
            const double rev = (double)ang * 0.15915494309189535; const float fr = (float)(rev - floor(rev)); WSF(WS_CR)[i] = __builtin_amdgcn_cosf(fr); WSF(WS_SR)[i] = __builtin_amdgcn_sinf(fr); }
        for (int i = gt; i < SEQ * 16; i += NGT) { const int s = i >> 4, f = i & 15; const float inv = exp2f(-(float)f * (13.287712379549449f / 16.f)); const float ang = (float)s * inv;
            const double rev = (double)ang * 0.15915494309189535; const float fr = (float)(rev - floor(rev)); WSF(WS_CM)[i] = __builtin_amdgcn_cosf(fr); WSF(WS_SM)[i] = __builtin_amdgcn_sinf(fr); }
    }
    xcd_barrier(bar);
#ifdef DBL_BAR
    xcd_barrier(bar);
#endif
    }

    REP(1) {
    if (PH(1))
    {
        { pg8::Gemm g{WSB(WS_A0), WSB(WS_WIN), T, NPROJ, 1024, 1024, 1024}; pg8::StaticOrder S; S.init(T, NPROJ, G, bx);
          pg8::EpiProj E{WSB(WS_PROJ), WSF(WS_SSQQ), WSF(WS_SSQKV), WSF(WS_CR), WSF(WS_SR), WSF(WS_CM), WSF(WS_SM)}; pg8::gemm_phase<pg8::EpiProj, pg8::StaticOrder, GEMM_ALIGN>(lds, g, S, E); }
#ifdef DUP_P1MAIN
        { pg8::Gemm g{WSB(WS_A0), WSB(WS_WIN), T, NPROJ, 1024, 1024, 1024}; pg8::StaticOrder S; S.init(T, NPROJ, G, bx);
          pg8::EpiProj E{WSB(WS_PROJ), WSF(WS_SSQQ), WSF(WS_SSQKV), WSF(WS_CR), WSF(WS_SR), WSF(WS_CM), WSF(WS_SM)}; pg8::gemm_phase<pg8::EpiProj, pg8::StaticOrder, GEMM_ALIGN>(lds, g, S, E); }
#endif
        { pg8::Gemm g{WSB(WS_WIN) + (size_t)2304 * 1024, WSB(WS_A0), 512, T, 1024, 1024, 1024}; pg8::StaticOrder S; S.init(512, T, G, (bx - 64 + G) % G);
          pg8::EpiPlain E{WSB(WS_RVT), TP}; pg8::gemm_phase<pg8::EpiPlain, pg8::StaticOrder, GEMM_ALIGN>(lds, g, S, E); }
        { pg8::Gemm g{WSB(WS_MEMN), WSB(WS_WXKV), 1024, 1024, 1024, 1024, 1024}; pg8::StaticOrder S; S.init(1024, 1024, G, (bx - 192 + G) % G);
          pg8::EpiPlain E{WSB(WS_KX), 1024}; pg8::gemm_phase<pg8::EpiPlain, pg8::StaticOrder, GEMM_ALIGN>(lds, g, S, E); }
        { pg8::Gemm g{WSB(WS_WXKV) + (size_t)1024 * 1024, WSB(WS_MEMN), 1024, 1024, 1024, 1024, 1024}; pg8::StaticOrder S; S.init(1024, 1024, G, (bx - 208 + G) % G);
          pg8::EpiPlain E{WSB(WS_VXT), 1024}; pg8::gemm_phase<pg8::EpiPlain, pg8::StaticOrder, GEMM_ALIGN>(lds, g, S, E); }
        {
            const int nd = G >= 64 ? 32 : G, d0 = G - nd;
            if (bx >= d0) {
                LAS float* scr = (LAS float*)(lds + wave * 16384);
                constexpr int I_UQ = 6 * 24, I_UKV = 4 * 32, I_SQ = 16 * 32, I_PQ = 16 * 64;
                constexpr int NITEMS = I_UQ + I_UKV + 3 * I_SQ + I_PQ;
                for (int it = (bx - d0) * NWAVES + wave; it < NITEMS; it += nd * NWAVES) {
                    int r = it;
                    if (r < I_UQ) { p0_transpose_item<2>(p.w_uq, 384, 768, WSB(WS_WUQ), p.g_q_lora, scr, r, lane); continue; } r -= I_UQ;
                    if (r < I_UKV) { p0_transpose_item<3>(p.w_ukv, 256, 1024, WSB(WS_WUKV), p.g_kv_lora, scr, r, lane); continue; } r -= I_UKV;
                    if (r < I_SQ) { p0_transpose_item<0>(p.w_o, 1024, 1024, WSB(WS_WO), nullptr, scr, r, lane); continue; } r -= I_SQ;
                    if (r < I_SQ) { p0_transpose_item<0>(p.w_xq, 1024, 1024, WSB(WS_WXQ), p.g_xattn, scr, r, lane); continue; } r -= I_SQ;
                    if (r < I_SQ) { p0_transpose_item<0>(p.w_xo, 1024, 1024, WSB(WS_WXO), nullptr, scr, r, lane); continue; } r -= I_SQ;
                    p0_transpose_item<0>(p.w_pq, 1024, 2048, WSB(WS_WPQ), p.g_ffn, scr, r, lane);
                }
            }
        }
    }
    xcd_barrier(bar);
#ifdef DBL_BAR
    xcd_barrier(bar);
#endif
    }

    REP(2) {
    if (PH(2))
    {
        { pg8::Gemm g{WSB(WS_PROJ), WSB(WS_WUQ), T, 768, 384, NPROJ, 384}; pg8::StaticOrder S; S.init(T, 768, G, bx);
          pg8::EpiQ E{WSB(WS_QM), WSF(WS_SSQQ), WSF(WS_CM), WSF(WS_SM)}; pg8::gemm_phase<pg8::EpiQ, pg8::StaticOrder, GEMM_ALIGN>(lds, g, S, E); }
        { pg8::Gemm g{WSB(WS_PROJ) + 384, WSB(WS_WUKV), T, 512, 256, NPROJ, 256}; pg8::StaticOrder S; S.init(T, 512, G, (bx - 192 + G) % G);
          pg8::EpiRowScale<8> E{WSB(WS_KN), 512, WSF(WS_SSQKV), 1.f / 256.f, 1.f}; pg8::gemm_phase<pg8::EpiRowScale<8>, pg8::StaticOrder, GEMM_ALIGN>(lds, g, S, E); }
        { pg8::Gemm g{WSB(WS_WUKV) + (size_t)512 * 256, WSB(WS_PROJ) + 384, 512, T, 256, 256, NPROJ}; pg8::StaticOrder S; S.init(512, T, G, (bx - 64 + G) % G);
          pg8::EpiColScale E{WSB(WS_VT), TP, WSF(WS_SSQKV), 1.f / 256.f}; pg8::gemm_phase<pg8::EpiColScale, pg8::StaticOrder, GEMM_ALIGN>(lds, g, S, E); }
        for (int u = vcu; u < 512; u += G) ret_state_unit(lds, u, WSB(WS_PROJ), WSB(WS_RVT), WSB(WS_RKVT));
    }
    xcd_barrier(bar);
#ifdef DBL_BAR
    xcd_barrier(bar);
#endif
    }

    REP(3) {
    if (PH(3))
    {
        unsigned* scan_cnt = (unsigned*)(p.ws + WS_CTL) + CW_QUEUE + 64 * Q3_SLOT;
#if (REP_MASK >> 3) & 1
        if (rep_ == 0)
#endif
        {
            bf16_t* RK = WSB(WS_RKVT);
            for (int e2 = vcu * 512 + tid; e2 < 16 * 8192; e2 += G * 512) {
                const int bh = e2 >> 13, off = e2 & 8191; const float cd = exp2f(128.f * ret_log2g(bh & 3));
                unsigned* base = (unsigned*)(RK + (size_t)bh * 32 * 16384) + off;
                unsigned x[32];
#pragma unroll
                for (int n = 0; n < 32; ++n) x[n] = base[(size_t)n * 8192];
                float r0 = 0.f, r1 = 0.f;
#pragma unroll
                for (int n = 0; n < 32; ++n) { const unsigned o = cvtpk(r0, r1); r0 = r0 * cd + bf2f((unsigned short)(x[n] & 0xffffu)); r1 = r1 * cd + bf2f((unsigned short)(x[n] >> 16)); base[(size_t)n * 8192] = o; }
            }
            asm volatile("s_waitcnt vmcnt(0)" ::: "memory");
            __syncthreads();
            if (tid == 0) { __builtin_amdgcn_fence(__ATOMIC_RELEASE, "agent"); asm volatile("s_waitcnt vmcnt(0)" ::: "memory"); __hip_atomic_fetch_add(scan_cnt, 1u, __ATOMIC_RELAXED, __HIP_MEMORY_SCOPE_AGENT); }
        }
#ifdef REP_MLA
        for (int rr_ = 0; rr_ < REP_MLA; ++rr_)
#endif
        for (int v2 = 2 * vcu; v2 < 512; v2 += (v2 & 1) ? 2 * G - 1 : 1) { const int v = v2 >> 1, bh = v >> 3, s = v & 7;
            mla_unit(lds, bh >> 3, bh & 7, (v2 & 1) ? s : 15 - s, WSB(WS_QM), WSB(WS_KN), WSB(WS_PROJ), WSB(WS_VT), WSB(WS_MIX)); }
#ifdef MLA_BAR
        xcd_barrier(bar);
#endif
        if (tid == 0) { unsigned sp = 0; while (__hip_atomic_load(scan_cnt, __ATOMIC_RELAXED, __HIP_MEMORY_SCOPE_AGENT) < (unsigned)G) { __builtin_amdgcn_s_sleep(2); if (++sp > XB_SPIN_CAP) break; }
            __builtin_amdgcn_fence(__ATOMIC_ACQUIRE, "agent"); asm volatile("s_waitcnt vmcnt(0)" ::: "memory"); }
        __syncthreads();
#ifdef REP_RET
        for (int rr_ = 0; rr_ < 2; ++rr_)
#endif
        for (int u = vcu; u < 512; u += G) ret_out_unit(lds, u, WSB(WS_PROJ), WSB(WS_RVT), WSB(WS_RKVT), p.g_ret_gn, WSB(WS_MIX));
    }
    xcd_barrier(bar);
#ifdef DBL_BAR
    xcd_barrier(bar);
#endif
    }

    REP(4) {
    if (PH(4))
#ifdef REP_P4NB
    for (int nb_ = 0; nb_ < 2; ++nb_)
#endif
    { pg8::Gemm g{WSB(WS_MIX), WSB(WS_WO), T, 1024, 1024, 1024, 1024}; pg8::StaticOrder S; S.init(T, 1024, G, bx);
      pg8::EpiRes E{p.x, nullptr, WSB(WS_H1B), WSF(WS_SSQ1)}; pg8::gemm_phase<pg8::EpiRes, pg8::StaticOrder, GEMM_ALIGN>(lds, g, S, E); }
    xcd_barrier(bar);
#ifdef DBL_BAR
    xcd_barrier(bar);
#endif
    }

    REP(5) {
    if (PH(5))
    { pg8::Gemm g{WSB(WS_H1B), WSB(WS_WXQ), T, 1024, 1024, 1024, 1024}; pg8::StaticOrder S; S.init(T, 1024, G, bx);
      pg8::EpiRowScale<16> E{WSB(WS_QX), 1024, WSF(WS_SSQ1), 1.f / 1024.f, C2_X}; pg8::gemm_phase<pg8::EpiRowScale<16>, pg8::StaticOrder, GEMM_ALIGN>(lds, g, S, E); }
    xcd_barrier(bar);
#ifdef DBL_BAR
    xcd_barrier(bar);
#endif
    }

    REP(6) {
    if (PH(6))
    {
        for (int u = vcu; u < 512; u += G) { const int dvh = u & 1, qb = (u >> 1) & 15, h = (u >> 5) & 3, b = u >> 7; xattn_unit(lds, b, h, qb, dvh, WSB(WS_QX), WSB(WS_KX), WSB(WS_VXT), WSB(WS_OX)); }
        unsigned char* U8 = ws + WS_U8; unsigned char* V8 = ws + WS_V8;
        const f32x4* gf = (const f32x4*)p.g_ffn + lane * 4;
        f32x4 gs[4];
#pragma unroll
        for (int i = 0; i < 4; ++i) gs[i] = gf[i] * U_SCALE;
        for (int e = gw; e < 2 * 16384; e += NGW) {
            const bool isv = e >= 16384; const int row = isv ? e - 16384 : e;
            const f32x4* src = (const f32x4*)((isv ? p.v_exp : p.u_exp) + (size_t)row * D) + lane * 4;
            u32x4 o; unsigned ow[4];
#pragma unroll
            for (int i = 0; i < 4; ++i) { f32x4 v = src[i]; v = isv ? v * V_SCALE : v * gs[i]; int pk = 0; pk = __builtin_amdgcn_cvt_pk_fp8_f32(v[0], v[1], pk, false); pk = __builtin_amdgcn_cvt_pk_fp8_f32(v[2], v[3], pk, true); ow[i] = (unsigned)pk; }
            o.x = ow[0]; o.y = ow[1]; o.z = ow[2]; o.w = ow[3];
            *(u32x4*)((isv ? V8 : U8) + (size_t)row * D + lane * 16) = o;
        }
    }
    xcd_barrier(bar);
#ifdef DBL_BAR
    xcd_barrier(bar);
#endif
    }

    REP(7) {
    if (PH(7))
    { pg8::Gemm g{WSB(WS_OX), WSB(WS_WXO), T, 1024, 1024, 1024, 1024}; pg8::StaticOrder S; S.init(T, 1024, G, bx);
      pg8::EpiRes E{nullptr, WSB(WS_H1B), WSB(WS_H2B), WSF(WS_SSQ2)}; pg8::gemm_phase<pg8::EpiRes, pg8::StaticOrder, GEMM_ALIGN>(lds, g, S, E); }
    xcd_barrier(bar);
#ifdef DBL_BAR
    xcd_barrier(bar);
#endif
    }

    REP(8) {
    if (PH(8))
    { pg8::Gemm g{WSB(WS_H2B), WSB(WS_WPQ), T, 2048, 1024, 1024, 1024}; pg8::StaticOrder S; S.init(T, 2048, G, bx);
      pg8::EpiRowScale<16> E{WSB(WS_QP), 2048, WSF(WS_SSQ2), 1.f / 1024.f, 1.f}; pg8::gemm_phase<pg8::EpiRowScale<16>, pg8::StaticOrder, GEMM_ALIGN>(lds, g, S, E); }
    xcd_barrier(bar);
#ifdef DBL_BAR
    xcd_barrier(bar);
#endif
    }

    REP(9) {
    if (PH(9))
    {
#if PEER_DSLICE
      const int myrank = (int)MISC[20];
      peer_phase<true>(lds, p, vcu, G);
      xcd_barrier(bar);
      peer_slice_phase<false>(p, bar.x, myrank, G, bx, wave, lane);
      xcd_barrier(bar);
      peer_combine_phase(p, gw, NGW, lane);
      xcd_barrier(bar);
      peer_slice_phase<true>(p, bar.x, myrank, G, bx, wave, lane);
      xcd_barrier(bar);
      peer_final_phase(p, gw, NGW, lane);
#else
      peer_phase<false>(lds, p, vcu, G);
      xcd_barrier(bar);
      peer_v_phase(p, vcu, G);
#endif
    }
#if (REP_MASK >> 9) & 1
    xcd_barrier(bar);
#endif
    }
}

extern "C" void kernel_launch(void* const* d_in, const int* in_sizes, int n_in, void* d_out, int out_size, void* d_ws, size_t ws_size, hipStream_t stream) {
    static int grid = 0;
    if (grid == 0) {
        if (n_in != 21 || out_size != T * D || ws_size < WS_END) { fprintf(stderr, "kernel_launch: unexpected shapes (n_in %d out %d ws %zu)\n", n_in, out_size, ws_size); grid = -1; return; }
        int dev = 0, cus = 0, per_cu = 0;
        if (hipGetDevice(&dev) != hipSuccess || hipDeviceGetAttribute(&cus, hipDeviceAttributeMultiprocessorCount, dev) != hipSuccess) { grid = -1; return; }
        if (hipFuncSetAttribute((const void*)fwd_megakernel, hipFuncAttributeMaxDynamicSharedMemorySize, LDS_BYTES) != hipSuccess) { fprintf(stderr, "kernel_launch: hipFuncSetAttribute failed\n"); grid = -1; return; }
        if (hipOccupancyMaxActiveBlocksPerMultiprocessor(&per_cu, (const void*)fwd_megakernel, NWAVES * 64, LDS_BYTES) != hipSuccess || per_cu < 1) { fprintf(stderr, "kernel_launch: occupancy query says %d\n", per_cu); grid = -1; return; }
        (void)hipGetLastError();
        grid = cus;
    }
    if (grid < 0) return;
    (void)hipMemsetAsync((char*)d_ws + WS_CTL, 0, CTL_ZERO_BYTES, stream);
    Params p{};
    const float** pp = (const float**)&p;
    for (int i = 0; i < 21; ++i) pp[i] = (const float*)d_in[i];
    p.out = (float*)d_out; p.ws = (unsigned char*)d_ws; p.never = 0; p.pad = 0;
    void* args[] = {&p};
    hipError_t e = hipLaunchCooperativeKernel((const void*)fwd_megakernel, dim3(grid), dim3(NWAVES * 64), args, LDS_BYTES, stream);
    if (e != hipSuccess) fprintf(stderr, "cooperative launch failed: %s (grid %d)\n", hipGetErrorString(e), grid);
}
```

```cpp
#include <hip/hip_runtime.h>
#include <hip/hip_cooperative_groups.h>
#include <cstdio>
#include <cstdint>
namespace cg = cooperative_groups;

#define LAS __attribute__((address_space(3)))
#define GAS __attribute__((address_space(1)))
typedef unsigned short bf16_t;
typedef short bf16x8 __attribute__((ext_vector_type(8)));
typedef short s16x4 __attribute__((ext_vector_type(4)));
typedef float f32x4 __attribute__((ext_vector_type(4)));
typedef float f32x2 __attribute__((ext_vector_type(2)));
typedef float f32x16 __attribute__((ext_vector_type(16)));
typedef unsigned u32x4 __attribute__((ext_vector_type(4)));
typedef unsigned u32x2 __attribute__((ext_vector_type(2)));
typedef __bf16 bf16x2_t __attribute__((ext_vector_type(2)));

constexpr int T = 16384, D = 1024, SEQ = 4096;
constexpr int NPROJ = 2304;
constexpr int NWIN = 2816;
constexpr float EPS = 1e-6f;
constexpr float LOG2E = 1.4426950408889634f;
constexpr float C2_MLA = 0.10206207261596575f * LOG2E;
constexpr float C2_X = 0.0625f * LOG2E;
constexpr float U_SCALE = 512.f, V_SCALE = 64.f;

constexpr size_t MiB = 1u << 20;
constexpr size_t WS_CTL = 0, CTL_ZERO_BYTES = 1 * MiB;
constexpr size_t WS_SSQQ = 227 * MiB, WS_SSQKV = 228 * MiB, WS_SSQ1 = 229 * MiB, WS_SSQ2 = 230 * MiB;
constexpr size_t WS_CR = 1 * MiB, WS_SR = 2 * MiB, WS_CM = 3 * MiB, WS_SM = 3 * MiB + 256 * 1024;
constexpr size_t WS_WIN = 4 * MiB, WS_WUQ = 10 * MiB, WS_WUKV = 11 * MiB, WS_WO = 12 * MiB, WS_WXQ = 14 * MiB, WS_WXKV = 16 * MiB, WS_WXO = 20 * MiB, WS_WPQ = 22 * MiB, WS_SK = 26 * MiB;
constexpr size_t WS_MEMN = 27 * MiB, WS_KX = 29 * MiB, WS_VXT = 31 * MiB;
constexpr size_t WS_A0 = 33 * MiB, WS_MIX = 33 * MiB, WS_QX = 33 * MiB;
constexpr size_t WS_EG = 33 * MiB, WS_WG = 41 * MiB, WS_SSQ3 = 49 * MiB, WS_PART = 65 * MiB;
constexpr size_t WS_PROJ = 65 * MiB, WS_H1B = 65 * MiB, WS_U8 = 137 * MiB, WS_V8 = 153 * MiB;
constexpr size_t WS_OX = 97 * MiB, WS_H2B = 169 * MiB, WS_QP = 65 * MiB;
constexpr size_t WS_RVT = 137 * MiB, WS_QM = 154 * MiB, WS_KN = 178 * MiB, WS_VT = 194 * MiB, WS_RKVT = 211 * MiB;
constexpr int TP = T + 64;
constexpr size_t WS_END = 231 * MiB;
constexpr int CW_BAR = 4096;
constexpr int CW_XRANK = 20480;
constexpr int CW_QUEUE = 16384, Q3_SLOT = 0;

constexpr int RING_BYTES = 131072;
constexpr int LDSCTL_OFF = 143360;
constexpr int LDS_BYTES = 147456;
constexpr int NWAVES = 8;

__device__ __forceinline__ unsigned cvtpk(float lo, float hi) { f32x2 v = {lo, hi}; bf16x2_t b = __builtin_convertvector(v, bf16x2_t); return __builtin_bit_cast(unsigned, b); }
__device__ __forceinline__ float bf2f(unsigned short b) { return __uint_as_float(((unsigned)b) << 16); }
__device__ __forceinline__ int crow(int r, int hi) { return (r & 3) + 8 * (r >> 2) + 4 * hi; }
template <int M> __device__ __forceinline__ float shx(float f, int lane) {
    const int v = (int)__float_as_uint(f); int r;
    if (M == 1) r = __builtin_amdgcn_mov_dpp(v, 0xB1, 0xF, 0xF, true);
    else if (M == 2) r = __builtin_amdgcn_mov_dpp(v, 0x4E, 0xF, 0xF, true);
    else if (M == 4) { r = __builtin_amdgcn_update_dpp(v, v, 0x104, 0xF, 0x5, false); r = __builtin_amdgcn_update_dpp(r, v, 0x114, 0xF, 0xA, false); }
    else if (M == 8) r = __builtin_amdgcn_mov_dpp(v, 0x128, 0xF, 0xF, true);
    else if (M == 16) { auto rr = __builtin_amdgcn_permlane16_swap((unsigned)v, (unsigned)v, false, false); r = (int)((lane & 16) ? rr[0] : rr[1]); }
    else { auto rr = __builtin_amdgcn_permlane32_swap((unsigned)v, (unsigned)v, false, false); r = (int)((lane & 32) ? rr[0] : rr[1]); }
    return __uint_as_float((unsigned)r);
}
__device__ __forceinline__ float wave_sum(float v) {
#pragma unroll
    for (int o = 1; o < 64; o <<= 1) v += __shfl_xor(v, o);
    return v;
}
__device__ __forceinline__ float wave_sum_fast(float v, int lane) {
    v += shx<1>(v, lane); v += shx<2>(v, lane); v += shx<4>(v, lane); v += shx<8>(v, lane); v += shx<16>(v, lane); v += shx<32>(v, lane);
    return v;
}
__device__ __forceinline__ float xhalf_max(float m) { auto rr = __builtin_amdgcn_permlane32_swap(__float_as_uint(m), __float_as_uint(m), false, false); return fmaxf(__uint_as_float(rr[0]), __uint_as_float(rr[1])); }
__device__ __forceinline__ float xhalf_sum(float m) { auto rr = __builtin_amdgcn_permlane32_swap(__float_as_uint(m), __float_as_uint(m), false, false); return __uint_as_float(rr[0]) + __uint_as_float(rr[1]); }
__device__ __forceinline__ unsigned xhalf_other(unsigned m, int hi) { auto rr = __builtin_amdgcn_permlane32_swap(m, m, false, false); return hi ? rr[0] : rr[1]; }
#define LDS_WAIT() asm volatile("s_waitcnt lgkmcnt(0)" ::: "memory")
template <int NP> __device__ __forceinline__ float ssq_sum(const float* part) {
    float s = 0.f;
#pragma unroll
    for (int i = 0; i < NP / 4; ++i) { const f32x4 v = *(const f32x4*)(part + 4 * i); s += v[0]; s += v[1]; s += v[2]; s += v[3]; }
    return s;
}
__device__ __forceinline__ int opaque_tid() { int t = threadIdx.x; asm volatile("" : "+v"(t)); return t; }
#define MFMA32(a, b, c) __builtin_amdgcn_mfma_f32_32x32x16_bf16((a), (b), (c), 0, 0, 0)
__device__ __forceinline__ float gelu_f(float v) {
    const float av = fabsf(v), t = __builtin_amdgcn_rcpf(av * 0.2316418882f + 1.0f);
    float q = t * 0.5307027145f + (-0.7265760135f); q = q * t + 0.7107068705f; q = q * t + (-0.142248368f); q = q * t + 0.127414796f; q = q * t;
    const float e = __builtin_amdgcn_exp2f((v * v) * (-0.72134752044f));
    const float m = v * (q * e);
    return v < 0.f ? m : v - m;
}

namespace pg8 {
constexpr int BM = 256, BK = 64, HALF = 128, HTB = HALF * BK * 2, STAGE_BYTES = 8 * HTB, NXCD = 8, WGM = 8;
__host__ __device__ __forceinline__ int lds_byte(int r, int c) { const int st = (r >> 4) * 2 + (c >> 5), rr = r & 15, cc = c & 31, ob = rr * 64 + cc * 2; return st * 1024 + (ob ^ (((ob >> 9) & 1) << 5)); }
__host__ __device__ __forceinline__ void stage_rc(int b, int& R, int& C) { const int st = b / 1024, sb = b % 1024, swz = sb ^ (((sb >> 9) & 1) << 5); R = (st >> 1) * 16 + swz / 64; C = (st & 1) * 32 + (swz % 64) / 2; }
struct Unit { int pm, pn; };
struct Gemm { const bf16_t* A; const bf16_t* Bt; int M, N, K, lda, ldb; };
struct StaticOrder {
    int nM, nN, nwg, G, c;
    __device__ void init(int M, int N, int G_, int c_) { nM = M / BM; nN = N / BM; nwg = nM * nN; G = G_; c = c_; }
    __device__ bool next(int i, Unit& u) const {
        const long L = (long)i * G + c; if (L >= nwg) return false;
        int wgid = (int)L; { const int q = nwg / NXCD, r = nwg % NXCD, xcd = wgid % NXCD, off = wgid / NXCD; wgid = (xcd < r ? xcd * (q + 1) : r * (q + 1) + (xcd - r) * q) + off; }
        const int nig = WGM * nN, gid = wgid / nig, fm = gid * WGM, gsz = (nM - fm) < WGM ? (nM - fm) : WGM;
        u.pm = fm + ((wgid % nig) % gsz); u.pn = (wgid % nig) / gsz; return true;
    }
};

template <class Epi, class Sched, bool ALIGN_EPI>
__device__ __forceinline__ void gemm_phase(LAS unsigned char* lds, const Gemm g, const Sched& S, const Epi& E) {
    const int tid = opaque_tid(), wid = __builtin_amdgcn_readfirstlane(tid >> 6), lane = tid & 63, wr = wid >> 2, wc = wid & 3, fr = lane & 15, fq = lane >> 4;
    const int K = g.K, nt = K / BK;
    unsigned voffA[2], voffB[2];
#pragma unroll
    for (int i = 0; i < 2; ++i) { int R, C; stage_rc(tid * 16 + i * 8192, R, C); voffA[i] = (unsigned)(R * g.lda + C) * 2u; voffB[i] = (unsigned)(R * g.ldb + C) * 2u; }
    const size_t kstep = (size_t)(BK * 2);
    const size_t hstepA = (size_t)HALF * g.lda * 2, hstepB = (size_t)HALF * g.ldb * 2, tstepA = 2 * hstepA, tstepB = 2 * hstepB;
    const unsigned ldsw = (unsigned)wid * 1024u;
    const int aoff = lds_byte(wr * 64 + fr, fq * 8), boff = lds_byte(wc * 32 + fr, fq * 8);
#define PG8_SA(b, h) (((b) * 2 + (h)) * HTB)
#define PG8_SB(b, h) ((4 + (b) * 2 + (h)) * HTB)
#define PG8_STAGE(bufoff, gbase, voff) do { _Pragma("unroll") for (int _i = 0; _i < 2; ++_i) \
        __builtin_amdgcn_global_load_lds((const unsigned*)((const char*)(gbase) + (voff)[_i]), (LAS unsigned*)(lds + (bufoff) + ldsw + _i * 8192), 16, 0, 0); } while (0)
#define PG8_LDA(dst, b, h) do { _Pragma("unroll") for (int m = 0; m < 4; ++m) _Pragma("unroll") for (int k = 0; k < 2; ++k) dst[m][k] = *(const LAS bf16x8*)(lds + PG8_SA(b, h) + aoff + m * 2048 + k * 1024); } while (0)
#define PG8_LDB(dst, b, h) do { _Pragma("unroll") for (int n = 0; n < 2; ++n) _Pragma("unroll") for (int k = 0; k < 2; ++k) dst[n][k] = *(const LAS bf16x8*)(lds + PG8_SB(b, h) + boff + n * 2048 + k * 1024); } while (0)
#define PG8_MMA(ai, bj, At, Bt) do { __builtin_amdgcn_s_setprio(1); _Pragma("unroll") for (int m = 0; m < 4; ++m) _Pragma("unroll") for (int n = 0; n < 2; ++n) _Pragma("unroll") for (int k = 0; k < 2; ++k) \
        acc[ai][bj][m][n] = __builtin_amdgcn_mfma_f32_16x16x32_bf16(Bt[n][k], At[m][k], acc[ai][bj][m][n], 0, 0, 0); __builtin_amdgcn_s_setprio(0); } while (0)
#define PG8_WAIT_V(n) asm volatile("s_waitcnt vmcnt(" #n ")" ::: "memory")
#define PG8_WAIT_L(n) asm volatile("s_waitcnt lgkmcnt(" #n ")" ::: "memory")
#define PG8_BAR __builtin_amdgcn_s_barrier()
#define PG8_SCHED __builtin_amdgcn_sched_barrier(0)
    Unit cur, nxt; int ui = 0;
    if (!S.next(0, cur)) return;
    f32x4 acc[2][2][4][2];
#pragma unroll
    for (int a = 0; a < 2; ++a)
#pragma unroll
        for (int b = 0; b < 2; ++b)
#pragma unroll
            for (int m = 0; m < 4; ++m)
#pragma unroll
                for (int n = 0; n < 2; ++n) acc[a][b][m][n] = (f32x4){0.f, 0.f, 0.f, 0.f};
    bf16x8 At[4][2], B0[2][2], B1[2][2];
    const char* cA = (const char*)g.A + (size_t)cur.pm * tstepA; const char* cB = (const char*)g.Bt + (size_t)cur.pn * tstepB;
    PG8_STAGE(PG8_SB(0, 0), cB, voffB); PG8_STAGE(PG8_SB(0, 1), cB + hstepB, voffB); PG8_STAGE(PG8_SA(0, 0), cA, voffA); PG8_STAGE(PG8_SA(0, 1), cA + hstepA, voffA);
    if (wr == 1) PG8_BAR;
    PG8_WAIT_V(2); PG8_BAR;
    PG8_STAGE(PG8_SB(1, 0), cB + kstep, voffB); PG8_STAGE(PG8_SA(1, 0), cA + kstep, voffA); PG8_STAGE(PG8_SB(1, 1), cB + hstepB + kstep, voffB);
    PG8_WAIT_V(6); PG8_BAR;
    for (;;) {
        const bool has_next = S.next(ui + 1, nxt);
        const char* nA = has_next ? (const char*)g.A + (size_t)nxt.pm * tstepA : cA; const char* nB = has_next ? (const char*)g.Bt + (size_t)nxt.pn * tstepB : cB;
#pragma nounroll
        for (int t = 0; t < nt; t += 2) {
            const bool last = (t == nt - 2);
            const char* a1 = cA + (size_t)(t + 1) * kstep;
            const char* a2 = last ? nA : cA + (size_t)(t + 2) * kstep; const char* b2 = last ? nB : cB + (size_t)(t + 2) * kstep;
            const char* a3 = a2 + kstep; const char* b3 = b2 + kstep;
            PG8_LDB(B0, 0, 0); PG8_LDB(B1, 0, 1); PG8_SCHED; PG8_LDA(At, 0, 0); PG8_STAGE(PG8_SA(1, 1), a1 + hstepA, voffA);
            PG8_WAIT_V(8); PG8_WAIT_L(0); PG8_BAR; PG8_MMA(0, 0, At, B0); PG8_MMA(0, 1, At, B1); PG8_BAR; PG8_SCHED;
            PG8_LDA(At, 0, 1); PG8_STAGE(PG8_SB(0, 0), b2, voffB); PG8_STAGE(PG8_SB(0, 1), b2 + hstepB, voffB); PG8_STAGE(PG8_SA(0, 0), a2, voffA);
            PG8_WAIT_V(8); PG8_WAIT_L(0); PG8_BAR; PG8_MMA(1, 0, At, B0); PG8_MMA(1, 1, At, B1); PG8_BAR; PG8_SCHED;
            PG8_LDB(B0, 1, 0); PG8_LDB(B1, 1, 1); PG8_SCHED; PG8_LDA(At, 1, 0); PG8_STAGE(PG8_SA(0, 1), a2 + hstepA, voffA);
            PG8_WAIT_V(8); PG8_WAIT_L(0); PG8_BAR; PG8_MMA(0, 0, At, B0); PG8_MMA(0, 1, At, B1); PG8_BAR; PG8_SCHED;
            PG8_LDA(At, 1, 1); PG8_STAGE(PG8_SB(1, 0), b3, voffB); PG8_STAGE(PG8_SB(1, 1), b3 + hstepB, voffB); PG8_STAGE(PG8_SA(1, 0), a3, voffA);
            PG8_WAIT_V(8); PG8_WAIT_L(0); PG8_BAR; PG8_MMA(1, 0, At, B0); PG8_MMA(1, 1, At, B1); PG8_BAR; PG8_SCHED;
        }
        if constexpr (ALIGN_EPI) { if (wr == 0) PG8_BAR; }
        E(acc, cur, wr, wc, fr, fq);
        if (!has_next) break;
#pragma unroll
        for (int a = 0; a < 2; ++a)
#pragma unroll
            for (int b = 0; b < 2; ++b)
#pragma unroll
                for (int m = 0; m < 4; ++m)
#pragma unroll
                    for (int n = 0; n < 2; ++n) acc[a][b][m][n] = (f32x4){0.f, 0.f, 0.f, 0.f};
        cur = nxt; cA = nA; cB = nB; ++ui;
        if constexpr (ALIGN_EPI) { if (wr == 1) PG8_BAR; }
    }
    PG8_WAIT_V(0);
    if constexpr (!ALIGN_EPI) { if (wr == 0) PG8_BAR; }
    PG8_BAR;
#undef PG8_SA
#undef PG8_SB
#undef PG8_STAGE
#undef PG8_LDA
#undef PG8_LDB
#undef PG8_MMA
#undef PG8_WAIT_V
#undef PG8_WAIT_L
#undef PG8_BAR
#undef PG8_SCHED
}

__device__ __forceinline__ void st_bf16x4(bf16_t* p, f32x4 v) { u32x2 w; w.x = cvtpk(v[0], v[1]); w.y = cvtpk(v[2], v[3]); *(u32x2*)p = w; }
#define EPI_LOOP_AM _Pragma("unroll") for (int ai = 0; ai < 2; ++ai) _Pragma("unroll") for (int m = 0; m < 4; ++m)
#define EPI_LOOP_BN _Pragma("unroll") for (int bj = 0; bj < 2; ++bj) _Pragma("unroll") for (int n = 0; n < 2; ++n)

struct EpiPlain {
    bf16_t* O; int ldc;
    __device__ __forceinline__ void operator()(const f32x4 (&acc)[2][2][4][2], const Unit& u, int wr, int wc, int fr, int fq) const {
        const int row0 = u.pm * BM + wr * 64 + fr, col0 = u.pn * BM + wc * 32 + 4 * fq;
        EPI_LOOP_AM { bf16_t* rowp = O + (size_t)(row0 + ai * HALF + m * 16) * ldc + col0;
            EPI_LOOP_BN st_bf16x4(rowp + bj * HALF + n * 16, acc[ai][bj][m][n]); }
    }
};
template <int NP> struct EpiRowScale {
    bf16_t* O; int ldc; const float* ssq; float invn, mul;
    __device__ __forceinline__ void operator()(const f32x4 (&acc)[2][2][4][2], const Unit& u, int wr, int wc, int fr, int fq) const {
        const int row0 = u.pm * BM + wr * 64 + fr, col0 = u.pn * BM + wc * 32 + 4 * fq;
        EPI_LOOP_AM { const int row = row0 + ai * HALF + m * 16; const float rs = rsqrtf(ssq_sum<NP>(ssq + (size_t)row * 16) * invn + EPS) * mul; bf16_t* rowp = O + (size_t)row * ldc + col0;
            EPI_LOOP_BN st_bf16x4(rowp + bj * HALF + n * 16, acc[ai][bj][m][n] * rs);
            if (m & 1) asm volatile("" ::: "memory"); }
    }
};
struct EpiColScale {
    bf16_t* O; int ldc; const float* ssq; float invn;
    __device__ __forceinline__ void operator()(const f32x4 (&acc)[2][2][4][2], const Unit& u, int wr, int wc, int fr, int fq) const {
        const int row0 = u.pm * BM + wr * 64 + fr, col0 = u.pn * BM + wc * 32 + 4 * fq;
        EPI_LOOP_BN { const float* sp = ssq + (size_t)(col0 + bj * HALF + n * 16) * 16;
            const f32x4 rs = (f32x4){rsqrtf(ssq_sum<8>(sp) * invn + EPS), rsqrtf(ssq_sum<8>(sp + 16) * invn + EPS), rsqrtf(ssq_sum<8>(sp + 32) * invn + EPS), rsqrtf(ssq_sum<8>(sp + 48) * invn + EPS)};
            EPI_LOOP_AM st_bf16x4(O + (size_t)(row0 + ai * HALF + m * 16) * ldc + col0 + bj * HALF + n * 16, acc[ai][bj][m][n] * rs);
            asm volatile("" ::: "memory"); }
    }
};
struct EpiRes {
    const float* basef; const bf16_t* baseb; bf16_t* hb; float* ssq;
    __device__ __forceinline__ void operator()(const f32x4 (&acc)[2][2][4][2], const Unit& u, int wr, int wc, int fr, int fq) const {
        const int row0 = u.pm * BM + wr * 64 + fr, col0 = u.pn * BM + wc * 32 + 4 * fq;
        EPI_LOOP_AM { const int row = row0 + ai * HALF + m * 16; const size_t off = (size_t)row * D + col0; float ss = 0.f;
            EPI_LOOP_BN { f32x4 b;
                if (basef) b = *(const f32x4*)(basef + off + bj * HALF + n * 16);
                else { const u32x2 r = *(const u32x2*)(baseb + off + bj * HALF + n * 16); b = (f32x4){bf2f((unsigned short)(r.x & 0xffffu)), bf2f((unsigned short)(r.x >> 16)), bf2f((unsigned short)(r.y & 0xffffu)), bf2f((unsigned short)(r.y >> 16))}; }
                const f32x4 h = b + acc[ai][bj][m][n];
                st_bf16x4(hb + off + bj * HALF + n * 16, h); ss += (h[0] * h[0] + h[1] * h[1]) + (h[2] * h[2] + h[3] * h[3]); }
            ss += __shfl_xor(ss, 16); ss += __shfl_xor(ss, 32);
            if (fq == 0) ssq[(size_t)row * 16 + u.pn * 4 + wc] = ss;
            asm volatile("" ::: "memory"); }
    }
};
struct EpiProj {
    bf16_t* P; float* ssq_q; float* ssq_kv; const float* cr; const float* sr; const float* cm; const float* sm;
    __device__ __forceinline__ void operator()(const f32x4 (&acc)[2][2][4][2], const Unit& u, int wr, int wc, int fr, int fq) const {
        const int row0 = u.pm * BM + wr * 64 + fr;
#pragma unroll
        for (int bj = 0; bj < 2; ++bj) {
            const int hb = 2 * u.pn + bj;
            if (hb == 17 && wc != 0) continue;
            const int kind = hb < 3 ? 0 : hb < 5 ? 1 : hb < 9 ? 2 : hb < 13 ? 3 : hb < 17 ? 4 : 5;
            const int col = hb * HALF + wc * 32 + 4 * fq;
            EPI_LOOP_AM { const int row = row0 + ai * HALF + m * 16; const int s = row & (SEQ - 1);
                f32x4 v0 = acc[ai][bj][m][0], v1 = acc[ai][bj][m][1];
                if (kind <= 1) {
                    float ss = (v0[0] * v0[0] + v0[1] * v0[1]) + (v0[2] * v0[2] + v0[3] * v0[3]) + (v1[0] * v1[0] + v1[1] * v1[1]) + (v1[2] * v1[2] + v1[3] * v1[3]);
                    ss += __shfl_xor(ss, 16); ss += __shfl_xor(ss, 32);
                    if (fq == 0) { if (kind == 0) ssq_q[(size_t)row * 16 + hb * 4 + wc] = ss; else ssq_kv[(size_t)row * 16 + (hb - 3) * 4 + wc] = ss; }
                } else if (kind == 2 || kind == 3) {
                    const f32x4 c = *(const f32x4*)(cr + (size_t)s * 64 + wc * 16 + 4 * fq), sn = *(const f32x4*)(sr + (size_t)s * 64 + wc * 16 + 4 * fq);
                    f32x4 y0 = v0 * c - v1 * sn, y1 = v0 * sn + v1 * c;
                    if (kind == 3) { y0 = y0 * 0.08838834764831845f; y1 = y1 * 0.08838834764831845f; }
                    v0 = y0; v1 = y1;
                } else if (kind == 5) {
                    const f32x4 c = *(const f32x4*)(cm + (size_t)s * 16 + 4 * fq), sn = *(const f32x4*)(sm + (size_t)s * 16 + 4 * fq);
                    const f32x4 y0 = v0 * c - v1 * sn, y1 = v0 * sn + v1 * c; v0 = y0; v1 = y1;
                }
                bf16_t* rowp = P + (size_t)row * NPROJ + col;
                st_bf16x4(rowp, v0); st_bf16x4(rowp + 16, v1);
                if (m & 1) asm volatile("" ::: "memory"); }
        }
    }
};
struct EpiQ {
    bf16_t* O; const float* ssq; const float* cm; const float* sm;
    __device__ __forceinline__ void operator()(const f32x4 (&acc)[2][2][4][2], const Unit& u, int wr, int wc, int fr, int fq) const {
        const int row0 = u.pm * BM + wr * 64 + fr, col0 = u.pn * BM + wc * 32 + 4 * fq;
        EPI_LOOP_AM { const int row = row0 + ai * HALF + m * 16; const int s = row & (SEQ - 1); const float rs = rsqrtf(ssq_sum<12>(ssq + (size_t)row * 16) * (1.f / 384.f) + EPS) * C2_MLA;
            bf16_t* rowp = O + (size_t)row * 768 + col0;
            f32x4 c = (f32x4){1.f, 1.f, 1.f, 1.f}, sn = (f32x4){0.f, 0.f, 0.f, 0.f};
            if (u.pn == 2) { c = *(const f32x4*)(cm + (size_t)s * 16 + 4 * fq); sn = *(const f32x4*)(sm + (size_t)s * 16 + 4 * fq); }
#pragma unroll
            for (int bj = 0; bj < 2; ++bj) { const f32x4 v0 = acc[ai][bj][m][0] * rs, v1 = acc[ai][bj][m][1] * rs;
                st_bf16x4(rowp + bj * HALF, v0 * c - v1 * sn); st_bf16x4(rowp + bj * HALF + 16, v0 * sn + v1 * c); }
            asm volatile("" ::: "memory"); }
    }
};
}

#define XB_TMO      128
#define XB_XCNT(j)  (256  + 64 * (j))
#define XB_XSUB(j)  (1280 + 64 * (j))
#define XB_XGEN(j)  (2304 + 64 * (j))
#define XB_TOP      3328
#define XB_TOPGEN   3392
#define XCD_BAR_WORDS 3456
#define XB_SPIN_CAP (1u << 21)
__device__ __forceinline__ unsigned xb_ld(unsigned* p)              { return __hip_atomic_load(p, __ATOMIC_RELAXED, __HIP_MEMORY_SCOPE_AGENT); }
__device__ __forceinline__ unsigned xb_add(unsigned* p, unsigned v) { return __hip_atomic_fetch_add(p, v, __ATOMIC_RELAXED, __HIP_MEMORY_SCOPE_AGENT); }
__device__ __forceinline__ unsigned xb_xcc_id() { return (unsigned)__builtin_amdgcn_s_getreg((3 << 11) | 20) & 0xFu; }
#define XB_SPIN(cond, bar) do { unsigned _sp = 0; while (cond) { __builtin_amdgcn_s_sleep(1); \
    if ((++_sp & 255u) == 0u) { if (xb_ld(&(bar)[XB_TMO])) break; if (_sp > XB_SPIN_CAP) { atomicAdd(&(bar)[XB_TMO], 1u); break; } } } } while (0)
struct XcdBarrier { unsigned* bar; unsigned x; volatile LAS unsigned* st; };
__device__ __forceinline__ XcdBarrier xcd_barrier_post(unsigned* bar, volatile LAS unsigned* st) {
    XcdBarrier b; b.bar = bar; b.x = xb_xcc_id(); b.st = st;
    if (threadIdx.x == 0) (void)xb_add(&bar[XB_XCNT(b.x)], 1u);
    return b;
}
__device__ __forceinline__ void xcd_barrier_complete(unsigned* bar, unsigned x, unsigned& nloc, unsigned& nx) {
    const unsigned G = gridDim.x * gridDim.y * gridDim.z;
    unsigned sum, cnt, mine, sp = 0u;
    for (;;) {
        sum = 0u; cnt = 0u; mine = 0u;
#pragma unroll
        for (unsigned j = 0; j < 16; ++j) { const unsigned c = xb_ld(&bar[XB_XCNT(j)]); sum += c; cnt += (c > 0u) ? 1u : 0u; mine = (j == x) ? c : mine; }
        if (sum == G) break;
        __builtin_amdgcn_s_sleep(1);
        if ((++sp & 255u) == 0u) { if (xb_ld(&bar[XB_TMO])) break; if (sp > XB_SPIN_CAP) { atomicAdd(&bar[XB_TMO], 1u); break; } }
    }
    nloc = mine > 0u ? mine : 1u; nx = cnt > 0u ? cnt : 1u;
}
__device__ __forceinline__ void xcd_barrier(const XcdBarrier& b) {
    asm volatile("s_waitcnt vmcnt(0)" ::: "memory");
    __syncthreads();
    if (threadIdx.x == 0) {
        unsigned* bar = b.bar;
        __builtin_amdgcn_s_waitcnt(0);
        unsigned nloc = b.st[0], nx = b.st[1];
        if (nloc == 0u) { xcd_barrier_complete(bar, b.x, nloc, nx); b.st[0] = nloc; b.st[1] = nx; }
        const unsigned old = xb_add(&bar[XB_XSUB(b.x)], 1u);
        const unsigned gen = old / nloc;
        if (old + 1u == (gen + 1u) * nloc) {
            __builtin_amdgcn_fence(__ATOMIC_RELEASE, "agent");
            asm volatile("s_waitcnt vmcnt(0)" ::: "memory");
            const unsigned og = xb_add(&bar[XB_TOP], 1u);
            const unsigned tg = og / nx;
            if (og + 1u == (tg + 1u) * nx) xb_add(&bar[XB_TOPGEN], 1u);
            else XB_SPIN(xb_ld(&bar[XB_TOPGEN]) == tg, bar);
            __builtin_amdgcn_fence(__ATOMIC_ACQUIRE, "agent");
            xb_add(&bar[XB_XGEN(b.x)], 1u);
            asm volatile("s_waitcnt vmcnt(0)" ::: "memory");
        } else {
            XB_SPIN(xb_ld(&bar[XB_XGEN(b.x)]) == gen, bar);
            __builtin_amdgcn_fence(__ATOMIC_ACQUIRE, "agent");
            asm volatile("s_waitcnt vmcnt(0)" ::: "memory");
        }
    }
    __syncthreads();
}

struct Params {
    const float *x, *mem, *g_mix, *w_in, *g_q_lora, *w_uq, *g_kv_lora, *w_ukv, *g_ret_gn, *w_o, *g_xattn, *g_mem, *w_xq, *w_xkv, *w_xo, *g_ffn, *w_pq, *sub_keys, *u_exp, *v_exp, *g_final;
    float* out; unsigned char* ws; int never; int pad;
};

__device__ __forceinline__ int permret(int i) { return i < 64 ? ((i >> 4) * 32 + (i & 15)) : (((i - 64) >> 4) * 32 + 16 + ((i - 64) & 15)); }
template <int MODE> __device__ __forceinline__ int dst_row(int c) {
    if (MODE == 1) {
        if (c < 640) return c;
        if (c < 672) return 2176 + (c - 640);
        if (c < 1184) { const int cc = c - 672; return 640 + (cc & ~127) + permret(cc & 127); }
        if (c < 1696) { const int cc = c - 1184; return 1152 + (cc & ~127) + permret(cc & 127); }
        if (c < 2208) return 2304 + (c - 1696);
        return 1664 + (c - 2208);
    } else if (MODE == 2) {
        const int h = c / 96, i = c - h * 96; return i < 64 ? h * 64 + i : 512 + h * 32 + (i - 64);
    } else if (MODE == 3) {
        const int h = c >> 7, i = c & 127; return i < 64 ? h * 64 + i : 512 + h * 64 + (i - 64);
    }
    return c;
}
template <int MODE> __device__ __forceinline__ void p0_transpose_item(const float* W, int K, int N, bf16_t* WT, const float* gain, LAS float* scr, int item, int lane) {
    const int nblk = N / 32, kb = item / nblk, nb = item % nblk, k0 = 64 * kb, n0 = 32 * nb;
    float v[32];
#pragma unroll
    for (int i = 0; i < 32; ++i) { const int kk = 2 * i + (lane >> 5); v[i] = W[(size_t)(k0 + kk) * N + n0 + (lane & 31)]; }
    if (gain) {
#pragma unroll
        for (int i = 0; i < 32; ++i) { const int kk = 2 * i + (lane >> 5); v[i] *= gain[k0 + kk]; }
    }
#pragma unroll
    for (int i = 0; i < 32; ++i) { const int kk = 2 * i + (lane >> 5); scr[kk * 33 + (lane & 31)] = v[i]; }
    LDS_WAIT(); asm volatile("" ::: "memory");
    const int c = lane & 7;
#pragma unroll
    for (int j = 0; j < 4; ++j) { const int n = (lane >> 3) + 8 * j; const LAS float* s = scr + (8 * c) * 33 + n;
        u32x4 o; o.x = cvtpk(s[0 * 33], s[1 * 33]); o.y = cvtpk(s[2 * 33], s[3 * 33]); o.z = cvtpk(s[4 * 33], s[5 * 33]); o.w = cvtpk(s[6 * 33], s[7 * 33]);
        *(u32x4*)(WT + (size_t)dst_row<MODE>(n0 + n) * K + k0 + 8 * c) = o; }
    LDS_WAIT(); asm volatile("" ::: "memory");
}
template <int NR> __device__ __forceinline__ void rms_rows_to_bf16(const float* xrow, const float* g, bf16_t* orow, size_t rstride, int lane) {
    f32x4 v[NR][4];
#pragma unroll
    for (int r = 0; r < NR; ++r)
#pragma unroll
        for (int j = 0; j < 4; ++j) v[r][j] = ((const f32x4*)(xrow + r * rstride) + lane)[64 * j];
    const f32x4* gr = (const f32x4*)g + lane;
    f32x4 gv[4];
#pragma unroll
    for (int j = 0; j < 4; ++j) gv[j] = gr[64 * j];
#pragma unroll
    for (int r = 0; r < NR; ++r) {
        float s = 0.f;
#pragma unroll
        for (int j = 0; j < 4; ++j) s += (v[r][j][0] * v[r][j][0] + v[r][j][1] * v[r][j][1]) + (v[r][j][2] * v[r][j][2] + v[r][j][3] * v[r][j][3]);
        const float rstd = rsqrtf(wave_sum(s) * (1.f / D) + EPS);
        u32x2* o8 = (u32x2*)(orow + r * rstride) + lane;
#pragma unroll
        for (int j = 0; j < 4; ++j) { const f32x4 y = v[r][j] * rstd * gv[j]; u32x2 w; w.x = cvtpk(y[0], y[1]); w.y = cvtpk(y[2], y[3]); o8[64 * j] = w; }
    }
}

struct NoMid { __device__ __forceinline__ void operator()() const {} };
__device__ __forceinline__ float max3f(float a, float b, float c) { return fmaxf(fmaxf(a, b), c); }
template <int NS, int NT, int KG, bool CINIT, bool MASK, class Mid>
__device__ __forceinline__ void flash_tile(const LAS unsigned char* Ks, int kpitch, const LAS unsigned char* Vs, int vpitch, const bf16x8 (&qf)[NS], f32x16 (&o)[NT],
                                           f32x16& negm, float& mref, float& lrun, bool first, int r32, int hi, bool domask, int qrel, int krel, const Mid& mid) {
    f32x16 p0, p1;
    const LAS unsigned char* k0 = Ks + r32 * kpitch + hi * 16; const LAS unsigned char* k1 = k0 + 32 * kpitch;
    if (CINIT) { p0 = negm; p1 = negm; }
    else {
#pragma unroll
        for (int r = 0; r < 16; ++r) { p0[r] = 0.f; p1[r] = 0.f; }
    }
#pragma unroll
    for (int g0 = 0; g0 < NS; g0 += KG) {
        bf16x8 ka[KG], kb2[KG];
#pragma unroll
        for (int s = 0; s < KG; ++s) { ka[s] = *(const LAS bf16x8*)(k0 + (g0 + s) * 32); kb2[s] = *(const LAS bf16x8*)(k1 + (g0 + s) * 32); }
        __builtin_amdgcn_sched_barrier(0);
#pragma unroll
        for (int s = 0; s < KG; ++s) { p0 = MFMA32(ka[s], qf[g0 + s], p0); p1 = MFMA32(kb2[s], qf[g0 + s], p1); }
        __builtin_amdgcn_sched_barrier(0);
    }
    if (!CINIT) {
#pragma unroll
        for (int r = 0; r < 16; ++r) { p0[r] -= mref; p1[r] -= mref; }
    }
    if (MASK) {
#pragma unroll
        for (int r = 0; r < 16; ++r) { const int kv = krel + crow(r, hi); if (kv > qrel) p0[r] = -1e30f; if (kv + 32 > qrel) p1[r] = -1e30f; }
    }
    float ma = max3f(p0[0], p0[1], p1[0]), mb = max3f(p0[2], p0[3], p1[1]); ma = max3f(ma, p1[2], p1[3]);
#pragma unroll
    for (int r = 4; r < 16; r += 4) { ma = max3f(ma, p0[r], p0[r + 1]); mb = max3f(mb, p0[r + 2], p0[r + 3]); ma = max3f(ma, p1[r], p1[r + 1]); mb = max3f(mb, p1[r + 2], p1[r + 3]); }
    const float mx = xhalf_max(fmaxf(ma, mb));
    if (first || __any(mx > 8.0f)) {
        const float dl = first ? mx : fmaxf(mx, 0.f);
        mref += dl;
#pragma unroll
        for (int r = 0; r < 16; ++r) { p0[r] -= dl; p1[r] -= dl; if (CINIT) negm[r] = -mref; }
        const float alpha = __builtin_amdgcn_exp2f(-dl);
        lrun *= alpha;
        if (!first) {
#pragma unroll
            for (int t = 0; t < NT; ++t)
#pragma unroll
                for (int r = 0; r < 16; ++r) o[t][r] *= alpha;
        }
    }
    float rs0 = 0.f, rs1 = 0.f;
#pragma unroll
    for (int r = 0; r < 16; ++r) { p0[r] = __builtin_amdgcn_exp2f(p0[r]); p1[r] = __builtin_amdgcn_exp2f(p1[r]); rs0 += p0[r]; rs1 += p1[r]; }
    lrun += rs0 + rs1;
    bf16x8 pb[4];
#pragma unroll
    for (int ks = 0; ks < 2; ++ks) {
        u32x4 w0, w1;
        w0.x = cvtpk(p0[8 * ks + 0], p0[8 * ks + 1]); w0.y = cvtpk(p0[8 * ks + 2], p0[8 * ks + 3]); w0.z = cvtpk(p0[8 * ks + 4], p0[8 * ks + 5]); w0.w = cvtpk(p0[8 * ks + 6], p0[8 * ks + 7]);
        w1.x = cvtpk(p1[8 * ks + 0], p1[8 * ks + 1]); w1.y = cvtpk(p1[8 * ks + 2], p1[8 * ks + 3]); w1.z = cvtpk(p1[8 * ks + 4], p1[8 * ks + 5]); w1.w = cvtpk(p1[8 * ks + 6], p1[8 * ks + 7]);
        pb[ks] = __builtin_bit_cast(bf16x8, w0); pb[2 + ks] = __builtin_bit_cast(bf16x8, w1);
    }
    mid();
    const LAS unsigned char* vb = Vs + r32 * vpitch + hi * 8;
#pragma unroll
    for (int t = 0; t < NT; ++t) {
        s16x4 lo[4], hh[4];
#pragma unroll
        for (int ks = 0; ks < 4; ++ks) { lo[ks] = *(const LAS s16x4*)(vb + t * 32 * vpitch + ks * 32); hh[ks] = *(const LAS s16x4*)(vb + t * 32 * vpitch + ks * 32 + 16); }
        __builtin_amdgcn_sched_barrier(0);
#pragma unroll
        for (int ks = 0; ks < 4; ++ks) { const bf16x8 a = (bf16x8){lo[ks][0], lo[ks][1], lo[ks][2], lo[ks][3], hh[ks][0], hh[ks][1], hh[ks][2], hh[ks][3]}; o[t] = MFMA32(a, pb[ks], o[t]); }
        __builtin_amdgcn_sched_barrier(0);
    }
}

constexpr int MLA_KP = 208, MLA_VP = 264;
constexpr int MLA_KT = 128 * MLA_KP, MLA_VTB = 64 * MLA_VP, MLA_BUF = MLA_KT + MLA_VTB;
__device__ __forceinline__ void mla_unit(LAS unsigned char* lds, int b, int h, int qb, const bf16_t* QM, const bf16_t* KN, const bf16_t* PROJ, const bf16_t* VT, bf16_t* MIX) {
    const int tid = opaque_tid(), lane = tid & 63, r32 = lane & 31, hi = lane >> 5, wid = __builtin_amdgcn_readfirstlane(tid >> 6);
    const size_t tb = (size_t)b * SEQ;
    const int q0 = qb * 256 + wid * 32;
    bf16x8 qf[6];
    { const bf16_t* qr = QM + (tb + q0 + r32) * 768;
#pragma unroll
      for (int s = 0; s < 4; ++s) qf[s] = *(const bf16x8*)(qr + h * 64 + s * 16 + hi * 8);
#pragma unroll
      for (int s = 0; s < 2; ++s) qf[4 + s] = *(const bf16x8*)(qr + 512 + h * 32 + s * 16 + hi * 8); }
    f32x16 o[2], negm;
#pragma unroll
    for (int r = 0; r < 16; ++r) { o[0][r] = 0.f; o[1][r] = 0.f; negm[r] = 0.f; }
    float mref = 0.f, lrun = 0.f;
    const int NCH = 2 * qb + 2;
    const int kr = tid >> 3, kc = tid & 7;
    const int pr = tid >> 2, pc = tid & 3;
    const int vr = tid >> 4, vc = tid & 15;
    const bf16_t* ksrc = KN + (tb + kr) * 512 + h * 64 + kc * 8;
    const bf16_t* psrc = PROJ + (tb + pr) * NPROJ + 2176 + pc * 8;
    const bf16_t* vsrc = VT + (size_t)(h * 64 + vr) * TP + tb + vc * 8;
    struct Stg { u32x4 k0, k1, pe, v0, v1; };
    Stg sa, sb;
    auto stage_load = [&](Stg& s, int ch) { const size_t ko = (size_t)ch * 128;
        s.k0 = *(const u32x4*)(ksrc + ko * 512); s.k1 = *(const u32x4*)(ksrc + (ko + 64) * 512); s.pe = *(const u32x4*)(psrc + ko * NPROJ);
        s.v0 = *(const u32x4*)(vsrc + ko); s.v1 = *(const u32x4*)(vsrc + (size_t)32 * TP + ko); };
    auto stage_write = [&](const Stg& s, int buf) {
        LAS unsigned char* kb = lds + buf * MLA_BUF; LAS unsigned char* vbp = kb + MLA_KT;
        *(LAS u32x4*)(kb + kr * MLA_KP + kc * 16) = s.k0; *(LAS u32x4*)(kb + (kr + 64) * MLA_KP + kc * 16) = s.k1;
        *(LAS u32x4*)(kb + pr * MLA_KP + 128 + pc * 16) = s.pe;
        { LAS unsigned char* d = vbp + vr * MLA_VP + vc * 16; *(LAS u32x2*)d = (u32x2){s.v0.x, s.v0.y}; *(LAS u32x2*)(d + 8) = (u32x2){s.v0.z, s.v0.w}; }
        { LAS unsigned char* d = vbp + (vr + 32) * MLA_VP + vc * 16; *(LAS u32x2*)d = (u32x2){s.v1.x, s.v1.y}; *(LAS u32x2*)(d + 8) = (u32x2){s.v1.z, s.v1.w}; }
    };
    const int qrel = wid * 32 + r32;
    auto compute = [&](int buf, int ch) {
        const LAS unsigned char* kb = lds + buf * MLA_BUF;
#pragma unroll
        for (int j = 0; j < 2; ++j)
            flash_tile<6, 2, 6, true, false>(kb + j * 64 * MLA_KP, MLA_KP, kb + MLA_KT + j * 128, MLA_VP, qf, o, negm, mref, lrun, ch == 0 && j == 0, r32, hi, false, qrel, 0, NoMid());
    };
    auto compute_band = [&](int buf, int ch) {
        const LAS unsigned char* kb = lds + buf * MLA_BUF;
#pragma unroll
        for (int j = 0; j < 2; ++j) {
            const int krel = ch * 128 + j * 64 - qb * 256;
            if (krel <= wid * 32 + 31)
                flash_tile<6, 2, 6, true, true>(kb + j * 64 * MLA_KP, MLA_KP, kb + MLA_KT + j * 128, MLA_VP, qf, o, negm, mref, lrun, ch == 0 && j == 0, r32, hi, true, qrel, krel, NoMid());
        }
    };
    stage_load(sa, 0); stage_write(sa, 0);
    stage_load(sa, 1);
    __syncthreads();
    for (int ch = 0; ch < NCH - 2; ch += 2) {
        stage_load(sb, ch + 2);
        compute(0, ch);
        stage_write(sa, 1);
        __syncthreads();
        stage_load(sa, ch + 3);
        compute(1, ch + 1);
        stage_write(sb, 0);
        __syncthreads();
    }
    {
        compute_band(0, NCH - 2);
        stage_write(sa, 1);
        __syncthreads();
        compute_band(1, NCH - 1);
        __syncthreads();
    }
    const float inv = 1.f / xhalf_sum(lrun);
    bf16_t* orow = MIX + (tb + q0 + r32) * D + h * 64;
#pragma unroll
    for (int t = 0; t < 2; ++t)
#pragma unroll
        for (int g = 0; g < 4; ++g) { u32x2 w; w.x = cvtpk(o[t][4 * g] * inv, o[t][4 * g + 1] * inv); w.y = cvtpk(o[t][4 * g + 2] * inv, o[t][4 * g + 3] * inv);
            *(u32x2*)(orow + 32 * t + 8 * g + 4 * hi) = w; }
}

constexpr int XA_KP = 528, XA_VP = 136;
constexpr int XA_KT = 64 * XA_KP, XA_VTB = 128 * XA_VP;
__device__ __forceinline__ void xattn_unit(LAS unsigned char* lds, int b, int h, int qb, int dvh, const bf16_t* QX, const bf16_t* KX, const bf16_t* VXT, bf16_t* OX) {
    const int tid = opaque_tid(), lane = tid & 63, r32 = lane & 31, hi = lane >> 5, wid = __builtin_amdgcn_readfirstlane(tid >> 6);
    const size_t tb = (size_t)b * SEQ;
    const int q0 = qb * 256 + wid * 32;
    bf16x8 qf[16];
    { const bf16_t* qr = QX + (tb + q0 + r32) * D + h * 256 + hi * 8;
#pragma unroll
      for (int s = 0; s < 16; ++s) qf[s] = *(const bf16x8*)(qr + s * 16); }
    f32x16 o[4], negm;
#pragma unroll
    for (int t = 0; t < 4; ++t)
#pragma unroll
        for (int r = 0; r < 16; ++r) o[t][r] = 0.f;
#pragma unroll
    for (int r = 0; r < 16; ++r) negm[r] = 0.f;
    float mref = 0.f, lrun = 0.f;
    const bf16_t* kbase = KX + (size_t)(b * 256) * D + h * 256;
    const bf16_t* vbase = VXT + (size_t)(h * 256 + dvh * 128) * D + b * 256;
    u32x4 kreg[4], vreg[2];
    auto stage_load = [&](int kt) {
#pragma unroll
        for (int i = 0; i < 4; ++i) { const int idx = tid + 512 * i, row = idx >> 5, c = idx & 31; kreg[i] = *(const u32x4*)(kbase + (size_t)(kt * 64 + row) * D + c * 8); }
#pragma unroll
        for (int i = 0; i < 2; ++i) { const int idx = tid + 512 * i, dv = idx >> 3, c = idx & 7; vreg[i] = *(const u32x4*)(vbase + (size_t)dv * D + kt * 64 + c * 8); }
    };
    auto stage_write = [&](int buf) {
        LAS unsigned char* kb = lds + buf * (XA_KT + XA_VTB); LAS unsigned char* vbp = kb + XA_KT;
#pragma unroll
        for (int i = 0; i < 4; ++i) { const int idx = tid + 512 * i, row = idx >> 5, c = idx & 31; *(LAS u32x4*)(kb + row * XA_KP + c * 16) = kreg[i]; }
#pragma unroll
        for (int i = 0; i < 2; ++i) { const int idx = tid + 512 * i, dv = idx >> 3, c = idx & 7;
            *(LAS u32x2*)(vbp + dv * XA_VP + c * 16) = (u32x2){vreg[i].x, vreg[i].y}; *(LAS u32x2*)(vbp + dv * XA_VP + c * 16 + 8) = (u32x2){vreg[i].z, vreg[i].w}; }
    };
    stage_load(0); stage_write(0);
    __syncthreads();
    for (int kt = 0; kt < 4; ++kt) {
        const int buf = kt & 1;
        const LAS unsigned char* kb = lds + buf * (XA_KT + XA_VTB);
        auto mid = [&]() { if (kt + 1 < 4) stage_load(kt + 1); };
        flash_tile<16, 4, 4, false, false>(kb, XA_KP, kb + XA_KT, XA_VP, qf, o, negm, mref, lrun, kt == 0, r32, hi, false, 0, 0, mid);
        if (kt + 1 < 4) stage_write(buf ^ 1);
        __syncthreads();
    }
    const float inv = 1.f / xhalf_sum(lrun);
    bf16_t* orow = OX + (tb + q0 + r32) * D + h * 256 + dvh * 128;
#pragma unroll
    for (int t = 0; t < 4; ++t)
#pragma unroll
        for (int g = 0; g < 4; ++g) { u32x2 w; w.x = cvtpk(o[t][4 * g] * inv, o[t][4 * g + 1] * inv); w.y = cvtpk(o[t][4 * g + 2] * inv, o[t][4 * g + 3] * inv);
            *(u32x2*)(orow + 32 * t + 8 * g + 4 * hi) = w; }
}

constexpr int RT_P = 272;
constexpr int RT_PV = 264;
__device__ __forceinline__ float ret_log2g(int h) { return log2f(1.0f - exp2f(-5.0f - (float)h)); }
__device__ __forceinline__ void ret_state_unit(LAS unsigned char* lds, int unit, const bf16_t* PROJ, const bf16_t* RVT, bf16_t* RKVT) {
    const int tid = opaque_tid(), lane = tid & 63, r32 = lane & 31, hi = lane >> 5, wid = __builtin_amdgcn_readfirstlane(tid >> 6);
    const int n = unit & 31, h = (unit >> 5) & 3, b = unit >> 7;
    const size_t t0 = (size_t)b * SEQ + n * 128;
    const float l2g = ret_log2g(h);
    LAS unsigned char* Vs = lds;
    LAS unsigned char* Ks = lds + 128 * RT_P;
#pragma unroll
    for (int i = 0; i < 4; ++i) { const int idx = tid + 512 * i, e = idx >> 4, c = idx & 15;
        *(LAS u32x4*)(Vs + e * RT_P + c * 16) = *(const u32x4*)(RVT + (size_t)(h * 128 + e) * TP + t0 + c * 8); }
#pragma unroll
    for (int i = 0; i < 4; ++i) { const int idx = tid + 512 * i, j = idx >> 4, c = idx & 15;
        const u32x4 v = *(const u32x4*)(PROJ + (t0 + j) * NPROJ + 1152 + h * 128 + c * 8);
        const float z = exp2f((float)(127 - j) * l2g);
        const unsigned w[4] = {v.x, v.y, v.z, v.w};
#pragma unroll
        for (int q = 0; q < 4; ++q) { const float lo = bf2f((unsigned short)(w[q] & 0xffffu)) * z, hh = bf2f((unsigned short)(w[q] >> 16)) * z; const unsigned pk = cvtpk(lo, hh);
            *(LAS unsigned short*)(Ks + (c * 8 + 2 * q) * RT_P + j * 2) = (unsigned short)(pk & 0xffffu); *(LAS unsigned short*)(Ks + (c * 8 + 2 * q + 1) * RT_P + j * 2) = (unsigned short)(pk >> 16); } }
    __syncthreads();
    const int eb = (wid & 3) * 32, db = (wid >> 2) * 64;
    f32x16 acc[2];
#pragma unroll
    for (int t = 0; t < 2; ++t)
#pragma unroll
        for (int r = 0; r < 16; ++r) acc[t][r] = 0.f;
#pragma unroll
    for (int ks = 0; ks < 8; ++ks) {
        const bf16x8 a = *(const LAS bf16x8*)(Vs + (eb + r32) * RT_P + ks * 32 + hi * 16);
#pragma unroll
        for (int t = 0; t < 2; ++t) { const bf16x8 bb = *(const LAS bf16x8*)(Ks + (db + 32 * t + r32) * RT_P + ks * 32 + hi * 16); acc[t] = MFMA32(a, bb, acc[t]); }
    }
    bf16_t* O = RKVT + (size_t)unit * 16384;
#pragma unroll
    for (int t = 0; t < 2; ++t)
#pragma unroll
        for (int r = 0; r < 16; ++r) { const unsigned pk = cvtpk(acc[t][r], 0.f); O[(size_t)(eb + crow(r, hi)) * 128 + db + 32 * t + r32] = (unsigned short)(pk & 0xffffu); }
    __syncthreads();
}
__device__ __forceinline__ void ret_out_unit(LAS unsigned char* lds, int unit, const bf16_t* PROJ, const bf16_t* RVT, const bf16_t* RKVT, const float* g_gn, bf16_t* MIX) {
    const int tid = opaque_tid(), lane = tid & 63, r32 = lane & 31, hi = lane >> 5, wid = __builtin_amdgcn_readfirstlane(tid >> 6);
    const int n = unit & 31, h = (unit >> 5) & 3, b = unit >> 7;
    const size_t t0 = (size_t)b * SEQ + n * 128;
    const float l2g = ret_log2g(h);
    LAS unsigned char* Ks = lds;
    LAS unsigned char* Vs = lds + 128 * RT_P;
    LAS unsigned char* Rs = Vs + 128 * RT_PV;
    LAS float* Xs = (LAS float*)(Rs + 128 * RT_P);
#pragma unroll
    for (int i = 0; i < 4; ++i) { const int idx = tid + 512 * i, j = idx >> 4, c = idx & 15;
        *(LAS u32x4*)(Ks + j * RT_P + c * 16) = *(const u32x4*)(PROJ + (t0 + j) * NPROJ + 1152 + h * 128 + c * 8); }
#pragma unroll
    for (int i = 0; i < 4; ++i) { const int idx = tid + 512 * i, e = idx >> 4, c = idx & 15;
        const u32x4 v = *(const u32x4*)(RVT + (size_t)(h * 128 + e) * TP + t0 + c * 8);
        *(LAS u32x2*)(Vs + e * RT_PV + c * 16) = (u32x2){v.x, v.y}; *(LAS u32x2*)(Vs + e * RT_PV + c * 16 + 8) = (u32x2){v.z, v.w}; }
    {
        const bf16_t* src = RKVT + (size_t)unit * 16384;
#pragma unroll
        for (int i = 0; i < 4; ++i) { const int idx = tid + 512 * i, e = idx >> 4, c = idx & 15; *(LAS u32x4*)(Rs + e * RT_P + c * 16) = *(const u32x4*)(src + idx * 8); }
    }
    const int ib = wid & 3, eh = wid >> 2;
    bf16x8 qf[8];
    { const bf16_t* qr = PROJ + (t0 + ib * 32 + r32) * NPROJ + 640 + h * 128 + hi * 8;
#pragma unroll
      for (int s = 0; s < 8; ++s) qf[s] = *(const bf16x8*)(qr + s * 16); }
    __syncthreads();
    f32x16 oi[2], oc[2];
#pragma unroll
    for (int t = 0; t < 2; ++t)
#pragma unroll
        for (int r = 0; r < 16; ++r) { oi[t][r] = 0.f; oc[t][r] = 0.f; }
#pragma unroll
    for (int s = 0; s < 8; ++s)
#pragma unroll
        for (int t = 0; t < 2; ++t) { const bf16x8 a = *(const LAS bf16x8*)(Rs + (eh * 64 + t * 32 + r32) * RT_P + s * 32 + hi * 16); oc[t] = MFMA32(a, qf[s], oc[t]); }
    for (int jt = 0; jt <= ib; ++jt) {
        f32x16 p;
#pragma unroll
        for (int r = 0; r < 16; ++r) p[r] = 0.f;
#pragma unroll
        for (int s = 0; s < 8; ++s) { const bf16x8 a = *(const LAS bf16x8*)(Ks + (jt * 32 + r32) * RT_P + s * 32 + hi * 16); p = MFMA32(a, qf[s], p); }
        const int dbase = (ib - jt) * 32 + r32;
#pragma unroll
        for (int r = 0; r < 16; ++r) { const int dd = dbase - crow(r, hi); p[r] = dd >= 0 ? p[r] * exp2f((float)dd * l2g) : 0.f; }
        bf16x8 pb[2];
#pragma unroll
        for (int ks = 0; ks < 2; ++ks) { u32x4 w; w.x = cvtpk(p[8 * ks + 0], p[8 * ks + 1]); w.y = cvtpk(p[8 * ks + 2], p[8 * ks + 3]); w.z = cvtpk(p[8 * ks + 4], p[8 * ks + 5]); w.w = cvtpk(p[8 * ks + 6], p[8 * ks + 7]); pb[ks] = __builtin_bit_cast(bf16x8, w); }
#pragma unroll
        for (int t = 0; t < 2; ++t)
#pragma unroll
            for (int ks = 0; ks < 2; ++ks) { const LAS unsigned char* vp = Vs + (eh * 64 + t * 32 + r32) * RT_PV + (jt * 32 + ks * 16) * 2 + hi * 8;
                const s16x4 lo = *(const LAS s16x4*)vp, hh = *(const LAS s16x4*)(vp + 16);
                const bf16x8 a = (bf16x8){lo[0], lo[1], lo[2], lo[3], hh[0], hh[1], hh[2], hh[3]}; oi[t] = MFMA32(a, pb[ks], oi[t]); }
    }
    const float xi = exp2f((float)(ib * 32 + r32 + 1) * l2g);
    float s1 = 0.f, s2 = 0.f;
#pragma unroll
    for (int t = 0; t < 2; ++t)
#pragma unroll
        for (int r = 0; r < 16; ++r) { const float v = oi[t][r] + oc[t][r] * xi; oi[t][r] = v; s1 += v; s2 += v * v; }
    s1 = xhalf_sum(s1); s2 = xhalf_sum(s2);
    if (hi == 0) { Xs[(wid * 32 + r32) * 2] = s1; Xs[(wid * 32 + r32) * 2 + 1] = s2; }
    __syncthreads();
    { const int ow = wid ^ 4; s1 += Xs[(ow * 32 + r32) * 2]; s2 += Xs[(ow * 32 + r32) * 2 + 1]; }
    const float mean = s1 * (1.f / 128.f), var = fmaxf(s2 * (1.f / 128.f) - mean * mean, 0.f), rstd = rsqrtf(var + EPS);
    const size_t trow = t0 + ib * 32 + r32;
    const bf16_t* grow = PROJ + trow * NPROJ + 1664 + h * 128;
    bf16_t* orow = MIX + trow * D + 512 + h * 128;
#pragma unroll
    for (int t = 0; t < 2; ++t)
#pragma unroll
        for (int g = 0; g < 4; ++g) { const int e = eh * 64 + t * 32 + 8 * g + 4 * hi;
            const u32x2 gg = *(const u32x2*)(grow + e); const f32x4 gn = *(const f32x4*)(g_gn + h * 128 + e);
            const float rg[4] = {bf2f((unsigned short)(gg.x & 0xffffu)), bf2f((unsigned short)(gg.x >> 16)), bf2f((unsigned short)(gg.y & 0xffffu)), bf2f((unsigned short)(gg.y >> 16))};
            float y[4];
#pragma unroll
            for (int q = 0; q < 4; ++q) { const float sil = rg[q] / (1.f + __expf(-rg[q])); y[q] = (oi[t][4 * g + q] - mean) * rstd * gn[q] * sil; }
            u32x2 w; w.x = cvtpk(y[0], y[1]); w.y = cvtpk(y[2], y[3]); *(u32x2*)(orow + e) = w; }
    __syncthreads();
}

constexpr int PK_P = 272;
constexpr int PEER_SK = 0, PEER_LST = 2 * 128 * PK_P;
constexpr int PEER_ENT = PEER_LST + NWAVES * 4096;
__device__ __forceinline__ unsigned f_ord(float f) { const unsigned u = __float_as_uint(f); return u ^ ((unsigned)((int)u >> 31) | 0x80000000u); }
__device__ __forceinline__ float f_unord(unsigned k) { return __uint_as_float((k & 0x80000000u) ? (k ^ 0x80000000u) : ~k); }
#define TK_INS(L, x) do { unsigned _x = (x); _Pragma("unroll") for (int _j = 0; _j < 16; ++_j) { const unsigned _h = max(_x, L[_j]); _x = min(_x, L[_j]); L[_j] = _h; } } while (0)
#define TK_CE(a, b) do { const unsigned _hi = max((a), (b)), _lo = min((a), (b)); (a) = _hi; (b) = _lo; } while (0)
__device__ __forceinline__ void tk_sort16(unsigned (&v)[16]) {
#pragma unroll
    for (int k = 2; k <= 16; k <<= 1)
#pragma unroll
        for (int j = k >> 1; j >= 1; j >>= 1)
#pragma unroll
            for (int i = 0; i < 16; ++i) { const int l = i ^ j; if (l > i) { if ((i & k) == 0) TK_CE(v[i], v[l]); else TK_CE(v[l], v[i]); } }
}
__device__ __forceinline__ void tk_merge16(unsigned (&a)[16], const unsigned (&b)[16]) {
#pragma unroll
    for (int i = 0; i < 16; ++i) a[i] = max(a[i], b[15 - i]);
#pragma unroll
    for (int st = 8; st >= 1; st >>= 1)
#pragma unroll
        for (int i = 0; i < 16; ++i) if ((i & st) == 0) TK_CE(a[i], a[i + st]);
}
__device__ __forceinline__ void tk_merge_partner(unsigned (&L)[16], int hi) {
    unsigned M[16];
#pragma unroll
    for (int i = 0; i < 16; ++i) { const unsigned o = xhalf_other(L[15 - i], hi); M[i] = max(L[i], o); }
#pragma unroll
    for (int st = 8; st >= 1; st >>= 1)
#pragma unroll
        for (int i = 0; i < 16; ++i) if ((i & st) == 0) { const unsigned a = max(M[i], M[i + st]), bq = min(M[i], M[i + st]); M[i] = a; M[i + st] = bq; }
#pragma unroll
    for (int i = 0; i < 16; ++i) L[i] = M[i];
}

template <bool RETR_ONLY>
__device__ __forceinline__ void peer_phase(LAS unsigned char* lds, const Params& p, int vcu, int G) {
    const int tid = opaque_tid(), lane = tid & 63, r32 = lane & 31, hi = lane >> 5, wid = __builtin_amdgcn_readfirstlane(tid >> 6);
    const bf16_t* SK = (const bf16_t*)(p.ws + WS_SK); const bf16_t* QP = (const bf16_t*)(p.ws + WS_QP);
    const unsigned char* U8 = p.ws + WS_U8; const float* ssq2 = (const float*)(p.ws + WS_SSQ2); unsigned* EG = (unsigned*)(p.ws + WS_EG); float* WG = (float*)(p.ws + WS_WG);
    for (int idx = tid; idx < 2 * 128 * 16; idx += 512) { const int row = idx >> 4, c = idx & 15; *(LAS u32x4*)(lds + PEER_SK + row * PK_P + c * 16) = *(const u32x4*)(SK + row * 128 + c * 8); }
    __syncthreads();
    LAS unsigned* LST = (LAS unsigned*)(lds + PEER_LST + wid * 4096);
    LAS u32x2* ENT = (LAS u32x2*)(lds + PEER_ENT + wid * 4096);
    for (int grp = vcu * NWAVES + wid; grp < T / 4; grp += G * NWAVES) {
        const int tok0 = grp * 4;
        int lg = lane; asm volatile("" : "+v"(lg));
        const int r32 = lg & 31, hi = lg >> 5;
        const unsigned hi4 = (unsigned)hi << 2;
        {
            const bf16_t* qrow = QP + (size_t)(tok0 + (r32 >> 3)) * 2048 + (r32 & 7) * 256 + hi * 8;
            unsigned LA[16], LB[16];
#pragma unroll
            for (int pp = 0; pp < 2; ++pp) {
                bf16x8 qf[8];
#pragma unroll
                for (int s = 0; s < 8; ++s) qf[s] = *(const bf16x8*)(qrow + pp * 128 + s * 16);
                unsigned L[16];
#pragma unroll
                for (int i = 0; i < 16; ++i) L[i] = 0u;
#pragma unroll
                for (int kt = 0; kt < 4; ++kt) {
                    f32x16 sc;
#pragma unroll
                    for (int r = 0; r < 16; ++r) sc[r] = 0.f;
#pragma unroll
                    for (int s = 0; s < 8; ++s) { const bf16x8 a = *(const LAS bf16x8*)(lds + PEER_SK + (pp * 128 + kt * 32 + r32) * PK_P + s * 32 + hi * 16); sc = MFMA32(a, qf[s], sc); }
                    { unsigned kv[16];
#pragma unroll
                      for (int r = 0; r < 16; ++r) { const unsigned code = 127u - (unsigned)(32 * kt + (r & 3) + 8 * (r >> 2)); kv[r] = ((f_ord(sc[r]) & ~0x7Fu) | code) ^ hi4; }
                      tk_sort16(kv);
                      if (kt == 0) {
#pragma unroll
                          for (int r = 0; r < 16; ++r) L[r] = kv[r];
                      } else tk_merge16(L, kv); }
                }
                tk_merge_partner(L, hi);
#pragma unroll
                for (int i = 0; i < 16; ++i) { if (pp == 0) LA[i] = L[i]; else LB[i] = L[i]; }
            }
#pragma unroll
            for (int i = 0; i < 16; ++i) { LST[i * 32 + r32] = LA[i]; LST[(16 + i) * 32 + r32] = LB[i]; }
            float va[16], vb[16];
#pragma unroll
            for (int i = 0; i < 16; ++i) { va[i] = f_unord(LA[i] & ~0x7Fu); vb[i] = f_unord(LB[i] & ~0x7Fu); }
            unsigned C[16];
#pragma unroll
            for (int j = 0; j < 16; ++j) C[j] = (f_ord(va[0] + vb[j]) & ~0xFFu) | (255u - (unsigned)j);
#pragma unroll
            for (int i = 1; i < 16; ++i)
#pragma unroll
                for (int j = 0; j < 16; ++j) if ((i + 1) * (j + 1) <= 16) { const unsigned code = 255u - (unsigned)(16 * i + j); TK_INS(C, (f_ord(va[i] + vb[j]) & ~0xFFu) | code); }
            LDS_WAIT();
            float bs[16]; unsigned ex[16]; float mx = -1e30f;
#pragma unroll
            for (int k = 0; k < 16; ++k) { const unsigned code = 255u - (C[k] & 0xFFu); const unsigned i = code >> 4, j = code & 15u;
                const unsigned ka = LST[i * 32 + r32], kbq = LST[(16 + j) * 32 + r32];
                bs[k] = f_unord(ka & ~0x7Fu) + f_unord(kbq & ~0x7Fu); ex[k] = (127u - (ka & 0x7Fu)) * 128u + (127u - (kbq & 0x7Fu)); mx = fmaxf(mx, bs[k]); }
            float sum = 0.f;
#pragma unroll
            for (int k = 0; k < 16; ++k) { bs[k] = __expf(bs[k] - mx); sum += bs[k]; }
            const float rinv = 1.f / sum;
            if (hi == 0) {
#pragma unroll
                for (int k = 0; k < 16; ++k) ENT[(r32 >> 3) * 128 + (r32 & 7) * 16 + k] = (u32x2){ex[k], __float_as_uint(bs[k] * rinv)};
            }
            LDS_WAIT();
        }
        if (RETR_ONLY) {
            for (int tk = 0; tk < 4; ++tk) { const int t = tok0 + tk;
                int ln = lane; asm volatile("" : "+v"(ln));
                const u32x2 a0 = ENT[tk * 128 + ln], a1 = ENT[tk * 128 + 64 + ln];
                const int j0 = 16 * (ln & 7) + (ln >> 3), j1 = j0 + 8;
                EG[(size_t)t * 128 + j0] = a0.x; WG[(size_t)t * 128 + j0] = __uint_as_float(a0.y);
                EG[(size_t)t * 128 + j1] = a1.x; WG[(size_t)t * 128 + j1] = __uint_as_float(a1.y); }
            continue;
        }
        for (int tk = 0; tk < 4; ++tk) {
            const int t = tok0 + tk;
            int ln = lane; asm volatile("" : "+v"(ln));
            const bf16_t* hrow = (const bf16_t*)(p.ws + WS_H2B) + (size_t)t * D + ln * 16;
            f32x2 hv[8];
#pragma unroll
            for (int i = 0; i < 2; ++i) { const u32x4 v = *(const u32x4*)(hrow + 8 * i); const unsigned w[4] = {v.x, v.y, v.z, v.w};
#pragma unroll
                for (int q = 0; q < 4; ++q) hv[4 * i + q] = (f32x2){bf2f((unsigned short)(w[q] & 0xffffu)), bf2f((unsigned short)(w[q] >> 16))}; }
            const float rstd2 = rsqrtf(ssq_sum<16>(ssq2 + (size_t)t * 16) * (1.f / D) + EPS);
            EG[(size_t)t * 128 + ln] = ENT[tk * 128 + ln].x; EG[(size_t)t * 128 + 64 + ln] = ENT[tk * 128 + 64 + ln].x;
            u32x4 ua[16], ub[16];
            { const unsigned ex = ENT[tk * 128 + (ln & 15)].x;
#pragma unroll
              for (int k = 0; k < 16; ++k) { const unsigned e = (unsigned)__builtin_amdgcn_readlane((int)ex, k); ua[k] = *(const u32x4*)(U8 + (size_t)e * D + ln * 16); } }
            auto head = [&](u32x4 (&cur)[16], u32x4 (&nxt)[16], int hd) {
                if (hd < 7) { const unsigned ex = ENT[tk * 128 + (hd + 1) * 16 + (ln & 15)].x;
#pragma unroll
                    for (int k = 0; k < 16; ++k) { const unsigned e = (unsigned)__builtin_amdgcn_readlane((int)ex, k); nxt[k] = *(const u32x4*)(U8 + (size_t)e * D + ln * 16); } }
                const float gate = __uint_as_float(ENT[tk * 128 + hd * 16 + ((ln >> 2) & 15)].y);
                float dt[16];
#pragma unroll
                for (int k = 0; k < 16; ++k) { f32x2 a0 = (f32x2){0.f, 0.f}, a1 = (f32x2){0.f, 0.f}; const unsigned w[4] = {cur[k].x, cur[k].y, cur[k].z, cur[k].w};
#pragma unroll
                    for (int q = 0; q < 4; ++q) { const f32x2 lo = __builtin_amdgcn_cvt_pk_f32_fp8((int)w[q], false), h2 = __builtin_amdgcn_cvt_pk_f32_fp8((int)w[q], true);
                        a0 += lo * hv[2 * q]; a1 += h2 * hv[2 * q + 1]; }
                    const f32x2 a = a0 + a1; dt[k] = a[0] + a[1]; if (k & 1) __builtin_amdgcn_sched_barrier(0); }
                float y8[8], y4[4], y2[2], y1;
                { const bool bsel = (ln & 32) != 0;
#pragma unroll
                  for (int k = 0; k < 8; ++k) { const float snd = bsel ? dt[k] : dt[k + 8], kp = bsel ? dt[k + 8] : dt[k]; y8[k] = kp + __shfl_xor(snd, 32); } }
                { const bool bsel = (ln & 16) != 0;
#pragma unroll
                  for (int k = 0; k < 4; ++k) { const float snd = bsel ? y8[k] : y8[k + 4], kp = bsel ? y8[k + 4] : y8[k]; y4[k] = kp + __shfl_xor(snd, 16); } }
                { const bool bsel = (ln & 8) != 0;
#pragma unroll
                  for (int k = 0; k < 2; ++k) { const float snd = bsel ? y4[k] : y4[k + 2], kp = bsel ? y4[k + 2] : y4[k]; y2[k] = kp + __shfl_xor(snd, 8); } }
                { const bool bsel = (ln & 4) != 0; const float snd = bsel ? y2[0] : y2[1], kp = bsel ? y2[1] : y2[0]; y1 = kp + __shfl_xor(snd, 4); }
                y1 += __shfl_xor(y1, 2); y1 += __shfl_xor(y1, 1);
                const float act = y1 * rstd2 * (1.f / U_SCALE);
                const float wgt = gate * gelu_f(act) * (1.f / V_SCALE);
                if ((ln & 3) == 0) WG[(size_t)t * 128 + hd * 16 + ((ln >> 2) & 15)] = wgt;
            };
            for (int hd = 0; hd < 8; hd += 2) { head(ua, ub, hd); head(ub, ua, hd + 1); }
        }
    }
}

__device__ __forceinline__ void peer_v_phase(const Params& p, int vcu, int G) {
    const int tid = opaque_tid(), lane = tid & 63, wid = __builtin_amdgcn_readfirstlane(tid >> 6);
    const unsigned char* V8 = p.ws + WS_V8; const unsigned* EG = (const unsigned*)(p.ws + WS_EG); const float* WG = (const float*)(p.ws + WS_WG);
    for (int grp = vcu * NWAVES + wid; grp < T / 4; grp += G * NWAVES) {
        for (int tk = 0; tk < 4; ++tk) {
            const int t = grp * 4 + tk;
            int ln = lane; asm volatile("" : "+v"(ln));
            const unsigned e0 = EG[(size_t)t * 128 + ln], e1 = EG[(size_t)t * 128 + 64 + ln];
            const float w0 = WG[(size_t)t * 128 + ln], w1 = WG[(size_t)t * 128 + 64 + ln];
            f32x2 ov[8];
#pragma unroll
            for (int i = 0; i < 8; ++i) ov[i] = (f32x2){0.f, 0.f};
            u32x4 va[16], vb[16];
#pragma unroll
            for (int k = 0; k < 16; ++k) { const unsigned e = (unsigned)__builtin_amdgcn_readlane((int)e0, k); va[k] = *(const u32x4*)(V8 + (size_t)e * D + ln * 16); }
            auto head = [&](u32x4 (&cur)[16], u32x4 (&nxt)[16], int hd) {
                if (hd < 7) { const int h1 = hd + 1; const unsigned er = (h1 & 4) ? e1 : e0; const int lb = (h1 & 3) * 16;
#pragma unroll
                    for (int k = 0; k < 16; ++k) { const unsigned e = (unsigned)__builtin_amdgcn_readlane((int)er, lb + k); nxt[k] = *(const u32x4*)(V8 + (size_t)e * D + ln * 16); } }
                const float wr = (hd & 4) ? w1 : w0; const int lb0 = (hd & 3) * 16;
#pragma unroll
                for (int k = 0; k < 16; ++k) { const float wk = __uint_as_float((unsigned)__builtin_amdgcn_readlane((int)__float_as_uint(wr), lb0 + k)); const f32x2 wk2 = (f32x2){wk, wk};
                    const unsigned w[4] = {cur[k].x, cur[k].y, cur[k].z, cur[k].w};
#pragma unroll
                    for (int q = 0; q < 4; ++q) { const f32x2 lo = __builtin_amdgcn_cvt_pk_f32_fp8((int)w[q], false), h2 = __builtin_amdgcn_cvt_pk_f32_fp8((int)w[q], true);
                        ov[2 * q] += wk2 * lo; ov[2 * q + 1] += wk2 * h2; }
                    if (k & 1) __builtin_amdgcn_sched_barrier(0); }
            };
            for (int hd = 0; hd < 8; hd += 2) { head(va, vb, hd); head(vb, va, hd + 1); }
            float* hrow = p.out + (size_t)t * D + ln * 16;
            const bf16_t* hb = (const bf16_t*)(p.ws + WS_H2B) + (size_t)t * D + ln * 16;
            float ss = 0.f; f32x4 h3[4];
#pragma unroll
            for (int q2 = 0; q2 < 2; ++q2) { const u32x4 v = *(const u32x4*)(hb + 8 * q2);
                h3[2 * q2] = (f32x4){bf2f((unsigned short)(v.x & 0xffffu)), bf2f((unsigned short)(v.x >> 16)), bf2f((unsigned short)(v.y & 0xffffu)), bf2f((unsigned short)(v.y >> 16))};
                h3[2 * q2 + 1] = (f32x4){bf2f((unsigned short)(v.z & 0xffffu)), bf2f((unsigned short)(v.z >> 16)), bf2f((unsigned short)(v.w & 0xffffu)), bf2f((unsigned short)(v.w >> 16))}; }
#pragma unroll
            for (int q = 0; q < 4; ++q) { h3[q] = h3[q] + (f32x4){ov[2 * q][0], ov[2 * q][1], ov[2 * q + 1][0], ov[2 * q + 1][1]};
                ss += (h3[q][0] * h3[q][0] + h3[q][1] * h3[q][1]) + (h3[q][2] * h3[q][2] + h3[q][3] * h3[q][3]); }
            const float rstd3 = rsqrtf(wave_sum(ss) * (1.f / D) + EPS);
#pragma unroll
            for (int q = 0; q < 4; ++q) { const f32x4 gf = *(const f32x4*)(p.g_final + ln * 16 + 4 * q); *(f32x4*)(hrow + 4 * q) = h3[q] * rstd3 * gf; }
        }
    }
}

template <bool VSIDE>
__device__ __forceinline__ void peer_slice_tokens(const Params& p, int x, int w0, int nwv, int lane) {
    const unsigned char* TB = p.ws + (VSIDE ? WS_V8 : WS_U8) + 128 * x;
    const unsigned* EG = (const unsigned*)(p.ws + WS_EG); const float* WG = (const float*)(p.ws + WS_WG);
    const bf16_t* H2 = (const bf16_t*)(p.ws + WS_H2B) + 128 * x;
    float* PART = (float*)(p.ws + WS_PART) + (size_t)x * T * 128; float* SSQ3 = (float*)(p.ws + WS_SSQ3);
    int ln = lane; asm volatile("" : "+v"(ln));
    const int r = ln >> 3, c = ln & 7;
    if (w0 >= T) return;
    u32x4 idn[4];
    f32x4 wn[4], wc[4];
    u32x4 hn[2], hc[2];
    u32x4 ra[16], rb[16];
    auto load_meta = [&](int t) {
#pragma unroll
        for (int q = 0; q < 4; ++q) idn[q] = *(const u32x4*)(EG + (size_t)t * 128 + 16 * r + 4 * q);
        if (VSIDE) {
#pragma unroll
            for (int q = 0; q < 4; ++q) wn[q] = *(const f32x4*)(WG + (size_t)t * 128 + 16 * r + 4 * q);
        } else { hn[0] = *(const u32x4*)(H2 + (size_t)t * D + 16 * c); hn[1] = *(const u32x4*)(H2 + (size_t)t * D + 16 * c + 8); }
    };
    auto issue = [&](u32x4 (&buf)[16]) {
#pragma unroll
        for (int q = 0; q < 4; ++q) { const unsigned e4[4] = {idn[q].x, idn[q].y, idn[q].z, idn[q].w};
#pragma unroll
            for (int j = 0; j < 4; ++j) buf[4 * q + j] = *(const u32x4*)(TB + (size_t)e4[j] * D + 16 * c); }
    };
    auto compute = [&](u32x4 (&cur)[16], int t) {
        if (!VSIDE) {
            f32x2 hv[8];
#pragma unroll
            for (int i2 = 0; i2 < 2; ++i2) { const unsigned w[4] = {hc[i2].x, hc[i2].y, hc[i2].z, hc[i2].w};
#pragma unroll
                for (int q = 0; q < 4; ++q) hv[4 * i2 + q] = (f32x2){bf2f((unsigned short)(w[q] & 0xffffu)), bf2f((unsigned short)(w[q] >> 16))}; }
            float dt[16];
#pragma unroll
            for (int i = 0; i < 16; ++i) { f32x2 a0 = (f32x2){0.f, 0.f}, a1 = (f32x2){0.f, 0.f}; const unsigned w[4] = {cur[i].x, cur[i].y, cur[i].z, cur[i].w};
#pragma unroll
                for (int q = 0; q < 4; ++q) { const f32x2 lo = __builtin_amdgcn_cvt_pk_f32_fp8((int)w[q], false), h2 = __builtin_amdgcn_cvt_pk_f32_fp8((int)w[q], true);
                    a0 += lo * hv[2 * q]; a1 += h2 * hv[2 * q + 1]; }
                const f32x2 a = a0 + a1; dt[i] = a[0] + a[1]; if (i & 1) __builtin_amdgcn_sched_barrier(0); }
            float y8[8], y4[4], y2[2];
            { const bool bs = (ln & 4) != 0;
#pragma unroll
              for (int k = 0; k < 8; ++k) { const float snd = bs ? dt[k] : dt[k + 8], kp = bs ? dt[k + 8] : dt[k]; y8[k] = kp + shx<4>(snd, ln); } }
            { const bool bs = (ln & 2) != 0;
#pragma unroll
              for (int k = 0; k < 4; ++k) { const float snd = bs ? y8[k] : y8[k + 4], kp = bs ? y8[k + 4] : y8[k]; y4[k] = kp + shx<2>(snd, ln); } }
            { const bool bs = (ln & 1) != 0;
#pragma unroll
              for (int k = 0; k < 2; ++k) { const float snd = bs ? y4[k] : y4[k + 2], kp = bs ? y4[k + 2] : y4[k]; y2[k] = kp + shx<1>(snd, ln); } }
            *(f32x2*)(PART + (size_t)t * 128 + 2 * ln) = (f32x2){y2[0], y2[1]};
        } else {
            f32x2 ov[8];
#pragma unroll
            for (int q = 0; q < 8; ++q) ov[q] = (f32x2){0.f, 0.f};
#pragma unroll
            for (int i = 0; i < 16; ++i) { const float wk = wc[i >> 2][i & 3]; const f32x2 wk2 = (f32x2){wk, wk}; const unsigned w[4] = {cur[i].x, cur[i].y, cur[i].z, cur[i].w};
#pragma unroll
                for (int q = 0; q < 4; ++q) { const f32x2 lo = __builtin_amdgcn_cvt_pk_f32_fp8((int)w[q], false), h2 = __builtin_amdgcn_cvt_pk_f32_fp8((int)w[q], true);
                    ov[2 * q] += wk2 * lo; ov[2 * q + 1] += wk2 * h2; }
                if (i & 1) __builtin_amdgcn_sched_barrier(0); }
            f32x2 z4[4], z2[2], z1;
            { const bool bs = (ln & 32) != 0;
#pragma unroll
              for (int k = 0; k < 4; ++k) { const f32x2 snd = bs ? ov[k] : ov[k + 4], kp = bs ? ov[k + 4] : ov[k]; z4[k] = kp + (f32x2){shx<32>(snd[0], ln), shx<32>(snd[1], ln)}; } }
            { const bool bs = (ln & 16) != 0;
#pragma unroll
              for (int k = 0; k < 2; ++k) { const f32x2 snd = bs ? z4[k] : z4[k + 2], kp = bs ? z4[k + 2] : z4[k]; z2[k] = kp + (f32x2){shx<16>(snd[0], ln), shx<16>(snd[1], ln)}; } }
            { const bool bs = (ln & 8) != 0; const f32x2 snd = bs ? z2[0] : z2[1], kp = bs ? z2[1] : z2[0]; z1 = kp + (f32x2){shx<8>(snd[0], ln), shx<8>(snd[1], ln)}; }
            const int dd = 16 * c + ((ln >> 5) & 1) * 8 + ((ln >> 4) & 1) * 4 + ((ln >> 3) & 1) * 2;
            const unsigned hb = *(const unsigned*)(H2 + (size_t)t * D + dd);
            const f32x2 h3 = (f32x2){bf2f((unsigned short)(hb & 0xffffu)) + z1[0], bf2f((unsigned short)(hb >> 16)) + z1[1]};
            *(f32x2*)(p.out + (size_t)t * D + 128 * x + dd) = h3;
            const float ss = wave_sum_fast(h3[0] * h3[0] + h3[1] * h3[1], ln);
            if (ln == 0) SSQ3[(size_t)t * 8 + x] = ss;
        }
    };
    load_meta(w0);
    issue(ra);
    if (VSIDE) {
#pragma unroll
        for (int q = 0; q < 4; ++q) wc[q] = wn[q];
    } else { hc[0] = hn[0]; hc[1] = hn[1]; }
    if (w0 + nwv < T) load_meta(w0 + nwv);
    for (int t = w0; t < T; t += 2 * nwv) {
        const bool m1 = t + nwv < T, m2 = t + 2 * nwv < T, m3 = t + 3 * nwv < T;
        f32x4 w1[4]; u32x4 h1[2];
        if (m1) { issue(rb);
            if (VSIDE) {
#pragma unroll
                for (int q = 0; q < 4; ++q) w1[q] = wn[q];
            } else { h1[0] = hn[0]; h1[1] = hn[1]; }
            if (m2) load_meta(t + 2 * nwv); }
        compute(ra, t);
        if (!m1) break;
        if (VSIDE) {
#pragma unroll
            for (int q = 0; q < 4; ++q) wc[q] = w1[q];
        } else { hc[0] = h1[0]; hc[1] = h1[1]; }
        if (m2) { issue(ra); }
        f32x4 w2[4]; u32x4 h2x[2];
        if (m2) {
            if (VSIDE) {
#pragma unroll
                for (int q = 0; q < 4; ++q) w2[q] = wn[q];
            } else { h2x[0] = hn[0]; h2x[1] = hn[1]; }
            if (m3) load_meta(t + 3 * nwv); }
        compute(rb, t + nwv);
        if (!m2) break;
        if (VSIDE) {
#pragma unroll
            for (int q = 0; q < 4; ++q) wc[q] = w2[q];
        } else { hc[0] = h2x[0]; hc[1] = h2x[1]; }
    }
}
template <bool VSIDE>
__device__ __forceinline__ void peer_slice_phase(const Params& p, unsigned xcc, int rank, int G, int bx, int wave, int lane) {
    unsigned* ctl = (unsigned*)(p.ws + WS_CTL);
    for (int x = 0; x < 8; ++x) {
        const int cx = (int)__builtin_amdgcn_readfirstlane((int)__hip_atomic_load(ctl + CW_BAR + XB_XCNT(x), __ATOMIC_RELAXED, __HIP_MEMORY_SCOPE_AGENT));
        if (cx != 0 && (int)xcc != x) continue;
        const int nwv = (cx == 0 ? G : cx) * NWAVES, w0 = (cx == 0 ? bx : rank) * NWAVES + wave;
        peer_slice_tokens<VSIDE>(p, x, w0, nwv, lane);
    }
}
__device__ __forceinline__ void peer_combine_phase(const Params& p, int gw, int NGW, int lane) {
    const float* PART = (const float*)(p.ws + WS_PART); float* WG = (float*)(p.ws + WS_WG); const float* ssq2 = (const float*)(p.ws + WS_SSQ2);
    for (int t = gw; t < T; t += NGW) {
        f32x2 s = (f32x2){0.f, 0.f};
#pragma unroll
        for (int x = 0; x < 8; ++x) s += *(const f32x2*)(PART + ((size_t)x * T + t) * 128 + 2 * lane);
        const float rs = rsqrtf(ssq_sum<16>(ssq2 + (size_t)t * 16) * (1.f / D) + EPS) * (1.f / U_SCALE);
        f32x2* wp = (f32x2*)(WG + (size_t)t * 128 + 2 * lane);
        const f32x2 g = *wp;
        *wp = (f32x2){g[0] * gelu_f(s[0] * rs) * (1.f / V_SCALE), g[1] * gelu_f(s[1] * rs) * (1.f / V_SCALE)};
    }
}
__device__ __forceinline__ void peer_final_phase(const Params& p, int gw, int NGW, int lane) {
    const float* SSQ3 = (const float*)(p.ws + WS_SSQ3);
    for (int t = gw; t < T; t += NGW) {
        float* row = p.out + (size_t)t * D + lane * 16;
        f32x4 v[4];
#pragma unroll
        for (int q = 0; q < 4; ++q) v[q] = *(const f32x4*)(row + 4 * q);
        const float rstd3 = rsqrtf(ssq_sum<8>(SSQ3 + (size_t)t * 8) * (1.f / D) + EPS);
#pragma unroll
        for (int q = 0; q < 4; ++q) { const f32x4 gf = *(const f32x4*)(p.g_final + lane * 16 + 4 * q); *(f32x4*)(row + 4 * q) = v[q] * rstd3 * gf; }
    }
}

#ifndef PH_MASK
#define PH_MASK 0xFFFF
#endif
#define PH(k) ((PH_MASK >> (k)) & 1)
#ifndef PEER_DSLICE
#define PEER_DSLICE 1
#endif
#ifndef GEMM_ALIGN
#define GEMM_ALIGN true
#endif
#ifndef REP_MASK
#define REP_MASK 0
#endif
#if (REP_MASK >> 0) & 1
#define REP_0 for (int rep_ = 0; rep_ < 2; ++rep_)
#else
#define REP_0
#endif
#if (REP_MASK >> 1) & 1
#define REP_1 for (int rep_ = 0; rep_ < 2; ++rep_)
#else
#define REP_1
#endif
#if (REP_MASK >> 2) & 1
#define REP_2 for (int rep_ = 0; rep_ < 2; ++rep_)
#else
#define REP_2
#endif
#if (REP_MASK >> 3) & 1
#define REP_3 for (int rep_ = 0; rep_ < 2; ++rep_)
#else
#define REP_3
#endif
#if (REP_MASK >> 4) & 1
#define REP_4 for (int rep_ = 0; rep_ < 2; ++rep_)
#else
#define REP_4
#endif
#if (REP_MASK >> 5) & 1
#define REP_5 for (int rep_ = 0; rep_ < 2; ++rep_)
#else
#define REP_5
#endif
#if (REP_MASK >> 6) & 1
#define REP_6 for (int rep_ = 0; rep_ < 2; ++rep_)
#else
#define REP_6
#endif
#if (REP_MASK >> 7) & 1
#define REP_7 for (int rep_ = 0; rep_ < 2; ++rep_)
#else
#define REP_7
#endif
#if (REP_MASK >> 8) & 1
#define REP_8 for (int rep_ = 0; rep_ < 2; ++rep_)
#else
#define REP_8
#endif
#if (REP_MASK >> 9) & 1
#define REP_9 for (int rep_ = 0; rep_ < 2; ++rep_)
#else
#define REP_9
#endif
#define REP(k) REP_##k
__global__ void __launch_bounds__(NWAVES * 64, 2) fwd_megakernel(Params p) {
    extern __shared__ __attribute__((aligned(16))) unsigned char lds_raw[];
    LAS unsigned char* lds = (LAS unsigned char*)lds_raw;
    const int tid = threadIdx.x, lane = tid & 63, wave = __builtin_amdgcn_readfirstlane(tid >> 6);
    const int G = gridDim.x; const int bx = blockIdx.x;
    const int vcu = (G % 8 == 0) ? (bx % 8) * (G / 8) + bx / 8 : bx;
    if (p.never) { cg::this_grid().sync(); }
    unsigned char* const ws = p.ws;
    volatile LAS unsigned* MISC = (volatile LAS unsigned*)(lds + LDSCTL_OFF);
    for (int u = tid; u < (LDS_BYTES - LDSCTL_OFF) / 4; u += NWAVES * 64) ((LAS unsigned*)(lds + LDSCTL_OFF))[u] = 0u;
    __syncthreads();
    XcdBarrier bar = xcd_barrier_post((unsigned*)(ws + WS_CTL) + CW_BAR, MISC + 8);
    if (tid == 0) MISC[20] = __hip_atomic_fetch_add((unsigned*)(ws + WS_CTL) + CW_XRANK + 64 * bar.x, 1u, __ATOMIC_RELAXED, __HIP_MEMORY_SCOPE_AGENT);
    const int gw = vcu * NWAVES + wave, NGW = G * NWAVES;

#define WSB(off) ((bf16_t*)(p.ws + (off)))
#define WSF(off) ((float*)(p.ws + (off)))
    REP(0) {
    if (PH(0))
    {
        LAS float* scr = (LAS float*)(lds + wave * 16384);
        constexpr int I_IN = 16 * 85, I_XKV = 16 * 64;
        constexpr int NITEMS = I_IN + I_XKV;
        for (int it = gw; it < NITEMS; it += NGW) {
            int r = it;
            if (r < I_IN) { p0_transpose_item<1>(p.w_in, 1024, 2720, WSB(WS_WIN), nullptr, scr, r, lane); continue; } r -= I_IN;
            p0_transpose_item<0>(p.w_xkv, 1024, 2048, WSB(WS_WXKV), nullptr, scr, r, lane);
        }
        for (int m = gw; m < T / 4; m += NGW) rms_rows_to_bf16<4>(p.x + (size_t)m * D, p.g_mix, WSB(WS_A0) + (size_t)m * D, (size_t)(T / 4) * D, lane);
        for (int m = gw; m < 1024; m += NGW) rms_rows_to_bf16<1>(p.mem + (size_t)m * D, p.g_mem, WSB(WS_MEMN) + (size_t)m * D, 0, lane);
        const int gt = vcu * 512 + tid, NGT = G * 512;
        for (int i = gt; i < 2 * 128 * 128 / 2; i += NGT) { const f32x2 v = *(const f32x2*)(p.sub_keys + 2 * i); ((unsigned*)WSB(WS_SK))[i] = cvtpk(v[0], v[1]); }
        for (int i = gt; i < 96 * 1024 / 8; i += NGT) ((u32x4*)(WSB(WS_WIN) + (size_t)2208 * 1024))[i] = (u32x4){0u, 0u, 0u, 0u};
        for (int i = gt; i < SEQ * 64; i += NGT) { const int s = i >> 6, f = i & 63; const float inv = exp2f(-(float)f * (13.287712379549449f / 64.f)); const float ang = (float)s * inv;
            const double rev = (double)ang * 0.15915494309189535; const float fr = (float)(rev - floor(rev)); WSF(WS_CR)[i] = __builtin_amdgcn_cosf(fr); WSF(WS_SR)[i] = __builtin_amdgcn_sinf(fr); }
        for (int i = gt; i < SEQ * 16; i += NGT) { const int s = i >> 4, f = i & 15; const float inv = exp2f(-(float)f * (13.287712379549449f / 16.f)); const float ang = (float)s * inv;
            const double rev = (double)ang * 0.15915494309189535; const float fr = (float)(rev - floor(rev)); WSF(WS_CM)[i] = __builtin_amdgcn_cosf(fr); WSF(WS_SM)[i] = __builtin_amdgcn_sinf(fr); }
    }
    xcd_barrier(bar);
#ifdef DBL_BAR
    xcd_barrier(bar);
#endif
    }

    REP(1) {
    if (PH(1))
    {
        { pg8::Gemm g{WSB(WS_A0), WSB(WS_WIN), T, NPROJ, 1024, 1024, 1024}; pg8::StaticOrder S; S.init(T, NPROJ, G, bx);
          pg8::EpiProj E{WSB(WS_PROJ), WSF(WS_SSQQ), WSF(WS_SSQKV), WSF(WS_CR), WSF(WS_SR), WSF(WS_CM), WSF(WS_SM)}; pg8::gemm_phase<pg8::EpiProj, pg8::StaticOrder, GEMM_ALIGN>(lds, g, S, E); }
#ifdef DUP_P1MAIN
        { pg8::Gemm g{WSB(WS_A0), WSB(WS_WIN), T, NPROJ, 1024, 1024, 1024}; pg8::StaticOrder S; S.init(T, NPROJ, G, bx);
          pg8::EpiProj E{WSB(WS_PROJ), WSF(WS_SSQQ), WSF(WS_SSQKV), WSF(WS_CR), WSF(WS_SR), WSF(WS_CM), WSF(WS_SM)}; pg8::gemm_phase<pg8::EpiProj, pg8::StaticOrder, GEMM_ALIGN>(lds, g, S, E); }
#endif
        { pg8::Gemm g{WSB(WS_WIN) + (size_t)2304 * 1024, WSB(WS_A0), 512, T, 1024, 1024, 1024}; pg8::StaticOrder S; S.init(512, T, G, (bx - 64 + G) % G);
          pg8::EpiPlain E{WSB(WS_RVT), TP}; pg8::gemm_phase<pg8::EpiPlain, pg8::StaticOrder, GEMM_ALIGN>(lds, g, S, E); }
        { pg8::Gemm g{WSB(WS_MEMN), WSB(WS_WXKV), 1024, 1024, 1024, 1024, 1024}; pg8::StaticOrder S; S.init(1024, 1024, G, (bx - 192 + G) % G);
          pg8::EpiPlain E{WSB(WS_KX), 1024}; pg8::gemm_phase<pg8::EpiPlain, pg8::StaticOrder, GEMM_ALIGN>(lds, g, S, E); }
        { pg8::Gemm g{WSB(WS_WXKV) + (size_t)1024 * 1024, WSB(WS_MEMN), 1024, 1024, 1024, 1024, 1024}; pg8::StaticOrder S; S.init(1024, 1024, G, (bx - 208 + G) % G);
          pg8::EpiPlain E{WSB(WS_VXT), 1024}; pg8::gemm_phase<pg8::EpiPlain, pg8::StaticOrder, GEMM_ALIGN>(lds, g, S, E); }
        {
            const int nd = G >= 64 ? 32 : G, d0 = G - nd;
            if (bx >= d0) {
                LAS float* scr = (LAS float*)(lds + wave * 16384);
                constexpr int I_UQ = 6 * 24, I_UKV = 4 * 32, I_SQ = 16 * 32, I_PQ = 16 * 64;
                constexpr int NITEMS = I_UQ + I_UKV + 3 * I_SQ + I_PQ;
                for (int it = (bx - d0) * NWAVES + wave; it < NITEMS; it += nd * NWAVES) {
                    int r = it;
                    if (r < I_UQ) { p0_transpose_item<2>(p.w_uq, 384, 768, WSB(WS_WUQ), p.g_q_lora, scr, r, lane); continue; } r -= I_UQ;
                    if (r < I_UKV) { p0_transpose_item<3>(p.w_ukv, 256, 1024, WSB(WS_WUKV), p.g_kv_lora, scr, r, lane); continue; } r -= I_UKV;
                    if (r < I_SQ) { p0_transpose_item<0>(p.w_o, 1024, 1024, WSB(WS_WO), nullptr, scr, r, lane); continue; } r -= I_SQ;
                    if (r < I_SQ) { p0_transpose_item<0>(p.w_xq, 1024, 1024, WSB(WS_WXQ), p.g_xattn, scr, r, lane); continue; } r -= I_SQ;
                    if (r < I_SQ) { p0_transpose_item<0>(p.w_xo, 1024, 1024, WSB(WS_WXO), nullptr, scr, r, lane); continue; } r -= I_SQ;
                    p0_transpose_item<0>(p.w_pq, 1024, 2048, WSB(WS_WPQ), p.g_ffn, scr, r, lane);
                }
            }
        }
    }
    xcd_barrier(bar);
#ifdef DBL_BAR
    xcd_barrier(bar);
#endif
    }

    REP(2) {
    if (PH(2))
    {
        { pg8::Gemm g{WSB(WS_PROJ), WSB(WS_WUQ), T, 768, 384, NPROJ, 384}; pg8::StaticOrder S; S.init(T, 768, G, bx);
          pg8::EpiQ E{WSB(WS_QM), WSF(WS_SSQQ), WSF(WS_CM), WSF(WS_SM)}; pg8::gemm_phase<pg8::EpiQ, pg8::StaticOrder, GEMM_ALIGN>(lds, g, S, E); }
        { pg8::Gemm g{WSB(WS_PROJ) + 384, WSB(WS_WUKV), T, 512, 256, NPROJ, 256}; pg8::StaticOrder S; S.init(T, 512, G, (bx - 192 + G) % G);
          pg8::EpiRowScale<8> E{WSB(WS_KN), 512, WSF(WS_SSQKV), 1.f / 256.f, 1.f}; pg8::gemm_phase<pg8::EpiRowScale<8>, pg8::StaticOrder, GEMM_ALIGN>(lds, g, S, E); }
        { pg8::Gemm g{WSB(WS_WUKV) + (size_t)512 * 256, WSB(WS_PROJ) + 384, 512, T, 256, 256, NPROJ}; pg8::StaticOrder S; S.init(512, T, G, (bx - 64 + G) % G);
          pg8::EpiColScale E{WSB(WS_VT), TP, WSF(WS_SSQKV), 1.f / 256.f}; pg8::gemm_phase<pg8::EpiColScale, pg8::StaticOrder, GEMM_ALIGN>(lds, g, S, E); }
        for (int u = vcu; u < 512; u += G) ret_state_unit(lds, u, WSB(WS_PROJ), WSB(WS_RVT), WSB(WS_RKVT));
    }
    xcd_barrier(bar);
#ifdef DBL_BAR
    xcd_barrier(bar);
#endif
    }

    REP(3) {
    if (PH(3))
    {
        unsigned* scan_cnt = (unsigned*)(p.ws + WS_CTL) + CW_QUEUE + 64 * Q3_SLOT;
#if (REP_MASK >> 3) & 1
        if (rep_ == 0)
#endif
        {
            bf16_t* RK = WSB(WS_RKVT);
            for (int e2 = vcu * 512 + tid; e2 < 16 * 8192; e2 += G * 512) {
                const int bh = e2 >> 13, off = e2 & 8191; const float cd = exp2f(128.f * ret_log2g(bh & 3));
                unsigned* base = (unsigned*)(RK + (size_t)bh * 32 * 16384) + off;
                unsigned x[32];
#pragma unroll
                for (int n = 0; n < 32; ++n) x[n] = base[(size_t)n * 8192];
                float r0 = 0.f, r1 = 0.f;
#pragma unroll
                for (int n = 0; n < 32; ++n) { const unsigned o = cvtpk(r0, r1); r0 = r0 * cd + bf2f((unsigned short)(x[n] & 0xffffu)); r1 = r1 * cd + bf2f((unsigned short)(x[n] >> 16)); base[(size_t)n * 8192] = o; }
            }
            asm volatile("s_waitcnt vmcnt(0)" ::: "memory");
            __syncthreads();
            if (tid == 0) { __builtin_amdgcn_fence(__ATOMIC_RELEASE, "agent"); asm volatile("s_waitcnt vmcnt(0)" ::: "memory"); __hip_atomic_fetch_add(scan_cnt, 1u, __ATOMIC_RELAXED, __HIP_MEMORY_SCOPE_AGENT); }
        }
#ifdef REP_MLA
        for (int rr_ = 0; rr_ < REP_MLA; ++rr_)
#endif
        for (int v2 = 2 * vcu; v2 < 512; v2 += (v2 & 1) ? 2 * G - 1 : 1) { const int v = v2 >> 1, bh = v >> 3, s = v & 7;
            mla_unit(lds, bh >> 3, bh & 7, (v2 & 1) ? s : 15 - s, WSB(WS_QM), WSB(WS_KN), WSB(WS_PROJ), WSB(WS_VT), WSB(WS_MIX)); }
#ifdef MLA_BAR
        xcd_barrier(bar);
#endif
        if (tid == 0) { unsigned sp = 0; while (__hip_atomic_load(scan_cnt, __ATOMIC_RELAXED, __HIP_MEMORY_SCOPE_AGENT) < (unsigned)G) { __builtin_amdgcn_s_sleep(2); if (++sp > XB_SPIN_CAP) break; }
            __builtin_amdgcn_fence(__ATOMIC_ACQUIRE, "agent"); asm volatile("s_waitcnt vmcnt(0)" ::: "memory"); }
        __syncthreads();
#ifdef REP_RET
        for (int rr_ = 0; rr_ < 2; ++rr_)
#endif
        for (int u = vcu; u < 512; u += G) ret_out_unit(lds, u, WSB(WS_PROJ), WSB(WS_RVT), WSB(WS_RKVT), p.g_ret_gn, WSB(WS_MIX));
    }
    xcd_barrier(bar);
#ifdef DBL_BAR
    xcd_barrier(bar);
#endif
    }

    REP(4) {
    if (PH(4))
#ifdef REP_P4NB
    for (int nb_ = 0; nb_ < 2; ++nb_)
#endif
    { pg8::Gemm g{WSB(WS_MIX), WSB(WS_WO), T, 1024, 1024, 1024, 1024}; pg8::StaticOrder S; S.init(T, 1024, G, bx);
      pg8::EpiRes E{p.x, nullptr, WSB(WS_H1B), WSF(WS_SSQ1)}; pg8::gemm_phase<pg8::EpiRes, pg8::StaticOrder, GEMM_ALIGN>(lds, g, S, E); }
    xcd_barrier(bar);
#ifdef DBL_BAR
    xcd_barrier(bar);
#endif
    }

    REP(5) {
    if (PH(5))
    { pg8::Gemm g{WSB(WS_H1B), WSB(WS_WXQ), T, 1024, 1024, 1024, 1024}; pg8::StaticOrder S; S.init(T, 1024, G, bx);
      pg8::EpiRowScale<16> E{WSB(WS_QX), 1024, WSF(WS_SSQ1), 1.f / 1024.f, C2_X}; pg8::gemm_phase<pg8::EpiRowScale<16>, pg8::StaticOrder, GEMM_ALIGN>(lds, g, S, E); }
    xcd_barrier(bar);
#ifdef DBL_BAR
    xcd_barrier(bar);
#endif
    }

    REP(6) {
    if (PH(6))
    {
        for (int u = vcu; u < 512; u += G) { const int dvh = u & 1, qb = (u >> 1) & 15, h = (u >> 5) & 3, b = u >> 7; xattn_unit(lds, b, h, qb, dvh, WSB(WS_QX), WSB(WS_KX), WSB(WS_VXT), WSB(WS_OX)); }
        unsigned char* U8 = ws + WS_U8; unsigned char* V8 = ws + WS_V8;
        const f32x4* gf = (const f32x4*)p.g_ffn + lane * 4;
        f32x4 gs[4];
#pragma unroll
        for (int i = 0; i < 4; ++i) gs[i] = gf[i] * U_SCALE;
        for (int e = gw; e < 2 * 16384; e += NGW) {
            const bool isv = e >= 16384; const int row = isv ? e - 16384 : e;
            const f32x4* src = (const f32x4*)((isv ? p.v_exp : p.u_exp) + (size_t)row * D) + lane * 4;
            u32x4 o; unsigned ow[4];
#pragma unroll
            for (int i = 0; i < 4; ++i) { f32x4 v = src[i]; v = isv ? v * V_SCALE : v * gs[i]; int pk = 0; pk = __builtin_amdgcn_cvt_pk_fp8_f32(v[0], v[1], pk, false); pk = __builtin_amdgcn_cvt_pk_fp8_f32(v[2], v[3], pk, true); ow[i] = (unsigned)pk; }
            o.x = ow[0]; o.y = ow[1]; o.z = ow[2]; o.w = ow[3];
            *(u32x4*)((isv ? V8 : U8) + (size_t)row * D + lane * 16) = o;
        }
    }
    xcd_barrier(bar);
#ifdef DBL_BAR
    xcd_barrier(bar);
#endif
    }

    REP(7) {
    if (PH(7))
    { pg8::Gemm g{WSB(WS_OX), WSB(WS_WXO), T, 1024, 1024, 1024, 1024}; pg8::StaticOrder S; S.init(T, 1024, G, bx);
      pg8::EpiRes E{nullptr, WSB(WS_H1B), WSB(WS_H2B), WSF(WS_SSQ2)}; pg8::gemm_phase<pg8::EpiRes, pg8::StaticOrder, GEMM_ALIGN>(lds, g, S, E); }
    xcd_barrier(bar);
#ifdef DBL_BAR
    xcd_barrier(bar);
#endif
    }

    REP(8) {
    if (PH(8))
    { pg8::Gemm g{WSB(WS_H2B), WSB(WS_WPQ), T, 2048, 1024, 1024, 1024}; pg8::StaticOrder S; S.init(T, 2048, G, bx);
      pg8::EpiRowScale<16> E{WSB(WS_QP), 2048, WSF(WS_SSQ2), 1.f / 1024.f, 1.f}; pg8::gemm_phase<pg8::EpiRowScale<16>, pg8::StaticOrder, GEMM_ALIGN>(lds, g, S, E); }
    xcd_barrier(bar);
#ifdef DBL_BAR
    xcd_barrier(bar);
#endif
    }

    REP(9) {
    if (PH(9))
    {
#if PEER_DSLICE
      const int myrank = (int)MISC[20];
      peer_phase<true>(lds, p, vcu, G);
      xcd_barrier(bar);
#ifdef DUP_RETR
      peer_phase<true>(lds, p, vcu, G);
      xcd_barrier(bar);
#endif
      peer_slice_phase<false>(p, bar.x, myrank, G, bx, wave, lane);
      xcd_barrier(bar);
#ifdef DUP_USL
      peer_slice_phase<false>(p, bar.x, myrank, G, bx, wave, lane);
      xcd_barrier(bar);
#endif
      peer_combine_phase(p, gw, NGW, lane);
      xcd_barrier(bar);
      peer_slice_phase<true>(p, bar.x, myrank, G, bx, wave, lane);
      xcd_barrier(bar);
#ifdef DUP_VSL
      peer_slice_phase<true>(p, bar.x, myrank, G, bx, wave, lane);
      xcd_barrier(bar);
#endif
      peer_final_phase(p, gw, NGW, lane);
#else
      peer_phase<false>(lds, p, vcu, G);
      xcd_barrier(bar);
      peer_v_phase(p, vcu, G);
#endif
    }
#if (REP_MASK >> 9) & 1
    xcd_barrier(bar);
#endif
    }
}

extern "C" void kernel_launch(void* const* d_in, const int* in_sizes, int n_in, void* d_out, int out_size, void* d_ws, size_t ws_size, hipStream_t stream) {
    static int grid = 0;
    if (grid == 0) {
        if (n_in != 21 || out_size != T * D || ws_size < WS_END) { fprintf(stderr, "kernel_launch: unexpected shapes (n_in %d out %d ws %zu)\n", n_in, out_size, ws_size); grid = -1; return; }
        int dev = 0, cus = 0, per_cu = 0;
        if (hipGetDevice(&dev) != hipSuccess || hipDeviceGetAttribute(&cus, hipDeviceAttributeMultiprocessorCount, dev) != hipSuccess) { grid = -1; return; }
        if (hipFuncSetAttribute((const void*)fwd_megakernel, hipFuncAttributeMaxDynamicSharedMemorySize, LDS_BYTES) != hipSuccess) { fprintf(stderr, "kernel_launch: hipFuncSetAttribute failed\n"); grid = -1; return; }
        if (hipOccupancyMaxActiveBlocksPerMultiprocessor(&per_cu, (const void*)fwd_megakernel, NWAVES * 64, LDS_BYTES) != hipSuccess || per_cu < 1) { fprintf(stderr, "kernel_launch: occupancy query says %d\n", per_cu); grid = -1; return; }
        (void)hipGetLastError();
        grid = cus;
    }
    if (grid < 0) return;
    (void)hipMemsetAsync((char*)d_ws + WS_CTL, 0, CTL_ZERO_BYTES, stream);
    Params p{};
    const float** pp = (const float**)&p;
    for (int i = 0; i < 21; ++i) pp[i] = (const float*)d_in[i];
    p.out = (float*)d_out; p.ws = (unsigned char*)d_ws; p.never = 0; p.pad = 0;
    void* args[] = {&p};
    hipError_t e = hipLaunchCooperativeKernel((const void*)fwd_megakernel, dim3(grid), dim3(NWAVES * 64), args, LDS_BYTES, stream);
    if (e != hipSuccess) fprintf(stderr, "cooperative launch failed: %s (grid %d)\n", hipGetErrorString(e), grid);
}
```

```cpp
#include <hip/hip_runtime.h>
#include <hip/hip_cooperative_groups.h>
#include <cstdio>
#include <cstdint>
namespace cg = cooperative_groups;

#define LAS __attribute__((address_space(3)))
#define GAS __attribute__((address_space(1)))
typedef unsigned short bf16_t;
typedef short bf16x8 __attribute__((ext_vector_type(8)));
typedef short s16x4 __attribute__((ext_vector_type(4)));
typedef float f32x4 __attribute__((ext_vector_type(4)));
typedef float f32x2 __attribute__((ext_vector_type(2)));
typedef float f32x16 __attribute__((ext_vector_type(16)));
typedef unsigned u32x4 __attribute__((ext_vector_type(4)));
typedef unsigned u32x2 __attribute__((ext_vector_type(2)));
typedef __bf16 bf16x2_t __attribute__((ext_vector_type(2)));

constexpr int T = 16384, D = 1024, SEQ = 4096;
constexpr int NPROJ = 2304;
constexpr int NWIN = 2816;
constexpr float EPS = 1e-6f;
constexpr float LOG2E = 1.4426950408889634f;
constexpr float C2_MLA = 0.10206207261596575f * LOG2E;
constexpr float C2_X = 0.0625f * LOG2E;
constexpr float U_SCALE = 512.f, V_SCALE = 64.f;

constexpr size_t MiB = 1u << 20;
constexpr size_t WS_CTL = 0, CTL_ZERO_BYTES = 1 * MiB;
constexpr size_t WS_SSQQ = 227 * MiB, WS_SSQKV = 228 * MiB, WS_SSQ1 = 229 * MiB, WS_SSQ2 = 230 * MiB;
constexpr size_t WS_CR = 1 * MiB, WS_SR = 2 * MiB, WS_CM = 3 * MiB, WS_SM = 3 * MiB + 256 * 1024;
constexpr size_t WS_WIN = 4 * MiB, WS_WUQ = 10 * MiB, WS_WUKV = 11 * MiB, WS_WO = 12 * MiB, WS_WXQ = 14 * MiB, WS_WXKV = 16 * MiB, WS_WXO = 20 * MiB, WS_WPQ = 22 * MiB, WS_SK = 26 * MiB;
constexpr size_t WS_MEMN = 27 * MiB, WS_KX = 29 * MiB, WS_VXT = 31 * MiB;
constexpr size_t WS_A0 = 33 * MiB, WS_MIX = 33 * MiB, WS_QX = 33 * MiB;
constexpr size_t WS_EG = 33 * MiB, WS_WG = 41 * MiB, WS_SSQ3 = 49 * MiB, WS_PART = 65 * MiB;
constexpr size_t WS_PROJ = 65 * MiB, WS_H1B = 65 * MiB, WS_U8 = 137 * MiB, WS_V8 = 153 * MiB;
constexpr size_t WS_OX = 97 * MiB, WS_H2B = 169 * MiB, WS_QP = 65 * MiB;
constexpr size_t WS_RVT = 137 * MiB, WS_QM = 154 * MiB, WS_KN = 178 * MiB, WS_VT = 194 * MiB, WS_RKVT = 211 * MiB;
constexpr int TP = T + 64;
constexpr size_t WS_END = 231 * MiB;
constexpr int CW_BAR = 4096;
constexpr int CW_XRANK = 20480;
constexpr int CW_QUEUE = 16384, Q3_SLOT = 0;

constexpr int RING_BYTES = 131072;
constexpr int LDSCTL_OFF = 143360;
constexpr int LDS_BYTES = 147456;
constexpr int NWAVES = 8;

__device__ __forceinline__ unsigned cvtpk(float lo, float hi) { f32x2 v = {lo, hi}; bf16x2_t b = __builtin_convertvector(v, bf16x2_t); return __builtin_bit_cast(unsigned, b); }
__device__ __forceinline__ float bf2f(unsigned short b) { return __uint_as_float(((unsigned)b) << 16); }
__device__ __forceinline__ int crow(int r, int hi) { return (r & 3) + 8 * (r >> 2) + 4 * hi; }
template <int M> __device__ __forceinline__ float shx(float f, int lane) {
    const int v = (int)__float_as_uint(f); int r;
    if (M == 1) r = __builtin_amdgcn_mov_dpp(v, 0xB1, 0xF, 0xF, true);
    else if (M == 2) r = __builtin_amdgcn_mov_dpp(v, 0x4E, 0xF, 0xF, true);
    else if (M == 4) { r = __builtin_amdgcn_update_dpp(v, v, 0x104, 0xF, 0x5, false); r = __builtin_amdgcn_update_dpp(r, v, 0x114, 0xF, 0xA, false); }
    else if (M == 8) r = __builtin_amdgcn_mov_dpp(v, 0x128, 0xF, 0xF, true);
    else if (M == 16) { auto rr = __builtin_amdgcn_permlane16_swap((unsigned)v, (unsigned)v, false, false); r = (int)((lane & 16) ? rr[0] : rr[1]); }
    else { auto rr = __builtin_amdgcn_permlane32_swap((unsigned)v, (unsigned)v, false, false); r = (int)((lane & 32) ? rr[0] : rr[1]); }
    return __uint_as_float((unsigned)r);
}
__device__ __forceinline__ float wave_sum(float v) {
#pragma unroll
    for (int o = 1; o < 64; o <<= 1) v += __shfl_xor(v, o);
    return v;
}
__device__ __forceinline__ float wave_sum_fast(float v, int lane) {
    v += shx<1>(v, lane); v += shx<2>(v, lane); v += shx<4>(v, lane); v += shx<8>(v, lane); v += shx<16>(v, lane); v += shx<32>(v, lane);
    return v;
}
__device__ __forceinline__ float xhalf_max(float m) { auto rr = __builtin_amdgcn_permlane32_swap(__float_as_uint(m), __float_as_uint(m), false, false); return fmaxf(__uint_as_float(rr[0]), __uint_as_float(rr[1])); }
__device__ __forceinline__ float xhalf_sum(float m) { auto rr = __builtin_amdgcn_permlane32_swap(__float_as_uint(m), __float_as_uint(m), false, false); return __uint_as_float(rr[0]) + __uint_as_float(rr[1]); }
__device__ __forceinline__ unsigned xhalf_other(unsigned m, int hi) { auto rr = __builtin_amdgcn_permlane32_swap(m, m, false, false); return hi ? rr[0] : rr[1]; }
#define LDS_WAIT() asm volatile("s_waitcnt lgkmcnt(0)" ::: "memory")
template <int NP> __device__ __forceinline__ float ssq_sum(const float* part) {
    float s = 0.f;
#pragma unroll
    for (int i = 0; i < NP / 4; ++i) { const f32x4 v = *(const f32x4*)(part + 4 * i); s += v[0]; s += v[1]; s += v[2]; s += v[3]; }
    return s;
}
__device__ __forceinline__ int opaque_tid() { int t = threadIdx.x; asm volatile("" : "+v"(t)); return t; }
#define MFMA32(a, b, c) __builtin_amdgcn_mfma_f32_32x32x16_bf16((a), (b), (c), 0, 0, 0)
__device__ __forceinline__ float gelu_f(float v) {
    const float av = fabsf(v), t = __builtin_amdgcn_rcpf(av * 0.2316418882f + 1.0f);
    float q = t * 0.5307027145f + (-0.7265760135f); q = q * t + 0.7107068705f; q = q * t + (-0.142248368f); q = q * t + 0.127414796f; q = q * t;
    const float e = __builtin_amdgcn_exp2f((v * v) * (-0.72134752044f));
    const float m = v * (q * e);
    return v < 0.f ? m : v - m;
}

namespace pg8 {
constexpr int BM = 256, BK = 64, HALF = 128, HTB = HALF * BK * 2, STAGE_BYTES = 8 * HTB, NXCD = 8, WGM = 8;
__host__ __device__ __forceinline__ int lds_byte(int r, int c) { const int st = (r >> 4) * 2 + (c >> 5), rr = r & 15, cc = c & 31, ob = rr * 64 + cc * 2; return st * 1024 + (ob ^ (((ob >> 9) & 1) << 5)); }
__host__ __device__ __forceinline__ void stage_rc(int b, int& R, int& C) { const int st = b / 1024, sb = b % 1024, swz = sb ^ (((sb >> 9) & 1) << 5); R = (st >> 1) * 16 + swz / 64; C = (st & 1) * 32 + (swz % 64) / 2; }
struct Unit { int pm, pn; };
struct Gemm { const bf16_t* A; const bf16_t* Bt; int M, N, K, lda, ldb; };
struct StaticOrder {
    int nM, nN, nwg, G, c;
    __device__ void init(int M, int N, int G_, int c_) { nM = M / BM; nN = N / BM; nwg = nM * nN; G = G_; c = c_; }
    __device__ bool next(int i, Unit& u) const {
        const long L = (long)i * G + c; if (L >= nwg) return false;
        int wgid = (int)L; { const int q = nwg / NXCD, r = nwg % NXCD, xcd = wgid % NXCD, off = wgid / NXCD; wgid = (xcd < r ? xcd * (q + 1) : r * (q + 1) + (xcd - r) * q) + off; }
        const int nig = WGM * nN, gid = wgid / nig, fm = gid * WGM, gsz = (nM - fm) < WGM ? (nM - fm) : WGM;
        u.pm = fm + ((wgid % nig) % gsz); u.pn = (wgid % nig) / gsz; return true;
    }
};

template <class Epi, class Sched, bool ALIGN_EPI>
__device__ __forceinline__ void gemm_phase(LAS unsigned char* lds, const Gemm g, const Sched& S, const Epi& E) {
    const int tid = opaque_tid(), wid = __builtin_amdgcn_readfirstlane(tid >> 6), lane = tid & 63, wr = wid >> 2, wc = wid & 3, fr = lane & 15, fq = lane >> 4;
    const int K = g.K, nt = K / BK;
    unsigned voffA[2], voffB[2];
#pragma unroll
    for (int i = 0; i < 2; ++i) { int R, C; stage_rc(tid * 16 + i * 8192, R, C); voffA[i] = (unsigned)(R * g.lda + C) * 2u; voffB[i] = (unsigned)(R * g.ldb + C) * 2u; }
    const size_t kstep = (size_t)(BK * 2);
    const size_t hstepA = (size_t)HALF * g.lda * 2, hstepB = (size_t)HALF * g.ldb * 2, tstepA = 2 * hstepA, tstepB = 2 * hstepB;
    const unsigned ldsw = (unsigned)wid * 1024u;
    const int aoff = lds_byte(wr * 64 + fr, fq * 8), boff = lds_byte(wc * 32 + fr, fq * 8);
#define PG8_SA(b, h) (((b) * 2 + (h)) * HTB)
#define PG8_SB(b, h) ((4 + (b) * 2 + (h)) * HTB)
#define PG8_STAGE(bufoff, gbase, voff) do { _Pragma("unroll") for (int _i = 0; _i < 2; ++_i) \
        __builtin_amdgcn_global_load_lds((const unsigned*)((const char*)(gbase) + (voff)[_i]), (LAS unsigned*)(lds + (bufoff) + ldsw + _i * 8192), 16, 0, 0); } while (0)
#define PG8_LDA(dst, b, h) do { _Pragma("unroll") for (int m = 0; m < 4; ++m) _Pragma("unroll") for (int k = 0; k < 2; ++k) dst[m][k] = *(const LAS bf16x8*)(lds + PG8_SA(b, h) + aoff + m * 2048 + k * 1024); } while (0)
#define PG8_LDB(dst, b, h) do { _Pragma("unroll") for (int n = 0; n < 2; ++n) _Pragma("unroll") for (int k = 0; k < 2; ++k) dst[n][k] = *(const LAS bf16x8*)(lds + PG8_SB(b, h) + boff + n * 2048 + k * 1024); } while (0)
#define PG8_MMA(ai, bj, At, Bt) do { __builtin_amdgcn_s_setprio(1); _Pragma("unroll") for (int m = 0; m < 4; ++m) _Pragma("unroll") for (int n = 0; n < 2; ++n) _Pragma("unroll") for (int k = 0; k < 2; ++k) \
        acc[ai][bj][m][n] = __builtin_amdgcn_mfma_f32_16x16x32_bf16(Bt[n][k], At[m][k], acc[ai][bj][m][n], 0, 0, 0); __builtin_amdgcn_s_setprio(0); } while (0)
#define PG8_WAIT_V(n) asm volatile("s_waitcnt vmcnt(" #n ")" ::: "memory")
#define PG8_WAIT_L(n) asm volatile("s_waitcnt lgkmcnt(" #n ")" ::: "memory")
#define PG8_BAR __builtin_amdgcn_s_barrier()
#define PG8_SCHED __builtin_amdgcn_sched_barrier(0)
    Unit cur, nxt; int ui = 0;
    if (!S.next(0, cur)) return;
    f32x4 acc[2][2][4][2];
#pragma unroll
    for (int a = 0; a < 2; ++a)
#pragma unroll
        for (int b = 0; b < 2; ++b)
#pragma unroll
            for (int m = 0; m < 4; ++m)
#pragma unroll
                for (int n = 0; n < 2; ++n) acc[a][b][m][n] = (f32x4){0.f, 0.f, 0.f, 0.f};
    bf16x8 At[4][2], B0[2][2], B1[2][2];
    const char* cA = (const char*)g.A + (size_t)cur.pm * tstepA; const char* cB = (const char*)g.Bt + (size_t)cur.pn * tstepB;
    PG8_STAGE(PG8_SB(0, 0), cB, voffB); PG8_STAGE(PG8_SB(0, 1), cB + hstepB, voffB); PG8_STAGE(PG8_SA(0, 0), cA, voffA); PG8_STAGE(PG8_SA(0, 1), cA + hstepA, voffA);
    if (wr == 1) PG8_BAR;
    PG8_WAIT_V(2); PG8_BAR;
    PG8_STAGE(PG8_SB(1, 0), cB + kstep, voffB); PG8_STAGE(PG8_SA(1, 0), cA + kstep, voffA); PG8_STAGE(PG8_SB(1, 1), cB + hstepB + kstep, voffB);
    PG8_WAIT_V(6); PG8_BAR;
    for (;;) {
        const bool has_next = S.next(ui + 1, nxt);
        const char* nA = has_next ? (const char*)g.A + (size_t)nxt.pm * tstepA : cA; const char* nB = has_next ? (const char*)g.Bt + (size_t)nxt.pn * tstepB : cB;
#pragma nounroll
        for (int t = 0; t < nt; t += 2) {
            const bool last = (t == nt - 2);
            const char* a1 = cA + (size_t)(t + 1) * kstep;
            const char* a2 = last ? nA : cA + (size_t)(t + 2) * kstep; const char* b2 = last ? nB : cB + (size_t)(t + 2) * kstep;
            const char* a3 = a2 + kstep; const char* b3 = b2 + kstep;
            PG8_LDB(B0, 0, 0); PG8_LDB(B1, 0, 1); PG8_SCHED; PG8_LDA(At, 0, 0); PG8_STAGE(PG8_SA(1, 1), a1 + hstepA, voffA);
            PG8_WAIT_V(8); PG8_WAIT_L(0); PG8_BAR; PG8_MMA(0, 0, At, B0); PG8_MMA(0, 1, At, B1); PG8_BAR; PG8_SCHED;
            PG8_LDA(At, 0, 1); PG8_STAGE(PG8_SB(0, 0), b2, voffB); PG8_STAGE(PG8_SB(0, 1), b2 + hstepB, voffB); PG8_STAGE(PG8_SA(0, 0), a2, voffA);
            PG8_WAIT_V(8); PG8_WAIT_L(0); PG8_BAR; PG8_MMA(1, 0, At, B0); PG8_MMA(1, 1, At, B1); PG8_BAR; PG8_SCHED;
            PG8_LDB(B0, 1, 0); PG8_LDB(B1, 1, 1); PG8_SCHED; PG8_LDA(At, 1, 0); PG8_STAGE(PG8_SA(0, 1), a2 + hstepA, voffA);
            PG8_WAIT_V(8); PG8_WAIT_L(0); PG8_BAR; PG8_MMA(0, 0, At, B0); PG8_MMA(0, 1, At, B1); PG8_BAR; PG8_SCHED;
            PG8_LDA(At, 1, 1); PG8_STAGE(PG8_SB(1, 0), b3, voffB); PG8_STAGE(PG8_SB(1, 1), b3 + hstepB, voffB); PG8_STAGE(PG8_SA(1, 0), a3, voffA);
            PG8_WAIT_V(8); PG8_WAIT_L(0); PG8_BAR; PG8_MMA(1, 0, At, B0); PG8_MMA(1, 1, At, B1); PG8_BAR; PG8_SCHED;
        }
        if constexpr (ALIGN_EPI) { if (wr == 0) PG8_BAR; }
        E(acc, cur, wr, wc, fr, fq);
        if (!has_next) break;
#pragma unroll
        for (int a = 0; a < 2; ++a)
#pragma unroll
            for (int b = 0; b < 2; ++b)
#pragma unroll
                for (int m = 0; m < 4; ++m)
#pragma unroll
                    for (int n = 0; n < 2; ++n) acc[a][b][m][n] = (f32x4){0.f, 0.f, 0.f, 0.f};
        cur = nxt; cA = nA; cB = nB; ++ui;
        if constexpr (ALIGN_EPI) { if (wr == 1) PG8_BAR; }
    }
    PG8_WAIT_V(0);
    if constexpr (!ALIGN_EPI) { if (wr == 0) PG8_BAR; }
    PG8_BAR;
#undef PG8_SA
#undef PG8_SB
#undef PG8_STAGE
#undef PG8_LDA
#undef PG8_LDB
#undef PG8_MMA
#undef PG8_WAIT_V
#undef PG8_WAIT_L
#undef PG8_BAR
#undef PG8_SCHED
}

__device__ __forceinline__ void st_bf16x4(bf16_t* p, f32x4 v) { u32x2 w; w.x = cvtpk(v[0], v[1]); w.y = cvtpk(v[2], v[3]); *(u32x2*)p = w; }
#define EPI_LOOP_AM _Pragma("unroll") for (int ai = 0; ai < 2; ++ai) _Pragma("unroll") for (int m = 0; m < 4; ++m)
#define EPI_LOOP_BN _Pragma("unroll") for (int bj = 0; bj < 2; ++bj) _Pragma("unroll") for (int n = 0; n < 2; ++n)

struct EpiPlain {
    bf16_t* O; int ldc;
    __device__ __forceinline__ void operator()(const f32x4 (&acc)[2][2][4][2], const Unit& u, int wr, int wc, int fr, int fq) const {
        const int row0 = u.pm * BM + wr * 64 + fr, col0 = u.pn * BM + wc * 32 + 4 * fq;
        EPI_LOOP_AM { bf16_t* rowp = O + (size_t)(row0 + ai * HALF + m * 16) * ldc + col0;
            EPI_LOOP_BN st_bf16x4(rowp + bj * HALF + n * 16, acc[ai][bj][m][n]); }
    }
};
template <int NP> struct EpiRowScale {
    bf16_t* O; int ldc; const float* ssq; float invn, mul;
    __device__ __forceinline__ void operator()(const f32x4 (&acc)[2][2][4][2], const Unit& u, int wr, int wc, int fr, int fq) const {
        const int row0 = u.pm * BM + wr * 64 + fr, col0 = u.pn * BM + wc * 32 + 4 * fq;
        EPI_LOOP_AM { const int row = row0 + ai * HALF + m * 16; const float rs = rsqrtf(ssq_sum<NP>(ssq + (size_t)row * 16) * invn + EPS) * mul; bf16_t* rowp = O + (size_t)row * ldc + col0;
            EPI_LOOP_BN st_bf16x4(rowp + bj * HALF + n * 16, acc[ai][bj][m][n] * rs);
            if (m & 1) asm volatile("" ::: "memory"); }
    }
};
struct EpiColScale {
    bf16_t* O; int ldc; const float* ssq; float invn;
    __device__ __forceinline__ void operator()(const f32x4 (&acc)[2][2][4][2], const Unit& u, int wr, int wc, int fr, int fq) const {
        const int row0 = u.pm * BM + wr * 64 + fr, col0 = u.pn * BM + wc * 32 + 4 * fq;
        EPI_LOOP_BN { const float* sp = ssq + (size_t)(col0 + bj * HALF + n * 16) * 16;
            const f32x4 rs = (f32x4){rsqrtf(ssq_sum<8>(sp) * invn + EPS), rsqrtf(ssq_sum<8>(sp + 16) * invn + EPS), rsqrtf(ssq_sum<8>(sp + 32) * invn + EPS), rsqrtf(ssq_sum<8>(sp + 48) * invn + EPS)};
            EPI_LOOP_AM st_bf16x4(O + (size_t)(row0 + ai * HALF + m * 16) * ldc + col0 + bj * HALF + n * 16, acc[ai][bj][m][n] * rs);
            asm volatile("" ::: "memory"); }
    }
};
struct EpiRes {
    const float* basef; const bf16_t* baseb; bf16_t* hb; float* ssq;
    __device__ __forceinline__ void operator()(const f32x4 (&acc)[2][2][4][2], const Unit& u, int wr, int wc, int fr, int fq) const {
        const int row0 = u.pm * BM + wr * 64 + fr, col0 = u.pn * BM + wc * 32 + 4 * fq;
        EPI_LOOP_AM { const int row = row0 + ai * HALF + m * 16; const size_t off = (size_t)row * D + col0; float ss = 0.f;
            EPI_LOOP_BN { f32x4 b;
                if (basef) b = *(const f32x4*)(basef + off + bj * HALF + n * 16);
                else { const u32x2 r = *(const u32x2*)(baseb + off + bj * HALF + n * 16); b = (f32x4){bf2f((unsigned short)(r.x & 0xffffu)), bf2f((unsigned short)(r.x >> 16)), bf2f((unsigned short)(r.y & 0xffffu)), bf2f((unsigned short)(r.y >> 16))}; }
                const f32x4 h = b + acc[ai][bj][m][n];
                st_bf16x4(hb + off + bj * HALF + n * 16, h); ss += (h[0] * h[0] + h[1] * h[1]) + (h[2] * h[2] + h[3] * h[3]); }
            ss += __shfl_xor(ss, 16); ss += __shfl_xor(ss, 32);
            if (fq == 0) ssq[(size_t)row * 16 + u.pn * 4 + wc] = ss;
            asm volatile("" ::: "memory"); }
    }
};
struct EpiProj {
    bf16_t* P; float* ssq_q; float* ssq_kv; const float* cr; const float* sr; const float* cm; const float* sm;
    __device__ __forceinline__ void operator()(const f32x4 (&acc)[2][2][4][2], const Unit& u, int wr, int wc, int fr, int fq) const {
        const int row0 = u.pm * BM + wr * 64 + fr;
#pragma unroll
        for (int bj = 0; bj < 2; ++bj) {
            const int hb = 2 * u.pn + bj;
            if (hb == 17 && wc != 0) continue;
            const int kind = hb < 3 ? 0 : hb < 5 ? 1 : hb < 9 ? 2 : hb < 13 ? 3 : hb < 17 ? 4 : 5;
            const int col = hb * HALF + wc * 32 + 4 * fq;
            EPI_LOOP_AM { const int row = row0 + ai * HALF + m * 16; const int s = row & (SEQ - 1);
                f32x4 v0 = acc[ai][bj][m][0], v1 = acc[ai][bj][m][1];
                if (kind <= 1) {
                    float ss = (v0[0] * v0[0] + v0[1] * v0[1]) + (v0[2] * v0[2] + v0[3] * v0[3]) + (v1[0] * v1[0] + v1[1] * v1[1]) + (v1[2] * v1[2] + v1[3] * v1[3]);
                    ss += __shfl_xor(ss, 16); ss += __shfl_xor(ss, 32);
                    if (fq == 0) { if (kind == 0) ssq_q[(size_t)row * 16 + hb * 4 + wc] = ss; else ssq_kv[(size_t)row * 16 + (hb - 3) * 4 + wc] = ss; }
                } else if (kind == 2 || kind == 3) {
                    const f32x4 c = *(const f32x4*)(cr + (size_t)s * 64 + wc * 16 + 4 * fq), sn = *(const f32x4*)(sr + (size_t)s * 64 + wc * 16 + 4 * fq);
                    f32x4 y0 = v0 * c - v1 * sn, y1 = v0 * sn + v1 * c;
                    if (kind == 3) { y0 = y0 * 0.08838834764831845f; y1 = y1 * 0.08838834764831845f; }
                    v0 = y0; v1 = y1;
                } else if (kind == 5) {
                    const f32x4 c = *(const f32x4*)(cm + (size_t)s * 16 + 4 * fq), sn = *(const f32x4*)(sm + (size_t)s * 16 + 4 * fq);
                    const f32x4 y0 = v0 * c - v1 * sn, y1 = v0 * sn + v1 * c; v0 = y0; v1 = y1;
                }
                bf16_t* rowp = P + (size_t)row * NPROJ + col;
                st_bf16x4(rowp, v0); st_bf16x4(rowp + 16, v1);
                if (m & 1) asm volatile("" ::: "memory"); }
        }
    }
};
struct EpiQ {
    bf16_t* O; const float* ssq; const float* cm; const float* sm;
    __device__ __forceinline__ void operator()(const f32x4 (&acc)[2][2][4][2], const Unit& u, int wr, int wc, int fr, int fq) const {
        const int row0 = u.pm * BM + wr * 64 + fr, col0 = u.pn * BM + wc * 32 + 4 * fq;
        EPI_LOOP_AM { const int row = row0 + ai * HALF + m * 16; const int s = row & (SEQ - 1); const float rs = rsqrtf(ssq_sum<12>(ssq + (size_t)row * 16) * (1.f / 384.f) + EPS) * C2_MLA;
            bf16_t* rowp = O + (size_t)row * 768 + col0;
            f32x4 c = (f32x4){1.f, 1.f, 1.f, 1.f}, sn = (f32x4){0.f, 0.f, 0.f, 0.f};
            if (u.pn == 2) { c = *(const f32x4*)(cm + (size_t)s * 16 + 4 * fq); sn = *(const f32x4*)(sm + (size_t)s * 16 + 4 * fq); }
#pragma unroll
            for (int bj = 0; bj < 2; ++bj) { const f32x4 v0 = acc[ai][bj][m][0] * rs, v1 = acc[ai][bj][m][1] * rs;
                st_bf16x4(rowp + bj * HALF, v0 * c - v1 * sn); st_bf16x4(rowp + bj * HALF + 16, v0 * sn + v1 * c); }
            asm volatile("" ::: "memory"); }
    }
};
}

#define XB_TMO      128
#define XB_XCNT(j)  (256  + 64 * (j))
#define XB_XSUB(j)  (1280 + 64 * (j))
#define XB_XGEN(j)  (2304 + 64 * (j))
#define XB_TOP      3328
#define XB_TOPGEN   3392
#define XCD_BAR_WORDS 3456
#define XB_SPIN_CAP (1u << 21)
__device__ __forceinline__ unsigned xb_ld(unsigned* p)              { return __hip_atomic_load(p, __ATOMIC_RELAXED, __HIP_MEMORY_SCOPE_AGENT); }
__device__ __forceinline__ unsigned xb_add(unsigned* p, unsigned v) { return __hip_atomic_fetch_add(p, v, __ATOMIC_RELAXED, __HIP_MEMORY_SCOPE_AGENT); }
__device__ __forceinline__ unsigned xb_xcc_id() { return (unsigned)__builtin_amdgcn_s_getreg((3 << 11) | 20) & 0xFu; }
#define XB_SPIN(cond, bar) do { unsigned _sp = 0; while (cond) { __builtin_amdgcn_s_sleep(1); \
    if ((++_sp & 255u) == 0u) { if (xb_ld(&(bar)[XB_TMO])) break; if (_sp > XB_SPIN_CAP) { atomicAdd(&(bar)[XB_TMO], 1u); break; } } } } while (0)
struct XcdBarrier { unsigned* bar; unsigned x; volatile LAS unsigned* st; };
__device__ __forceinline__ XcdBarrier xcd_barrier_post(unsigned* bar, volatile LAS unsigned* st) {
    XcdBarrier b; b.bar = bar; b.x = xb_xcc_id(); b.st = st;
    if (threadIdx.x == 0) (void)xb_add(&bar[XB_XCNT(b.x)], 1u);
    return b;
}
__device__ __forceinline__ void xcd_barrier_complete(unsigned* bar, unsigned x, unsigned& nloc, unsigned& nx) {
    const unsigned G = gridDim.x * gridDim.y * gridDim.z;
    unsigned sum, cnt, mine, sp = 0u;
    for (;;) {
        sum = 0u; cnt = 0u; mine = 0u;
#pragma unroll
        for (unsigned j = 0; j < 16; ++j) { const unsigned c = xb_ld(&bar[XB_XCNT(j)]); sum += c; cnt += (c > 0u) ? 1u : 0u; mine = (j == x) ? c : mine; }
        if (sum == G) break;
        __builtin_amdgcn_s_sleep(1);
        if ((++sp & 255u) == 0u) { if (xb_ld(&bar[XB_TMO])) break; if (sp > XB_SPIN_CAP) { atomicAdd(&bar[XB_TMO], 1u); break; } }
    }
    nloc = mine > 0u ? mine : 1u; nx = cnt > 0u ? cnt : 1u;
}
__device__ __forceinline__ void xcd_barrier(const XcdBarrier& b) {
    asm volatile("s_waitcnt vmcnt(0)" ::: "memory");
    __syncthreads();
    if (threadIdx.x == 0) {
        unsigned* bar = b.bar;
        __builtin_amdgcn_s_waitcnt(0);
        unsigned nloc = b.st[0], nx = b.st[1];
        if (nloc == 0u) { xcd_barrier_complete(bar, b.x, nloc, nx); b.st[0] = nloc; b.st[1] = nx; }
        const unsigned old = xb_add(&bar[XB_XSUB(b.x)], 1u);
        const unsigned gen = old / nloc;
        if (old + 1u == (gen + 1u) * nloc) {
            __builtin_amdgcn_fence(__ATOMIC_RELEASE, "agent");
            asm volatile("s_waitcnt vmcnt(0)" ::: "memory");
            const unsigned og = xb_add(&bar[XB_TOP], 1u);
            const unsigned tg = og / nx;
            if (og + 1u == (tg + 1u) * nx) xb_add(&bar[XB_TOPGEN], 1u);
            else XB_SPIN(xb_ld(&bar[XB_TOPGEN]) == tg, bar);
            __builtin_amdgcn_fence(__ATOMIC_ACQUIRE, "agent");
            xb_add(&bar[XB_XGEN(b.x)], 1u);
            asm volatile("s_waitcnt vmcnt(0)" ::: "memory");
        } else {
            XB_SPIN(xb_ld(&bar[XB_XGEN(b.x)]) == gen, bar);
            __builtin_amdgcn_fence(__ATOMIC_ACQUIRE, "agent");
            asm volatile("s_waitcnt vmcnt(0)" ::: "memory");
        }
    }
    __syncthreads();
}

struct Params {
    const float *x, *mem, *g_mix, *w_in, *g_q_lora, *w_uq, *g_kv_lora, *w_ukv, *g_ret_gn, *w_o, *g_xattn, *g_mem, *w_xq, *w_xkv, *w_xo, *g_ffn, *w_pq, *sub_keys, *u_exp, *v_exp, *g_final;
    float* out; unsigned char* ws; int never; int pad;
};

__device__ __forceinline__ int permret(int i) { return i < 64 ? ((i >> 4) * 32 + (i & 15)) : (((i - 64) >> 4) * 32 + 16 + ((i - 64) & 15)); }
template <int MODE> __device__ __forceinline__ int dst_row(int c) {
    if (MODE == 1) {
        if (c < 640) return c;
        if (c < 672) return 2176 + (c - 640);
        if (c < 1184) { const int cc = c - 672; return 640 + (cc & ~127) + permret(cc & 127); }
        if (c < 1696) { const int cc = c - 1184; return 1152 + (cc & ~127) + permret(cc & 127); }
        if (c < 2208) return 2304 + (c - 1696);
        return 1664 + (c - 2208);
    } else if (MODE == 2) {
        const int h = c / 96, i = c - h * 96; return i < 64 ? h * 64 + i : 512 + h * 32 + (i - 64);
    } else if (MODE == 3) {
        const int h = c >> 7, i = c & 127; return i < 64 ? h * 64 + i : 512 + h * 64 + (i - 64);
    }
    return c;
}
template <int MODE> __device__ __forceinline__ void p0_transpose_item(const float* W, int K, int N, bf16_t* WT, const float* gain, LAS float* scr, int item, int lane) {
    const int nblk = N / 32, kb = item / nblk, nb = item % nblk, k0 = 64 * kb, n0 = 32 * nb;
    float v[32];
#pragma unroll
    for (int i = 0; i < 32; ++i) { const int kk = 2 * i + (lane >> 5); v[i] = W[(size_t)(k0 + kk) * N + n0 + (lane & 31)]; }
    if (gain) {
#pragma unroll
        for (int i = 0; i < 32; ++i) { const int kk = 2 * i + (lane >> 5); v[i] *= gain[k0 + kk]; }
    }
#pragma unroll
    for (int i = 0; i < 32; ++i) { const int kk = 2 * i + (lane >> 5); scr[kk * 33 + (lane & 31)] = v[i]; }
    LDS_WAIT(); asm volatile("" ::: "memory");
    const int c = lane & 7;
#pragma unroll
    for (int j = 0; j < 4; ++j) { const int n = (lane >> 3) + 8 * j; const LAS float* s = scr + (8 * c) * 33 + n;
        u32x4 o; o.x = cvtpk(s[0 * 33], s[1 * 33]); o.y = cvtpk(s[2 * 33], s[3 * 33]); o.z = cvtpk(s[4 * 33], s[5 * 33]); o.w = cvtpk(s[6 * 33], s[7 * 33]);
        *(u32x4*)(WT + (size_t)dst_row<MODE>(n0 + n) * K + k0 + 8 * c) = o; }
    LDS_WAIT(); asm volatile("" ::: "memory");
}
template <int NR> __device__ __forceinline__ void rms_rows_to_bf16(const float* xrow, const float* g, bf16_t* orow, size_t rstride, int lane) {
    f32x4 v[NR][4];
#pragma unroll
    for (int r = 0; r < NR; ++r)
#pragma unroll
        for (int j = 0; j < 4; ++j) v[r][j] = ((const f32x4*)(xrow + r * rstride) + lane)[64 * j];
    const f32x4* gr = (const f32x4*)g + lane;
    f32x4 gv[4];
#pragma unroll
    for (int j = 0; j < 4; ++j) gv[j] = gr[64 * j];
#pragma unroll
    for (int r = 0; r < NR; ++r) {
        float s = 0.f;
#pragma unroll
        for (int j = 0; j < 4; ++j) s += (v[r][j][0] * v[r][j][0] + v[r][j][1] * v[r][j][1]) + (v[r][j][2] * v[r][j][2] + v[r][j][3] * v[r][j][3]);
        const float rstd = rsqrtf(wave_sum(s) * (1.f / D) + EPS);
        u32x2* o8 = (u32x2*)(orow + r * rstride) + lane;
#pragma unroll
        for (int j = 0; j < 4; ++j) { const f32x4 y = v[r][j] * rstd * gv[j]; u32x2 w; w.x = cvtpk(y[0], y[1]); w.y = cvtpk(y[2], y[3]); o8[64 * j] = w; }
    }
}

struct NoMid { __device__ __forceinline__ void operator()() const {} };
__device__ __forceinline__ float max3f(float a, float b, float c) { return fmaxf(fmaxf(a, b), c); }
template <int NS, int NT, int KG, bool CINIT, bool MASK, class Mid>
__device__ __forceinline__ void flash_tile(const LAS unsigned char* Ks, int kpitch, const LAS unsigned char* Vs, int vpitch, const bf16x8 (&qf)[NS], f32x16 (&o)[NT],
                                           f32x16& negm, float& mref, float& lrun, bool first, int r32, int hi, bool domask, int qrel, int krel, const Mid& mid) {
    f32x16 p0, p1;
    const LAS unsigned char* k0 = Ks + r32 * kpitch + hi * 16; const LAS unsigned char* k1 = k0 + 32 * kpitch;
    if (CINIT) { p0 = negm; p1 = negm; }
    else {
#pragma unroll
        for (int r = 0; r < 16; ++r) { p0[r] = 0.f; p1[r] = 0.f; }
    }
#pragma unroll
    for (int g0 = 0; g0 < NS; g0 += KG) {
        bf16x8 ka[KG], kb2[KG];
#pragma unroll
        for (int s = 0; s < KG; ++s) { ka[s] = *(const LAS bf16x8*)(k0 + (g0 + s) * 32); kb2[s] = *(const LAS bf16x8*)(k1 + (g0 + s) * 32); }
        __builtin_amdgcn_sched_barrier(0);
#pragma unroll
        for (int s = 0; s < KG; ++s) { p0 = MFMA32(ka[s], qf[g0 + s], p0); p1 = MFMA32(kb2[s], qf[g0 + s], p1); }
        __builtin_amdgcn_sched_barrier(0);
    }
    if (!CINIT) {
#pragma unroll
        for (int r = 0; r < 16; ++r) { p0[r] -= mref; p1[r] -= mref; }
    }
    if (MASK) {
#pragma unroll
        for (int r = 0; r < 16; ++r) { const int kv = krel + crow(r, hi); if (kv > qrel) p0[r] = -1e30f; if (kv + 32 > qrel) p1[r] = -1e30f; }
    }
    float ma = max3f(p0[0], p0[1], p1[0]), mb = max3f(p0[2], p0[3], p1[1]); ma = max3f(ma, p1[2], p1[3]);
#pragma unroll
    for (int r = 4; r < 16; r += 4) { ma = max3f(ma, p0[r], p0[r + 1]); mb = max3f(mb, p0[r + 2], p0[r + 3]); ma = max3f(ma, p1[r], p1[r + 1]); mb = max3f(mb, p1[r + 2], p1[r + 3]); }
    const float mx = xhalf_max(fmaxf(ma, mb));
    if (first || __any(mx > 8.0f)) {
        const float dl = first ? mx : fmaxf(mx, 0.f);
        mref += dl;
#pragma unroll
        for (int r = 0; r < 16; ++r) { p0[r] -= dl; p1[r] -= dl; if (CINIT) negm[r] = -mref; }
        const float alpha = __builtin_amdgcn_exp2f(-dl);
        lrun *= alpha;
        if (!first) {
#pragma unroll
            for (int t = 0; t < NT; ++t)
#pragma unroll
                for (int r = 0; r < 16; ++r) o[t][r] *= alpha;
        }
    }
    float rs0 = 0.f, rs1 = 0.f;
#pragma unroll
    for (int r = 0; r < 16; ++r) { p0[r] = __builtin_amdgcn_exp2f(p0[r]); p1[r] = __builtin_amdgcn_exp2f(p1[r]); rs0 += p0[r]; rs1 += p1[r]; }
    lrun += rs0 + rs1;
    bf16x8 pb[4];
#pragma unroll
    for (int ks = 0; ks < 2; ++ks) {
        u32x4 w0, w1;
        w0.x = cvtpk(p0[8 * ks + 0], p0[8 * ks + 1]); w0.y = cvtpk(p0[8 * ks + 2], p0[8 * ks + 3]); w0.z = cvtpk(p0[8 * ks + 4], p0[8 * ks + 5]); w0.w = cvtpk(p0[8 * ks + 6], p0[8 * ks + 7]);
        w1.x = cvtpk(p1[8 * ks + 0], p1[8 * ks + 1]); w1.y = cvtpk(p1[8 * ks + 2], p1[8 * ks + 3]); w1.z = cvtpk(p1[8 * ks + 4], p1[8 * ks + 5]); w1.w = cvtpk(p1[8 * ks + 6], p1[8 * ks + 7]);
        pb[ks] = __builtin_bit_cast(bf16x8, w0); pb[2 + ks] = __builtin_bit_cast(bf16x8, w1);
    }
    mid();
    const LAS unsigned char* vb = Vs + r32 * vpitch + hi * 8;
#pragma unroll
    for (int t = 0; t < NT; ++t) {
        s16x4 lo[4], hh[4];
#pragma unroll
        for (int ks = 0; ks < 4; ++ks) { lo[ks] = *(const LAS s16x4*)(vb + t * 32 * vpitch + ks * 32); hh[ks] = *(const LAS s16x4*)(vb + t * 32 * vpitch + ks * 32 + 16); }
        __builtin_amdgcn_sched_barrier(0);
#pragma unroll
        for (int ks = 0; ks < 4; ++ks) { const bf16x8 a = (bf16x8){lo[ks][0], lo[ks][1], lo[ks][2], lo[ks][3], hh[ks][0], hh[ks][1], hh[ks][2], hh[ks][3]}; o[t] = MFMA32(a, pb[ks], o[t]); }
        __builtin_amdgcn_sched_barrier(0);
    }
}

constexpr int MLA_KP = 208, MLA_VP = 264;
constexpr int MLA_KT = 128 * MLA_KP, MLA_VTB = 64 * MLA_VP, MLA_BUF = MLA_KT + MLA_VTB;
__device__ __forceinline__ void mla_unit(LAS unsigned char* lds, int b, int h, int qb, const bf16_t* QM, const bf16_t* KN, const bf16_t* PROJ, const bf16_t* VT, bf16_t* MIX) {
    const int tid = opaque_tid(), lane = tid & 63, r32 = lane & 31, hi = lane >> 5, wid = __builtin_amdgcn_readfirstlane(tid >> 6);
    const size_t tb = (size_t)b * SEQ;
    const int q0 = qb * 256 + wid * 32;
    bf16x8 qf[6];
    { const bf16_t* qr = QM + (tb + q0 + r32) * 768;
#pragma unroll
      for (int s = 0; s < 4; ++s) qf[s] = *(const bf16x8*)(qr + h * 64 + s * 16 + hi * 8);
#pragma unroll
      for (int s = 0; s < 2; ++s) qf[4 + s] = *(const bf16x8*)(qr + 512 + h * 32 + s * 16 + hi * 8); }
    f32x16 o[2], negm;
#pragma unroll
    for (int r = 0; r < 16; ++r) { o[0][r] = 0.f; o[1][r] = 0.f; negm[r] = 0.f; }
    float mref = 0.f, lrun = 0.f;
    const int NCH = 2 * qb + 2;
    const int kr = tid >> 3, kc = tid & 7;
    const int pr = tid >> 2, pc = tid & 3;
    const int vr = tid >> 4, vc = tid & 15;
    const bf16_t* ksrc = KN + (tb + kr) * 512 + h * 64 + kc * 8;
    const bf16_t* psrc = PROJ + (tb + pr) * NPROJ + 2176 + pc * 8;
    const bf16_t* vsrc = VT + (size_t)(h * 64 + vr) * TP + tb + vc * 8;
    struct Stg { u32x4 k0, k1, pe, v0, v1; };
    Stg sa, sb;
    auto stage_load = [&](Stg& s, int ch) { const size_t ko = (size_t)ch * 128;
        s.k0 = *(const u32x4*)(ksrc + ko * 512); s.k1 = *(const u32x4*)(ksrc + (ko + 64) * 512); s.pe = *(const u32x4*)(psrc + ko * NPROJ);
        s.v0 = *(const u32x4*)(vsrc + ko); s.v1 = *(const u32x4*)(vsrc + (size_t)32 * TP + ko); };
    auto stage_write = [&](const Stg& s, int buf) {
        LAS unsigned char* kb = lds + buf * MLA_BUF; LAS unsigned char* vbp = kb + MLA_KT;
        *(LAS u32x4*)(kb + kr * MLA_KP + kc * 16) = s.k0; *(LAS u32x4*)(kb + (kr + 64) * MLA_KP + kc * 16) = s.k1;
        *(LAS u32x4*)(kb + pr * MLA_KP + 128 + pc * 16) = s.pe;
        { LAS unsigned char* d = vbp + vr * MLA_VP + vc * 16; *(LAS u32x2*)d = (u32x2){s.v0.x, s.v0.y}; *(LAS u32x2*)(d + 8) = (u32x2){s.v0.z, s.v0.w}; }
        { LAS unsigned char* d = vbp + (vr + 32) * MLA_VP + vc * 16; *(LAS u32x2*)d = (u32x2){s.v1.x, s.v1.y}; *(LAS u32x2*)(d + 8) = (u32x2){s.v1.z, s.v1.w}; }
    };
    const int qrel = wid * 32 + r32;
    auto compute = [&](int buf, int ch) {
        const LAS unsigned char* kb = lds + buf * MLA_BUF;
#pragma unroll
        for (int j = 0; j < 2; ++j)
            flash_tile<6, 2, 6, true, false>(kb + j * 64 * MLA_KP, MLA_KP, kb + MLA_KT + j * 128, MLA_VP, qf, o, negm, mref, lrun, ch == 0 && j == 0, r32, hi, false, qrel, 0, NoMid());
    };
    auto compute_band = [&](int buf, int ch) {
        const LAS unsigned char* kb = lds + buf * MLA_BUF;
#pragma unroll
        for (int j = 0; j < 2; ++j) {
            const int krel = ch * 128 + j * 64 - qb * 256;
            if (krel <= wid * 32 + 31)
                flash_tile<6, 2, 6, true, true>(kb + j * 64 * MLA_KP, MLA_KP, kb + MLA_KT + j * 128, MLA_VP, qf, o, negm, mref, lrun, ch == 0 && j == 0, r32, hi, true, qrel, krel, NoMid());
        }
    };
    stage_load(sa, 0); stage_write(sa, 0);
    stage_load(sa, 1);
    __syncthreads();
    for (int ch = 0; ch < NCH - 2; ch += 2) {
        stage_load(sb, ch + 2);
        compute(0, ch);
        stage_write(sa, 1);
        __syncthreads();
        stage_load(sa, ch + 3);
        compute(1, ch + 1);
        stage_write(sb, 0);
        __syncthreads();
    }
    {
        compute_band(0, NCH - 2);
        stage_write(sa, 1);
        __syncthreads();
        compute_band(1, NCH - 1);
        __syncthreads();
    }
    const float inv = 1.f / xhalf_sum(lrun);
    bf16_t* orow = MIX + (tb + q0 + r32) * D + h * 64;
#pragma unroll
    for (int t = 0; t < 2; ++t)
#pragma unroll
        for (int g = 0; g < 4; ++g) { u32x2 w; w.x = cvtpk(o[t][4 * g] * inv, o[t][4 * g + 1] * inv); w.y = cvtpk(o[t][4 * g + 2] * inv, o[t][4 * g + 3] * inv);
            *(u32x2*)(orow + 32 * t + 8 * g + 4 * hi) = w; }
}

constexpr int XA_KP = 528, XA_VP = 136;
constexpr int XA_KT = 64 * XA_KP, XA_VTB = 128 * XA_VP;
__device__ __forceinline__ void xattn_unit(LAS unsigned char* lds, int b, int h, int qb, int dvh, const bf16_t* QX, const bf16_t* KX, const bf16_t* VXT, bf16_t* OX) {
    const int tid = opaque_tid(), lane = tid & 63, r32 = lane & 31, hi = lane >> 5, wid = __builtin_amdgcn_readfirstlane(tid >> 6);
    const size_t tb = (size_t)b * SEQ;
    const int q0 = qb * 256 + wid * 32;
    bf16x8 qf[16];
    { const bf16_t* qr = QX + (tb + q0 + r32) * D + h * 256 + hi * 8;
#pragma unroll
      for (int s = 0; s < 16; ++s) qf[s] = *(const bf16x8*)(qr + s * 16); }
    f32x16 o[4], negm;
#pragma unroll
    for (int t = 0; t < 4; ++t)
#pragma unroll
        for (int r = 0; r < 16; ++r) o[t][r] = 0.f;
#pragma unroll
    for (int r = 0; r < 16; ++r) negm[r] = 0.f;
    float mref = 0.f, lrun = 0.f;
    const bf16_t* kbase = KX + (size_t)(b * 256) * D + h * 256;
    const bf16_t* vbase = VXT + (size_t)(h * 256 + dvh * 128) * D + b * 256;
    u32x4 kreg[4], vreg[2];
    auto stage_load = [&](int kt) {
#pragma unroll
        for (int i = 0; i < 4; ++i) { const int idx = tid + 512 * i, row = idx >> 5, c = idx & 31; kreg[i] = *(const u32x4*)(kbase + (size_t)(kt * 64 + row) * D + c * 8); }
#pragma unroll
        for (int i = 0; i < 2; ++i) { const int idx = tid + 512 * i, dv = idx >> 3, c = idx & 7; vreg[i] = *(const u32x4*)(vbase + (size_t)dv * D + kt * 64 + c * 8); }
    };
    auto stage_write = [&](int buf) {
        LAS unsigned char* kb = lds + buf * (XA_KT + XA_VTB); LAS unsigned char* vbp = kb + XA_KT;
#pragma unroll
        for (int i = 0; i < 4; ++i) { const int idx = tid + 512 * i, row = idx >> 5, c = idx & 31; *(LAS u32x4*)(kb + row * XA_KP + c * 16) = kreg[i]; }
#pragma unroll
        for (int i = 0; i < 2; ++i) { const int idx = tid + 512 * i, dv = idx >> 3, c = idx & 7;
            *(LAS u32x2*)(vbp + dv * XA_VP + c * 16) = (u32x2){vreg[i].x, vreg[i].y}; *(LAS u32x2*)(vbp + dv * XA_VP + c * 16 + 8) = (u32x2){vreg[i].z, vreg[i].w}; }
    };
    stage_load(0); stage_write(0);
    __syncthreads();
    for (int kt = 0; kt < 4; ++kt) {
        const int buf = kt & 1;
        const LAS unsigned char* kb = lds + buf * (XA_KT + XA_VTB);
        auto mid = [&]() { if (kt + 1 < 4) stage_load(kt + 1); };
        flash_tile<16, 4, 4, false, false>(kb, XA_KP, kb + XA_KT, XA_VP, qf, o, negm, mref, lrun, kt == 0, r32, hi, false, 0, 0, mid);
        if (kt + 1 < 4) stage_write(buf ^ 1);
        __syncthreads();
    }
    const float inv = 1.f / xhalf_sum(lrun);
    bf16_t* orow = OX + (tb + q0 + r32) * D + h * 256 + dvh * 128;
#pragma unroll
    for (int t = 0; t < 4; ++t)
#pragma unroll
        for (int g = 0; g < 4; ++g) { u32x2 w; w.x = cvtpk(o[t][4 * g] * inv, o[t][4 * g + 1] * inv); w.y = cvtpk(o[t][4 * g + 2] * inv, o[t][4 * g + 3] * inv);
            *(u32x2*)(orow + 32 * t + 8 * g + 4 * hi) = w; }
}

constexpr int RT_P = 272;
constexpr int RT_PV = 264;
__device__ __forceinline__ float ret_log2g(int h) { return log2f(1.0f - exp2f(-5.0f - (float)h)); }
__device__ __forceinline__ void ret_state_unit(LAS unsigned char* lds, int unit, const bf16_t* PROJ, const bf16_t* RVT, bf16_t* RKVT) {
    const int tid = opaque_tid(), lane = tid & 63, r32 = lane & 31, hi = lane >> 5, wid = __builtin_amdgcn_readfirstlane(tid >> 6);
    const int n = unit & 31, h = (unit >> 5) & 3, b = unit >> 7;
    const size_t t0 = (size_t)b * SEQ + n * 128;
    const float l2g = ret_log2g(h);
    LAS unsigned char* Vs = lds;
    LAS unsigned char* Ks = lds + 128 * RT_P;
#pragma unroll
    for (int i = 0; i < 4; ++i) { const int idx = tid + 512 * i, e = idx >> 4, c = idx & 15;
        *(LAS u32x4*)(Vs + e * RT_P + c * 16) = *(const u32x4*)(RVT + (size_t)(h * 128 + e) * TP + t0 + c * 8); }
#pragma unroll
    for (int i = 0; i < 4; ++i) { const int idx = tid + 512 * i, j = idx >> 4, c = idx & 15;
        const u32x4 v = *(const u32x4*)(PROJ + (t0 + j) * NPROJ + 1152 + h * 128 + c * 8);
        const float z = exp2f((float)(127 - j) * l2g);
        const unsigned w[4] = {v.x, v.y, v.z, v.w};
#pragma unroll
        for (int q = 0; q < 4; ++q) { const float lo = bf2f((unsigned short)(w[q] & 0xffffu)) * z, hh = bf2f((unsigned short)(w[q] >> 16)) * z; const unsigned pk = cvtpk(lo, hh);
            *(LAS unsigned short*)(Ks + (c * 8 + 2 * q) * RT_P + j * 2) = (unsigned short)(pk & 0xffffu); *(LAS unsigned short*)(Ks + (c * 8 + 2 * q + 1) * RT_P + j * 2) = (unsigned short)(pk >> 16); } }
    __syncthreads();
    const int eb = (wid & 3) * 32, db = (wid >> 2) * 64;
    f32x16 acc[2];
#pragma unroll
    for (int t = 0; t < 2; ++t)
#pragma unroll
        for (int r = 0; r < 16; ++r) acc[t][r] = 0.f;
#pragma unroll
    for (int ks = 0; ks < 8; ++ks) {
        const bf16x8 a = *(const LAS bf16x8*)(Vs + (eb + r32) * RT_P + ks * 32 + hi * 16);
#pragma unroll
        for (int t = 0; t < 2; ++t) { const bf16x8 bb = *(const LAS bf16x8*)(Ks + (db + 32 * t + r32) * RT_P + ks * 32 + hi * 16); acc[t] = MFMA32(a, bb, acc[t]); }
    }
    bf16_t* O = RKVT + (size_t)unit * 16384;
#pragma unroll
    for (int t = 0; t < 2; ++t)
#pragma unroll
        for (int r = 0; r < 16; ++r) { const unsigned pk = cvtpk(acc[t][r], 0.f); O[(size_t)(eb + crow(r, hi)) * 128 + db + 32 * t + r32] = (unsigned short)(pk & 0xffffu); }
    __syncthreads();
}
__device__ __forceinline__ void ret_out_unit(LAS unsigned char* lds, int unit, const bf16_t* PROJ, const bf16_t* RVT, const bf16_t* RKVT, const float* g_gn, bf16_t* MIX) {
    const int tid = opaque_tid(), lane = tid & 63, r32 = lane & 31, hi = lane >> 5, wid = __builtin_amdgcn_readfirstlane(tid >> 6);
    const int n = unit & 31, h = (unit >> 5) & 3, b = unit >> 7;
    const size_t t0 = (size_t)b * SEQ + n * 128;
    const float l2g = ret_log2g(h);
    LAS unsigned char* Ks = lds;
    LAS unsigned char* Vs = lds + 128 * RT_P;
    LAS unsigned char* Rs = Vs + 128 * RT_PV;
    LAS float* Xs = (LAS float*)(Rs + 128 * RT_P);
#pragma unroll
    for (int i = 0; i < 4; ++i) { const int idx = tid + 512 * i, j = idx >> 4, c = idx & 15;
        *(LAS u32x4*)(Ks + j * RT_P + c * 16) = *(const u32x4*)(PROJ + (t0 + j) * NPROJ + 1152 + h * 128 + c * 8); }
#pragma unroll
    for (int i = 0; i < 4; ++i) { const int idx = tid + 512 * i, e = idx >> 4, c = idx & 15;
        const u32x4 v = *(const u32x4*)(RVT + (size_t)(h * 128 + e) * TP + t0 + c * 8);
        *(LAS u32x2*)(Vs + e * RT_PV + c * 16) = (u32x2){v.x, v.y}; *(LAS u32x2*)(Vs + e * RT_PV + c * 16 + 8) = (u32x2){v.z, v.w}; }
    {
        const bf16_t* src = RKVT + (size_t)unit * 16384;
#pragma unroll
        for (int i = 0; i < 4; ++i) { const int idx = tid + 512 * i, e = idx >> 4, c = idx & 15; *(LAS u32x4*)(Rs + e * RT_P + c * 16) = *(const u32x4*)(src + idx * 8); }
    }
    const int ib = wid & 3, eh = wid >> 2;
    bf16x8 qf[8];
    { const bf16_t* qr = PROJ + (t0 + ib * 32 + r32) * NPROJ + 640 + h * 128 + hi * 8;
#pragma unroll
      for (int s = 0; s < 8; ++s) qf[s] = *(const bf16x8*)(qr + s * 16); }
    __syncthreads();
    f32x16 oi[2], oc[2];
#pragma unroll
    for (int t = 0; t < 2; ++t)
#pragma unroll
        for (int r = 0; r < 16; ++r) { oi[t][r] = 0.f; oc[t][r] = 0.f; }
#pragma unroll
    for (int s = 0; s < 8; ++s)
#pragma unroll
        for (int t = 0; t < 2; ++t) { const bf16x8 a = *(const LAS bf16x8*)(Rs + (eh * 64 + t * 32 + r32) * RT_P + s * 32 + hi * 16); oc[t] = MFMA32(a, qf[s], oc[t]); }
    for (int jt = 0; jt <= ib; ++jt) {
        f32x16 p;
#pragma unroll
        for (int r = 0; r < 16; ++r) p[r] = 0.f;
#pragma unroll
        for (int s = 0; s < 8; ++s) { const bf16x8 a = *(const LAS bf16x8*)(Ks + (jt * 32 + r32) * RT_P + s * 32 + hi * 16); p = MFMA32(a, qf[s], p); }
        const int dbase = (ib - jt) * 32 + r32;
#pragma unroll
        for (int r = 0; r < 16; ++r) { const int dd = dbase - crow(r, hi); p[r] = dd >= 0 ? p[r] * exp2f((float)dd * l2g) : 0.f; }
        bf16x8 pb[2];
#pragma unroll
        for (int ks = 0; ks < 2; ++ks) { u32x4 w; w.x = cvtpk(p[8 * ks + 0], p[8 * ks + 1]); w.y = cvtpk(p[8 * ks + 2], p[8 * ks + 3]); w.z = cvtpk(p[8 * ks + 4], p[8 * ks + 5]); w.w = cvtpk(p[8 * ks + 6], p[8 * ks + 7]); pb[ks] = __builtin_bit_cast(bf16x8, w); }
#pragma unroll
        for (int t = 0; t < 2; ++t)
#pragma unroll
            for (int ks = 0; ks < 2; ++ks) { const LAS unsigned char* vp = Vs + (eh * 64 + t * 32 + r32) * RT_PV + (jt * 32 + ks * 16) * 2 + hi * 8;
                const s16x4 lo = *(const LAS s16x4*)vp, hh = *(const LAS s16x4*)(vp + 16);
                const bf16x8 a = (bf16x8){lo[0], lo[1], lo[2], lo[3], hh[0], hh[1], hh[2], hh[3]}; oi[t] = MFMA32(a, pb[ks], oi[t]); }
    }
    const float xi = exp2f((float)(ib * 32 + r32 + 1) * l2g);
    float s1 = 0.f, s2 = 0.f;
#pragma unroll
    for (int t = 0; t < 2; ++t)
#pragma unroll
        for (int r = 0; r < 16; ++r) { const float v = oi[t][r] + oc[t][r] * xi; oi[t][r] = v; s1 += v; s2 += v * v; }
    s1 = xhalf_sum(s1); s2 = xhalf_sum(s2);
    if (hi == 0) { Xs[(wid * 32 + r32) * 2] = s1; Xs[(wid * 32 + r32) * 2 + 1] = s2; }
    __syncthreads();
    { const int ow = wid ^ 4; s1 += Xs[(ow * 32 + r32) * 2]; s2 += Xs[(ow * 32 + r32) * 2 + 1]; }
    const float mean = s1 * (1.f / 128.f), var = fmaxf(s2 * (1.f / 128.f) - mean * mean, 0.f), rstd = rsqrtf(var + EPS);
    const size_t trow = t0 + ib * 32 + r32;
    const bf16_t* grow = PROJ + trow * NPROJ + 1664 + h * 128;
    bf16_t* orow = MIX + trow * D + 512 + h * 128;
#pragma unroll
    for (int t = 0; t < 2; ++t)
#pragma unroll
        for (int g = 0; g < 4; ++g) { const int e = eh * 64 + t * 32 + 8 * g + 4 * hi;
            const u32x2 gg = *(const u32x2*)(grow + e); const f32x4 gn = *(const f32x4*)(g_gn + h * 128 + e);
            const float rg[4] = {bf2f((unsigned short)(gg.x & 0xffffu)), bf2f((unsigned short)(gg.x >> 16)), bf2f((unsigned short)(gg.y & 0xffffu)), bf2f((unsigned short)(gg.y >> 16))};
            float y[4];
#pragma unroll
            for (int q = 0; q < 4; ++q) { const float sil = rg[q] / (1.f + __expf(-rg[q])); y[q] = (oi[t][4 * g + q] - mean) * rstd * gn[q] * sil; }
            u32x2 w; w.x = cvtpk(y[0], y[1]); w.y = cvtpk(y[2], y[3]); *(u32x2*)(orow + e) = w; }
    __syncthreads();
}

constexpr int PK_P = 272;
constexpr int PEER_SK = 0, PEER_LST = 2 * 128 * PK_P;
constexpr int PEER_ENT = PEER_LST + NWAVES * 4096;
__device__ __forceinline__ unsigned f_ord(float f) { const unsigned u = __float_as_uint(f); return u ^ ((unsigned)((int)u >> 31) | 0x80000000u); }
__device__ __forceinline__ float f_unord(unsigned k) { return __uint_as_float((k & 0x80000000u) ? (k ^ 0x80000000u) : ~k); }
#define TK_INS(L, x) do { unsigned _x = (x); _Pragma("unroll") for (int _j = 0; _j < 16; ++_j) { const unsigned _h = max(_x, L[_j]); _x = min(_x, L[_j]); L[_j] = _h; } } while (0)
#define TK_CE(a, b) do { const unsigned _hi = max((a), (b)), _lo = min((a), (b)); (a) = _hi; (b) = _lo; } while (0)
__device__ __forceinline__ void tk_sort16(unsigned (&v)[16]) {
#pragma unroll
    for (int k = 2; k <= 16; k <<= 1)
#pragma unroll
        for (int j = k >> 1; j >= 1; j >>= 1)
#pragma unroll
            for (int i = 0; i < 16; ++i) { const int l = i ^ j; if (l > i) { if ((i & k) == 0) TK_CE(v[i], v[l]); else TK_CE(v[l], v[i]); } }
}
__device__ __forceinline__ void tk_merge16(unsigned (&a)[16], const unsigned (&b)[16]) {
#pragma unroll
    for (int i = 0; i < 16; ++i) a[i] = max(a[i], b[15 - i]);
#pragma unroll
    for (int st = 8; st >= 1; st >>= 1)
#pragma unroll
        for (int i = 0; i < 16; ++i) if ((i & st) == 0) TK_CE(a[i], a[i + st]);
}
__device__ __forceinline__ void tk_merge_partner(unsigned (&L)[16], int hi) {
    unsigned M[16];
#pragma unroll
    for (int i = 0; i < 16; ++i) { const unsigned o = xhalf_other(L[15 - i], hi); M[i] = max(L[i], o); }
#pragma unroll
    for (int st = 8; st >= 1; st >>= 1)
#pragma unroll
        for (int i = 0; i < 16; ++i) if ((i & st) == 0) { const unsigned a = max(M[i], M[i + st]), bq = min(M[i], M[i + st]); M[i] = a; M[i + st] = bq; }
#pragma unroll
    for (int i = 0; i < 16; ++i) L[i] = M[i];
}

template <bool RETR_ONLY>
__device__ __forceinline__ void peer_phase(LAS unsigned char* lds, const Params& p, int vcu, int G) {
    const int tid = opaque_tid(), lane = tid & 63, r32 = lane & 31, hi = lane >> 5, wid = __builtin_amdgcn_readfirstlane(tid >> 6);
    const bf16_t* SK = (const bf16_t*)(p.ws + WS_SK); const bf16_t* QP = (const bf16_t*)(p.ws + WS_QP);
    const unsigned char* U8 = p.ws + WS_U8; const float* ssq2 = (const float*)(p.ws + WS_SSQ2); unsigned* EG = (unsigned*)(p.ws + WS_EG); float* WG = (float*)(p.ws + WS_WG);
    for (int idx = tid; idx < 2 * 128 * 16; idx += 512) { const int row = idx >> 4, c = idx & 15; *(LAS u32x4*)(lds + PEER_SK + row * PK_P + c * 16) = *(const u32x4*)(SK + row * 128 + c * 8); }
    __syncthreads();
    LAS unsigned* LST = (LAS unsigned*)(lds + PEER_LST + wid * 4096);
    LAS u32x2* ENT = (LAS u32x2*)(lds + PEER_ENT + wid * 4096);
    for (int grp = vcu * NWAVES + wid; grp < T / 4; grp += G * NWAVES) {
        const int tok0 = grp * 4;
        int lg = lane; asm volatile("" : "+v"(lg));
        const int r32 = lg & 31, hi = lg >> 5;
        const unsigned hi4 = (unsigned)hi << 2;
        {
            const bf16_t* qrow = QP + (size_t)(tok0 + (r32 >> 3)) * 2048 + (r32 & 7) * 256 + hi * 8;
            unsigned LA[16], LB[16];
#pragma unroll
            for (int pp = 0; pp < 2; ++pp) {
                bf16x8 qf[8];
#pragma unroll
                for (int s = 0; s < 8; ++s) qf[s] = *(const bf16x8*)(qrow + pp * 128 + s * 16);
                unsigned L[16];
#pragma unroll
                for (int i = 0; i < 16; ++i) L[i] = 0u;
#pragma unroll
                for (int kt = 0; kt < 4; ++kt) {
                    f32x16 sc;
#pragma unroll
                    for (int r = 0; r < 16; ++r) sc[r] = 0.f;
#pragma unroll
                    for (int s = 0; s < 8; ++s) { const bf16x8 a = *(const LAS bf16x8*)(lds + PEER_SK + (pp * 128 + kt * 32 + r32) * PK_P + s * 32 + hi * 16); sc = MFMA32(a, qf[s], sc); }
                    { unsigned kv[16];
#pragma unroll
                      for (int r = 0; r < 16; ++r) { const unsigned code = 127u - (unsigned)(32 * kt + (r & 3) + 8 * (r >> 2)); kv[r] = ((f_ord(sc[r]) & ~0x7Fu) | code) ^ hi4; }
                      tk_sort16(kv);
                      if (kt == 0) {
#pragma unroll
                          for (int r = 0; r < 16; ++r) L[r] = kv[r];
                      } else tk_merge16(L, kv); }
                }
                tk_merge_partner(L, hi);
#pragma unroll
                for (int i = 0; i < 16; ++i) { if (pp == 0) LA[i] = L[i]; else LB[i] = L[i]; }
            }
#pragma unroll
            for (int i = 0; i < 16; ++i) { LST[i * 32 + r32] = LA[i]; LST[(16 + i) * 32 + r32] = LB[i]; }
            float va[16], vb[16];
#pragma unroll
            for (int i = 0; i < 16; ++i) { va[i] = f_unord(LA[i] & ~0x7Fu); vb[i] = f_unord(LB[i] & ~0x7Fu); }
            unsigned C[16];
#pragma unroll
            for (int j = 0; j < 16; ++j) C[j] = (f_ord(va[0] + vb[j]) & ~0xFFu) | (255u - (unsigned)j);
#pragma unroll
            for (int i = 1; i < 16; ++i)
#pragma unroll
                for (int j = 0; j < 16; ++j) if ((i + 1) * (j + 1) <= 16) { const unsigned code = 255u - (unsigned)(16 * i + j); TK_INS(C, (f_ord(va[i] + vb[j]) & ~0xFFu) | code); }
            LDS_WAIT();
            float bs[16]; unsigned ex[16]; float mx = -1e30f;
#pragma unroll
            for (int k = 0; k < 16; ++k) { const unsigned code = 255u - (C[k] & 0xFFu); const unsigned i = code >> 4, j = code & 15u;
                const unsigned ka = LST[i * 32 + r32], kbq = LST[(16 + j) * 32 + r32];
                bs[k] = f_unord(ka & ~0x7Fu) + f_unord(kbq & ~0x7Fu); ex[k] = (127u - (ka & 0x7Fu)) * 128u + (127u - (kbq & 0x7Fu)); mx = fmaxf(mx, bs[k]); }
            float sum = 0.f;
#pragma unroll
            for (int k = 0; k < 16; ++k) { bs[k] = __expf(bs[k] - mx); sum += bs[k]; }
            const float rinv = 1.f / sum;
            if (hi == 0) {
#pragma unroll
                for (int k = 0; k < 16; ++k) ENT[(r32 >> 3) * 128 + (r32 & 7) * 16 + k] = (u32x2){ex[k], __float_as_uint(bs[k] * rinv)};
            }
            LDS_WAIT();
        }
        if (RETR_ONLY) {
            for (int tk = 0; tk < 4; ++tk) { const int t = tok0 + tk;
                int ln = lane; asm volatile("" : "+v"(ln));
                const u32x2 a0 = ENT[tk * 128 + ln], a1 = ENT[tk * 128 + 64 + ln];
                const int j0 = 16 * (ln & 7) + (ln >> 3), j1 = j0 + 8;
                EG[(size_t)t * 128 + j0] = a0.x; WG[(size_t)t * 128 + j0] = __uint_as_float(a0.y);
                EG[(size_t)t * 128 + j1] = a1.x; WG[(size_t)t * 128 + j1] = __uint_as_float(a1.y); }
            continue;
        }
        for (int tk = 0; tk < 4; ++tk) {
            const int t = tok0 + tk;
            int ln = lane; asm volatile("" : "+v"(ln));
            const bf16_t* hrow = (const bf16_t*)(p.ws + WS_H2B) + (size_t)t * D + ln * 16;
            f32x2 hv[8];
#pragma unroll
            for (int i = 0; i < 2; ++i) { const u32x4 v = *(const u32x4*)(hrow + 8 * i); const unsigned w[4] = {v.x, v.y, v.z, v.w};
#pragma unroll
                for (int q = 0; q < 4; ++q) hv[4 * i + q] = (f32x2){bf2f((unsigned short)(w[q] & 0xffffu)), bf2f((unsigned short)(w[q] >> 16))}; }
            const float rstd2 = rsqrtf(ssq_sum<16>(ssq2 + (size_t)t * 16) * (1.f / D) + EPS);
            EG[(size_t)t * 128 + ln] = ENT[tk * 128 + ln].x; EG[(size_t)t * 128 + 64 + ln] = ENT[tk * 128 + 64 + ln].x;
            u32x4 ua[16], ub[16];
            { const unsigned ex = ENT[tk * 128 + (ln & 15)].x;
#pragma unroll
              for (int k = 0; k < 16; ++k) { const unsigned e = (unsigned)__builtin_amdgcn_readlane((int)ex, k); ua[k] = *(const u32x4*)(U8 + (size_t)e * D + ln * 16); } }
            auto head = [&](u32x4 (&cur)[16], u32x4 (&nxt)[16], int hd) {
                if (hd < 7) { const unsigned ex = ENT[tk * 128 + (hd + 1) * 16 + (ln & 15)].x;
#pragma unroll
                    for (int k = 0; k < 16; ++k) { const unsigned e = (unsigned)__builtin_amdgcn_readlane((int)ex, k); nxt[k] = *(const u32x4*)(U8 + (size_t)e * D + ln * 16); } }
                const float gate = __uint_as_float(ENT[tk * 128 + hd * 16 + ((ln >> 2) & 15)].y);
                float dt[16];
#pragma unroll
                for (int k = 0; k < 16; ++k) { f32x2 a0 = (f32x2){0.f, 0.f}, a1 = (f32x2){0.f, 0.f}; const unsigned w[4] = {cur[k].x, cur[k].y, cur[k].z, cur[k].w};
#pragma unroll
                    for (int q = 0; q < 4; ++q) { const f32x2 lo = __builtin_amdgcn_cvt_pk_f32_fp8((int)w[q], false), h2 = __builtin_amdgcn_cvt_pk_f32_fp8((int)w[q], true);
                        a0 += lo * hv[2 * q]; a1 += h2 * hv[2 * q + 1]; }
                    const f32x2 a = a0 + a1; dt[k] = a[0] + a[1]; if (k & 1) __builtin_amdgcn_sched_barrier(0); }
                float y8[8], y4[4], y2[2], y1;
                { const bool bsel = (ln & 32) != 0;
#pragma unroll
                  for (int k = 0; k < 8; ++k) { const float snd = bsel ? dt[k] : dt[k + 8], kp = bsel ? dt[k + 8] : dt[k]; y8[k] = kp + __shfl_xor(snd, 32); } }
                { const bool bsel = (ln & 16) != 0;
#pragma unroll
                  for (int k = 0; k < 4; ++k) { const float snd = bsel ? y8[k] : y8[k + 4], kp = bsel ? y8[k + 4] : y8[k]; y4[k] = kp + __shfl_xor(snd, 16); } }
                { const bool bsel = (ln & 8) != 0;
#pragma unroll
                  for (int k = 0; k < 2; ++k) { const float snd = bsel ? y4[k] : y4[k + 2], kp = bsel ? y4[k + 2] : y4[k]; y2[k] = kp + __shfl_xor(snd, 8); } }
                { const bool bsel = (ln & 4) != 0; const float snd = bsel ? y2[0] : y2[1], kp = bsel ? y2[1] : y2[0]; y1 = kp + __shfl_xor(snd, 4); }
                y1 += __shfl_xor(y1, 2); y1 += __shfl_xor(y1, 1);
                const float act = y1 * rstd2 * (1.f / U_SCALE);
                const float wgt = gate * gelu_f(act) * (1.f / V_SCALE);
                if ((ln & 3) == 0) WG[(size_t)t * 128 + hd * 16 + ((ln >> 2) & 15)] = wgt;
            };
            for (int hd = 0; hd < 8; hd += 2) { head(ua, ub, hd); head(ub, ua, hd + 1); }
        }
    }
}

__device__ __forceinline__ void peer_v_phase(const Params& p, int vcu, int G) {
    const int tid = opaque_tid(), lane = tid & 63, wid = __builtin_amdgcn_readfirstlane(tid >> 6);
    const unsigned char* V8 = p.ws + WS_V8; const unsigned* EG = (const unsigned*)(p.ws + WS_EG); const float* WG = (const float*)(p.ws + WS_WG);
    for (int grp = vcu * NWAVES + wid; grp < T / 4; grp += G * NWAVES) {
        for (int tk = 0; tk < 4; ++tk) {
            const int t = grp * 4 + tk;
            int ln = lane; asm volatile("" : "+v"(ln));
            const unsigned e0 = EG[(size_t)t * 128 + ln], e1 = EG[(size_t)t * 128 + 64 + ln];
            const float w0 = WG[(size_t)t * 128 + ln], w1 = WG[(size_t)t * 128 + 64 + ln];
            f32x2 ov[8];
#pragma unroll
            for (int i = 0; i < 8; ++i) ov[i] = (f32x2){0.f, 0.f};
            u32x4 va[16], vb[16];
#pragma unroll
            for (int k = 0; k < 16; ++k) { const unsigned e = (unsigned)__builtin_amdgcn_readlane((int)e0, k); va[k] = *(const u32x4*)(V8 + (size_t)e * D + ln * 16); }
            auto head = [&](u32x4 (&cur)[16], u32x4 (&nxt)[16], int hd) {
                if (hd < 7) { const int h1 = hd + 1; const unsigned er = (h1 & 4) ? e1 : e0; const int lb = (h1 & 3) * 16;
#pragma unroll
                    for (int k = 0; k < 16; ++k) { const unsigned e = (unsigned)__builtin_amdgcn_readlane((int)er, lb + k); nxt[k] = *(const u32x4*)(V8 + (size_t)e * D + ln * 16); } }
                const float wr = (hd & 4) ? w1 : w0; const int lb0 = (hd & 3) * 16;
#pragma unroll
                for (int k = 0; k < 16; ++k) { const float wk = __uint_as_float((unsigned)__builtin_amdgcn_readlane((int)__float_as_uint(wr), lb0 + k)); const f32x2 wk2 = (f32x2){wk, wk};
                    const unsigned w[4] = {cur[k].x, cur[k].y, cur[k].z, cur[k].w};
#pragma unroll
                    for (int q = 0; q < 4; ++q) { const f32x2 lo = __builtin_amdgcn_cvt_pk_f32_fp8((int)w[q], false), h2 = __builtin_amdgcn_cvt_pk_f32_fp8((int)w[q], true);
                        ov[2 * q] += wk2 * lo; ov[2 * q + 1] += wk2 * h2; }
                    if (k & 1) __builtin_amdgcn_sched_barrier(0); }
            };
            for (int hd = 0; hd < 8; hd += 2) { head(va, vb, hd); head(vb, va, hd + 1); }
            float* hrow = p.out + (size_t)t * D + ln * 16;
            const bf16_t* hb = (const bf16_t*)(p.ws + WS_H2B) + (size_t)t * D + ln * 16;
            float ss = 0.f; f32x4 h3[4];
#pragma unroll
            for (int q2 = 0; q2 < 2; ++q2) { const u32x4 v = *(const u32x4*)(hb + 8 * q2);
                h3[2 * q2] = (f32x4){bf2f((unsigned short)(v.x & 0xffffu)), bf2f((unsigned short)(v.x >> 16)), bf2f((unsigned short)(v.y & 0xffffu)), bf2f((unsigned short)(v.y >> 16))};
                h3[2 * q2 + 1] = (f32x4){bf2f((unsigned short)(v.z & 0xffffu)), bf2f((unsigned short)(v.z >> 16)), bf2f((unsigned short)(v.w & 0xffffu)), bf2f((unsigned short)(v.w >> 16))}; }
#pragma unroll
            for (int q = 0; q < 4; ++q) { h3[q] = h3[q] + (f32x4){ov[2 * q][0], ov[2 * q][1], ov[2 * q + 1][0], ov[2 * q + 1][1]};
                ss += (h3[q][0] * h3[q][0] + h3[q][1] * h3[q][1]) + (h3[q][2] * h3[q][2] + h3[q][3] * h3[q][3]); }
            const float rstd3 = rsqrtf(wave_sum(ss) * (1.f / D) + EPS);
#pragma unroll
            for (int q = 0; q < 4; ++q) { const f32x4 gf = *(const f32x4*)(p.g_final + ln * 16 + 4 * q); *(f32x4*)(hrow + 4 * q) = h3[q] * rstd3 * gf; }
        }
    }
}

template <bool VSIDE>
__device__ __forceinline__ void peer_slice_tokens(const Params& p, int x, int w0, int nwv, int lane) {
    const unsigned char* TB = p.ws + (VSIDE ? WS_V8 : WS_U8) + (size_t)x * (16384 * 128);
    const unsigned* EG = (const unsigned*)(p.ws + WS_EG); const float* WG = (const float*)(p.ws + WS_WG);
    const bf16_t* H2 = (const bf16_t*)(p.ws + WS_H2B) + 128 * x;
    float* PART = (float*)(p.ws + WS_PART) + (size_t)x * T * 128; float* SSQ3 = (float*)(p.ws + WS_SSQ3);
    int ln = lane; asm volatile("" : "+v"(ln));
    const int r = ln >> 3, c = ln & 7;
    if (w0 >= T) return;
    u32x4 idn[4];
    f32x4 wn[4], wc[4];
    u32x4 hn[2], hc[2];
    u32x4 ra[16], rb[16];
    auto load_meta = [&](int t) {
#pragma unroll
        for (int q = 0; q < 4; ++q) idn[q] = *(const u32x4*)(EG + (size_t)t * 128 + 16 * r + 4 * q);
        if (VSIDE) {
#pragma unroll
            for (int q = 0; q < 4; ++q) wn[q] = *(const f32x4*)(WG + (size_t)t * 128 + 16 * r + 4 * q);
        } else { hn[0] = *(const u32x4*)(H2 + (size_t)t * D + 16 * c); hn[1] = *(const u32x4*)(H2 + (size_t)t * D + 16 * c + 8); }
    };
    auto issue = [&](u32x4 (&buf)[16]) {
#pragma unroll
        for (int q = 0; q < 4; ++q) { const unsigned e4[4] = {idn[q].x, idn[q].y, idn[q].z, idn[q].w};
#pragma unroll
            for (int j = 0; j < 4; ++j) buf[4 * q + j] = *(const u32x4*)(TB + (e4[j] * 128u + 16u * (unsigned)c)); }
    };
    auto compute = [&](u32x4 (&cur)[16], int t) {
        if (!VSIDE) {
            f32x2 hv[8];
#pragma unroll
            for (int i2 = 0; i2 < 2; ++i2) { const unsigned w[4] = {hc[i2].x, hc[i2].y, hc[i2].z, hc[i2].w};
#pragma unroll
                for (int q = 0; q < 4; ++q) hv[4 * i2 + q] = (f32x2){bf2f((unsigned short)(w[q] & 0xffffu)), bf2f((unsigned short)(w[q] >> 16))}; }
            float dt[16];
#pragma unroll
            for (int i = 0; i < 16; ++i) { f32x2 a0 = (f32x2){0.f, 0.f}, a1 = (f32x2){0.f, 0.f}; const unsigned w[4] = {cur[i].x, cur[i].y, cur[i].z, cur[i].w};
#pragma unroll
                for (int q = 0; q < 4; ++q) { const f32x2 lo = __builtin_amdgcn_cvt_pk_f32_fp8((int)w[q], false), h2 = __builtin_amdgcn_cvt_pk_f32_fp8((int)w[q], true);
                    a0 += lo * hv[2 * q]; a1 += h2 * hv[2 * q + 1]; }
                const f32x2 a = a0 + a1; dt[i] = a[0] + a[1]; if (i & 1) __builtin_amdgcn_sched_barrier(0); }
            float y8[8], y4[4], y2[2];
            { const bool bs = (ln & 4) != 0;
#pragma unroll
              for (int k = 0; k < 8; ++k) { const float snd = bs ? dt[k] : dt[k + 8], kp = bs ? dt[k + 8] : dt[k]; y8[k] = kp + shx<4>(snd, ln); } }
            { const bool bs = (ln & 2) != 0;
#pragma unroll
              for (int k = 0; k < 4; ++k) { const float snd = bs ? y8[k] : y8[k + 4], kp = bs ? y8[k + 4] : y8[k]; y4[k] = kp + shx<2>(snd, ln); } }
            { const bool bs = (ln & 1) != 0;
#pragma unroll
              for (int k = 0; k < 2; ++k) { const float snd = bs ? y4[k] : y4[k + 2], kp = bs ? y4[k + 2] : y4[k]; y2[k] = kp + shx<1>(snd, ln); } }
            *(f32x2*)(PART + (size_t)t * 128 + 2 * ln) = (f32x2){y2[0], y2[1]};
        } else {
            f32x2 ov[8];
#pragma unroll
            for (int q = 0; q < 8; ++q) ov[q] = (f32x2){0.f, 0.f};
#pragma unroll
            for (int i = 0; i < 16; ++i) { const float wk = wc[i >> 2][i & 3]; const f32x2 wk2 = (f32x2){wk, wk}; const unsigned w[4] = {cur[i].x, cur[i].y, cur[i].z, cur[i].w};
#pragma unroll
                for (int q = 0; q < 4; ++q) { const f32x2 lo = __builtin_amdgcn_cvt_pk_f32_fp8((int)w[q], false), h2 = __builtin_amdgcn_cvt_pk_f32_fp8((int)w[q], true);
                    ov[2 * q] += wk2 * lo; ov[2 * q + 1] += wk2 * h2; }
                if (i & 1) __builtin_amdgcn_sched_barrier(0); }
            f32x2 z4[4], z2[2], z1;
            { const bool bs = (ln & 32) != 0;
#pragma unroll
              for (int k = 0; k < 4; ++k) { const f32x2 snd = bs ? ov[k] : ov[k + 4], kp = bs ? ov[k + 4] : ov[k]; z4[k] = kp + (f32x2){shx<32>(snd[0], ln), shx<32>(snd[1], ln)}; } }
            { const bool bs = (ln & 16) != 0;
#pragma unroll
              for (int k = 0; k < 2; ++k) { const f32x2 snd = bs ? z4[k] : z4[k + 2], kp = bs ? z4[k + 2] : z4[k]; z2[k] = kp + (f32x2){shx<16>(snd[0], ln), shx<16>(snd[1], ln)}; } }
            { const bool bs = (ln & 8) != 0; const f32x2 snd = bs ? z2[0] : z2[1], kp = bs ? z2[1] : z2[0]; z1 = kp + (f32x2){shx<8>(snd[0], ln), shx<8>(snd[1], ln)}; }
            const int dd = 16 * c + ((ln >> 5) & 1) * 8 + ((ln >> 4) & 1) * 4 + ((ln >> 3) & 1) * 2;
            const unsigned hb = *(const unsigned*)(H2 + (size_t)t * D + dd);
            const f32x2 h3 = (f32x2){bf2f((unsigned short)(hb & 0xffffu)) + z1[0], bf2f((unsigned short)(hb >> 16)) + z1[1]};
            *(f32x2*)(p.out + (size_t)t * D + 128 * x + dd) = h3;
            const float ss = wave_sum_fast(h3[0] * h3[0] + h3[1] * h3[1], ln);
            if (ln == 0) SSQ3[(size_t)t * 8 + x] = ss;
        }
    };
    load_meta(w0);
    issue(ra);
    if (VSIDE) {
#pragma unroll
        for (int q = 0; q < 4; ++q) wc[q] = wn[q];
    } else { hc[0] = hn[0]; hc[1] = hn[1]; }
    if (w0 + nwv < T) load_meta(w0 + nwv);
    for (int t = w0; t < T; t += 2 * nwv) {
        const bool m1 = t + nwv < T, m2 = t + 2 * nwv < T, m3 = t + 3 * nwv < T;
        f32x4 w1[4]; u32x4 h1[2];
        if (m1) { issue(rb);
            if (VSIDE) {
#pragma unroll
                for (int q = 0; q < 4; ++q) w1[q] = wn[q];
            } else { h1[0] = hn[0]; h1[1] = hn[1]; }
            if (m2) load_meta(t + 2 * nwv); }
        compute(ra, t);
        if (!m1) break;
        if (VSIDE) {
#pragma unroll
            for (int q = 0; q < 4; ++q) wc[q] = w1[q];
        } else { hc[0] = h1[0]; hc[1] = h1[1]; }
        if (m2) { issue(ra); }
        f32x4 w2[4]; u32x4 h2x[2];
        if (m2) {
            if (VSIDE) {
#pragma unroll
                for (int q = 0; q < 4; ++q) w2[q] = wn[q];
            } else { h2x[0] = hn[0]; h2x[1] = hn[1]; }
            if (m3) load_meta(t + 3 * nwv); }
        compute(rb, t + nwv);
        if (!m2) break;
        if (VSIDE) {
#pragma unroll
            for (int q = 0; q < 4; ++q) wc[q] = w2[q];
        } else { hc[0] = h2x[0]; hc[1] = h2x[1]; }
    }
}
template <bool VSIDE>
__device__ __forceinline__ void peer_slice_phase(const Params& p, unsigned xcc, int rank, int G, int bx, int wave, int lane) {
    unsigned* ctl = (unsigned*)(p.ws + WS_CTL);
    for (int x = 0; x < 8; ++x) {
        const int cx = (int)__builtin_amdgcn_readfirstlane((int)__hip_atomic_load(ctl + CW_BAR + XB_XCNT(x), __ATOMIC_RELAXED, __HIP_MEMORY_SCOPE_AGENT));
        if (cx != 0 && (int)xcc != x) continue;
        const int nwv = (cx == 0 ? G : cx) * NWAVES, w0 = (cx == 0 ? bx : rank) * NWAVES + wave;
        peer_slice_tokens<VSIDE>(p, x, w0, nwv, lane);
    }
}
__device__ __forceinline__ void peer_combine_phase(const Params& p, int gw, int NGW, int lane) {
    const float* PART = (const float*)(p.ws + WS_PART); float* WG = (float*)(p.ws + WS_WG); const float* ssq2 = (const float*)(p.ws + WS_SSQ2);
    for (int t = gw; t < T; t += NGW) {
        f32x2 s = (f32x2){0.f, 0.f};
#pragma unroll
        for (int x = 0; x < 8; ++x) s += *(const f32x2*)(PART + ((size_t)x * T + t) * 128 + 2 * lane);
        const float rs = rsqrtf(ssq_sum<16>(ssq2 + (size_t)t * 16) * (1.f / D) + EPS) * (1.f / U_SCALE);
        f32x2* wp = (f32x2*)(WG + (size_t)t * 128 + 2 * lane);
        const f32x2 g = *wp;
        *wp = (f32x2){g[0] * gelu_f(s[0] * rs) * (1.f / V_SCALE), g[1] * gelu_f(s[1] * rs) * (1.f / V_SCALE)};
    }
}
__device__ __forceinline__ void peer_final_phase(const Params& p, int gw, int NGW, int lane) {
    const float* SSQ3 = (const float*)(p.ws + WS_SSQ3);
    for (int t = gw; t < T; t += NGW) {
        float* row = p.out + (size_t)t * D + lane * 16;
        f32x4 v[4];
#pragma unroll
        for (int q = 0; q < 4; ++q) v[q] = *(const f32x4*)(row + 4 * q);
        const float rstd3 = rsqrtf(ssq_sum<8>(SSQ3 + (size_t)t * 8) * (1.f / D) + EPS);
#pragma unroll
        for (int q = 0; q < 4; ++q) { const f32x4 gf = *(const f32x4*)(p.g_final + lane * 16 + 4 * q); *(f32x4*)(row + 4 * q) = v[q] * rstd3 * gf; }
    }
}

#ifndef PH_MASK
#define PH_MASK 0xFFFF
#endif
#define PH(k) ((PH_MASK >> (k)) & 1)
#ifdef TPROBE
#define TMARK(k) do { const unsigned long long tn_ = __builtin_amdgcn_s_memrealtime(); if (TPROBE == (k)) { const unsigned long long d_ = tn_ - tprev_; while (__builtin_amdgcn_s_memrealtime() - tn_ < d_) __builtin_amdgcn_s_sleep(8); } tprev_ = __builtin_amdgcn_s_memrealtime(); } while (0)
#else
#define TMARK(k)
#endif
#ifndef PEER_DSLICE
#define PEER_DSLICE 1
#endif
#ifndef GEMM_ALIGN
#define GEMM_ALIGN true
#endif
#ifndef REP_MASK
#define REP_MASK 0
#endif
#if (REP_MASK >> 0) & 1
#define REP_0 for (int rep_ = 0; rep_ < 2; ++rep_)
#else
#define REP_0
#endif
#if (REP_MASK >> 1) & 1
#define REP_1 for (int rep_ = 0; rep_ < 2; ++rep_)
#else
#define REP_1
#endif
#if (REP_MASK >> 2) & 1
#define REP_2 for (int rep_ = 0; rep_ < 2; ++rep_)
#else
#define REP_2
#endif
#if (REP_MASK >> 3) & 1
#define REP_3 for (int rep_ = 0; rep_ < 2; ++rep_)
#else
#define REP_3
#endif
#if (REP_MASK >> 4) & 1
#define REP_4 for (int rep_ = 0; rep_ < 2; ++rep_)
#else
#define REP_4
#endif
#if (REP_MASK >> 5) & 1
#define REP_5 for (int rep_ = 0; rep_ < 2; ++rep_)
#else
#define REP_5
#endif
#if (REP_MASK >> 6) & 1
#define REP_6 for (int rep_ = 0; rep_ < 2; ++rep_)
#else
#define REP_6
#endif
#if (REP_MASK >> 7) & 1
#define REP_7 for (int rep_ = 0; rep_ < 2; ++rep_)
#else
#define REP_7
#endif
#if (REP_MASK >> 8) & 1
#define REP_8 for (int rep_ = 0; rep_ < 2; ++rep_)
#else
#define REP_8
#endif
#if (REP_MASK >> 9) & 1
#define REP_9 for (int rep_ = 0; rep_ < 2; ++rep_)
#else
#define REP_9
#endif
#define REP(k) REP_##k
__global__ void __launch_bounds__(NWAVES * 64, 2) fwd_megakernel(Params p) {
    extern __shared__ __attribute__((aligned(16))) unsigned char lds_raw[];
    LAS unsigned char* lds = (LAS unsigned char*)lds_raw;
    const int tid = threadIdx.x, lane = tid & 63, wave = __builtin_amdgcn_readfirstlane(tid >> 6);
    const int G = gridDim.x; const int bx = blockIdx.x;
    const int vcu = (G % 8 == 0) ? (bx % 8) * (G / 8) + bx / 8 : bx;
    if (p.never) { cg::this_grid().sync(); }
    unsigned char* const ws = p.ws;
    volatile LAS unsigned* MISC = (volatile LAS unsigned*)(lds + LDSCTL_OFF);
    for (int u = tid; u < (LDS_BYTES - LDSCTL_OFF) / 4; u += NWAVES * 64) ((LAS unsigned*)(lds + LDSCTL_OFF))[u] = 0u;
    __syncthreads();
    XcdBarrier bar = xcd_barrier_post((unsigned*)(ws + WS_CTL) + CW_BAR, MISC + 8);
    if (tid == 0) MISC[20] = __hip_atomic_fetch_add((unsigned*)(ws + WS_CTL) + CW_XRANK + 64 * bar.x, 1u, __ATOMIC_RELAXED, __HIP_MEMORY_SCOPE_AGENT);
    const int gw = vcu * NWAVES + wave, NGW = G * NWAVES;
#ifdef TPROBE
    unsigned long long tprev_ = __builtin_amdgcn_s_memrealtime();
#endif

#define WSB(off) ((bf16_t*)(p.ws + (off)))
#define WSF(off) ((float*)(p.ws + (off)))
    REP(0) {
    if (PH(0))
    {
        LAS float* scr = (LAS float*)(lds + wave * 16384);
        constexpr int I_IN = 16 * 85, I_XKV = 16 * 64;
        constexpr int NITEMS = I_IN + I_XKV;
        for (int it = gw; it < NITEMS; it += NGW) {
            int r = it;
            if (r < I_IN) { p0_transpose_item<1>(p.w_in, 1024, 2720, WSB(WS_WIN), nullptr, scr, r, lane); continue; } r -= I_IN;
            p0_transpose_item<0>(p.w_xkv, 1024, 2048, WSB(WS_WXKV), nullptr, scr, r, lane);
        }
        for (int m = gw; m < T / 4; m += NGW) rms_rows_to_bf16<4>(p.x + (size_t)m * D, p.g_mix, WSB(WS_A0) + (size_t)m * D, (size_t)(T / 4) * D, lane);
        for (int m = gw; m < 1024; m += NGW) rms_rows_to_bf16<1>(p.mem + (size_t)m * D, p.g_mem, WSB(WS_MEMN) + (size_t)m * D, 0, lane);
        const int gt = vcu * 512 + tid, NGT = G * 512;
        for (int i = gt; i < 2 * 128 * 128 / 2; i += NGT) { const f32x2 v = *(const f32x2*)(p.sub_keys + 2 * i); ((unsigned*)WSB(WS_SK))[i] = cvtpk(v[0], v[1]); }
        for (int i = gt; i < 96 * 1024 / 8; i += NGT) ((u32x4*)(WSB(WS_WIN) + (size_t)2208 * 1024))[i] = (u32x4){0u, 0u, 0u, 0u};
        for (int i = gt; i < SEQ * 64; i += NGT) { const int s = i >> 6, f = i & 63; const float inv = exp2f(-(float)f * (13.287712379549449f / 64.f)); const float ang = (float)s * inv;
            const double rev = (double)ang * 0.15915494309189535; const float fr = (float)(rev - floor(rev)); WSF(WS_CR)[i] = __builtin_amdgcn_cosf(fr); WSF(WS_SR)[i] = __builtin_amdgcn_sinf(fr); }
        for (int i = gt; i < SEQ * 16; i += NGT) { const int s = i >> 4, f = i & 15; const float inv = exp2f(-(float)f * (13.287712379549449f / 16.f)); const float ang = (float)s * inv;
            const double rev = (double)ang * 0.15915494309189535; const float fr = (float)(rev - floor(rev)); WSF(WS_CM)[i] = __builtin_amdgcn_cosf(fr); WSF(WS_SM)[i] = __builtin_amdgcn_sinf(fr); }
    }
    xcd_barrier(bar);
    TMARK(0);
#ifdef DBL_BAR
    xcd_barrier(bar);
#endif
    }

    REP(1) {
    if (PH(1))
    {
        { pg8::Gemm g{WSB(WS_A0), WSB(WS_WIN), T, NPROJ, 1024, 1024, 1024}; pg8::StaticOrder S; S.init(T, NPROJ, G, bx);
          pg8::EpiProj E{WSB(WS_PROJ), WSF(WS_SSQQ), WSF(WS_SSQKV), WSF(WS_CR), WSF(WS_SR), WSF(WS_CM), WSF(WS_SM)}; pg8::gemm_phase<pg8::EpiProj, pg8::StaticOrder, GEMM_ALIGN>(lds, g, S, E); }
#ifdef DUP_P1MAIN
        { pg8::Gemm g{WSB(WS_A0), WSB(WS_WIN), T, NPROJ, 1024, 1024, 1024}; pg8::StaticOrder S; S.init(T, NPROJ, G, bx);
          pg8::EpiProj E{WSB(WS_PROJ), WSF(WS_SSQQ), WSF(WS_SSQKV), WSF(WS_CR), WSF(WS_SR), WSF(WS_CM), WSF(WS_SM)}; pg8::gemm_phase<pg8::EpiProj, pg8::StaticOrder, GEMM_ALIGN>(lds, g, S, E); }
#endif
        { pg8::Gemm g{WSB(WS_WIN) + (size_t)2304 * 1024, WSB(WS_A0), 512, T, 1024, 1024, 1024}; pg8::StaticOrder S; S.init(512, T, G, (bx - 64 + G) % G);
          pg8::EpiPlain E{WSB(WS_RVT), TP}; pg8::gemm_phase<pg8::EpiPlain, pg8::StaticOrder, GEMM_ALIGN>(lds, g, S, E); }
        { pg8::Gemm g{WSB(WS_MEMN), WSB(WS_WXKV), 1024, 1024, 1024, 1024, 1024}; pg8::StaticOrder S; S.init(1024, 1024, G, (bx - 192 + G) % G);
          pg8::EpiPlain E{WSB(WS_KX), 1024}; pg8::gemm_phase<pg8::EpiPlain, pg8::StaticOrder, GEMM_ALIGN>(lds, g, S, E); }
        { pg8::Gemm g{WSB(WS_WXKV) + (size_t)1024 * 1024, WSB(WS_MEMN), 1024, 1024, 1024, 1024, 1024}; pg8::StaticOrder S; S.init(1024, 1024, G, (bx - 208 + G) % G);
          pg8::EpiPlain E{WSB(WS_VXT), 1024}; pg8::gemm_phase<pg8::EpiPlain, pg8::StaticOrder, GEMM_ALIGN>(lds, g, S, E); }
        {
            const int nd = G >= 64 ? 32 : G, d0 = G - nd;
            if (bx >= d0) {
                LAS float* scr = (LAS float*)(lds + wave * 16384);
                constexpr int I_UQ = 6 * 24, I_UKV = 4 * 32, I_SQ = 16 * 32, I_PQ = 16 * 64;
                constexpr int NITEMS = I_UQ + I_UKV + 3 * I_SQ + I_PQ;
                for (int it = (bx - d0) * NWAVES + wave; it < NITEMS; it += nd * NWAVES) {
                    int r = it;
                    if (r < I_UQ) { p0_transpose_item<2>(p.w_uq, 384, 768, WSB(WS_WUQ), p.g_q_lora, scr, r, lane); continue; } r -= I_UQ;
                    if (r < I_UKV) { p0_transpose_item<3>(p.w_ukv, 256, 1024, WSB(WS_WUKV), p.g_kv_lora, scr, r, lane); continue; } r -= I_UKV;
                    if (r < I_SQ) { p0_transpose_item<0>(p.w_o, 1024, 1024, WSB(WS_WO), nullptr, scr, r, lane); continue; } r -= I_SQ;
                    if (r < I_SQ) { p0_transpose_item<0>(p.w_xq, 1024, 1024, WSB(WS_WXQ), p.g_xattn, scr, r, lane); continue; } r -= I_SQ;
                    if (r < I_SQ) { p0_transpose_item<0>(p.w_xo, 1024, 1024, WSB(WS_WXO), nullptr, scr, r, lane); continue; } r -= I_SQ;
                    p0_transpose_item<0>(p.w_pq, 1024, 2048, WSB(WS_WPQ), p.g_ffn, scr, r, lane);
                }
            }
        }
    }
    xcd_barrier(bar);
    TMARK(1);
#ifdef DBL_BAR
    xcd_barrier(bar);
#endif
    }

    REP(2) {
    if (PH(2))
    {
        { pg8::Gemm g{WSB(WS_PROJ), WSB(WS_WUQ), T, 768, 384, NPROJ, 384}; pg8::StaticOrder S; S.init(T, 768, G, bx);
          pg8::EpiQ E{WSB(WS_QM), WSF(WS_SSQQ), WSF(WS_CM), WSF(WS_SM)}; pg8::gemm_phase<pg8::EpiQ, pg8::StaticOrder, GEMM_ALIGN>(lds, g, S, E); }
        { pg8::Gemm g{WSB(WS_PROJ) + 384, WSB(WS_WUKV), T, 512, 256, NPROJ, 256}; pg8::StaticOrder S; S.init(T, 512, G, (bx - 192 + G) % G);
          pg8::EpiRowScale<8> E{WSB(WS_KN), 512, WSF(WS_SSQKV), 1.f / 256.f, 1.f}; pg8::gemm_phase<pg8::EpiRowScale<8>, pg8::StaticOrder, GEMM_ALIGN>(lds, g, S, E); }
        { pg8::Gemm g{WSB(WS_WUKV) + (size_t)512 * 256, WSB(WS_PROJ) + 384, 512, T, 256, 256, NPROJ}; pg8::StaticOrder S; S.init(512, T, G, (bx - 64 + G) % G);
          pg8::EpiColScale E{WSB(WS_VT), TP, WSF(WS_SSQKV), 1.f / 256.f}; pg8::gemm_phase<pg8::EpiColScale, pg8::StaticOrder, GEMM_ALIGN>(lds, g, S, E); }
        for (int u = vcu; u < 512; u += G) ret_state_unit(lds, u, WSB(WS_PROJ), WSB(WS_RVT), WSB(WS_RKVT));
    }
    xcd_barrier(bar);
    TMARK(2);
#ifdef DBL_BAR
    xcd_barrier(bar);
#endif
    }

    REP(3) {
    if (PH(3))
    {
        unsigned* scan_cnt = (unsigned*)(p.ws + WS_CTL) + CW_QUEUE + 64 * Q3_SLOT;
#if (REP_MASK >> 3) & 1
        if (rep_ == 0)
#endif
        {
            bf16_t* RK = WSB(WS_RKVT);
            for (int e2 = vcu * 512 + tid; e2 < 16 * 8192; e2 += G * 512) {
                const int bh = e2 >> 13, off = e2 & 8191; const float cd = exp2f(128.f * ret_log2g(bh & 3));
                unsigned* base = (unsigned*)(RK + (size_t)bh * 32 * 16384) + off;
                unsigned x[32];
#pragma unroll
                for (int n = 0; n < 32; ++n) x[n] = base[(size_t)n * 8192];
                float r0 = 0.f, r1 = 0.f;
#pragma unroll
                for (int n = 0; n < 32; ++n) { const unsigned o = cvtpk(r0, r1); r0 = r0 * cd + bf2f((unsigned short)(x[n] & 0xffffu)); r1 = r1 * cd + bf2f((unsigned short)(x[n] >> 16)); base[(size_t)n * 8192] = o; }
            }
            asm volatile("s_waitcnt vmcnt(0)" ::: "memory");
            __syncthreads();
            if (tid == 0) { __builtin_amdgcn_fence(__ATOMIC_RELEASE, "agent"); asm volatile("s_waitcnt vmcnt(0)" ::: "memory"); __hip_atomic_fetch_add(scan_cnt, 1u, __ATOMIC_RELAXED, __HIP_MEMORY_SCOPE_AGENT); }
        }
#ifdef REP_MLA
        for (int rr_ = 0; rr_ < REP_MLA; ++rr_)
#endif
        for (int v2 = 2 * vcu; v2 < 512; v2 += (v2 & 1) ? 2 * G - 1 : 1) { const int v = v2 >> 1, bh = v >> 3, s = v & 7;
            mla_unit(lds, bh >> 3, bh & 7, (v2 & 1) ? s : 15 - s, WSB(WS_QM), WSB(WS_KN), WSB(WS_PROJ), WSB(WS_VT), WSB(WS_MIX)); }
#ifdef MLA_BAR
        xcd_barrier(bar);
#endif
        if (tid == 0) { unsigned sp = 0; while (__hip_atomic_load(scan_cnt, __ATOMIC_RELAXED, __HIP_MEMORY_SCOPE_AGENT) < (unsigned)G) { __builtin_amdgcn_s_sleep(2); if (++sp > XB_SPIN_CAP) break; }
            __builtin_amdgcn_fence(__ATOMIC_ACQUIRE, "agent"); asm volatile("s_waitcnt vmcnt(0)" ::: "memory"); }
        __syncthreads();
#ifdef REP_RET
        for (int rr_ = 0; rr_ < 2; ++rr_)
#endif
        for (int u = vcu; u < 512; u += G) ret_out_unit(lds, u, WSB(WS_PROJ), WSB(WS_RVT), WSB(WS_RKVT), p.g_ret_gn, WSB(WS_MIX));
    }
    xcd_barrier(bar);
    TMARK(3);
#ifdef DBL_BAR
    xcd_barrier(bar);
#endif
    }

    REP(4) {
    if (PH(4))
#ifdef REP_P4NB
    for (int nb_ = 0; nb_ < 2; ++nb_)
#endif
    { pg8::Gemm g{WSB(WS_MIX), WSB(WS_WO), T, 1024, 1024, 1024, 1024}; pg8::StaticOrder S; S.init(T, 1024, G, bx);
      pg8::EpiRes E{p.x, nullptr, WSB(WS_H1B), WSF(WS_SSQ1)}; pg8::gemm_phase<pg8::EpiRes, pg8::StaticOrder, GEMM_ALIGN>(lds, g, S, E); }
    xcd_barrier(bar);
    TMARK(4);
#ifdef DBL_BAR
    xcd_barrier(bar);
#endif
    }

    REP(5) {
    if (PH(5))
    { pg8::Gemm g{WSB(WS_H1B), WSB(WS_WXQ), T, 1024, 1024, 1024, 1024}; pg8::StaticOrder S; S.init(T, 1024, G, bx);
      pg8::EpiRowScale<16> E{WSB(WS_QX), 1024, WSF(WS_SSQ1), 1.f / 1024.f, C2_X}; pg8::gemm_phase<pg8::EpiRowScale<16>, pg8::StaticOrder, GEMM_ALIGN>(lds, g, S, E); }
    xcd_barrier(bar);
    TMARK(5);
#ifdef DBL_BAR
    xcd_barrier(bar);
#endif
    }

    REP(6) {
    if (PH(6))
    {
        for (int u = vcu; u < 512; u += G) { const int dvh = u & 1, qb = (u >> 1) & 15, h = (u >> 5) & 3, b = u >> 7; xattn_unit(lds, b, h, qb, dvh, WSB(WS_QX), WSB(WS_KX), WSB(WS_VXT), WSB(WS_OX)); }
        unsigned char* U8 = ws + WS_U8; unsigned char* V8 = ws + WS_V8;
        const f32x4* gf = (const f32x4*)p.g_ffn + lane * 4;
        f32x4 gs[4];
#pragma unroll
        for (int i = 0; i < 4; ++i) gs[i] = gf[i] * U_SCALE;
        for (int e = gw; e < 2 * 16384; e += NGW) {
            const bool isv = e >= 16384; const int row = isv ? e - 16384 : e;
            const f32x4* src = (const f32x4*)((isv ? p.v_exp : p.u_exp) + (size_t)row * D) + lane * 4;
            u32x4 o; unsigned ow[4];
#pragma unroll
            for (int i = 0; i < 4; ++i) { f32x4 v = src[i]; v = isv ? v * V_SCALE : v * gs[i]; int pk = 0; pk = __builtin_amdgcn_cvt_pk_fp8_f32(v[0], v[1], pk, false); pk = __builtin_amdgcn_cvt_pk_fp8_f32(v[2], v[3], pk, true); ow[i] = (unsigned)pk; }
            o.x = ow[0]; o.y = ow[1]; o.z = ow[2]; o.w = ow[3];
            *(u32x4*)((isv ? V8 : U8) + (size_t)(lane >> 3) * (16384 * 128) + (size_t)row * 128 + (lane & 7) * 16) = o;
        }
    }
    xcd_barrier(bar);
    TMARK(6);
#ifdef DBL_BAR
    xcd_barrier(bar);
#endif
    }

    REP(7) {
    if (PH(7))
    { pg8::Gemm g{WSB(WS_OX), WSB(WS_WXO), T, 1024, 1024, 1024, 1024}; pg8::StaticOrder S; S.init(T, 1024, G, bx);
      pg8::EpiRes E{nullptr, WSB(WS_H1B), WSB(WS_H2B), WSF(WS_SSQ2)}; pg8::gemm_phase<pg8::EpiRes, pg8::StaticOrder, GEMM_ALIGN>(lds, g, S, E); }
    xcd_barrier(bar);
    TMARK(7);
#ifdef DBL_BAR
    xcd_barrier(bar);
#endif
    }

    REP(8) {
    if (PH(8))
    { pg8::Gemm g{WSB(WS_H2B), WSB(WS_WPQ), T, 2048, 1024, 1024, 1024}; pg8::StaticOrder S; S.init(T, 2048, G, bx);
      pg8::EpiRowScale<16> E{WSB(WS_QP), 2048, WSF(WS_SSQ2), 1.f / 1024.f, 1.f}; pg8::gemm_phase<pg8::EpiRowScale<16>, pg8::StaticOrder, GEMM_ALIGN>(lds, g, S, E); }
    xcd_barrier(bar);
    TMARK(8);
#ifdef DBL_BAR
    xcd_barrier(bar);
#endif
    }

    REP(9) {
    if (PH(9))
    {
#if PEER_DSLICE
      const int myrank = (int)MISC[20];
      peer_phase<true>(lds, p, vcu, G);
      xcd_barrier(bar);
    TMARK(9);
#ifdef DUP_RETR
      peer_phase<true>(lds, p, vcu, G);
      xcd_barrier(bar);
#endif
      peer_slice_phase<false>(p, bar.x, myrank, G, bx, wave, lane);
      xcd_barrier(bar);
    TMARK(10);
#ifdef DUP_USL
      peer_slice_phase<false>(p, bar.x, myrank, G, bx, wave, lane);
      xcd_barrier(bar);
#endif
      peer_combine_phase(p, gw, NGW, lane);
      xcd_barrier(bar);
    TMARK(11);
      peer_slice_phase<true>(p, bar.x, myrank, G, bx, wave, lane);
      xcd_barrier(bar);
    TMARK(12);
#ifdef DUP_VSL
      peer_slice_phase<true>(p, bar.x, myrank, G, bx, wave, lane);
      xcd_barrier(bar);
#endif
      peer_final_phase(p, gw, NGW, lane);
      TMARK(13);
#else
      peer_phase<false>(lds, p, vcu, G);
      xcd_barrier(bar);
      peer_v_phase(p, vcu, G);
#endif
    }
#if (REP_MASK >> 9) & 1
    xcd_barrier(bar);
#endif
    }
}

extern "C" void kernel_launch(void* const* d_in, const int* in_sizes, int n_in, void* d_out, int out_size, void* d_ws, size_t ws_size, hipStream_t stream) {
    static int grid = 0;
    if (grid == 0) {
        if (n_in != 21 || out_size != T * D || ws_size < WS_END) { fprintf(stderr, "kernel_launch: unexpected shapes (n_in %d out %d ws %zu)\n", n_in, out_size, ws_size); grid = -1; return; }
        int dev = 0, cus = 0, per_cu = 0;
        if (hipGetDevice(&dev) != hipSuccess || hipDeviceGetAttribute(&cus, hipDeviceAttributeMultiprocessorCount, dev) != hipSuccess) { grid = -1; return; }
        if (hipFuncSetAttribute((const void*)fwd_megakernel, hipFuncAttributeMaxDynamicSharedMemorySize, LDS_BYTES) != hipSuccess) { fprintf(stderr, "kernel_launch: hipFuncSetAttribute failed\n"); grid = -1; return; }
        if (hipOccupancyMaxActiveBlocksPerMultiprocessor(&per_cu, (const void*)fwd_megakernel, NWAVES * 64, LDS_BYTES) != hipSuccess || per_cu < 1) { fprintf(stderr, "kernel_launch: occupancy query says %d\n", per_cu); grid = -1; return; }
        (void)hipGetLastError();
        grid = cus;
    }
    if (grid < 0) return;
    (void)hipMemsetAsync((char*)d_ws + WS_CTL, 0, CTL_ZERO_BYTES, stream);
    Params p{};
    const float** pp = (const float**)&p;
    for (int i = 0; i < 21; ++i) pp[i] = (const float*)d_in[i];
    p.out = (float*)d_out; p.ws = (unsigned char*)d_ws; p.never = 0; p.pad = 0;
    void* args[] = {&p};
    hipError_t e = hipLaunchCooperativeKernel((const void*)fwd_megakernel, dim3(grid), dim3(NWAVES * 64), args, LDS_BYTES, stream);
    if (e != hipSuccess) fprintf(stderr, "cooperative launch failed: %s (grid %d)\n", hipGetErrorString(e), grid);
}
```

```cpp
#include <hip/hip_runtime.h>
#include <hip/hip_cooperative_groups.h>
#include <cstdio>
#include <cstdint>
namespace cg = cooperative_groups;

#define LAS __attribute__((address_space(3)))
#define GAS __attribute__((address_space(1)))
typedef unsigned short bf16_t;
typedef short bf16x8 __attribute__((ext_vector_type(8)));
typedef short s16x4 __attribute__((ext_vector_type(4)));
typedef float f32x4 __attribute__((ext_vector_type(4)));
typedef float f32x2 __attribute__((ext_vector_type(2)));
typedef float f32x16 __attribute__((ext_vector_type(16)));
typedef unsigned u32x4 __attribute__((ext_vector_type(4)));
typedef unsigned u32x2 __attribute__((ext_vector_type(2)));
typedef __bf16 bf16x2_t __attribute__((ext_vector_type(2)));

constexpr int T = 16384, D = 1024, SEQ = 4096;
constexpr int NPROJ = 2304;
constexpr int NWIN = 2816;
constexpr float EPS = 1e-6f;
constexpr float LOG2E = 1.4426950408889634f;
constexpr float C2_MLA = 0.10206207261596575f * LOG2E;
constexpr float C2_X = 0.0625f * LOG2E;
constexpr float U_SCALE = 512.f, V_SCALE = 64.f;

constexpr size_t MiB = 1u << 20;
constexpr size_t WS_CTL = 0, CTL_ZERO_BYTES = 1 * MiB;
constexpr size_t WS_SSQQ = 227 * MiB, WS_SSQKV = 228 * MiB, WS_SSQ1 = 229 * MiB, WS_SSQ2 = 230 * MiB;
constexpr size_t WS_CR = 1 * MiB, WS_SR = 2 * MiB, WS_CM = 3 * MiB, WS_SM = 3 * MiB + 256 * 1024;
constexpr size_t WS_WIN = 4 * MiB, WS_WUQ = 10 * MiB, WS_WUKV = 11 * MiB, WS_WO = 12 * MiB, WS_WXQ = 14 * MiB, WS_WXKV = 16 * MiB, WS_WXO = 20 * MiB, WS_WPQ = 22 * MiB, WS_SK = 26 * MiB;
constexpr size_t WS_MEMN = 27 * MiB, WS_KX = 29 * MiB, WS_VXT = 31 * MiB;
constexpr size_t WS_A0 = 33 * MiB, WS_MIX = 33 * MiB, WS_QX = 33 * MiB;
constexpr size_t WS_EG = 33 * MiB, WS_WG = 41 * MiB, WS_SSQ3 = 49 * MiB, WS_PART = 65 * MiB;
constexpr size_t WS_PROJ = 65 * MiB, WS_H1B = 65 * MiB, WS_U8 = 137 * MiB, WS_V8 = 153 * MiB;
constexpr size_t WS_OX = 97 * MiB, WS_H2B = 169 * MiB, WS_QP = 65 * MiB;
constexpr size_t WS_RVT = 137 * MiB, WS_QM = 154 * MiB, WS_KN = 178 * MiB, WS_VT = 194 * MiB, WS_RKVT = 211 * MiB;
constexpr int TP = T + 64;
constexpr size_t WS_END = 231 * MiB;
constexpr int CW_BAR = 4096;
constexpr int CW_XRANK = 20480;
constexpr int CW_QUEUE = 16384, Q3_SLOT = 0;

constexpr int RING_BYTES = 131072;
constexpr int LDSCTL_OFF = 143360;
constexpr int LDS_BYTES = 147456;
constexpr int NWAVES = 8;

__device__ __forceinline__ unsigned cvtpk(float lo, float hi) { f32x2 v = {lo, hi}; bf16x2_t b = __builtin_convertvector(v, bf16x2_t); return __builtin_bit_cast(unsigned, b); }
__device__ __forceinline__ float bf2f(unsigned short b) { return __uint_as_float(((unsigned)b) << 16); }
__device__ __forceinline__ int crow(int r, int hi) { return (r & 3) + 8 * (r >> 2) + 4 * hi; }
template <int M> __device__ __forceinline__ float shx(float f, int lane) {
    const int v = (int)__float_as_uint(f); int r;
    if (M == 1) r = __builtin_amdgcn_mov_dpp(v, 0xB1, 0xF, 0xF, true);
    else if (M == 2) r = __builtin_amdgcn_mov_dpp(v, 0x4E, 0xF, 0xF, true);
    else if (M == 4) { r = __builtin_amdgcn_update_dpp(v, v, 0x104, 0xF, 0x5, false); r = __builtin_amdgcn_update_dpp(r, v, 0x114, 0xF, 0xA, false); }
    else if (M == 8) r = __builtin_amdgcn_mov_dpp(v, 0x128, 0xF, 0xF, true);
    else if (M == 16) { auto rr = __builtin_amdgcn_permlane16_swap((unsigned)v, (unsigned)v, false, false); r = (int)((lane & 16) ? rr[0] : rr[1]); }
    else { auto rr = __builtin_amdgcn_permlane32_swap((unsigned)v, (unsigned)v, false, false); r = (int)((lane & 32) ? rr[0] : rr[1]); }
    return __uint_as_float((unsigned)r);
}
__device__ __forceinline__ float wave_sum(float v) {
#pragma unroll
    for (int o = 1; o < 64; o <<= 1) v += __shfl_xor(v, o);
    return v;
}
__device__ __forceinline__ float wave_sum_fast(float v, int lane) {
    v += shx<1>(v, lane); v += shx<2>(v, lane); v += shx<4>(v, lane); v += shx<8>(v, lane); v += shx<16>(v, lane); v += shx<32>(v, lane);
    return v;
}
__device__ __forceinline__ float xhalf_max(float m) { auto rr = __builtin_amdgcn_permlane32_swap(__float_as_uint(m), __float_as_uint(m), false, false); return fmaxf(__uint_as_float(rr[0]), __uint_as_float(rr[1])); }
__device__ __forceinline__ float xhalf_sum(float m) { auto rr = __builtin_amdgcn_permlane32_swap(__float_as_uint(m), __float_as_uint(m), false, false); return __uint_as_float(rr[0]) + __uint_as_float(rr[1]); }
__device__ __forceinline__ unsigned xhalf_other(unsigned m, int hi) { auto rr = __builtin_amdgcn_permlane32_swap(m, m, false, false); return hi ? rr[0] : rr[1]; }
#define LDS_WAIT() asm volatile("s_waitcnt lgkmcnt(0)" ::: "memory")
template <int NP> __device__ __forceinline__ float ssq_sum(const float* part) {
    float s = 0.f;
#pragma unroll
    for (int i = 0; i < NP / 4; ++i) { const f32x4 v = *(const f32x4*)(part + 4 * i); s += v[0]; s += v[1]; s += v[2]; s += v[3]; }
    return s;
}
__device__ __forceinline__ int opaque_tid() { int t = threadIdx.x; asm volatile("" : "+v"(t)); return t; }
#define MFMA32(a, b, c) __builtin_amdgcn_mfma_f32_32x32x16_bf16((a), (b), (c), 0, 0, 0)
__device__ __forceinline__ float gelu_f(float v) {
    const float av = fabsf(v), t = __builtin_amdgcn_rcpf(av * 0.2316418882f + 1.0f);
    float q = t * 0.5307027145f + (-0.7265760135f); q = q * t + 0.7107068705f; q = q * t + (-0.142248368f); q = q * t + 0.127414796f; q = q * t;
    const float e = __builtin_amdgcn_exp2f((v * v) * (-0.72134752044f));
    const float m = v * (q * e);
    return v < 0.f ? m : v - m;
}

namespace pg8 {
constexpr int BM = 256, BK = 64, HALF = 128, HTB = HALF * BK * 2, STAGE_BYTES = 8 * HTB, NXCD = 8, WGM = 8;
__host__ __device__ __forceinline__ int lds_byte(int r, int c) { const int st = (r >> 4) * 2 + (c >> 5), rr = r & 15, cc = c & 31, ob = rr * 64 + cc * 2; return st * 1024 + (ob ^ (((ob >> 9) & 1) << 5)); }
__host__ __device__ __forceinline__ void stage_rc(int b, int& R, int& C) { const int st = b / 1024, sb = b % 1024, swz = sb ^ (((sb >> 9) & 1) << 5); R = (st >> 1) * 16 + swz / 64; C = (st & 1) * 32 + (swz % 64) / 2; }
__host__ __device__ __forceinline__ int perm32(int rho) { const int n = rho >> 4, i = rho & 15; return 8 * (i >> 2) + 4 * n + (i & 3); }
struct Unit { int pm, pn; };
struct Gemm { const bf16_t* A; const bf16_t* Bt; int M, N, K, lda, ldb; };
struct StaticOrder {
    int nM, nN, nwg, G, c;
    __device__ void init(int M, int N, int G_, int c_) { nM = M / BM; nN = N / BM; nwg = nM * nN; G = G_; c = c_; }
    __device__ bool next(int i, Unit& u) const {
        const long L = (long)i * G + c; if (L >= nwg) return false;
        int wgid = (int)L; { const int q = nwg / NXCD, r = nwg % NXCD, xcd = wgid % NXCD, off = wgid / NXCD; wgid = (xcd < r ? xcd * (q + 1) : r * (q + 1) + (xcd - r) * q) + off; }
        const int nig = WGM * nN, gid = wgid / nig, fm = gid * WGM, gsz = (nM - fm) < WGM ? (nM - fm) : WGM;
        u.pm = fm + ((wgid % nig) % gsz); u.pn = (wgid % nig) / gsz; return true;
    }
};

template <class Epi, class Sched, bool ALIGN_EPI>
__device__ __forceinline__ void gemm_phase(LAS unsigned char* lds, const Gemm g, const Sched& S, const Epi& E) {
    const int tid = opaque_tid(), wid = __builtin_amdgcn_readfirstlane(tid >> 6), lane = tid & 63, wr = wid >> 2, wc = wid & 3, fr = lane & 15, fq = lane >> 4;
    const int K = g.K, nt = K / BK;
    unsigned voffA[2], voffB[2];
#pragma unroll
    for (int i = 0; i < 2; ++i) { int R, C; stage_rc(tid * 16 + i * 8192, R, C); const int Rb = (R & ~31) + perm32(R & 31); voffA[i] = (unsigned)(R * g.lda + C) * 2u; voffB[i] = (unsigned)(Rb * g.ldb + C) * 2u; }
    const size_t kstep = (size_t)(BK * 2);
    const size_t hstepA = (size_t)HALF * g.lda * 2, hstepB = (size_t)HALF * g.ldb * 2, tstepA = 2 * hstepA, tstepB = 2 * hstepB;
    const unsigned ldsw = (unsigned)wid * 1024u;
    const int aoff = lds_byte(wr * 64 + fr, fq * 8), boff = lds_byte(wc * 32 + fr, fq * 8);
#define PG8_SA(b, h) (((b) * 2 + (h)) * HTB)
#define PG8_SB(b, h) ((4 + (b) * 2 + (h)) * HTB)
#define PG8_STAGE(bufoff, gbase, voff) do { _Pragma("unroll") for (int _i = 0; _i < 2; ++_i) \
        __builtin_amdgcn_global_load_lds((const unsigned*)((const char*)(gbase) + (voff)[_i]), (LAS unsigned*)(lds + (bufoff) + ldsw + _i * 8192), 16, 0, 0); } while (0)
#define PG8_LDA(dst, b, h) do { _Pragma("unroll") for (int m = 0; m < 4; ++m) _Pragma("unroll") for (int k = 0; k < 2; ++k) dst[m][k] = *(const LAS bf16x8*)(lds + PG8_SA(b, h) + aoff + m * 2048 + k * 1024); } while (0)
#define PG8_LDB(dst, b, h) do { _Pragma("unroll") for (int n = 0; n < 2; ++n) _Pragma("unroll") for (int k = 0; k < 2; ++k) dst[n][k] = *(const LAS bf16x8*)(lds + PG8_SB(b, h) + boff + n * 2048 + k * 1024); } while (0)
#define PG8_MMA(ai, bj, At, Bt) do { __builtin_amdgcn_s_setprio(1); _Pragma("unroll") for (int m = 0; m < 4; ++m) _Pragma("unroll") for (int n = 0; n < 2; ++n) _Pragma("unroll") for (int k = 0; k < 2; ++k) \
        acc[ai][bj][m][n] = __builtin_amdgcn_mfma_f32_16x16x32_bf16(Bt[n][k], At[m][k], acc[ai][bj][m][n], 0, 0, 0); __builtin_amdgcn_s_setprio(0); } while (0)
#define PG8_WAIT_V(n) asm volatile("s_waitcnt vmcnt(" #n ")" ::: "memory")
#define PG8_WAIT_L(n) asm volatile("s_waitcnt lgkmcnt(" #n ")" ::: "memory")
#define PG8_BAR __builtin_amdgcn_s_barrier()
#define PG8_SCHED __builtin_amdgcn_sched_barrier(0)
    Unit cur, nxt; int ui = 0;
    if (!S.next(0, cur)) return;
    f32x4 acc[2][2][4][2];
#pragma unroll
    for (int a = 0; a < 2; ++a)
#pragma unroll
        for (int b = 0; b < 2; ++b)
#pragma unroll
            for (int m = 0; m < 4; ++m)
#pragma unroll
                for (int n = 0; n < 2; ++n) acc[a][b][m][n] = (f32x4){0.f, 0.f, 0.f, 0.f};
    bf16x8 At[4][2], B0[2][2], B1[2][2];
    const char* cA = (const char*)g.A + (size_t)cur.pm * tstepA; const char* cB = (const char*)g.Bt + (size_t)cur.pn * tstepB;
    PG8_STAGE(PG8_SB(0, 0), cB, voffB); PG8_STAGE(PG8_SB(0, 1), cB + hstepB, voffB); PG8_STAGE(PG8_SA(0, 0), cA, voffA); PG8_STAGE(PG8_SA(0, 1), cA + hstepA, voffA);
    if (wr == 1) PG8_BAR;
    PG8_WAIT_V(2); PG8_BAR;
    PG8_STAGE(PG8_SB(1, 0), cB + kstep, voffB); PG8_STAGE(PG8_SA(1, 0), cA + kstep, voffA); PG8_STAGE(PG8_SB(1, 1), cB + hstepB + kstep, voffB);
    PG8_WAIT_V(6); PG8_BAR;
    for (;;) {
        const bool has_next = S.next(ui + 1, nxt);
        const char* nA = has_next ? (const char*)g.A + (size_t)nxt.pm * tstepA : cA; const char* nB = has_next ? (const char*)g.Bt + (size_t)nxt.pn * tstepB : cB;
#pragma nounroll
        for (int t = 0; t < nt; t += 2) {
            const bool last = (t == nt - 2);
            const char* a1 = cA + (size_t)(t + 1) * kstep;
            const char* a2 = last ? nA : cA + (size_t)(t + 2) * kstep; const char* b2 = last ? nB : cB + (size_t)(t + 2) * kstep;
            const char* a3 = a2 + kstep; const char* b3 = b2 + kstep;
            PG8_LDB(B0, 0, 0); PG8_LDB(B1, 0, 1); PG8_SCHED; PG8_LDA(At, 0, 0); PG8_STAGE(PG8_SA(1, 1), a1 + hstepA, voffA);
            PG8_WAIT_V(8); PG8_WAIT_L(0); PG8_BAR; PG8_MMA(0, 0, At, B0); PG8_MMA(0, 1, At, B1); PG8_BAR; PG8_SCHED;
            PG8_LDA(At, 0, 1); PG8_STAGE(PG8_SB(0, 0), b2, voffB); PG8_STAGE(PG8_SB(0, 1), b2 + hstepB, voffB); PG8_STAGE(PG8_SA(0, 0), a2, voffA);
            PG8_WAIT_V(8); PG8_WAIT_L(0); PG8_BAR; PG8_MMA(1, 0, At, B0); PG8_MMA(1, 1, At, B1); PG8_BAR; PG8_SCHED;
            PG8_LDB(B0, 1, 0); PG8_LDB(B1, 1, 1); PG8_SCHED; PG8_LDA(At, 1, 0); PG8_STAGE(PG8_SA(0, 1), a2 + hstepA, voffA);
            PG8_WAIT_V(8); PG8_WAIT_L(0); PG8_BAR; PG8_MMA(0, 0, At, B0); PG8_MMA(0, 1, At, B1); PG8_BAR; PG8_SCHED;
            PG8_LDA(At, 1, 1); PG8_STAGE(PG8_SB(1, 0), b3, voffB); PG8_STAGE(PG8_SB(1, 1), b3 + hstepB, voffB); PG8_STAGE(PG8_SA(1, 0), a3, voffA);
            PG8_WAIT_V(8); PG8_WAIT_L(0); PG8_BAR; PG8_MMA(1, 0, At, B0); PG8_MMA(1, 1, At, B1); PG8_BAR; PG8_SCHED;
        }
        if constexpr (ALIGN_EPI) { if (wr == 0) PG8_BAR; }
        E(acc, cur, wr, wc, fr, fq);
        if (!has_next) break;
#pragma unroll
        for (int a = 0; a < 2; ++a)
#pragma unroll
            for (int b = 0; b < 2; ++b)
#pragma unroll
                for (int m = 0; m < 4; ++m)
#pragma unroll
                    for (int n = 0; n < 2; ++n) acc[a][b][m][n] = (f32x4){0.f, 0.f, 0.f, 0.f};
        cur = nxt; cA = nA; cB = nB; ++ui;
        if constexpr (ALIGN_EPI) { if (wr == 1) PG8_BAR; }
    }
    PG8_WAIT_V(0);
    if constexpr (!ALIGN_EPI) { if (wr == 0) PG8_BAR; }
    PG8_BAR;
#undef PG8_SA
#undef PG8_SB
#undef PG8_STAGE
#undef PG8_LDA
#undef PG8_LDB
#undef PG8_MMA
#undef PG8_WAIT_V
#undef PG8_WAIT_L
#undef PG8_BAR
#undef PG8_SCHED
}

__device__ __forceinline__ void st_bf16x8(bf16_t* p, f32x4 v0, f32x4 v1) { u32x4 w; w.x = cvtpk(v0[0], v0[1]); w.y = cvtpk(v0[2], v0[3]); w.z = cvtpk(v1[0], v1[1]); w.w = cvtpk(v1[2], v1[3]); *(u32x4*)p = w; }
#define EPI_LOOP_AM _Pragma("unroll") for (int ai = 0; ai < 2; ++ai) _Pragma("unroll") for (int m = 0; m < 4; ++m)

struct EpiPlain {
    bf16_t* O; int ldc;
    __device__ __forceinline__ void operator()(const f32x4 (&acc)[2][2][4][2], const Unit& u, int wr, int wc, int fr, int fq) const {
        const int row0 = u.pm * BM + wr * 64 + fr, col0 = u.pn * BM + wc * 32 + 8 * fq;
        EPI_LOOP_AM { bf16_t* rowp = O + (size_t)(row0 + ai * HALF + m * 16) * ldc + col0;
#pragma unroll
            for (int bj = 0; bj < 2; ++bj) st_bf16x8(rowp + bj * HALF, acc[ai][bj][m][0], acc[ai][bj][m][1]); }
    }
};
template <int NP> struct EpiRowScale {
    bf16_t* O; int ldc; const float* ssq; float invn, mul;
    __device__ __forceinline__ void operator()(const f32x4 (&acc)[2][2][4][2], const Unit& u, int wr, int wc, int fr, int fq) const {
        const int row0 = u.pm * BM + wr * 64 + fr, col0 = u.pn * BM + wc * 32 + 8 * fq;
        EPI_LOOP_AM { const int row = row0 + ai * HALF + m * 16; const float rs = rsqrtf(ssq_sum<NP>(ssq + (size_t)row * 16) * invn + EPS) * mul; bf16_t* rowp = O + (size_t)row * ldc + col0;
#pragma unroll
            for (int bj = 0; bj < 2; ++bj) st_bf16x8(rowp + bj * HALF, acc[ai][bj][m][0] * rs, acc[ai][bj][m][1] * rs);
            if (m & 1) asm volatile("" ::: "memory"); }
    }
};
struct EpiColScale {
    bf16_t* O; int ldc; const float* ssq; float invn;
    __device__ __forceinline__ void operator()(const f32x4 (&acc)[2][2][4][2], const Unit& u, int wr, int wc, int fr, int fq) const {
        const int row0 = u.pm * BM + wr * 64 + fr, col0 = u.pn * BM + wc * 32 + 8 * fq;
#pragma unroll
        for (int bj = 0; bj < 2; ++bj) { const float* sp = ssq + (size_t)(col0 + bj * HALF) * 16; f32x4 rs[2];
#pragma unroll
            for (int n = 0; n < 2; ++n) rs[n] = (f32x4){rsqrtf(ssq_sum<8>(sp + (4 * n) * 16) * invn + EPS), rsqrtf(ssq_sum<8>(sp + (4 * n + 1) * 16) * invn + EPS), rsqrtf(ssq_sum<8>(sp + (4 * n + 2) * 16) * invn + EPS), rsqrtf(ssq_sum<8>(sp + (4 * n + 3) * 16) * invn + EPS)};
            EPI_LOOP_AM st_bf16x8(O + (size_t)(row0 + ai * HALF + m * 16) * ldc + col0 + bj * HALF, acc[ai][bj][m][0] * rs[0], acc[ai][bj][m][1] * rs[1]);
            asm volatile("" ::: "memory"); }
    }
};
struct EpiRes {
    const float* basef; const bf16_t* baseb; bf16_t* hb; float* ssq;
    __device__ __forceinline__ void operator()(const f32x4 (&acc)[2][2][4][2], const Unit& u, int wr, int wc, int fr, int fq) const {
        const int row0 = u.pm * BM + wr * 64 + fr, col0 = u.pn * BM + wc * 32 + 8 * fq;
        EPI_LOOP_AM { const int row = row0 + ai * HALF + m * 16; const size_t off = (size_t)row * D + col0; float ss = 0.f;
#pragma unroll
            for (int bj = 0; bj < 2; ++bj) { f32x4 b0, b1;
                if (basef) { b0 = *(const f32x4*)(basef + off + bj * HALF); b1 = *(const f32x4*)(basef + off + bj * HALF + 4); }
                else { const u32x4 r = *(const u32x4*)(baseb + off + bj * HALF);
                    b0 = (f32x4){bf2f((unsigned short)(r.x & 0xffffu)), bf2f((unsigned short)(r.x >> 16)), bf2f((unsigned short)(r.y & 0xffffu)), bf2f((unsigned short)(r.y >> 16))};
                    b1 = (f32x4){bf2f((unsigned short)(r.z & 0xffffu)), bf2f((unsigned short)(r.z >> 16)), bf2f((unsigned short)(r.w & 0xffffu)), bf2f((unsigned short)(r.w >> 16))}; }
                const f32x4 h0 = b0 + acc[ai][bj][m][0], h1 = b1 + acc[ai][bj][m][1];
                st_bf16x8(hb + off + bj * HALF, h0, h1);
                ss += (h0[0] * h0[0] + h0[1] * h0[1]) + (h0[2] * h0[2] + h0[3] * h0[3]) + (h1[0] * h1[0] + h1[1] * h1[1]) + (h1[2] * h1[2] + h1[3] * h1[3]); }
            ss += __shfl_xor(ss, 16); ss += __shfl_xor(ss, 32);
            if (fq == 0) ssq[(size_t)row * 16 + u.pn * 4 + wc] = ss;
            asm volatile("" ::: "memory"); }
    }
};
struct EpiProj {
    bf16_t* P; float* ssq_q; float* ssq_kv; const float* cr; const float* sr; const float* cm; const float* sm;
    __device__ __forceinline__ void operator()(const f32x4 (&acc)[2][2][4][2], const Unit& u, int wr, int wc, int fr, int fq) const {
        const int row0 = u.pm * BM + wr * 64 + fr;
#pragma unroll
        for (int bj = 0; bj < 2; ++bj) {
            const int hb = 2 * u.pn + bj;
            if (hb == 17 && wc != 0) continue;
            const int kind = hb < 3 ? 0 : hb < 5 ? 1 : hb < 9 ? 2 : hb < 13 ? 3 : hb < 17 ? 4 : 5;
            const int col = hb * HALF + wc * 32 + 8 * fq;
            EPI_LOOP_AM { const int row = row0 + ai * HALF + m * 16; const int s = row & (SEQ - 1);
                f32x4 v0 = acc[ai][bj][m][0], v1 = acc[ai][bj][m][1];
                if (kind <= 1) {
                    float ss = (v0[0] * v0[0] + v0[1] * v0[1]) + (v0[2] * v0[2] + v0[3] * v0[3]) + (v1[0] * v1[0] + v1[1] * v1[1]) + (v1[2] * v1[2] + v1[3] * v1[3]);
                    ss += __shfl_xor(ss, 16); ss += __shfl_xor(ss, 32);
                    if (fq == 0) { if (kind == 0) ssq_q[(size_t)row * 16 + hb * 4 + wc] = ss; else ssq_kv[(size_t)row * 16 + (hb - 3) * 4 + wc] = ss; }
                } else if (kind == 2 || kind == 3) {
                    const f32x4 c = *(const f32x4*)(cr + (size_t)s * 64 + wc * 16 + 4 * fq), sn = *(const f32x4*)(sr + (size_t)s * 64 + wc * 16 + 4 * fq);
                    f32x4 y0 = v0 * c - v1 * sn, y1 = v0 * sn + v1 * c;
                    if (kind == 3) { y0 = y0 * 0.08838834764831845f; y1 = y1 * 0.08838834764831845f; }
                    v0 = y0; v1 = y1;
                } else if (kind == 5) {
                    const f32x4 c = *(const f32x4*)(cm + (size_t)s * 16 + 4 * fq), sn = *(const f32x4*)(sm + (size_t)s * 16 + 4 * fq);
                    const f32x4 y0 = v0 * c - v1 * sn, y1 = v0 * sn + v1 * c; v0 = y0; v1 = y1;
                }
                st_bf16x8(P + (size_t)row * NPROJ + col, v0, v1);
                if (m & 1) asm volatile("" ::: "memory"); }
        }
    }
};
struct EpiQ {
    bf16_t* O; const float* ssq; const float* cm; const float* sm;
    __device__ __forceinline__ void operator()(const f32x4 (&acc)[2][2][4][2], const Unit& u, int wr, int wc, int fr, int fq) const {
        const int row0 = u.pm * BM + wr * 64 + fr, col0 = u.pn * BM + wc * 32 + 8 * fq;
        EPI_LOOP_AM { const int row = row0 + ai * HALF + m * 16; const int s = row & (SEQ - 1); const float rs = rsqrtf(ssq_sum<12>(ssq + (size_t)row * 16) * (1.f / 384.f) + EPS) * C2_MLA;
            bf16_t* rowp = O + (size_t)row * 768 + col0;
            f32x4 c = (f32x4){1.f, 1.f, 1.f, 1.f}, sn = (f32x4){0.f, 0.f, 0.f, 0.f};
            if (u.pn == 2) { c = *(const f32x4*)(cm + (size_t)s * 16 + 4 * fq); sn = *(const f32x4*)(sm + (size_t)s * 16 + 4 * fq); }
#pragma unroll
            for (int bj = 0; bj < 2; ++bj) { const f32x4 v0 = acc[ai][bj][m][0] * rs, v1 = acc[ai][bj][m][1] * rs;
                st_bf16x8(rowp + bj * HALF, v0 * c - v1 * sn, v0 * sn + v1 * c); }
            asm volatile("" ::: "memory"); }
    }
};
}

#define XB_TMO      128
#define XB_XCNT(j)  (256  + 64 * (j))
#define XB_XSUB(j)  (1280 + 64 * (j))
#define XB_XGEN(j)  (2304 + 64 * (j))
#define XB_TOP      3328
#define XB_TOPGEN   3392
#define XCD_BAR_WORDS 3456
#define XB_SPIN_CAP (1u << 21)
__device__ __forceinline__ unsigned xb_ld(unsigned* p)              { return __hip_atomic_load(p, __ATOMIC_RELAXED, __HIP_MEMORY_SCOPE_AGENT); }
__device__ __forceinline__ unsigned xb_add(unsigned* p, unsigned v) { return __hip_atomic_fetch_add(p, v, __ATOMIC_RELAXED, __HIP_MEMORY_SCOPE_AGENT); }
__device__ __forceinline__ unsigned xb_xcc_id() { return (unsigned)__builtin_amdgcn_s_getreg((3 << 11) | 20) & 0xFu; }
#define XB_SPIN(cond, bar) do { unsigned _sp = 0; while (cond) { __builtin_amdgcn_s_sleep(1); \
    if ((++_sp & 255u) == 0u) { if (xb_ld(&(bar)[XB_TMO])) break; if (_sp > XB_SPIN_CAP) { atomicAdd(&(bar)[XB_TMO], 1u); break; } } } } while (0)
struct XcdBarrier { unsigned* bar; unsigned x; volatile LAS unsigned* st; };
__device__ __forceinline__ XcdBarrier xcd_barrier_post(unsigned* bar, volatile LAS unsigned* st) {
    XcdBarrier b; b.bar = bar; b.x = xb_xcc_id(); b.st = st;
    if (threadIdx.x == 0) (void)xb_add(&bar[XB_XCNT(b.x)], 1u);
    return b;
}
__device__ __forceinline__ void xcd_barrier_complete(unsigned* bar, unsigned x, unsigned& nloc, unsigned& nx) {
    const unsigned G = gridDim.x * gridDim.y * gridDim.z;
    unsigned sum, cnt, mine, sp = 0u;
    for (;;) {
        sum = 0u; cnt = 0u; mine = 0u;
#pragma unroll
        for (unsigned j = 0; j < 16; ++j) { const unsigned c = xb_ld(&bar[XB_XCNT(j)]); sum += c; cnt += (c > 0u) ? 1u : 0u; mine = (j == x) ? c : mine; }
        if (sum == G) break;
        __builtin_amdgcn_s_sleep(1);
        if ((++sp & 255u) == 0u) { if (xb_ld(&bar[XB_TMO])) break; if (sp > XB_SPIN_CAP) { atomicAdd(&bar[XB_TMO], 1u); break; } }
    }
    nloc = mine > 0u ? mine : 1u; nx = cnt > 0u ? cnt : 1u;
}
__device__ __forceinline__ void xcd_barrier(const XcdBarrier& b) {
    asm volatile("s_waitcnt vmcnt(0)" ::: "memory");
    __syncthreads();
    if (threadIdx.x == 0) {
        unsigned* bar = b.bar;
        __builtin_amdgcn_s_waitcnt(0);
        unsigned nloc = b.st[0], nx = b.st[1];
        if (nloc == 0u) { xcd_barrier_complete(bar, b.x, nloc, nx); b.st[0] = nloc; b.st[1] = nx; }
        const unsigned old = xb_add(&bar[XB_XSUB(b.x)], 1u);
        const unsigned gen = old / nloc;
        if (old + 1u == (gen + 1u) * nloc) {
            __builtin_amdgcn_fence(__ATOMIC_RELEASE, "agent");
            asm volatile("s_waitcnt vmcnt(0)" ::: "memory");
            const unsigned og = xb_add(&bar[XB_TOP], 1u);
            const unsigned tg = og / nx;
            if (og + 1u == (tg + 1u) * nx) xb_add(&bar[XB_TOPGEN], 1u);
            else XB_SPIN(xb_ld(&bar[XB_TOPGEN]) == tg, bar);
            __builtin_amdgcn_fence(__ATOMIC_ACQUIRE, "agent");
            xb_add(&bar[XB_XGEN(b.x)], 1u);
            asm volatile("s_waitcnt vmcnt(0)" ::: "memory");
        } else {
            XB_SPIN(xb_ld(&bar[XB_XGEN(b.x)]) == gen, bar);
            __builtin_amdgcn_fence(__ATOMIC_ACQUIRE, "agent");
            asm volatile("s_waitcnt vmcnt(0)" ::: "memory");
        }
    }
    __syncthreads();
}

struct Params {
    const float *x, *mem, *g_mix, *w_in, *g_q_lora, *w_uq, *g_kv_lora, *w_ukv, *g_ret_gn, *w_o, *g_xattn, *g_mem, *w_xq, *w_xkv, *w_xo, *g_ffn, *w_pq, *sub_keys, *u_exp, *v_exp, *g_final;
    float* out; unsigned char* ws; int never; int pad;
};

__device__ __forceinline__ int rope32(int r, int second) { return 8 * (r >> 2) + 4 * second + (r & 3); }
__device__ __forceinline__ int permret(int i) { return i < 64 ? ((i >> 4) * 32 + rope32(i & 15, 0)) : (((i - 64) >> 4) * 32 + rope32((i - 64) & 15, 1)); }
template <int MODE> __device__ __forceinline__ int dst_row(int c) {
    if (MODE == 1) {
        if (c < 640) return c;
        if (c < 672) { const int r = c - 640; return 2176 + rope32(r & 15, r >> 4); }
        if (c < 1184) { const int cc = c - 672; return 640 + (cc & ~127) + permret(cc & 127); }
        if (c < 1696) { const int cc = c - 1184; return 1152 + (cc & ~127) + permret(cc & 127); }
        if (c < 2208) return 2304 + (c - 1696);
        return 1664 + (c - 2208);
    } else if (MODE == 2) {
        const int h = c / 96, i = c - h * 96; return i < 64 ? h * 64 + i : 512 + h * 32 + rope32((i - 64) & 15, (i - 64) >> 4);
    } else if (MODE == 3) {
        const int h = c >> 7, i = c & 127; return i < 64 ? h * 64 + i : 512 + h * 64 + (i - 64);
    }
    return c;
}
template <int MODE> __device__ __forceinline__ void p0_transpose_item(const float* W, int K, int N, bf16_t* WT, const float* gain, LAS float* scr, int item, int lane) {
    const int nblk = N / 32, kb = item / nblk, nb = item % nblk, k0 = 64 * kb, n0 = 32 * nb;
    float v[32];
#pragma unroll
    for (int i = 0; i < 32; ++i) { const int kk = 2 * i + (lane >> 5); v[i] = W[(size_t)(k0 + kk) * N + n0 + (lane & 31)]; }
    if (gain) {
#pragma unroll
        for (int i = 0; i < 32; ++i) { const int kk = 2 * i + (lane >> 5); v[i] *= gain[k0 + kk]; }
    }
#pragma unroll
    for (int i = 0; i < 32; ++i) { const int kk = 2 * i + (lane >> 5); scr[kk * 33 + (lane & 31)] = v[i]; }
    LDS_WAIT(); asm volatile("" ::: "memory");
    const int c = lane & 7;
#pragma unroll
    for (int j = 0; j < 4; ++j) { const int n = (lane >> 3) + 8 * j; const LAS float* s = scr + (8 * c) * 33 + n;
        u32x4 o; o.x = cvtpk(s[0 * 33], s[1 * 33]); o.y = cvtpk(s[2 * 33], s[3 * 33]); o.z = cvtpk(s[4 * 33], s[5 * 33]); o.w = cvtpk(s[6 * 33], s[7 * 33]);
        *(u32x4*)(WT + (size_t)dst_row<MODE>(n0 + n) * K + k0 + 8 * c) = o; }
    LDS_WAIT(); asm volatile("" ::: "memory");
}
template <int NR> __device__ __forceinline__ void rms_rows_to_bf16(const float* xrow, const float* g, bf16_t* orow, size_t rstride, int lane) {
    f32x4 v[NR][4];
#pragma unroll
    for (int r = 0; r < NR; ++r)
#pragma unroll
        for (int j = 0; j < 4; ++j) v[r][j] = ((const f32x4*)(xrow + r * rstride) + lane)[64 * j];
    const f32x4* gr = (const f32x4*)g + lane;
    f32x4 gv[4];
#pragma unroll
    for (int j = 0; j < 4; ++j) gv[j] = gr[64 * j];
#pragma unroll
    for (int r = 0; r < NR; ++r) {
        float s = 0.f;
#pragma unroll
        for (int j = 0; j < 4; ++j) s += (v[r][j][0] * v[r][j][0] + v[r][j][1] * v[r][j][1]) + (v[r][j][2] * v[r][j][2] + v[r][j][3] * v[r][j][3]);
        const float rstd = rsqrtf(wave_sum(s) * (1.f / D) + EPS);
        u32x2* o8 = (u32x2*)(orow + r * rstride) + lane;
#pragma unroll
        for (int j = 0; j < 4; ++j) { const f32x4 y = v[r][j] * rstd * gv[j]; u32x2 w; w.x = cvtpk(y[0], y[1]); w.y = cvtpk(y[2], y[3]); o8[64 * j] = w; }
    }
}

struct NoMid { __device__ __forceinline__ void operator()() const {} };
__device__ __forceinline__ float max3f(float a, float b, float c) { return fmaxf(fmaxf(a, b), c); }
template <int NS, int NT, int KG, bool CINIT, bool MASK, class Mid>
__device__ __forceinline__ void flash_tile(const LAS unsigned char* Ks, int kpitch, const LAS unsigned char* Vs, int vpitch, const bf16x8 (&qf)[NS], f32x16 (&o)[NT],
                                           f32x16& negm, float& mref, float& lrun, bool first, int r32, int hi, bool domask, int qrel, int krel, const Mid& mid) {
    f32x16 p0, p1;
    const LAS unsigned char* k0 = Ks + r32 * kpitch + hi * 16; const LAS unsigned char* k1 = k0 + 32 * kpitch;
    if (CINIT) { p0 = negm; p1 = negm; }
    else {
#pragma unroll
        for (int r = 0; r < 16; ++r) { p0[r] = 0.f; p1[r] = 0.f; }
    }
#pragma unroll
    for (int g0 = 0; g0 < NS; g0 += KG) {
        bf16x8 ka[KG], kb2[KG];
#pragma unroll
        for (int s = 0; s < KG; ++s) { ka[s] = *(const LAS bf16x8*)(k0 + (g0 + s) * 32); kb2[s] = *(const LAS bf16x8*)(k1 + (g0 + s) * 32); }
        __builtin_amdgcn_sched_barrier(0);
#pragma unroll
        for (int s = 0; s < KG; ++s) { p0 = MFMA32(ka[s], qf[g0 + s], p0); p1 = MFMA32(kb2[s], qf[g0 + s], p1); }
        __builtin_amdgcn_sched_barrier(0);
    }
    if (!CINIT) {
#pragma unroll
        for (int r = 0; r < 16; ++r) { p0[r] -= mref; p1[r] -= mref; }
    }
    if (MASK) {
#pragma unroll
        for (int r = 0; r < 16; ++r) { const int kv = krel + crow(r, hi); if (kv > qrel) p0[r] = -1e30f; if (kv + 32 > qrel) p1[r] = -1e30f; }
    }
    float ma = max3f(p0[0], p0[1], p1[0]), mb = max3f(p0[2], p0[3], p1[1]); ma = max3f(ma, p1[2], p1[3]);
#pragma unroll
    for (int r = 4; r < 16; r += 4) { ma = max3f(ma, p0[r], p0[r + 1]); mb = max3f(mb, p0[r + 2], p0[r + 3]); ma = max3f(ma, p1[r], p1[r + 1]); mb = max3f(mb, p1[r + 2], p1[r + 3]); }
    const float mx = xhalf_max(fmaxf(ma, mb));
    if (first || __any(mx > 8.0f)) {
        const float dl = first ? mx : fmaxf(mx, 0.f);
        mref += dl;
#pragma unroll
        for (int r = 0; r < 16; ++r) { p0[r] -= dl; p1[r] -= dl; if (CINIT) negm[r] = -mref; }
        const float alpha = __builtin_amdgcn_exp2f(-dl);
        lrun *= alpha;
        if (!first) {
#pragma unroll
            for (int t = 0; t < NT; ++t)
#pragma unroll
                for (int r = 0; r < 16; ++r) o[t][r] *= alpha;
        }
    }
    float rs0 = 0.f, rs1 = 0.f;
#pragma unroll
    for (int r = 0; r < 16; ++r) { p0[r] = __builtin_amdgcn_exp2f(p0[r]); p1[r] = __builtin_amdgcn_exp2f(p1[r]); rs0 += p0[r]; rs1 += p1[r]; }
    lrun += rs0 + rs1;
    bf16x8 pb[4];
#pragma unroll
    for (int ks = 0; ks < 2; ++ks) {
        u32x4 w0, w1;
        w0.x = cvtpk(p0[8 * ks + 0], p0[8 * ks + 1]); w0.y = cvtpk(p0[8 * ks + 2], p0[8 * ks + 3]); w0.z = cvtpk(p0[8 * ks + 4], p0[8 * ks + 5]); w0.w = cvtpk(p0[8 * ks + 6], p0[8 * ks + 7]);
        w1.x = cvtpk(p1[8 * ks + 0], p1[8 * ks + 1]); w1.y = cvtpk(p1[8 * ks + 2], p1[8 * ks + 3]); w1.z = cvtpk(p1[8 * ks + 4], p1[8 * ks + 5]); w1.w = cvtpk(p1[8 * ks + 6], p1[8 * ks + 7]);
        pb[ks] = __builtin_bit_cast(bf16x8, w0); pb[2 + ks] = __builtin_bit_cast(bf16x8, w1);
    }
    mid();
    const LAS unsigned char* vb = Vs + r32 * vpitch + hi * 8;
#pragma unroll
    for (int t = 0; t < NT; ++t) {
        s16x4 lo[4], hh[4];
#pragma unroll
        for (int ks = 0; ks < 4; ++ks) { lo[ks] = *(const LAS s16x4*)(vb + t * 32 * vpitch + ks * 32); hh[ks] = *(const LAS s16x4*)(vb + t * 32 * vpitch + ks * 32 + 16); }
        __builtin_amdgcn_sched_barrier(0);
#pragma unroll
        for (int ks = 0; ks < 4; ++ks) { const bf16x8 a = (bf16x8){lo[ks][0], lo[ks][1], lo[ks][2], lo[ks][3], hh[ks][0], hh[ks][1], hh[ks][2], hh[ks][3]}; o[t] = MFMA32(a, pb[ks], o[t]); }
        __builtin_amdgcn_sched_barrier(0);
    }
}

constexpr int MLA_KP = 208, MLA_VP = 264;
constexpr int MLA_KT = 128 * MLA_KP, MLA_VTB = 64 * MLA_VP, MLA_BUF = MLA_KT + MLA_VTB;
__device__ __forceinline__ void mla_unit(LAS unsigned char* lds, int b, int h, int qb, const bf16_t* QM, const bf16_t* KN, const bf16_t* PROJ, const bf16_t* VT, bf16_t* MIX) {
    const int tid = opaque_tid(), lane = tid & 63, r32 = lane & 31, hi = lane >> 5, wid = __builtin_amdgcn_readfirstlane(tid >> 6);
    const size_t tb = (size_t)b * SEQ;
    const int q0 = qb * 256 + wid * 32;
    bf16x8 qf[6];
    { const bf16_t* qr = QM + (tb + q0 + r32) * 768;
#pragma unroll
      for (int s = 0; s < 4; ++s) qf[s] = *(const bf16x8*)(qr + h * 64 + s * 16 + hi * 8);
#pragma unroll
      for (int s = 0; s < 2; ++s) qf[4 + s] = *(const bf16x8*)(qr + 512 + h * 32 + s * 16 + hi * 8); }
    f32x16 o[2], negm;
#pragma unroll
    for (int r = 0; r < 16; ++r) { o[0][r] = 0.f; o[1][r] = 0.f; negm[r] = 0.f; }
    float mref = 0.f, lrun = 0.f;
    const int NCH = 2 * qb + 2;
    const int kr = tid >> 3, kc = tid & 7;
    const int pr = tid >> 2, pc = tid & 3;
    const int vr = tid >> 4, vc = tid & 15;
    const bf16_t* ksrc = KN + (tb + kr) * 512 + h * 64 + kc * 8;
    const bf16_t* psrc = PROJ + (tb + pr) * NPROJ + 2176 + pc * 8;
    const bf16_t* vsrc = VT + (size_t)(h * 64 + vr) * TP + tb + vc * 8;
    struct Stg { u32x4 k0, k1, pe, v0, v1; };
    Stg sa, sb;
    auto stage_load = [&](Stg& s, int ch) { const size_t ko = (size_t)ch * 128;
        s.k0 = *(const u32x4*)(ksrc + ko * 512); s.k1 = *(const u32x4*)(ksrc + (ko + 64) * 512); s.pe = *(const u32x4*)(psrc + ko * NPROJ);
        s.v0 = *(const u32x4*)(vsrc + ko); s.v1 = *(const u32x4*)(vsrc + (size_t)32 * TP + ko); };
    auto stage_write = [&](const Stg& s, int buf) {
        LAS unsigned char* kb = lds + buf * MLA_BUF; LAS unsigned char* vbp = kb + MLA_KT;
        *(LAS u32x4*)(kb + kr * MLA_KP + kc * 16) = s.k0; *(LAS u32x4*)(kb + (kr + 64) * MLA_KP + kc * 16) = s.k1;
        *(LAS u32x4*)(kb + pr * MLA_KP + 128 + pc * 16) = s.pe;
        { LAS unsigned char* d = vbp + vr * MLA_VP + vc * 16; *(LAS u32x2*)d = (u32x2){s.v0.x, s.v0.y}; *(LAS u32x2*)(d + 8) = (u32x2){s.v0.z, s.v0.w}; }
        { LAS unsigned char* d = vbp + (vr + 32) * MLA_VP + vc * 16; *(LAS u32x2*)d = (u32x2){s.v1.x, s.v1.y}; *(LAS u32x2*)(d + 8) = (u32x2){s.v1.z, s.v1.w}; }
    };
    const int qrel = wid * 32 + r32;
    auto compute = [&](int buf, int ch) {
        const LAS unsigned char* kb = lds + buf * MLA_BUF;
#pragma unroll
        for (int j = 0; j < 2; ++j)
            flash_tile<6, 2, 6, true, false>(kb + j * 64 * MLA_KP, MLA_KP, kb + MLA_KT + j * 128, MLA_VP, qf, o, negm, mref, lrun, ch == 0 && j == 0, r32, hi, false, qrel, 0, NoMid());
    };
    auto compute_band = [&](int buf, int ch) {
        const LAS unsigned char* kb = lds + buf * MLA_BUF;
#pragma unroll
        for (int j = 0; j < 2; ++j) {
            const int krel = ch * 128 + j * 64 - qb * 256;
            if (krel <= wid * 32 + 31)
                flash_tile<6, 2, 6, true, true>(kb + j * 64 * MLA_KP, MLA_KP, kb + MLA_KT + j * 128, MLA_VP, qf, o, negm, mref, lrun, ch == 0 && j == 0, r32, hi, true, qrel, krel, NoMid());
        }
    };
    stage_load(sa, 0); stage_write(sa, 0);
    stage_load(sa, 1);
    __syncthreads();
    for (int ch = 0; ch < NCH - 2; ch += 2) {
        stage_load(sb, ch + 2);
        compute(0, ch);
        stage_write(sa, 1);
        __syncthreads();
        stage_load(sa, ch + 3);
        compute(1, ch + 1);
        stage_write(sb, 0);
        __syncthreads();
    }
    {
        compute_band(0, NCH - 2);
        stage_write(sa, 1);
        __syncthreads();
        compute_band(1, NCH - 1);
        __syncthreads();
    }
    const float inv = 1.f / xhalf_sum(lrun);
    bf16_t* orow = MIX + (tb + q0 + r32) * D + h * 64;
#pragma unroll
    for (int t = 0; t < 2; ++t)
#pragma unroll
        for (int g = 0; g < 4; ++g) { u32x2 w; w.x = cvtpk(o[t][4 * g] * inv, o[t][4 * g + 1] * inv); w.y = cvtpk(o[t][4 * g + 2] * inv, o[t][4 * g + 3] * inv);
            *(u32x2*)(orow + 32 * t + 8 * g + 4 * hi) = w; }
}

constexpr int XA_KP = 528, XA_VP = 136;
constexpr int XA_KT = 64 * XA_KP, XA_VTB = 128 * XA_VP;
__device__ __forceinline__ void xattn_unit(LAS unsigned char* lds, int b, int h, int qb, int dvh, const bf16_t* QX, const bf16_t* KX, const bf16_t* VXT, bf16_t* OX) {
    const int tid = opaque_tid(), lane = tid & 63, r32 = lane & 31, hi = lane >> 5, wid = __builtin_amdgcn_readfirstlane(tid >> 6);
    const size_t tb = (size_t)b * SEQ;
    const int q0 = qb * 256 + wid * 32;
    bf16x8 qf[16];
    { const bf16_t* qr = QX + (tb + q0 + r32) * D + h * 256 + hi * 8;
#pragma unroll
      for (int s = 0; s < 16; ++s) qf[s] = *(const bf16x8*)(qr + s * 16); }
    f32x16 o[4], negm;
#pragma unroll
    for (int t = 0; t < 4; ++t)
#pragma unroll
        for (int r = 0; r < 16; ++r) o[t][r] = 0.f;
#pragma unroll
    for (int r = 0; r < 16; ++r) negm[r] = 0.f;
    float mref = 0.f, lrun = 0.f;
    const bf16_t* kbase = KX + (size_t)(b * 256) * D + h * 256;
    const bf16_t* vbase = VXT + (size_t)(h * 256 + dvh * 128) * D + b * 256;
    u32x4 kreg[4], vreg[2];
    auto stage_load = [&](int kt) {
#pragma unroll
        for (int i = 0; i < 4; ++i) { const int idx = tid + 512 * i, row = idx >> 5, c = idx & 31; kreg[i] = *(const u32x4*)(kbase + (size_t)(kt * 64 + row) * D + c * 8); }
#pragma unroll
        for (int i = 0; i < 2; ++i) { const int idx = tid + 512 * i, dv = idx >> 3, c = idx & 7; vreg[i] = *(const u32x4*)(vbase + (size_t)dv * D + kt * 64 + c * 8); }
    };
    auto stage_write = [&](int buf) {
        LAS unsigned char* kb = lds + buf * (XA_KT + XA_VTB); LAS unsigned char* vbp = kb + XA_KT;
#pragma unroll
        for (int i = 0; i < 4; ++i) { const int idx = tid + 512 * i, row = idx >> 5, c = idx & 31; *(LAS u32x4*)(kb + row * XA_KP + c * 16) = kreg[i]; }
#pragma unroll
        for (int i = 0; i < 2; ++i) { const int idx = tid + 512 * i, dv = idx >> 3, c = idx & 7;
            *(LAS u32x2*)(vbp + dv * XA_VP + c * 16) = (u32x2){vreg[i].x, vreg[i].y}; *(LAS u32x2*)(vbp + dv * XA_VP + c * 16 + 8) = (u32x2){vreg[i].z, vreg[i].w}; }
    };
    stage_load(0); stage_write(0);
    __syncthreads();
    for (int kt = 0; kt < 4; ++kt) {
        const int buf = kt & 1;
        const LAS unsigned char* kb = lds + buf * (XA_KT + XA_VTB);
        auto mid = [&]() { if (kt + 1 < 4) stage_load(kt + 1); };
        flash_tile<16, 4, 4, false, false>(kb, XA_KP, kb + XA_KT, XA_VP, qf, o, negm, mref, lrun, kt == 0, r32, hi, false, 0, 0, mid);
        if (kt + 1 < 4) stage_write(buf ^ 1);
        __syncthreads();
    }
    const float inv = 1.f / xhalf_sum(lrun);
    bf16_t* orow = OX + (tb + q0 + r32) * D + h * 256 + dvh * 128;
#pragma unroll
    for (int t = 0; t < 4; ++t)
#pragma unroll
        for (int g = 0; g < 4; ++g) { u32x2 w; w.x = cvtpk(o[t][4 * g] * inv, o[t][4 * g + 1] * inv); w.y = cvtpk(o[t][4 * g + 2] * inv, o[t][4 * g + 3] * inv);
            *(u32x2*)(orow + 32 * t + 8 * g + 4 * hi) = w; }
}

constexpr int RT_P = 272;
constexpr int RT_PV = 264;
__device__ __forceinline__ float ret_log2g(int h) { return log2f(1.0f - exp2f(-5.0f - (float)h)); }
__device__ __forceinline__ void ret_state_unit(LAS unsigned char* lds, int unit, const bf16_t* PROJ, const bf16_t* RVT, bf16_t* RKVT) {
    const int tid = opaque_tid(), lane = tid & 63, r32 = lane & 31, hi = lane >> 5, wid = __builtin_amdgcn_readfirstlane(tid >> 6);
    const int n = unit & 31, h = (unit >> 5) & 3, b = unit >> 7;
    const size_t t0 = (size_t)b * SEQ + n * 128;
    const float l2g = ret_log2g(h);
    LAS unsigned char* Vs = lds;
    LAS unsigned char* Ks = lds + 128 * RT_P;
#pragma unroll
    for (int i = 0; i < 4; ++i) { const int idx = tid + 512 * i, e = idx >> 4, c = idx & 15;
        *(LAS u32x4*)(Vs + e * RT_P + c * 16) = *(const u32x4*)(RVT + (size_t)(h * 128 + e) * TP + t0 + c * 8); }
#pragma unroll
    for (int i = 0; i < 4; ++i) { const int idx = tid + 512 * i, j = idx >> 4, c = idx & 15;
        const u32x4 v = *(const u32x4*)(PROJ + (t0 + j) * NPROJ + 1152 + h * 128 + c * 8);
        const float z = exp2f((float)(127 - j) * l2g);
        const unsigned w[4] = {v.x, v.y, v.z, v.w};
#pragma unroll
        for (int q = 0; q < 4; ++q) { const float lo = bf2f((unsigned short)(w[q] & 0xffffu)) * z, hh = bf2f((unsigned short)(w[q] >> 16)) * z; const unsigned pk = cvtpk(lo, hh);
            *(LAS unsigned short*)(Ks + (c * 8 + 2 * q) * RT_P + j * 2) = (unsigned short)(pk & 0xffffu); *(LAS unsigned short*)(Ks + (c * 8 + 2 * q + 1) * RT_P + j * 2) = (unsigned short)(pk >> 16); } }
    __syncthreads();
    const int eb = (wid & 3) * 32, db = (wid >> 2) * 64;
    f32x16 acc[2];
#pragma unroll
    for (int t = 0; t < 2; ++t)
#pragma unroll
        for (int r = 0; r < 16; ++r) acc[t][r] = 0.f;
#pragma unroll
    for (int ks = 0; ks < 8; ++ks) {
        const bf16x8 a = *(const LAS bf16x8*)(Vs + (eb + r32) * RT_P + ks * 32 + hi * 16);
#pragma unroll
        for (int t = 0; t < 2; ++t) { const bf16x8 bb = *(const LAS bf16x8*)(Ks + (db + 32 * t + r32) * RT_P + ks * 32 + hi * 16); acc[t] = MFMA32(a, bb, acc[t]); }
    }
    bf16_t* O = RKVT + (size_t)unit * 16384;
#pragma unroll
    for (int t = 0; t < 2; ++t)
#pragma unroll
        for (int r = 0; r < 16; ++r) { const unsigned pk = cvtpk(acc[t][r], 0.f); O[(size_t)(eb + crow(r, hi)) * 128 + db + 32 * t + r32] = (unsigned short)(pk & 0xffffu); }
    __syncthreads();
}
__device__ __forceinline__ void ret_out_unit(LAS unsigned char* lds, int unit, const bf16_t* PROJ, const bf16_t* RVT, const bf16_t* RKVT, const float* g_gn, bf16_t* MIX) {
    const int tid = opaque_tid(), lane = tid & 63, r32 = lane & 31, hi = lane >> 5, wid = __builtin_amdgcn_readfirstlane(tid >> 6);
    const int n = unit & 31, h = (unit >> 5) & 3, b = unit >> 7;
    const size_t t0 = (size_t)b * SEQ + n * 128;
    const float l2g = ret_log2g(h);
    LAS unsigned char* Ks = lds;
    LAS unsigned char* Vs = lds + 128 * RT_P;
    LAS unsigned char* Rs = Vs + 128 * RT_PV;
    LAS float* Xs = (LAS float*)(Rs + 128 * RT_P);
#pragma unroll
    for (int i = 0; i < 4; ++i) { const int idx = tid + 512 * i, j = idx >> 4, c = idx & 15;
        *(LAS u32x4*)(Ks + j * RT_P + c * 16) = *(const u32x4*)(PROJ + (t0 + j) * NPROJ + 1152 + h * 128 + c * 8); }
#pragma unroll
    for (int i = 0; i < 4; ++i) { const int idx = tid + 512 * i, e = idx >> 4, c = idx & 15;
        const u32x4 v = *(const u32x4*)(RVT + (size_t)(h * 128 + e) * TP + t0 + c * 8);
        *(LAS u32x2*)(Vs + e * RT_PV + c * 16) = (u32x2){v.x, v.y}; *(LAS u32x2*)(Vs + e * RT_PV + c * 16 + 8) = (u32x2){v.z, v.w}; }
    {
        const bf16_t* src = RKVT + (size_t)unit * 16384;
#pragma unroll
        for (int i = 0; i < 4; ++i) { const int idx = tid + 512 * i, e = idx >> 4, c = idx & 15; *(LAS u32x4*)(Rs + e * RT_P + c * 16) = *(const u32x4*)(src + idx * 8); }
    }
    const int ib = wid & 3, eh = wid >> 2;
    bf16x8 qf[8];
    { const bf16_t* qr = PROJ + (t0 + ib * 32 + r32) * NPROJ + 640 + h * 128 + hi * 8;
#pragma unroll
      for (int s = 0; s < 8; ++s) qf[s] = *(const bf16x8*)(qr + s * 16); }
    __syncthreads();
    f32x16 oi[2], oc[2];
#pragma unroll
    for (int t = 0; t < 2; ++t)
#pragma unroll
        for (int r = 0; r < 16; ++r) { oi[t][r] = 0.f; oc[t][r] = 0.f; }
#pragma unroll
    for (int s = 0; s < 8; ++s)
#pragma unroll
        for (int t = 0; t < 2; ++t) { const bf16x8 a = *(const LAS bf16x8*)(Rs + (eh * 64 + t * 32 + r32) * RT_P + s * 32 + hi * 16); oc[t] = MFMA32(a, qf[s], oc[t]); }
    for (int jt = 0; jt <= ib; ++jt) {
        f32x16 p;
#pragma unroll
        for (int r = 0; r < 16; ++r) p[r] = 0.f;
#pragma unroll
        for (int s = 0; s < 8; ++s) { const bf16x8 a = *(const LAS bf16x8*)(Ks + (jt * 32 + r32) * RT_P + s * 32 + hi * 16); p = MFMA32(a, qf[s], p); }
        const int dbase = (ib - jt) * 32 + r32;
#pragma unroll
        for (int r = 0; r < 16; ++r) { const int dd = dbase - crow(r, hi); p[r] = dd >= 0 ? p[r] * exp2f((float)dd * l2g) : 0.f; }
        bf16x8 pb[2];
#pragma unroll
        for (int ks = 0; ks < 2; ++ks) { u32x4 w; w.x = cvtpk(p[8 * ks + 0], p[8 * ks + 1]); w.y = cvtpk(p[8 * ks + 2], p[8 * ks + 3]); w.z = cvtpk(p[8 * ks + 4], p[8 * ks + 5]); w.w = cvtpk(p[8 * ks + 6], p[8 * ks + 7]); pb[ks] = __builtin_bit_cast(bf16x8, w); }
#pragma unroll
        for (int t = 0; t < 2; ++t)
#pragma unroll
            for (int ks = 0; ks < 2; ++ks) { const LAS unsigned char* vp = Vs + (eh * 64 + t * 32 + r32) * RT_PV + (jt * 32 + ks * 16) * 2 + hi * 8;
                const s16x4 lo = *(const LAS s16x4*)vp, hh = *(const LAS s16x4*)(vp + 16);
                const bf16x8 a = (bf16x8){lo[0], lo[1], lo[2], lo[3], hh[0], hh[1], hh[2], hh[3]}; oi[t] = MFMA32(a, pb[ks], oi[t]); }
    }
    const float xi = exp2f((float)(ib * 32 + r32 + 1) * l2g);
    float s1 = 0.f, s2 = 0.f;
#pragma unroll
    for (int t = 0; t < 2; ++t)
#pragma unroll
        for (int r = 0; r < 16; ++r) { const float v = oi[t][r] + oc[t][r] * xi; oi[t][r] = v; s1 += v; s2 += v * v; }
    s1 = xhalf_sum(s1); s2 = xhalf_sum(s2);
    if (hi == 0) { Xs[(wid * 32 + r32) * 2] = s1; Xs[(wid * 32 + r32) * 2 + 1] = s2; }
    __syncthreads();
    { const int ow = wid ^ 4; s1 += Xs[(ow * 32 + r32) * 2]; s2 += Xs[(ow * 32 + r32) * 2 + 1]; }
    const float mean = s1 * (1.f / 128.f), var = fmaxf(s2 * (1.f / 128.f) - mean * mean, 0.f), rstd = rsqrtf(var + EPS);
    const size_t trow = t0 + ib * 32 + r32;
    const bf16_t* grow = PROJ + trow * NPROJ + 1664 + h * 128;
    bf16_t* orow = MIX + trow * D + 512 + h * 128;
#pragma unroll
    for (int t = 0; t < 2; ++t)
#pragma unroll
        for (int g = 0; g < 4; ++g) { const int e = eh * 64 + t * 32 + 8 * g + 4 * hi;
            const u32x2 gg = *(const u32x2*)(grow + e); const f32x4 gn = *(const f32x4*)(g_gn + h * 128 + e);
            const float rg[4] = {bf2f((unsigned short)(gg.x & 0xffffu)), bf2f((unsigned short)(gg.x >> 16)), bf2f((unsigned short)(gg.y & 0xffffu)), bf2f((unsigned short)(gg.y >> 16))};
            float y[4];
#pragma unroll
            for (int q = 0; q < 4; ++q) { const float sil = rg[q] / (1.f + __expf(-rg[q])); y[q] = (oi[t][4 * g + q] - mean) * rstd * gn[q] * sil; }
            u32x2 w; w.x = cvtpk(y[0], y[1]); w.y = cvtpk(y[2], y[3]); *(u32x2*)(orow + e) = w; }
    __syncthreads();
}

constexpr int PK_P = 272;
constexpr int PEER_SK = 0, PEER_LST = 2 * 128 * PK_P;
constexpr int PEER_ENT = PEER_LST + NWAVES * 4096;
__device__ __forceinline__ unsigned f_ord(float f) { const unsigned u = __float_as_uint(f); return u ^ ((unsigned)((int)u >> 31) | 0x80000000u); }
__device__ __forceinline__ float f_unord(unsigned k) { return __uint_as_float((k & 0x80000000u) ? (k ^ 0x80000000u) : ~k); }
#define TK_INS(L, x) do { unsigned _x = (x); _Pragma("unroll") for (int _j = 0; _j < 16; ++_j) { const unsigned _h = max(_x, L[_j]); _x = min(_x, L[_j]); L[_j] = _h; } } while (0)
#define TK_CE(a, b) do { const unsigned _hi = max((a), (b)), _lo = min((a), (b)); (a) = _hi; (b) = _lo; } while (0)
__device__ __forceinline__ void tk_sort16(unsigned (&v)[16]) {
#pragma unroll
    for (int k = 2; k <= 16; k <<= 1)
#pragma unroll
        for (int j = k >> 1; j >= 1; j >>= 1)
#pragma unroll
            for (int i = 0; i < 16; ++i) { const int l = i ^ j; if (l > i) { if ((i & k) == 0) TK_CE(v[i], v[l]); else TK_CE(v[l], v[i]); } }
}
__device__ __forceinline__ void tk_merge16(unsigned (&a)[16], const unsigned (&b)[16]) {
#pragma unroll
    for (int i = 0; i < 16; ++i) a[i] = max(a[i], b[15 - i]);
#pragma unroll
    for (int st = 8; st >= 1; st >>= 1)
#pragma unroll
        for (int i = 0; i < 16; ++i) if ((i & st) == 0) TK_CE(a[i], a[i + st]);
}
__device__ __forceinline__ void tk_merge_partner(unsigned (&L)[16], int hi) {
    unsigned M[16];
#pragma unroll
    for (int i = 0; i < 16; ++i) { const unsigned o = xhalf_other(L[15 - i], hi); M[i] = max(L[i], o); }
#pragma unroll
    for (int st = 8; st >= 1; st >>= 1)
#pragma unroll
        for (int i = 0; i < 16; ++i) if ((i & st) == 0) { const unsigned a = max(M[i], M[i + st]), bq = min(M[i], M[i + st]); M[i] = a; M[i + st] = bq; }
#pragma unroll
    for (int i = 0; i < 16; ++i) L[i] = M[i];
}

template <bool RETR_ONLY>
__device__ __forceinline__ void peer_phase(LAS unsigned char* lds, const Params& p, int vcu, int G) {
    const int tid = opaque_tid(), lane = tid & 63, r32 = lane & 31, hi = lane >> 5, wid = __builtin_amdgcn_readfirstlane(tid >> 6);
    const bf16_t* SK = (const bf16_t*)(p.ws + WS_SK); const bf16_t* QP = (const bf16_t*)(p.ws + WS_QP);
    const unsigned char* U8 = p.ws + WS_U8; const float* ssq2 = (const float*)(p.ws + WS_SSQ2); unsigned* EG = (unsigned*)(p.ws + WS_EG); float* WG = (float*)(p.ws + WS_WG);
    for (int idx = tid; idx < 2 * 128 * 16; idx += 512) { const int row = idx >> 4, c = idx & 15; *(LAS u32x4*)(lds + PEER_SK + row * PK_P + c * 16) = *(const u32x4*)(SK + row * 128 + c * 8); }
    __syncthreads();
    LAS unsigned* LST = (LAS unsigned*)(lds + PEER_LST + wid * 4096);
    LAS u32x2* ENT = (LAS u32x2*)(lds + PEER_ENT + wid * 4096);
    for (int grp = vcu * NWAVES + wid; grp < T / 4; grp += G * NWAVES) {
        const int tok0 = grp * 4;
        int lg = lane; asm volatile("" : "+v"(lg));
        const int r32 = lg & 31, hi = lg >> 5;
        const unsigned hi4 = (unsigned)hi << 2;
        {
            const bf16_t* qrow = QP + (size_t)(tok0 + (r32 >> 3)) * 2048 + (r32 & 7) * 256 + hi * 8;
            unsigned LA[16], LB[16];
#pragma unroll
            for (int pp = 0; pp < 2; ++pp) {
                bf16x8 qf[8];
#pragma unroll
                for (int s = 0; s < 8; ++s) qf[s] = *(const bf16x8*)(qrow + pp * 128 + s * 16);
                unsigned L[16];
#pragma unroll
                for (int i = 0; i < 16; ++i) L[i] = 0u;
#pragma unroll
                for (int kt = 0; kt < 4; ++kt) {
                    f32x16 sc;
#pragma unroll
                    for (int r = 0; r < 16; ++r) sc[r] = 0.f;
#pragma unroll
                    for (int s = 0; s < 8; ++s) { const bf16x8 a = *(const LAS bf16x8*)(lds + PEER_SK + (pp * 128 + kt * 32 + r32) * PK_P + s * 32 + hi * 16); sc = MFMA32(a, qf[s], sc); }
                    { unsigned kv[16];
#pragma unroll
                      for (int r = 0; r < 16; ++r) { const unsigned code = 127u - (unsigned)(32 * kt + (r & 3) + 8 * (r >> 2)); kv[r] = ((f_ord(sc[r]) & ~0x7Fu) | code) ^ hi4; }
                      tk_sort16(kv);
                      if (kt == 0) {
#pragma unroll
                          for (int r = 0; r < 16; ++r) L[r] = kv[r];
                      } else tk_merge16(L, kv); }
                }
                tk_merge_partner(L, hi);
#pragma unroll
                for (int i = 0; i < 16; ++i) { if (pp == 0) LA[i] = L[i]; else LB[i] = L[i]; }
            }
#pragma unroll
            for (int i = 0; i < 16; ++i) { LST[i * 32 + r32] = LA[i]; LST[(16 + i) * 32 + r32] = LB[i]; }
            float va[16], vb[16];
#pragma unroll
            for (int i = 0; i < 16; ++i) { va[i] = f_unord(LA[i] & ~0x7Fu); vb[i] = f_unord(LB[i] & ~0x7Fu); }
            unsigned C[16];
#pragma unroll
            for (int j = 0; j < 16; ++j) C[j] = (f_ord(va[0] + vb[j]) & ~0xFFu) | (255u - (unsigned)j);
#pragma unroll
            for (int i = 1; i < 16; ++i)
#pragma unroll
                for (int j = 0; j < 16; ++j) if ((i + 1) * (j + 1) <= 16) { const unsigned code = 255u - (unsigned)(16 * i + j); TK_INS(C, (f_ord(va[i] + vb[j]) & ~0xFFu) | code); }
            LDS_WAIT();
            float bs[16]; unsigned ex[16]; float mx = -1e30f;
#pragma unroll
            for (int k = 0; k < 16; ++k) { const unsigned code = 255u - (C[k] & 0xFFu); const unsigned i = code >> 4, j = code & 15u;
                const unsigned ka = LST[i * 32 + r32], kbq = LST[(16 + j) * 32 + r32];
                bs[k] = f_unord(ka & ~0x7Fu) + f_unord(kbq & ~0x7Fu); ex[k] = (127u - (ka & 0x7Fu)) * 128u + (127u - (kbq & 0x7Fu)); mx = fmaxf(mx, bs[k]); }
            float sum = 0.f;
#pragma unroll
            for (int k = 0; k < 16; ++k) { bs[k] = __expf(bs[k] - mx); sum += bs[k]; }
            const float rinv = 1.f / sum;
            if (hi == 0) {
#pragma unroll
                for (int k = 0; k < 16; ++k) ENT[(r32 >> 3) * 128 + (r32 & 7) * 16 + k] = (u32x2){ex[k], __float_as_uint(bs[k] * rinv)};
            }
            LDS_WAIT();
        }
        if (RETR_ONLY) {
            for (int tk = 0; tk < 4; ++tk) { const int t = tok0 + tk;
                int ln = lane; asm volatile("" : "+v"(ln));
                const u32x2 a0 = ENT[tk * 128 + ln], a1 = ENT[tk * 128 + 64 + ln];
                const int j0 = 16 * (ln & 7) + (ln >> 3), j1 = j0 + 8;
                EG[(size_t)t * 128 + j0] = a0.x; WG[(size_t)t * 128 + j0] = __uint_as_float(a0.y);
                EG[(size_t)t * 128 + j1] = a1.x; WG[(size_t)t * 128 + j1] = __uint_as_float(a1.y); }
            continue;
        }
        for (int tk = 0; tk < 4; ++tk) {
            const int t = tok0 + tk;
            int ln = lane; asm volatile("" : "+v"(ln));
            const bf16_t* hrow = (const bf16_t*)(p.ws + WS_H2B) + (size_t)t * D + ln * 16;
            f32x2 hv[8];
#pragma unroll
            for (int i = 0; i < 2; ++i) { const u32x4 v = *(const u32x4*)(hrow + 8 * i); const unsigned w[4] = {v.x, v.y, v.z, v.w};
#pragma unroll
                for (int q = 0; q < 4; ++q) hv[4 * i + q] = (f32x2){bf2f((unsigned short)(w[q] & 0xffffu)), bf2f((unsigned short)(w[q] >> 16))}; }
            const float rstd2 = rsqrtf(ssq_sum<16>(ssq2 + (size_t)t * 16) * (1.f / D) + EPS);
            EG[(size_t)t * 128 + ln] = ENT[tk * 128 + ln].x; EG[(size_t)t * 128 + 64 + ln] = ENT[tk * 128 + 64 + ln].x;
            u32x4 ua[16], ub[16];
            { const unsigned ex = ENT[tk * 128 + (ln & 15)].x;
#pragma unroll
              for (int k = 0; k < 16; ++k) { const unsigned e = (unsigned)__builtin_amdgcn_readlane((int)ex, k); ua[k] = *(const u32x4*)(U8 + (size_t)e * D + ln * 16); } }
            auto head = [&](u32x4 (&cur)[16], u32x4 (&nxt)[16], int hd) {
                if (hd < 7) { const unsigned ex = ENT[tk * 128 + (hd + 1) * 16 + (ln & 15)].x;
#pragma unroll
                    for (int k = 0; k < 16; ++k) { const unsigned e = (unsigned)__builtin_amdgcn_readlane((int)ex, k); nxt[k] = *(const u32x4*)(U8 + (size_t)e * D + ln * 16); } }
                const float gate = __uint_as_float(ENT[tk * 128 + hd * 16 + ((ln >> 2) & 15)].y);
                float dt[16];
#pragma unroll
                for (int k = 0; k < 16; ++k) { f32x2 a0 = (f32x2){0.f, 0.f}, a1 = (f32x2){0.f, 0.f}; const unsigned w[4] = {cur[k].x, cur[k].y, cur[k].z, cur[k].w};
#pragma unroll
                    for (int q = 0; q < 4; ++q) { const f32x2 lo = __builtin_amdgcn_cvt_pk_f32_fp8((int)w[q], false), h2 = __builtin_amdgcn_cvt_pk_f32_fp8((int)w[q], true);
                        a0 += lo * hv[2 * q]; a1 += h2 * hv[2 * q + 1]; }
                    const f32x2 a = a0 + a1; dt[k] = a[0] + a[1]; if (k & 1) __builtin_amdgcn_sched_barrier(0); }
                float y8[8], y4[4], y2[2], y1;
                { const bool bsel = (ln & 32) != 0;
#pragma unroll
                  for (int k = 0; k < 8; ++k) { const float snd = bsel ? dt[k] : dt[k + 8], kp = bsel ? dt[k + 8] : dt[k]; y8[k] = kp + __shfl_xor(snd, 32); } }
                { const bool bsel = (ln & 16) != 0;
#pragma unroll
                  for (int k = 0; k < 4; ++k) { const float snd = bsel ? y8[k] : y8[k + 4], kp = bsel ? y8[k + 4] : y8[k]; y4[k] = kp + __shfl_xor(snd, 16); } }
                { const bool bsel = (ln & 8) != 0;
#pragma unroll
                  for (int k = 0; k < 2; ++k) { const float snd = bsel ? y4[k] : y4[k + 2], kp = bsel ? y4[k + 2] : y4[k]; y2[k] = kp + __shfl_xor(snd, 8); } }
                { const bool bsel = (ln & 4) != 0; const float snd = bsel ? y2[0] : y2[1], kp = bsel ? y2[1] : y2[0]; y1 = kp + __shfl_xor(snd, 4); }
                y1 += __shfl_xor(y1, 2); y1 += __shfl_xor(y1, 1);
                const float act = y1 * rstd2 * (1.f / U_SCALE);
                const float wgt = gate * gelu_f(act) * (1.f / V_SCALE);
                if ((ln & 3) == 0) WG[(size_t)t * 128 + hd * 16 + ((ln >> 2) & 15)] = wgt;
            };
            for (int hd = 0; hd < 8; hd += 2) { head(ua, ub, hd); head(ub, ua, hd + 1); }
        }
    }
}

__device__ __forceinline__ void peer_v_phase(const Params& p, int vcu, int G) {
    const int tid = opaque_tid(), lane = tid & 63, wid = __builtin_amdgcn_readfirstlane(tid >> 6);
    const unsigned char* V8 = p.ws + WS_V8; const unsigned* EG = (const unsigned*)(p.ws + WS_EG); const float* WG = (const float*)(p.ws + WS_WG);
    for (int grp = vcu * NWAVES + wid; grp < T / 4; grp += G * NWAVES) {
        for (int tk = 0; tk < 4; ++tk) {
            const int t = grp * 4 + tk;
            int ln = lane; asm volatile("" : "+v"(ln));
            const unsigned e0 = EG[(size_t)t * 128 + ln], e1 = EG[(size_t)t * 128 + 64 + ln];
            const float w0 = WG[(size_t)t * 128 + ln], w1 = WG[(size_t)t * 128 + 64 + ln];
            f32x2 ov[8];
#pragma unroll
            for (int i = 0; i < 8; ++i) ov[i] = (f32x2){0.f, 0.f};
            u32x4 va[16], vb[16];
#pragma unroll
            for (int k = 0; k < 16; ++k) { const unsigned e = (unsigned)__builtin_amdgcn_readlane((int)e0, k); va[k] = *(const u32x4*)(V8 + (size_t)e * D + ln * 16); }
            auto head = [&](u32x4 (&cur)[16], u32x4 (&nxt)[16], int hd) {
                if (hd < 7) { const int h1 = hd + 1; const unsigned er = (h1 & 4) ? e1 : e0; const int lb = (h1 & 3) * 16;
#pragma unroll
                    for (int k = 0; k < 16; ++k) { const unsigned e = (unsigned)__builtin_amdgcn_readlane((int)er, lb + k); nxt[k] = *(const u32x4*)(V8 + (size_t)e * D + ln * 16); } }
                const float wr = (hd & 4) ? w1 : w0; const int lb0 = (hd & 3) * 16;
#pragma unroll
                for (int k = 0; k < 16; ++k) { const float wk = __uint_as_float((unsigned)__builtin_amdgcn_readlane((int)__float_as_uint(wr), lb0 + k)); const f32x2 wk2 = (f32x2){wk, wk};
                    const unsigned w[4] = {cur[k].x, cur[k].y, cur[k].z, cur[k].w};
#pragma unroll
                    for (int q = 0; q < 4; ++q) { const f32x2 lo = __builtin_amdgcn_cvt_pk_f32_fp8((int)w[q], false), h2 = __builtin_amdgcn_cvt_pk_f32_fp8((int)w[q], true);
                        ov[2 * q] += wk2 * lo; ov[2 * q + 1] += wk2 * h2; }
                    if (k & 1) __builtin_amdgcn_sched_barrier(0); }
            };
            for (int hd = 0; hd < 8; hd += 2) { head(va, vb, hd); head(vb, va, hd + 1); }
            float* hrow = p.out + (size_t)t * D + ln * 16;
            const bf16_t* hb = (const bf16_t*)(p.ws + WS_H2B) + (size_t)t * D + ln * 16;
            float ss = 0.f; f32x4 h3[4];
#pragma unroll
            for (int q2 = 0; q2 < 2; ++q2) { const u32x4 v = *(const u32x4*)(hb + 8 * q2);
                h3[2 * q2] = (f32x4){bf2f((unsigned short)(v.x & 0xffffu)), bf2f((unsigned short)(v.x >> 16)), bf2f((unsigned short)(v.y & 0xffffu)), bf2f((unsigned short)(v.y >> 16))};
                h3[2 * q2 + 1] = (f32x4){bf2f((unsigned short)(v.z & 0xffffu)), bf2f((unsigned short)(v.z >> 16)), bf2f((unsigned short)(v.w & 0xffffu)), bf2f((unsigned short)(v.w >> 16))}; }
#pragma unroll
            for (int q = 0; q < 4; ++q) { h3[q] = h3[q] + (f32x4){ov[2 * q][0], ov[2 * q][1], ov[2 * q + 1][0], ov[2 * q + 1][1]};
                ss += (h3[q][0] * h3[q][0] + h3[q][1] * h3[q][1]) + (h3[q][2] * h3[q][2] + h3[q][3] * h3[q][3]); }
            const float rstd3 = rsqrtf(wave_sum(ss) * (1.f / D) + EPS);
#pragma unroll
            for (int q = 0; q < 4; ++q) { const f32x4 gf = *(const f32x4*)(p.g_final + ln * 16 + 4 * q); *(f32x4*)(hrow + 4 * q) = h3[q] * rstd3 * gf; }
        }
    }
}

template <bool VSIDE>
__device__ __forceinline__ void peer_slice_tokens(const Params& p, int x, int w0, int nwv, int lane) {
    const unsigned char* TB = p.ws + (VSIDE ? WS_V8 : WS_U8) + (size_t)x * (16384 * 128);
    const unsigned* EG = (const unsigned*)(p.ws + WS_EG); const float* WG = (const float*)(p.ws + WS_WG);
    const bf16_t* H2 = (const bf16_t*)(p.ws + WS_H2B) + 128 * x;
    float* PART = (float*)(p.ws + WS_PART) + (size_t)x * T * 128; float* SSQ3 = (float*)(p.ws + WS_SSQ3);
    int ln = lane; asm volatile("" : "+v"(ln));
    const int r = ln >> 3, c = ln & 7;
    if (w0 >= T) return;
    u32x4 idn[4];
    f32x4 wn[4], wc[4];
    u32x4 hn[2], hc[2];
    u32x4 ra[16], rb[16];
    auto load_meta = [&](int t) {
#pragma unroll
        for (int q = 0; q < 4; ++q) idn[q] = *(const u32x4*)(EG + (size_t)t * 128 + 16 * r + 4 * q);
        if (VSIDE) {
#pragma unroll
            for (int q = 0; q < 4; ++q) wn[q] = *(const f32x4*)(WG + (size_t)t * 128 + 16 * r + 4 * q);
        } else { hn[0] = *(const u32x4*)(H2 + (size_t)t * D + 16 * c); hn[1] = *(const u32x4*)(H2 + (size_t)t * D + 16 * c + 8); }
    };
    auto issue = [&](u32x4 (&buf)[16]) {
#pragma unroll
        for (int q = 0; q < 4; ++q) { const unsigned e4[4] = {idn[q].x, idn[q].y, idn[q].z, idn[q].w};
#pragma unroll
            for (int j = 0; j < 4; ++j) buf[4 * q + j] = *(const u32x4*)(TB + (e4[j] * 128u + 16u * (unsigned)c)); }
    };
    auto compute = [&](u32x4 (&cur)[16], int t) {
        if (!VSIDE) {
            f32x2 hv[8];
#pragma unroll
            for (int i2 = 0; i2 < 2; ++i2) { const unsigned w[4] = {hc[i2].x, hc[i2].y, hc[i2].z, hc[i2].w};
#pragma unroll
                for (int q = 0; q < 4; ++q) hv[4 * i2 + q] = (f32x2){bf2f((unsigned short)(w[q] & 0xffffu)), bf2f((unsigned short)(w[q] >> 16))}; }
            float dt[16];
#pragma unroll
            for (int i = 0; i < 16; ++i) { f32x2 a0 = (f32x2){0.f, 0.f}, a1 = (f32x2){0.f, 0.f}; const unsigned w[4] = {cur[i].x, cur[i].y, cur[i].z, cur[i].w};
#pragma unroll
                for (int q = 0; q < 4; ++q) { const f32x2 lo = __builtin_amdgcn_cvt_pk_f32_fp8((int)w[q], false), h2 = __builtin_amdgcn_cvt_pk_f32_fp8((int)w[q], true);
                    a0 += lo * hv[2 * q]; a1 += h2 * hv[2 * q + 1]; }
                const f32x2 a = a0 + a1; dt[i] = a[0] + a[1]; if (i & 1) __builtin_amdgcn_sched_barrier(0); }
            float y8[8], y4[4], y2[2];
            { const bool bs = (ln & 4) != 0;
#pragma unroll
              for (int k = 0; k < 8; ++k) { const float snd = bs ? dt[k] : dt[k + 8], kp = bs ? dt[k + 8] : dt[k]; y8[k] = kp + shx<4>(snd, ln); } }
            { const bool bs = (ln & 2) != 0;
#pragma unroll
              for (int k = 0; k < 4; ++k) { const float snd = bs ? y8[k] : y8[k + 4], kp = bs ? y8[k + 4] : y8[k]; y4[k] = kp + shx<2>(snd, ln); } }
            { const bool bs = (ln & 1) != 0;
#pragma unroll
              for (int k = 0; k < 2; ++k) { const float snd = bs ? y4[k] : y4[k + 2], kp = bs ? y4[k + 2] : y4[k]; y2[k] = kp + shx<1>(snd, ln); } }
            *(f32x2*)(PART + (size_t)t * 128 + 2 * ln) = (f32x2){y2[0], y2[1]};
        } else {
            f32x2 ov[8];
#pragma unroll
            for (int q = 0; q < 8; ++q) ov[q] = (f32x2){0.f, 0.f};
#pragma unroll
            for (int i = 0; i < 16; ++i) { const float wk = wc[i >> 2][i & 3]; const f32x2 wk2 = (f32x2){wk, wk}; const unsigned w[4] = {cur[i].x, cur[i].y, cur[i].z, cur[i].w};
#pragma unroll
                for (int q = 0; q < 4; ++q) { const f32x2 lo = __builtin_amdgcn_cvt_pk_f32_fp8((int)w[q], false), h2 = __builtin_amdgcn_cvt_pk_f32_fp8((int)w[q], true);
                    ov[2 * q] += wk2 * lo; ov[2 * q + 1] += wk2 * h2; }
                if (i & 1) __builtin_amdgcn_sched_barrier(0); }
            f32x2 z4[4], z2[2], z1;
            { const bool bs = (ln & 32) != 0;
#pragma unroll
              for (int k = 0; k < 4; ++k) { const f32x2 snd = bs ? ov[k] : ov[k + 4], kp = bs ? ov[k + 4] : ov[k]; z4[k] = kp + (f32x2){shx<32>(snd[0], ln), shx<32>(snd[1], ln)}; } }
            { const bool bs = (ln & 16) != 0;
#pragma unroll
              for (int k = 0; k < 2; ++k) { const f32x2 snd = bs ? z4[k] : z4[k + 2], kp = bs ? z4[k + 2] : z4[k]; z2[k] = kp + (f32x2){shx<16>(snd[0], ln), shx<16>(snd[1], ln)}; } }
            { const bool bs = (ln & 8) != 0; const f32x2 snd = bs ? z2[0] : z2[1], kp = bs ? z2[1] : z2[0]; z1 = kp + (f32x2){shx<8>(snd[0], ln), shx<8>(snd[1], ln)}; }
            const int dd = 16 * c + ((ln >> 5) & 1) * 8 + ((ln >> 4) & 1) * 4 + ((ln >> 3) & 1) * 2;
            const unsigned hb = *(const unsigned*)(H2 + (size_t)t * D + dd);
            const f32x2 h3 = (f32x2){bf2f((unsigned short)(hb & 0xffffu)) + z1[0], bf2f((unsigned short)(hb >> 16)) + z1[1]};
            *(f32x2*)(p.out + (size_t)t * D + 128 * x + dd) = h3;
            const float ss = wave_sum_fast(h3[0] * h3[0] + h3[1] * h3[1], ln);
            if (ln == 0) SSQ3[(size_t)t * 8 + x] = ss;
        }
    };
    load_meta(w0);
    issue(ra);
    if (VSIDE) {
#pragma unroll
        for (int q = 0; q < 4; ++q) wc[q] = wn[q];
    } else { hc[0] = hn[0]; hc[1] = hn[1]; }
    if (w0 + nwv < T) load_meta(w0 + nwv);
    for (int t = w0; t < T; t += 2 * nwv) {
        const bool m1 = t + nwv < T, m2 = t + 2 * nwv < T, m3 = t + 3 * nwv < T;
        f32x4 w1[4]; u32x4 h1[2];
        if (m1) { issue(rb);
            if (VSIDE) {
#pragma unroll
                for (int q = 0; q < 4; ++q) w1[q] = wn[q];
            } else { h1[0] = hn[0]; h1[1] = hn[1]; }
            if (m2) load_meta(t + 2 * nwv); }
        compute(ra, t);
        if (!m1) break;
        if (VSIDE) {
#pragma unroll
            for (int q = 0; q < 4; ++q) wc[q] = w1[q];
        } else { hc[0] = h1[0]; hc[1] = h1[1]; }
        if (m2) { issue(ra); }
        f32x4 w2[4]; u32x4 h2x[2];
        if (m2) {
            if (VSIDE) {
#pragma unroll
                for (int q = 0; q < 4; ++q) w2[q] = wn[q];
            } else { h2x[0] = hn[0]; h2x[1] = hn[1]; }
            if (m3) load_meta(t + 3 * nwv); }
        compute(rb, t + nwv);
        if (!m2) break;
        if (VSIDE) {
#pragma unroll
            for (int q = 0; q < 4; ++q) wc[q] = w2[q];
        } else { hc[0] = h2x[0]; hc[1] = h2x[1]; }
    }
}
template <bool VSIDE>
__device__ __forceinline__ void peer_slice_phase(const Params& p, unsigned xcc, int rank, int G, int bx, int wave, int lane) {
    unsigned* ctl = (unsigned*)(p.ws + WS_CTL);
    for (int x = 0; x < 8; ++x) {
        const int cx = (int)__builtin_amdgcn_readfirstlane((int)__hip_atomic_load(ctl + CW_BAR + XB_XCNT(x), __ATOMIC_RELAXED, __HIP_MEMORY_SCOPE_AGENT));
        if (cx != 0 && (int)xcc != x) continue;
        const int nwv = (cx == 0 ? G : cx) * NWAVES, w0 = (cx == 0 ? bx : rank) * NWAVES + wave;
        peer_slice_tokens<VSIDE>(p, x, w0, nwv, lane);
    }
}
__device__ __forceinline__ void peer_combine_phase(const Params& p, int gw, int NGW, int lane) {
    const float* PART = (const float*)(p.ws + WS_PART); float* WG = (float*)(p.ws + WS_WG); const float* ssq2 = (const float*)(p.ws + WS_SSQ2);
    for (int t = gw; t < T; t += NGW) {
        f32x2 s = (f32x2){0.f, 0.f};
#pragma unroll
        for (int x = 0; x < 8; ++x) s += *(const f32x2*)(PART + ((size_t)x * T + t) * 128 + 2 * lane);
        const float rs = rsqrtf(ssq_sum<16>(ssq2 + (size_t)t * 16) * (1.f / D) + EPS) * (1.f / U_SCALE);
        f32x2* wp = (f32x2*)(WG + (size_t)t * 128 + 2 * lane);
        const f32x2 g = *wp;
        *wp = (f32x2){g[0] * gelu_f(s[0] * rs) * (1.f / V_SCALE), g[1] * gelu_f(s[1] * rs) * (1.f / V_SCALE)};
    }
}
__device__ __forceinline__ void peer_final_phase(const Params& p, int gw, int NGW, int lane) {
    const float* SSQ3 = (const float*)(p.ws + WS_SSQ3);
    for (int t = gw; t < T; t += NGW) {
        float* row = p.out + (size_t)t * D + lane * 16;
        f32x4 v[4];
#pragma unroll
        for (int q = 0; q < 4; ++q) v[q] = *(const f32x4*)(row + 4 * q);
        const float rstd3 = rsqrtf(ssq_sum<8>(SSQ3 + (size_t)t * 8) * (1.f / D) + EPS);
#pragma unroll
        for (int q = 0; q < 4; ++q) { const f32x4 gf = *(const f32x4*)(p.g_final + lane * 16 + 4 * q); *(f32x4*)(row + 4 * q) = v[q] * rstd3 * gf; }
    }
}

#ifndef PH_MASK
#define PH_MASK 0xFFFF
#endif
#define PH(k) ((PH_MASK >> (k)) & 1)
#ifdef TPROBE
#define TMARK(k) do { const unsigned long long tn_ = __builtin_amdgcn_s_memrealtime(); if (TPROBE == (k)) { const unsigned long long d_ = tn_ - tprev_; while (__builtin_amdgcn_s_memrealtime() - tn_ < d_) __builtin_amdgcn_s_sleep(8); } tprev_ = __builtin_amdgcn_s_memrealtime(); } while (0)
#else
#define TMARK(k)
#endif
#ifndef PEER_DSLICE
#define PEER_DSLICE 1
#endif
#ifndef GEMM_ALIGN
#define GEMM_ALIGN true
#endif
#ifndef REP_MASK
#define REP_MASK 0
#endif
#if (REP_MASK >> 0) & 1
#define REP_0 for (int rep_ = 0; rep_ < 2; ++rep_)
#else
#define REP_0
#endif
#if (REP_MASK >> 1) & 1
#define REP_1 for (int rep_ = 0; rep_ < 2; ++rep_)
#else
#define REP_1
#endif
#if (REP_MASK >> 2) & 1
#define REP_2 for (int rep_ = 0; rep_ < 2; ++rep_)
#else
#define REP_2
#endif
#if (REP_MASK >> 3) & 1
#define REP_3 for (int rep_ = 0; rep_ < 2; ++rep_)
#else
#define REP_3
#endif
#if (REP_MASK >> 4) & 1
#define REP_4 for (int rep_ = 0; rep_ < 2; ++rep_)
#else
#define REP_4
#endif
#if (REP_MASK >> 5) & 1
#define REP_5 for (int rep_ = 0; rep_ < 2; ++rep_)
#else
#define REP_5
#endif
#if (REP_MASK >> 6) & 1
#define REP_6 for (int rep_ = 0; rep_ < 2; ++rep_)
#else
#define REP_6
#endif
#if (REP_MASK >> 7) & 1
#define REP_7 for (int rep_ = 0; rep_ < 2; ++rep_)
#else
#define REP_7
#endif
#if (REP_MASK >> 8) & 1
#define REP_8 for (int rep_ = 0; rep_ < 2; ++rep_)
#else
#define REP_8
#endif
#if (REP_MASK >> 9) & 1
#define REP_9 for (int rep_ = 0; rep_ < 2; ++rep_)
#else
#define REP_9
#endif
#define REP(k) REP_##k
__global__ void __launch_bounds__(NWAVES * 64, 2) fwd_megakernel(Params p) {
    extern __shared__ __attribute__((aligned(16))) unsigned char lds_raw[];
    LAS unsigned char* lds = (LAS unsigned char*)lds_raw;
    const int tid = threadIdx.x, lane = tid & 63, wave = __builtin_amdgcn_readfirstlane(tid >> 6);
    const int G = gridDim.x; const int bx = blockIdx.x;
    const int vcu = (G % 8 == 0) ? (bx % 8) * (G / 8) + bx / 8 : bx;
    if (p.never) { cg::this_grid().sync(); }
    unsigned char* const ws = p.ws;
    volatile LAS unsigned* MISC = (volatile LAS unsigned*)(lds + LDSCTL_OFF);
    for (int u = tid; u < (LDS_BYTES - LDSCTL_OFF) / 4; u += NWAVES * 64) ((LAS unsigned*)(lds + LDSCTL_OFF))[u] = 0u;
    __syncthreads();
    XcdBarrier bar = xcd_barrier_post((unsigned*)(ws + WS_CTL) + CW_BAR, MISC + 8);
    if (tid == 0) MISC[20] = __hip_atomic_fetch_add((unsigned*)(ws + WS_CTL) + CW_XRANK + 64 * bar.x, 1u, __ATOMIC_RELAXED, __HIP_MEMORY_SCOPE_AGENT);
    const int gw = vcu * NWAVES + wave, NGW = G * NWAVES;
#ifdef TPROBE
    unsigned long long tprev_ = __builtin_amdgcn_s_memrealtime();
#endif

#define WSB(off) ((bf16_t*)(p.ws + (off)))
#define WSF(off) ((float*)(p.ws + (off)))
    REP(0) {
    if (PH(0))
    {
        LAS float* scr = (LAS float*)(lds + wave * 16384);
        constexpr int I_IN = 16 * 85, I_XKV = 16 * 64;
        constexpr int NITEMS = I_IN + I_XKV;
        for (int it = gw; it < NITEMS; it += NGW) {
            int r = it;
            if (r < I_IN) { p0_transpose_item<1>(p.w_in, 1024, 2720, WSB(WS_WIN), nullptr, scr, r, lane); continue; } r -= I_IN;
            p0_transpose_item<0>(p.w_xkv, 1024, 2048, WSB(WS_WXKV), nullptr, scr, r, lane);
        }
        for (int m = gw; m < T / 4; m += NGW) rms_rows_to_bf16<4>(p.x + (size_t)m * D, p.g_mix, WSB(WS_A0) + (size_t)m * D, (size_t)(T / 4) * D, lane);
        for (int m = gw; m < 1024; m += NGW) rms_rows_to_bf16<1>(p.mem + (size_t)m * D, p.g_mem, WSB(WS_MEMN) + (size_t)m * D, 0, lane);
        const int gt = vcu * 512 + tid, NGT = G * 512;
        for (int i = gt; i < 2 * 128 * 128 / 2; i += NGT) { const f32x2 v = *(const f32x2*)(p.sub_keys + 2 * i); ((unsigned*)WSB(WS_SK))[i] = cvtpk(v[0], v[1]); }
        for (int i = gt; i < 96 * 1024 / 8; i += NGT) ((u32x4*)(WSB(WS_WIN) + (size_t)2208 * 1024))[i] = (u32x4){0u, 0u, 0u, 0u};
        for (int i = gt; i < SEQ * 64; i += NGT) { const int s = i >> 6, f = i & 63; const float inv = exp2f(-(float)f * (13.287712379549449f / 64.f)); const float ang = (float)s * inv;
            const double rev = (double)ang * 0.15915494309189535; const float fr = (float)(rev - floor(rev)); WSF(WS_CR)[i] = __builtin_amdgcn_cosf(fr); WSF(WS_SR)[i] = __builtin_amdgcn_sinf(fr); }
        for (int i = gt; i < SEQ * 16; i += NGT) { const int s = i >> 4, f = i & 15; const float inv = exp2f(-(float)f * (13.287712379549449f / 16.f)); const float ang = (float)s * inv;
            const double rev = (double)ang * 0.15915494309189535; const float fr = (float)(rev - floor(rev)); WSF(WS_CM)[i] = __builtin_amdgcn_cosf(fr); WSF(WS_SM)[i] = __builtin_amdgcn_sinf(fr); }
    }
    xcd_barrier(bar);
    TMARK(0);
#ifdef DBL_BAR
    xcd_barrier(bar);
#endif
    }

    REP(1) {
    if (PH(1))
    {
        { pg8::Gemm g{WSB(WS_A0), WSB(WS_WIN), T, NPROJ, 1024, 1024, 1024}; pg8::StaticOrder S; S.init(T, NPROJ, G, bx);
          pg8::EpiProj E{WSB(WS_PROJ), WSF(WS_SSQQ), WSF(WS_SSQKV), WSF(WS_CR), WSF(WS_SR), WSF(WS_CM), WSF(WS_SM)}; pg8::gemm_phase<pg8::EpiProj, pg8::StaticOrder, GEMM_ALIGN>(lds, g, S, E); }
#ifdef DUP_P1MAIN
        { pg8::Gemm g{WSB(WS_A0), WSB(WS_WIN), T, NPROJ, 1024, 1024, 1024}; pg8::StaticOrder S; S.init(T, NPROJ, G, bx);
          pg8::EpiProj E{WSB(WS_PROJ), WSF(WS_SSQQ), WSF(WS_SSQKV), WSF(WS_CR), WSF(WS_SR), WSF(WS_CM), WSF(WS_SM)}; pg8::gemm_phase<pg8::EpiProj, pg8::StaticOrder, GEMM_ALIGN>(lds, g, S, E); }
#endif
        { pg8::Gemm g{WSB(WS_WIN) + (size_t)2304 * 1024, WSB(WS_A0), 512, T, 1024, 1024, 1024}; pg8::StaticOrder S; S.init(512, T, G, (bx - 64 + G) % G);
          pg8::EpiPlain E{WSB(WS_RVT), TP}; pg8::gemm_phase<pg8::EpiPlain, pg8::StaticOrder, GEMM_ALIGN>(lds, g, S, E); }
        { pg8::Gemm g{WSB(WS_MEMN), WSB(WS_WXKV), 1024, 1024, 1024, 1024, 1024}; pg8::StaticOrder S; S.init(1024, 1024, G, (bx - 192 + G) % G);
          pg8::EpiPlain E{WSB(WS_KX), 1024}; pg8::gemm_phase<pg8::EpiPlain, pg8::StaticOrder, GEMM_ALIGN>(lds, g, S, E); }
        { pg8::Gemm g{WSB(WS_WXKV) + (size_t)1024 * 1024, WSB(WS_MEMN), 1024, 1024, 1024, 1024, 1024}; pg8::StaticOrder S; S.init(1024, 1024, G, (bx - 208 + G) % G);
          pg8::EpiPlain E{WSB(WS_VXT), 1024}; pg8::gemm_phase<pg8::EpiPlain, pg8::StaticOrder, GEMM_ALIGN>(lds, g, S, E); }
        {
            const int nd = G >= 64 ? 32 : G, d0 = G - nd;
            if (bx >= d0) {
                LAS float* scr = (LAS float*)(lds + wave * 16384);
                constexpr int I_UQ = 6 * 24, I_UKV = 4 * 32, I_SQ = 16 * 32, I_PQ = 16 * 64;
                constexpr int NITEMS = I_UQ + I_UKV + 3 * I_SQ + I_PQ;
                for (int it = (bx - d0) * NWAVES + wave; it < NITEMS; it += nd * NWAVES) {
                    int r = it;
                    if (r < I_UQ) { p0_transpose_item<2>(p.w_uq, 384, 768, WSB(WS_WUQ), p.g_q_lora, scr, r, lane); continue; } r -= I_UQ;
                    if (r < I_UKV) { p0_transpose_item<3>(p.w_ukv, 256, 1024, WSB(WS_WUKV), p.g_kv_lora, scr, r, lane); continue; } r -= I_UKV;
                    if (r < I_SQ) { p0_transpose_item<0>(p.w_o, 1024, 1024, WSB(WS_WO), nullptr, scr, r, lane); continue; } r -= I_SQ;
                    if (r < I_SQ) { p0_transpose_item<0>(p.w_xq, 1024, 1024, WSB(WS_WXQ), p.g_xattn, scr, r, lane); continue; } r -= I_SQ;
                    if (r < I_SQ) { p0_transpose_item<0>(p.w_xo, 1024, 1024, WSB(WS_WXO), nullptr, scr, r, lane); continue; } r -= I_SQ;
                    p0_transpose_item<0>(p.w_pq, 1024, 2048, WSB(WS_WPQ), p.g_ffn, scr, r, lane);
                }
            }
        }
    }
    xcd_barrier(bar);
    TMARK(1);
#ifdef DBL_BAR
    xcd_barrier(bar);
#endif
    }

    REP(2) {
    if (PH(2))
    {
        { pg8::Gemm g{WSB(WS_PROJ), WSB(WS_WUQ), T, 768, 384, NPROJ, 384}; pg8::StaticOrder S; S.init(T, 768, G, bx);
          pg8::EpiQ E{WSB(WS_QM), WSF(WS_SSQQ), WSF(WS_CM), WSF(WS_SM)}; pg8::gemm_phase<pg8::EpiQ, pg8::StaticOrder, GEMM_ALIGN>(lds, g, S, E); }
        { pg8::Gemm g{WSB(WS_PROJ) + 384, WSB(WS_WUKV), T, 512, 256, NPROJ, 256}; pg8::StaticOrder S; S.init(T, 512, G, (bx - 192 + G) % G);
          pg8::EpiRowScale<8> E{WSB(WS_KN), 512, WSF(WS_SSQKV), 1.f / 256.f, 1.f}; pg8::gemm_phase<pg8::EpiRowScale<8>, pg8::StaticOrder, GEMM_ALIGN>(lds, g, S, E); }
        { pg8::Gemm g{WSB(WS_WUKV) + (size_t)512 * 256, WSB(WS_PROJ) + 384, 512, T, 256, 256, NPROJ}; pg8::StaticOrder S; S.init(512, T, G, (bx - 64 + G) % G);
          pg8::EpiColScale E{WSB(WS_VT), TP, WSF(WS_SSQKV), 1.f / 256.f}; pg8::gemm_phase<pg8::EpiColScale, pg8::StaticOrder, GEMM_ALIGN>(lds, g, S, E); }
        for (int u = vcu; u < 512; u += G) ret_state_unit(lds, u, WSB(WS_PROJ), WSB(WS_RVT), WSB(WS_RKVT));
    }
    xcd_barrier(bar);
    TMARK(2);
#ifdef DBL_BAR
    xcd_barrier(bar);
#endif
    }

    REP(3) {
    if (PH(3))
    {
        unsigned* scan_cnt = (unsigned*)(p.ws + WS_CTL) + CW_QUEUE + 64 * Q3_SLOT;
#if (REP_MASK >> 3) & 1
        if (rep_ == 0)
#endif
        {
            bf16_t* RK = WSB(WS_RKVT);
            for (int e2 = vcu * 512 + tid; e2 < 16 * 8192; e2 += G * 512) {
                const int bh = e2 >> 13, off = e2 & 8191; const float cd = exp2f(128.f * ret_log2g(bh & 3));
                unsigned* base = (unsigned*)(RK + (size_t)bh * 32 * 16384) + off;
                unsigned x[32];
#pragma unroll
                for (int n = 0; n < 32; ++n) x[n] = base[(size_t)n * 8192];
                float r0 = 0.f, r1 = 0.f;
#pragma unroll
                for (int n = 0; n < 32; ++n) { const unsigned o = cvtpk(r0, r1); r0 = r0 * cd + bf2f((unsigned short)(x[n] & 0xffffu)); r1 = r1 * cd + bf2f((unsigned short)(x[n] >> 16)); base[(size_t)n * 8192] = o; }
            }
            asm volatile("s_waitcnt vmcnt(0)" ::: "memory");
            __syncthreads();
            if (tid == 0) { __builtin_amdgcn_fence(__ATOMIC_RELEASE, "agent"); asm volatile("s_waitcnt vmcnt(0)" ::: "memory"); __hip_atomic_fetch_add(scan_cnt, 1u, __ATOMIC_RELAXED, __HIP_MEMORY_SCOPE_AGENT); }
        }
#ifdef REP_MLA
        for (int rr_ = 0; rr_ < REP_MLA; ++rr_)
#endif
        for (int v2 = 2 * vcu; v2 < 512; v2 += (v2 & 1) ? 2 * G - 1 : 1) { const int v = v2 >> 1, bh = v >> 3, s = v & 7;
            mla_unit(lds, bh >> 3, bh & 7, (v2 & 1) ? s : 15 - s, WSB(WS_QM), WSB(WS_KN), WSB(WS_PROJ), WSB(WS_VT), WSB(WS_MIX)); }
#ifdef MLA_BAR
        xcd_barrier(bar);
#endif
        if (tid == 0) { unsigned sp = 0; while (__hip_atomic_load(scan_cnt, __ATOMIC_RELAXED, __HIP_MEMORY_SCOPE_AGENT) < (unsigned)G) { __builtin_amdgcn_s_sleep(2); if (++sp > XB_SPIN_CAP) break; }
            __builtin_amdgcn_fence(__ATOMIC_ACQUIRE, "agent"); asm volatile("s_waitcnt vmcnt(0)" ::: "memory"); }
        __syncthreads();
#ifdef REP_RET
        for (int rr_ = 0; rr_ < 2; ++rr_)
#endif
        for (int u = vcu; u < 512; u += G) ret_out_unit(lds, u, WSB(WS_PROJ), WSB(WS_RVT), WSB(WS_RKVT), p.g_ret_gn, WSB(WS_MIX));
    }
    xcd_barrier(bar);
    TMARK(3);
#ifdef DBL_BAR
    xcd_barrier(bar);
#endif
    }

    REP(4) {
    if (PH(4))
#ifdef REP_P4NB
    for (int nb_ = 0; nb_ < 2; ++nb_)
#endif
    { pg8::Gemm g{WSB(WS_MIX), WSB(WS_WO), T, 1024, 1024, 1024, 1024}; pg8::StaticOrder S; S.init(T, 1024, G, bx);
      pg8::EpiRes E{p.x, nullptr, WSB(WS_H1B), WSF(WS_SSQ1)}; pg8::gemm_phase<pg8::EpiRes, pg8::StaticOrder, GEMM_ALIGN>(lds, g, S, E); }
    xcd_barrier(bar);
    TMARK(4);
#ifdef DBL_BAR
    xcd_barrier(bar);
#endif
    }

    REP(5) {
    if (PH(5))
    { pg8::Gemm g{WSB(WS_H1B), WSB(WS_WXQ), T, 1024, 1024, 1024, 1024}; pg8::StaticOrder S; S.init(T, 1024, G, bx);
      pg8::EpiRowScale<16> E{WSB(WS_QX), 1024, WSF(WS_SSQ1), 1.f / 1024.f, C2_X}; pg8::gemm_phase<pg8::EpiRowScale<16>, pg8::StaticOrder, GEMM_ALIGN>(lds, g, S, E); }
    xcd_barrier(bar);
    TMARK(5);
#ifdef DBL_BAR
    xcd_barrier(bar);
#endif
    }

    REP(6) {
    if (PH(6))
    {
        for (int u = vcu; u < 512; u += G) { const int dvh = u & 1, qb = (u >> 1) & 15, h = (u >> 5) & 3, b = u >> 7; xattn_unit(lds, b, h, qb, dvh, WSB(WS_QX), WSB(WS_KX), WSB(WS_VXT), WSB(WS_OX)); }
        unsigned char* U8 = ws + WS_U8; unsigned char* V8 = ws + WS_V8;
        const f32x4* gf = (const f32x4*)p.g_ffn + lane * 4;
        f32x4 gs[4];
#pragma unroll
        for (int i = 0; i < 4; ++i) gs[i] = gf[i] * U_SCALE;
        for (int e = gw; e < 2 * 16384; e += NGW) {
            const bool isv = e >= 16384; const int row = isv ? e - 16384 : e;
            const f32x4* src = (const f32x4*)((isv ? p.v_exp : p.u_exp) + (size_t)row * D) + lane * 4;
            u32x4 o; unsigned ow[4];
#pragma unroll
            for (int i = 0; i < 4; ++i) { f32x4 v = src[i]; v = isv ? v * V_SCALE : v * gs[i]; int pk = 0; pk = __builtin_amdgcn_cvt_pk_fp8_f32(v[0], v[1], pk, false); pk = __builtin_amdgcn_cvt_pk_fp8_f32(v[2], v[3], pk, true); ow[i] = (unsigned)pk; }
            o.x = ow[0]; o.y = ow[1]; o.z = ow[2]; o.w = ow[3];
            *(u32x4*)((isv ? V8 : U8) + (size_t)(lane >> 3) * (16384 * 128) + (size_t)row * 128 + (lane & 7) * 16) = o;
        }
    }
    xcd_barrier(bar);
    TMARK(6);
#ifdef DBL_BAR
    xcd_barrier(bar);
#endif
    }

    REP(7) {
    if (PH(7))
    { pg8::Gemm g{WSB(WS_OX), WSB(WS_WXO), T, 1024, 1024, 1024, 1024}; pg8::StaticOrder S; S.init(T, 1024, G, bx);
      pg8::EpiRes E{nullptr, WSB(WS_H1B), WSB(WS_H2B), WSF(WS_SSQ2)}; pg8::gemm_phase<pg8::EpiRes, pg8::StaticOrder, GEMM_ALIGN>(lds, g, S, E); }
    xcd_barrier(bar);
    TMARK(7);
#ifdef DBL_BAR
    xcd_barrier(bar);
#endif
    }

    REP(8) {
    if (PH(8))
    { pg8::Gemm g{WSB(WS_H2B), WSB(WS_WPQ), T, 2048, 1024, 1024, 1024}; pg8::StaticOrder S; S.init(T, 2048, G, bx);
      pg8::EpiRowScale<16> E{WSB(WS_QP), 2048, WSF(WS_SSQ2), 1.f / 1024.f, 1.f}; pg8::gemm_phase<pg8::EpiRowScale<16>, pg8::StaticOrder, GEMM_ALIGN>(lds, g, S, E); }
    xcd_barrier(bar);
    TMARK(8);
#ifdef DBL_BAR
    xcd_barrier(bar);
#endif
    }

    REP(9) {
    if (PH(9))
    {
#if PEER_DSLICE
      const int myrank = (int)MISC[20];
      peer_phase<true>(lds, p, vcu, G);
      xcd_barrier(bar);
    TMARK(9);
#ifdef DUP_RETR
      peer_phase<true>(lds, p, vcu, G);
      xcd_barrier(bar);
#endif
      peer_slice_phase<false>(p, bar.x, myrank, G, bx, wave, lane);
      xcd_barrier(bar);
    TMARK(10);
#ifdef DUP_USL
      peer_slice_phase<false>(p, bar.x, myrank, G, bx, wave, lane);
      xcd_barrier(bar);
#endif
      peer_combine_phase(p, gw, NGW, lane);
      xcd_barrier(bar);
    TMARK(11);
      peer_slice_phase<true>(p, bar.x, myrank, G, bx, wave, lane);
      xcd_barrier(bar);
    TMARK(12);
#ifdef DUP_VSL
      peer_slice_phase<true>(p, bar.x, myrank, G, bx, wave, lane);
      xcd_barrier(bar);
#endif
      peer_final_phase(p, gw, NGW, lane);
      TMARK(13);
#else
      peer_phase<false>(lds, p, vcu, G);
      xcd_barrier(bar);
      peer_v_phase(p, vcu, G);
#endif
    }
#if (REP_MASK >> 9) & 1
    xcd_barrier(bar);
#endif
    }
}

extern "C" void kernel_launch(void* const* d_in, const int* in_sizes, int n_in, void* d_out, int out_size, void* d_ws, size_t ws_size, hipStream_t stream) {
    static int grid = 0;
    if (grid == 0) {
        if (n_in != 21 || out_size != T * D || ws_size < WS_END) { fprintf(stderr, "kernel_launch: unexpected shapes (n_in %d out %d ws %zu)\n", n_in, out_size, ws_size); grid = -1; return; }
        int dev = 0, cus = 0, per_cu = 0;
        if (hipGetDevice(&dev) != hipSuccess || hipDeviceGetAttribute(&cus, hipDeviceAttributeMultiprocessorCount, dev) != hipSuccess) { grid = -1; return; }
        if (hipFuncSetAttribute((const void*)fwd_megakernel, hipFuncAttributeMaxDynamicSharedMemorySize, LDS_BYTES) != hipSuccess) { fprintf(stderr, "kernel_launch: hipFuncSetAttribute failed\n"); grid = -1; return; }
        if (hipOccupancyMaxActiveBlocksPerMultiprocessor(&per_cu, (const void*)fwd_megakernel, NWAVES * 64, LDS_BYTES) != hipSuccess || per_cu < 1) { fprintf(stderr, "kernel_launch: occupancy query says %d\n", per_cu); grid = -1; return; }
        (void)hipGetLastError();
        grid = cus;
    }
    if (grid < 0) return;
    (void)hipMemsetAsync((char*)d_ws + WS_CTL, 0, CTL_ZERO_BYTES, stream);
    Params p{};
    const float** pp = (const float**)&p;
    for (int i = 0; i < 21; ++i) pp[i] = (const float*)d_in[i];
    p.out = (float*)d_out; p.ws = (unsigned char*)d_ws; p.never = 0; p.pad = 0;
    void* args[] = {&p};
    hipError_t e = hipLaunchCooperativeKernel((const void*)fwd_megakernel, dim3(grid), dim3(NWAVES * 64), args, LDS_BYTES, stream);
    if (e != hipSuccess) fprintf(stderr, "cooperative launch failed: %s (grid %d)\n", hipGetErrorString(e), grid);
}
```

```cpp
#include <hip/hip_runtime.h>
#include <hip/hip_cooperative_groups.h>
#include <cstdio>
#include <cstdint>
namespace cg = cooperative_groups;

#define LAS __attribute__((address_space(3)))
#define GAS __attribute__((address_space(1)))
typedef unsigned short bf16_t;
typedef short bf16x8 __attribute__((ext_vector_type(8)));
typedef short s16x4 __attribute__((ext_vector_type(4)));
typedef float f32x4 __attribute__((ext_vector_type(4)));
typedef float f32x2 __attribute__((ext_vector_type(2)));
typedef float f32x16 __attribute__((ext_vector_type(16)));
typedef unsigned u32x4 __attribute__((ext_vector_type(4)));
typedef unsigned u32x2 __attribute__((ext_vector_type(2)));
typedef __bf16 bf16x2_t __attribute__((ext_vector_type(2)));

constexpr int T = 16384, D = 1024, SEQ = 4096;
constexpr int NPROJ = 2304;
constexpr int NWIN = 2816;
constexpr float EPS = 1e-6f;
constexpr float LOG2E = 1.4426950408889634f;
constexpr float C2_MLA = 0.10206207261596575f * LOG2E;
constexpr float C2_X = 0.0625f * LOG2E;
constexpr float U_SCALE = 512.f, V_SCALE = 64.f;

constexpr size_t MiB = 1u << 20;
constexpr size_t WS_CTL = 0, CTL_ZERO_BYTES = 1 * MiB;
constexpr size_t WS_SSQQ = 227 * MiB, WS_SSQKV = 228 * MiB, WS_SSQ1 = 229 * MiB, WS_SSQ2 = 230 * MiB;
constexpr size_t WS_CR = 1 * MiB, WS_SR = 2 * MiB, WS_CM = 3 * MiB, WS_SM = 3 * MiB + 256 * 1024;
constexpr size_t WS_WIN = 4 * MiB, WS_WUQ = 10 * MiB, WS_WUKV = 11 * MiB, WS_WO = 12 * MiB, WS_WXQ = 14 * MiB, WS_WXKV = 16 * MiB, WS_WXO = 20 * MiB, WS_WPQ = 22 * MiB, WS_SK = 26 * MiB;
constexpr size_t WS_MEMN = 27 * MiB, WS_KX = 29 * MiB, WS_VXT = 31 * MiB;
constexpr size_t WS_A0 = 33 * MiB, WS_MIX = 33 * MiB, WS_QX = 33 * MiB;
constexpr size_t WS_EG = 33 * MiB, WS_WG = 41 * MiB, WS_SSQ3 = 49 * MiB, WS_PART = 65 * MiB;
constexpr size_t WS_PROJ = 65 * MiB, WS_H1B = 65 * MiB, WS_U8 = 137 * MiB, WS_V8 = 153 * MiB;
constexpr size_t WS_OX = 97 * MiB, WS_H2B = 169 * MiB, WS_QP = 65 * MiB;
constexpr size_t WS_RVT = 137 * MiB, WS_QM = 154 * MiB, WS_KN = 178 * MiB, WS_VT = 194 * MiB, WS_RKVT = 211 * MiB;
constexpr int TP = T + 64;
constexpr size_t WS_END = 231 * MiB;
constexpr int CW_BAR = 4096;
constexpr int CW_XRANK = 20480;
constexpr int CW_QUEUE = 16384, Q3_SLOT = 0;

constexpr int RING_BYTES = 131072;
constexpr int LDSCTL_OFF = 143360;
constexpr int LDS_BYTES = 147456;
constexpr int NWAVES = 8;

__device__ __forceinline__ unsigned cvtpk(float lo, float hi) { f32x2 v = {lo, hi}; bf16x2_t b = __builtin_convertvector(v, bf16x2_t); return __builtin_bit_cast(unsigned, b); }
__device__ __forceinline__ float bf2f(unsigned short b) { return __uint_as_float(((unsigned)b) << 16); }
__device__ __forceinline__ int crow(int r, int hi) { return (r & 3) + 8 * (r >> 2) + 4 * hi; }
template <int M> __device__ __forceinline__ float shx(float f, int lane) {
    const int v = (int)__float_as_uint(f); int r;
    if (M == 1) r = __builtin_amdgcn_mov_dpp(v, 0xB1, 0xF, 0xF, true);
    else if (M == 2) r = __builtin_amdgcn_mov_dpp(v, 0x4E, 0xF, 0xF, true);
    else if (M == 4) { r = __builtin_amdgcn_update_dpp(v, v, 0x104, 0xF, 0x5, false); r = __builtin_amdgcn_update_dpp(r, v, 0x114, 0xF, 0xA, false); }
    else if (M == 8) r = __builtin_amdgcn_mov_dpp(v, 0x128, 0xF, 0xF, true);
    else if (M == 16) { auto rr = __builtin_amdgcn_permlane16_swap((unsigned)v, (unsigned)v, false, false); r = (int)((lane & 16) ? rr[0] : rr[1]); }
    else { auto rr = __builtin_amdgcn_permlane32_swap((unsigned)v, (unsigned)v, false, false); r = (int)((lane & 32) ? rr[0] : rr[1]); }
    return __uint_as_float((unsigned)r);
}
__device__ __forceinline__ float wave_sum(float v) {
#pragma unroll
    for (int o = 1; o < 64; o <<= 1) v += __shfl_xor(v, o);
    return v;
}
__device__ __forceinline__ float wave_sum_fast(float v, int lane) {
    v += shx<1>(v, lane); v += shx<2>(v, lane); v += shx<4>(v, lane); v += shx<8>(v, lane); v += shx<16>(v, lane); v += shx<32>(v, lane);
    return v;
}
__device__ __forceinline__ float xhalf_max(float m) { auto rr = __builtin_amdgcn_permlane32_swap(__float_as_uint(m), __float_as_uint(m), false, false); return fmaxf(__uint_as_float(rr[0]), __uint_as_float(rr[1])); }
__device__ __forceinline__ float xhalf_sum(float m) { auto rr = __builtin_amdgcn_permlane32_swap(__float_as_uint(m), __float_as_uint(m), false, false); return __uint_as_float(rr[0]) + __uint_as_float(rr[1]); }
__device__ __forceinline__ unsigned xhalf_other(unsigned m, int hi) { auto rr = __builtin_amdgcn_permlane32_swap(m, m, false, false); return hi ? rr[0] : rr[1]; }
#define LDS_WAIT() asm volatile("s_waitcnt lgkmcnt(0)" ::: "memory")
template <int NP> __device__ __forceinline__ float ssq_sum(const float* part) {
    float s = 0.f;
#pragma unroll
    for (int i = 0; i < NP / 4; ++i) { const f32x4 v = *(const f32x4*)(part + 4 * i); s += v[0]; s += v[1]; s += v[2]; s += v[3]; }
    return s;
}
__device__ __forceinline__ int opaque_tid() { int t = threadIdx.x; asm volatile("" : "+v"(t)); return t; }
#define MFMA32(a, b, c) __builtin_amdgcn_mfma_f32_32x32x16_bf16((a), (b), (c), 0, 0, 0)
__device__ __forceinline__ float gelu_f(float v) {
    const float av = fabsf(v), t = __builtin_amdgcn_rcpf(av * 0.2316418882f + 1.0f);
    float q = t * 0.5307027145f + (-0.7265760135f); q = q * t + 0.7107068705f; q = q * t + (-0.142248368f); q = q * t + 0.127414796f; q = q * t;
    const float e = __builtin_amdgcn_exp2f((v * v) * (-0.72134752044f));
    const float m = v * (q * e);
    return v < 0.f ? m : v - m;
}

namespace pg8 {
constexpr int BM = 256, BK = 64, HALF = 128, HTB = HALF * BK * 2, STAGE_BYTES = 8 * HTB, NXCD = 8, WGM = 8;
__host__ __device__ __forceinline__ int lds_byte(int r, int c) { const int st = (r >> 4) * 2 + (c >> 5), rr = r & 15, cc = c & 31, ob = rr * 64 + cc * 2; return st * 1024 + (ob ^ (((ob >> 9) & 1) << 5)); }
__host__ __device__ __forceinline__ void stage_rc(int b, int& R, int& C) { const int st = b / 1024, sb = b % 1024, swz = sb ^ (((sb >> 9) & 1) << 5); R = (st >> 1) * 16 + swz / 64; C = (st & 1) * 32 + (swz % 64) / 2; }
__host__ __device__ __forceinline__ int perm32(int rho) { const int n = rho >> 4, i = rho & 15; return 8 * (i >> 2) + 4 * n + (i & 3); }
struct Unit { int pm, pn; };
struct Gemm { const bf16_t* A; const bf16_t* Bt; int M, N, K, lda, ldb; };
struct StaticOrder {
    int nM, nN, nwg, G, c;
    __device__ void init(int M, int N, int G_, int c_) { nM = M / BM; nN = N / BM; nwg = nM * nN; G = G_; c = c_; }
    __device__ bool next(int i, Unit& u) const {
        const long L = (long)i * G + c; if (L >= nwg) return false;
        int wgid = (int)L; { const int q = nwg / NXCD, r = nwg % NXCD, xcd = wgid % NXCD, off = wgid / NXCD; wgid = (xcd < r ? xcd * (q + 1) : r * (q + 1) + (xcd - r) * q) + off; }
        const int nig = WGM * nN, gid = wgid / nig, fm = gid * WGM, gsz = (nM - fm) < WGM ? (nM - fm) : WGM;
        u.pm = fm + ((wgid % nig) % gsz); u.pn = (wgid % nig) / gsz; return true;
    }
};

template <class Epi, class Sched, bool ALIGN_EPI>
__device__ __forceinline__ void gemm_phase(LAS unsigned char* lds, const Gemm g, const Sched& S, const Epi& E) {
    const int tid = opaque_tid(), wid = __builtin_amdgcn_readfirstlane(tid >> 6), lane = tid & 63, wr = wid >> 2, wc = wid & 3, fr = lane & 15, fq = lane >> 4;
    const int K = g.K, nt = K / BK;
    unsigned voffA[2], voffB[2];
#pragma unroll
    for (int i = 0; i < 2; ++i) { int R, C; stage_rc(tid * 16 + i * 8192, R, C); const int Rb = 64 * (R >> 5) + perm32(R & 31); voffA[i] = (unsigned)(R * g.lda + C) * 2u; voffB[i] = (unsigned)(Rb * g.ldb + C) * 2u; }
    const size_t kstep = (size_t)(BK * 2);
    const size_t hstepA = (size_t)HALF * g.lda * 2, hstepB = (size_t)32 * g.ldb * 2, tstepA = 2 * hstepA, tstepB = (size_t)BM * g.ldb * 2;
    const unsigned ldsw = (unsigned)wid * 1024u;
    const int aoff = lds_byte(wr * 64 + fr, fq * 8), boff = lds_byte(wc * 32 + fr, fq * 8);
#define PG8_SA(b, h) (((b) * 2 + (h)) * HTB)
#define PG8_SB(b, h) ((4 + (b) * 2 + (h)) * HTB)
#define PG8_STAGE(bufoff, gbase, voff) do { _Pragma("unroll") for (int _i = 0; _i < 2; ++_i) \
        __builtin_amdgcn_global_load_lds((const unsigned*)((const char*)(gbase) + (voff)[_i]), (LAS unsigned*)(lds + (bufoff) + ldsw + _i * 8192), 16, 0, 0); } while (0)
#define PG8_LDA(dst, b, h) do { _Pragma("unroll") for (int m = 0; m < 4; ++m) _Pragma("unroll") for (int k = 0; k < 2; ++k) dst[m][k] = *(const LAS bf16x8*)(lds + PG8_SA(b, h) + aoff + m * 2048 + k * 1024); } while (0)
#define PG8_LDB(dst, b, h) do { _Pragma("unroll") for (int n = 0; n < 2; ++n) _Pragma("unroll") for (int k = 0; k < 2; ++k) dst[n][k] = *(const LAS bf16x8*)(lds + PG8_SB(b, h) + boff + n * 2048 + k * 1024); } while (0)
#define PG8_MMA(ai, bj, At, Bt) do { __builtin_amdgcn_s_setprio(1); _Pragma("unroll") for (int m = 0; m < 4; ++m) _Pragma("unroll") for (int n = 0; n < 2; ++n) _Pragma("unroll") for (int k = 0; k < 2; ++k) \
        acc[ai][bj][m][n] = __builtin_amdgcn_mfma_f32_16x16x32_bf16(Bt[n][k], At[m][k], acc[ai][bj][m][n], 0, 0, 0); __builtin_amdgcn_s_setprio(0); } while (0)
#define PG8_WAIT_V(n) asm volatile("s_waitcnt vmcnt(" #n ")" ::: "memory")
#define PG8_WAIT_L(n) asm volatile("s_waitcnt lgkmcnt(" #n ")" ::: "memory")
#define PG8_BAR __builtin_amdgcn_s_barrier()
#define PG8_SCHED __builtin_amdgcn_sched_barrier(0)
    Unit cur, nxt; int ui = 0;
    if (!S.next(0, cur)) return;
    f32x4 acc[2][2][4][2];
#pragma unroll
    for (int a = 0; a < 2; ++a)
#pragma unroll
        for (int b = 0; b < 2; ++b)
#pragma unroll
            for (int m = 0; m < 4; ++m)
#pragma unroll
                for (int n = 0; n < 2; ++n) acc[a][b][m][n] = (f32x4){0.f, 0.f, 0.f, 0.f};
    bf16x8 At[4][2], B0[2][2], B1[2][2];
    const char* cA = (const char*)g.A + (size_t)cur.pm * tstepA; const char* cB = (const char*)g.Bt + (size_t)cur.pn * tstepB;
    PG8_STAGE(PG8_SB(0, 0), cB, voffB); PG8_STAGE(PG8_SB(0, 1), cB + hstepB, voffB); PG8_STAGE(PG8_SA(0, 0), cA, voffA); PG8_STAGE(PG8_SA(0, 1), cA + hstepA, voffA);
    if (wr == 1) PG8_BAR;
    PG8_WAIT_V(2); PG8_BAR;
    PG8_STAGE(PG8_SB(1, 0), cB + kstep, voffB); PG8_STAGE(PG8_SA(1, 0), cA + kstep, voffA); PG8_STAGE(PG8_SB(1, 1), cB + hstepB + kstep, voffB);
    PG8_WAIT_V(6); PG8_BAR;
    for (;;) {
        const bool has_next = S.next(ui + 1, nxt);
        const char* nA = has_next ? (const char*)g.A + (size_t)nxt.pm * tstepA : cA; const char* nB = has_next ? (const char*)g.Bt + (size_t)nxt.pn * tstepB : cB;
#pragma nounroll
        for (int t = 0; t < nt; t += 2) {
            const bool last = (t == nt - 2);
            const char* a1 = cA + (size_t)(t + 1) * kstep;
            const char* a2 = last ? nA : cA + (size_t)(t + 2) * kstep; const char* b2 = last ? nB : cB + (size_t)(t + 2) * kstep;
            const char* a3 = a2 + kstep; const char* b3 = b2 + kstep;
            PG8_LDB(B0, 0, 0); PG8_LDB(B1, 0, 1); PG8_SCHED; PG8_LDA(At, 0, 0); PG8_STAGE(PG8_SA(1, 1), a1 + hstepA, voffA);
            PG8_WAIT_V(8); PG8_WAIT_L(0); PG8_BAR; PG8_MMA(0, 0, At, B0); PG8_MMA(0, 1, At, B1); PG8_BAR; PG8_SCHED;
            PG8_LDA(At, 0, 1); PG8_STAGE(PG8_SB(0, 0), b2, voffB); PG8_STAGE(PG8_SB(0, 1), b2 + hstepB, voffB); PG8_STAGE(PG8_SA(0, 0), a2, voffA);
            PG8_WAIT_V(8); PG8_WAIT_L(0); PG8_BAR; PG8_MMA(1, 0, At, B0); PG8_MMA(1, 1, At, B1); PG8_BAR; PG8_SCHED;
            PG8_LDB(B0, 1, 0); PG8_LDB(B1, 1, 1); PG8_SCHED; PG8_LDA(At, 1, 0); PG8_STAGE(PG8_SA(0, 1), a2 + hstepA, voffA);
            PG8_WAIT_V(8); PG8_WAIT_L(0); PG8_BAR; PG8_MMA(0, 0, At, B0); PG8_MMA(0, 1, At, B1); PG8_BAR; PG8_SCHED;
            PG8_LDA(At, 1, 1); PG8_STAGE(PG8_SB(1, 0), b3, voffB); PG8_STAGE(PG8_SB(1, 1), b3 + hstepB, voffB); PG8_STAGE(PG8_SA(1, 0), a3, voffA);
            PG8_WAIT_V(8); PG8_WAIT_L(0); PG8_BAR; PG8_MMA(1, 0, At, B0); PG8_MMA(1, 1, At, B1); PG8_BAR; PG8_SCHED;
        }
        if constexpr (ALIGN_EPI) { if (wr == 0) PG8_BAR; }
        E(acc, cur, wr, wc, fr, fq);
        if (!has_next) break;
#pragma unroll
        for (int a = 0; a < 2; ++a)
#pragma unroll
            for (int b = 0; b < 2; ++b)
#pragma unroll
                for (int m = 0; m < 4; ++m)
#pragma unroll
                    for (int n = 0; n < 2; ++n) acc[a][b][m][n] = (f32x4){0.f, 0.f, 0.f, 0.f};
        cur = nxt; cA = nA; cB = nB; ++ui;
        if constexpr (ALIGN_EPI) { if (wr == 1) PG8_BAR; }
    }
    PG8_WAIT_V(0);
    if constexpr (!ALIGN_EPI) { if (wr == 0) PG8_BAR; }
    PG8_BAR;
#undef PG8_SA
#undef PG8_SB
#undef PG8_STAGE
#undef PG8_LDA
#undef PG8_LDB
#undef PG8_MMA
#undef PG8_WAIT_V
#undef PG8_WAIT_L
#undef PG8_BAR
#undef PG8_SCHED
}

__device__ __forceinline__ u32x4 pk_bf16x8(f32x4 v0, f32x4 v1) { u32x4 w; w.x = cvtpk(v0[0], v0[1]); w.y = cvtpk(v0[2], v0[3]); w.z = cvtpk(v1[0], v1[1]); w.w = cvtpk(v1[2], v1[3]); return w; }
__device__ __forceinline__ void st_rows16(bf16_t* p0, int ldc, int fr, int fq, u32x4 A, u32x4 B) {
    u32x4 R;
    R.x = (unsigned)__builtin_amdgcn_mov_dpp((int)B.x, 0x128, 0xF, 0xF, true); R.y = (unsigned)__builtin_amdgcn_mov_dpp((int)B.y, 0x128, 0xF, 0xF, true);
    R.z = (unsigned)__builtin_amdgcn_mov_dpp((int)B.z, 0x128, 0xF, 0xF, true); R.w = (unsigned)__builtin_amdgcn_mov_dpp((int)B.w, 0x128, 0xF, 0xF, true);
    const bool low = fr < 8; const int f7 = fr & 7;
    bf16_t* q1 = p0 + (size_t)f7 * ldc + 8 * fq + (low ? 0 : 32);
    bf16_t* q2 = p0 + (size_t)(8 + f7) * ldc + 8 * fq + (low ? 32 : 0);
    *(u32x4*)q1 = low ? A : R;
    *(u32x4*)q2 = low ? R : A;
}
#define EPI_LOOP_AM _Pragma("unroll") for (int ai = 0; ai < 2; ++ai) _Pragma("unroll") for (int m = 0; m < 4; ++m)

struct EpiPlain {
    bf16_t* O; int ldc;
    __device__ __forceinline__ void operator()(const f32x4 (&acc)[2][2][4][2], const Unit& u, int wr, int wc, int fr, int fq) const {
        bf16_t* base = O + (size_t)(u.pm * BM + wr * 64) * ldc + u.pn * BM + wc * 64;
        EPI_LOOP_AM st_rows16(base + (size_t)(ai * HALF + m * 16) * ldc, ldc, fr, fq, pk_bf16x8(acc[ai][0][m][0], acc[ai][0][m][1]), pk_bf16x8(acc[ai][1][m][0], acc[ai][1][m][1]));
    }
};
template <int NP> struct EpiRowScale {
    bf16_t* O; int ldc; const float* ssq; float invn, mul;
    __device__ __forceinline__ void operator()(const f32x4 (&acc)[2][2][4][2], const Unit& u, int wr, int wc, int fr, int fq) const {
        const int row0 = u.pm * BM + wr * 64 + fr;
        bf16_t* base = O + (size_t)(u.pm * BM + wr * 64) * ldc + u.pn * BM + wc * 64;
        EPI_LOOP_AM { const int row = row0 + ai * HALF + m * 16; const float rs = rsqrtf(ssq_sum<NP>(ssq + (size_t)row * 16) * invn + EPS) * mul;
            st_rows16(base + (size_t)(ai * HALF + m * 16) * ldc, ldc, fr, fq, pk_bf16x8(acc[ai][0][m][0] * rs, acc[ai][0][m][1] * rs), pk_bf16x8(acc[ai][1][m][0] * rs, acc[ai][1][m][1] * rs));
            if (m & 1) asm volatile("" ::: "memory"); }
    }
};
struct EpiColScale {
    bf16_t* O; int ldc; const float* ssq; float invn;
    __device__ __forceinline__ void operator()(const f32x4 (&acc)[2][2][4][2], const Unit& u, int wr, int wc, int fr, int fq) const {
        const int col0 = u.pn * BM + wc * 64 + 8 * fq;
        bf16_t* base = O + (size_t)(u.pm * BM + wr * 64) * ldc + u.pn * BM + wc * 64;
        f32x4 rs[2][2];
#pragma unroll
        for (int bj = 0; bj < 2; ++bj) { const float* sp = ssq + (size_t)(col0 + bj * 32) * 16;
#pragma unroll
            for (int n = 0; n < 2; ++n) rs[bj][n] = (f32x4){rsqrtf(ssq_sum<8>(sp + (4 * n) * 16) * invn + EPS), rsqrtf(ssq_sum<8>(sp + (4 * n + 1) * 16) * invn + EPS), rsqrtf(ssq_sum<8>(sp + (4 * n + 2) * 16) * invn + EPS), rsqrtf(ssq_sum<8>(sp + (4 * n + 3) * 16) * invn + EPS)}; }
        EPI_LOOP_AM st_rows16(base + (size_t)(ai * HALF + m * 16) * ldc, ldc, fr, fq, pk_bf16x8(acc[ai][0][m][0] * rs[0][0], acc[ai][0][m][1] * rs[0][1]), pk_bf16x8(acc[ai][1][m][0] * rs[1][0], acc[ai][1][m][1] * rs[1][1]));
    }
};
struct EpiRes {
    const float* basef; const bf16_t* baseb; bf16_t* hb; float* ssq;
    __device__ __forceinline__ void operator()(const f32x4 (&acc)[2][2][4][2], const Unit& u, int wr, int wc, int fr, int fq) const {
        const int row0 = u.pm * BM + wr * 64 + fr, col0 = u.pn * BM + wc * 64 + 8 * fq;
        bf16_t* obase = hb + (size_t)(u.pm * BM + wr * 64) * D + u.pn * BM + wc * 64;
        EPI_LOOP_AM { const int row = row0 + ai * HALF + m * 16; const size_t off = (size_t)row * D + col0; float ss = 0.f; u32x4 pk[2];
#pragma unroll
            for (int bj = 0; bj < 2; ++bj) { f32x4 b0, b1;
                if (basef) { b0 = *(const f32x4*)(basef + off + bj * 32); b1 = *(const f32x4*)(basef + off + bj * 32 + 4); }
                else { const u32x4 r = *(const u32x4*)(baseb + off + bj * 32);
                    b0 = (f32x4){bf2f((unsigned short)(r.x & 0xffffu)), bf2f((unsigned short)(r.x >> 16)), bf2f((unsigned short)(r.y & 0xffffu)), bf2f((unsigned short)(r.y >> 16))};
                    b1 = (f32x4){bf2f((unsigned short)(r.z & 0xffffu)), bf2f((unsigned short)(r.z >> 16)), bf2f((unsigned short)(r.w & 0xffffu)), bf2f((unsigned short)(r.w >> 16))}; }
                const f32x4 h0 = b0 + acc[ai][bj][m][0], h1 = b1 + acc[ai][bj][m][1];
                pk[bj] = pk_bf16x8(h0, h1);
                ss += (h0[0] * h0[0] + h0[1] * h0[1]) + (h0[2] * h0[2] + h0[3] * h0[3]) + (h1[0] * h1[0] + h1[1] * h1[1]) + (h1[2] * h1[2] + h1[3] * h1[3]); }
            st_rows16(obase + (size_t)(ai * HALF + m * 16) * D, D, fr, fq, pk[0], pk[1]);
            ss += __shfl_xor(ss, 16); ss += __shfl_xor(ss, 32);
            if (fq == 0) ssq[(size_t)row * 16 + u.pn * 4 + wc] = ss;
            asm volatile("" ::: "memory"); }
    }
};
struct EpiProj {
    bf16_t* P; float* ssq_q; float* ssq_kv; const float* cr; const float* sr; const float* cm; const float* sm;
    __device__ __forceinline__ void operator()(const f32x4 (&acc)[2][2][4][2], const Unit& u, int wr, int wc, int fr, int fq) const {
        const int row0 = u.pm * BM + wr * 64 + fr;
        const int hb = 2 * u.pn + (wc >> 1);
        if (hb == 17 && (wc & 1) != 0) return;
        const int kind = hb < 3 ? 0 : hb < 5 ? 1 : hb < 9 ? 2 : hb < 13 ? 3 : hb < 17 ? 4 : 5;
        bf16_t* base = P + (size_t)(u.pm * BM + wr * 64) * NPROJ + u.pn * BM + wc * 64;
        EPI_LOOP_AM { const int row = row0 + ai * HALF + m * 16; const int s = row & (SEQ - 1); u32x4 pk[2];
#pragma unroll
            for (int bj = 0; bj < 2; ++bj) { const int g32 = 2 * (wc & 1) + bj;
                f32x4 v0 = acc[ai][bj][m][0], v1 = acc[ai][bj][m][1];
                if (kind <= 1) {
                    float ss = (v0[0] * v0[0] + v0[1] * v0[1]) + (v0[2] * v0[2] + v0[3] * v0[3]) + (v1[0] * v1[0] + v1[1] * v1[1]) + (v1[2] * v1[2] + v1[3] * v1[3]);
                    ss += __shfl_xor(ss, 16); ss += __shfl_xor(ss, 32);
                    if (fq == 0) { if (kind == 0) ssq_q[(size_t)row * 16 + hb * 4 + g32] = ss; else ssq_kv[(size_t)row * 16 + (hb - 3) * 4 + g32] = ss; }
                } else if (kind == 2 || kind == 3) {
                    const f32x4 c = *(const f32x4*)(cr + (size_t)s * 64 + g32 * 16 + 4 * fq), sn = *(const f32x4*)(sr + (size_t)s * 64 + g32 * 16 + 4 * fq);
                    f32x4 y0 = v0 * c - v1 * sn, y1 = v0 * sn + v1 * c;
                    if (kind == 3) { y0 = y0 * 0.08838834764831845f; y1 = y1 * 0.08838834764831845f; }
                    v0 = y0; v1 = y1;
                } else if (kind == 5 && bj == 0) {
                    const f32x4 c = *(const f32x4*)(cm + (size_t)s * 16 + 4 * fq), sn = *(const f32x4*)(sm + (size_t)s * 16 + 4 * fq);
                    const f32x4 y0 = v0 * c - v1 * sn, y1 = v0 * sn + v1 * c; v0 = y0; v1 = y1;
                }
                pk[bj] = pk_bf16x8(v0, v1); }
            st_rows16(base + (size_t)(ai * HALF + m * 16) * NPROJ, NPROJ, fr, fq, pk[0], pk[1]);
            if (m & 1) asm volatile("" ::: "memory"); }
    }
};
struct EpiQ {
    bf16_t* O; const float* ssq; const float* cm; const float* sm;
    __device__ __forceinline__ void operator()(const f32x4 (&acc)[2][2][4][2], const Unit& u, int wr, int wc, int fr, int fq) const {
        const int row0 = u.pm * BM + wr * 64 + fr;
        bf16_t* base = O + (size_t)(u.pm * BM + wr * 64) * 768 + u.pn * BM + wc * 64;
        EPI_LOOP_AM { const int row = row0 + ai * HALF + m * 16; const int s = row & (SEQ - 1); const float rs = rsqrtf(ssq_sum<12>(ssq + (size_t)row * 16) * (1.f / 384.f) + EPS) * C2_MLA;
            f32x4 c = (f32x4){1.f, 1.f, 1.f, 1.f}, sn = (f32x4){0.f, 0.f, 0.f, 0.f};
            if (u.pn == 2) { c = *(const f32x4*)(cm + (size_t)s * 16 + 4 * fq); sn = *(const f32x4*)(sm + (size_t)s * 16 + 4 * fq); }
            u32x4 pk[2];
#pragma unroll
            for (int bj = 0; bj < 2; ++bj) { const f32x4 v0 = acc[ai][bj][m][0] * rs, v1 = acc[ai][bj][m][1] * rs; pk[bj] = pk_bf16x8(v0 * c - v1 * sn, v0 * sn + v1 * c); }
            st_rows16(base + (size_t)(ai * HALF + m * 16) * 768, 768, fr, fq, pk[0], pk[1]);
            asm volatile("" ::: "memory"); }
    }
};
}

#define XB_TMO      128
#define XB_XCNT(j)  (256  + 64 * (j))
#define XB_XSUB(j)  (1280 + 64 * (j))
#define XB_XGEN(j)  (2304 + 64 * (j))
#define XB_TOP      3328
#define XB_TOPGEN   3392
#define XCD_BAR_WORDS 3456
#define XB_SPIN_CAP (1u << 21)
__device__ __forceinline__ unsigned xb_ld(unsigned* p)              { return __hip_atomic_load(p, __ATOMIC_RELAXED, __HIP_MEMORY_SCOPE_AGENT); }
__device__ __forceinline__ unsigned xb_add(unsigned* p, unsigned v) { return __hip_atomic_fetch_add(p, v, __ATOMIC_RELAXED, __HIP_MEMORY_SCOPE_AGENT); }
__device__ __forceinline__ unsigned xb_xcc_id() { return (unsigned)__builtin_amdgcn_s_getreg((3 << 11) | 20) & 0xFu; }
#define XB_SPIN(cond, bar) do { unsigned _sp = 0; while (cond) { __builtin_amdgcn_s_sleep(1); \
    if ((++_sp & 255u) == 0u) { if (xb_ld(&(bar)[XB_TMO])) break; if (_sp > XB_SPIN_CAP) { atomicAdd(&(bar)[XB_TMO], 1u); break; } } } } while (0)
struct XcdBarrier { unsigned* bar; unsigned x; volatile LAS unsigned* st; };
__device__ __forceinline__ XcdBarrier xcd_barrier_post(unsigned* bar, volatile LAS unsigned* st) {
    XcdBarrier b; b.bar = bar; b.x = xb_xcc_id(); b.st = st;
    if (threadIdx.x == 0) (void)xb_add(&bar[XB_XCNT(b.x)], 1u);
    return b;
}
__device__ __forceinline__ void xcd_barrier_complete(unsigned* bar, unsigned x, unsigned& nloc, unsigned& nx) {
    const unsigned G = gridDim.x * gridDim.y * gridDim.z;
    unsigned sum, cnt, mine, sp = 0u;
    for (;;) {
        sum = 0u; cnt = 0u; mine = 0u;
#pragma unroll
        for (unsigned j = 0; j < 16; ++j) { const unsigned c = xb_ld(&bar[XB_XCNT(j)]); sum += c; cnt += (c > 0u) ? 1u : 0u; mine = (j == x) ? c : mine; }
        if (sum == G) break;
        __builtin_amdgcn_s_sleep(1);
        if ((++sp & 255u) == 0u) { if (xb_ld(&bar[XB_TMO])) break; if (sp > XB_SPIN_CAP) { atomicAdd(&bar[XB_TMO], 1u); break; } }
    }
    nloc = mine > 0u ? mine : 1u; nx = cnt > 0u ? cnt : 1u;
}
__device__ __forceinline__ void xcd_barrier(const XcdBarrier& b) {
    asm volatile("s_waitcnt vmcnt(0)" ::: "memory");
    __syncthreads();
    if (threadIdx.x == 0) {
        unsigned* bar = b.bar;
        __builtin_amdgcn_s_waitcnt(0);
        unsigned nloc = b.st[0], nx = b.st[1];
        if (nloc == 0u) { xcd_barrier_complete(bar, b.x, nloc, nx); b.st[0] = nloc; b.st[1] = nx; }
        const unsigned old = xb_add(&bar[XB_XSUB(b.x)], 1u);
        const unsigned gen = old / nloc;
        if (old + 1u == (gen + 1u) * nloc) {
            __builtin_amdgcn_fence(__ATOMIC_RELEASE, "agent");
            asm volatile("s_waitcnt vmcnt(0)" ::: "memory");
            const unsigned og = xb_add(&bar[XB_TOP], 1u);
            const unsigned tg = og / nx;
            if (og + 1u == (tg + 1u) * nx) xb_add(&bar[XB_TOPGEN], 1u);
            else XB_SPIN(xb_ld(&bar[XB_TOPGEN]) == tg, bar);
            __builtin_amdgcn_fence(__ATOMIC_ACQUIRE, "agent");
            xb_add(&bar[XB_XGEN(b.x)], 1u);
            asm volatile("s_waitcnt vmcnt(0)" ::: "memory");
        } else {
            XB_SPIN(xb_ld(&bar[XB_XGEN(b.x)]) == gen, bar);
            __builtin_amdgcn_fence(__ATOMIC_ACQUIRE, "agent");
            asm volatile("s_waitcnt vmcnt(0)" ::: "memory");
        }
    }
    __syncthreads();
}

struct Params {
    const float *x, *mem, *g_mix, *w_in, *g_q_lora, *w_uq, *g_kv_lora, *w_ukv, *g_ret_gn, *w_o, *g_xattn, *g_mem, *w_xq, *w_xkv, *w_xo, *g_ffn, *w_pq, *sub_keys, *u_exp, *v_exp, *g_final;
    float* out; unsigned char* ws; int never; int pad;
};

__device__ __forceinline__ int rope32(int r, int second) { return 8 * (r >> 2) + 4 * second + (r & 3); }
__device__ __forceinline__ int permret(int i) { return i < 64 ? ((i >> 4) * 32 + rope32(i & 15, 0)) : (((i - 64) >> 4) * 32 + rope32((i - 64) & 15, 1)); }
template <int MODE> __device__ __forceinline__ int dst_row(int c) {
    if (MODE == 1) {
        if (c < 640) return c;
        if (c < 672) { const int r = c - 640; return 2176 + rope32(r & 15, r >> 4); }
        if (c < 1184) { const int cc = c - 672; return 640 + (cc & ~127) + permret(cc & 127); }
        if (c < 1696) { const int cc = c - 1184; return 1152 + (cc & ~127) + permret(cc & 127); }
        if (c < 2208) return 2304 + (c - 1696);
        return 1664 + (c - 2208);
    } else if (MODE == 2) {
        const int h = c / 96, i = c - h * 96; return i < 64 ? h * 64 + i : 512 + h * 32 + rope32((i - 64) & 15, (i - 64) >> 4);
    } else if (MODE == 3) {
        const int h = c >> 7, i = c & 127; return i < 64 ? h * 64 + i : 512 + h * 64 + (i - 64);
    }
    return c;
}
template <int MODE> __device__ __forceinline__ void p0_transpose_item(const float* W, int K, int N, bf16_t* WT, const float* gain, LAS float* scr, int item, int lane) {
    const int nblk = N / 32, kb = item / nblk, nb = item % nblk, k0 = 64 * kb, n0 = 32 * nb;
    float v[32];
#pragma unroll
    for (int i = 0; i < 32; ++i) { const int kk = 2 * i + (lane >> 5); v[i] = W[(size_t)(k0 + kk) * N + n0 + (lane & 31)]; }
    if (gain) {
#pragma unroll
        for (int i = 0; i < 32; ++i) { const int kk = 2 * i + (lane >> 5); v[i] *= gain[k0 + kk]; }
    }
#pragma unroll
    for (int i = 0; i < 32; ++i) { const int kk = 2 * i + (lane >> 5); scr[kk * 33 + (lane & 31)] = v[i]; }
    LDS_WAIT(); asm volatile("" ::: "memory");
    const int c = lane & 7;
#pragma unroll
    for (int j = 0; j < 4; ++j) { const int n = (lane >> 3) + 8 * j; const LAS float* s = scr + (8 * c) * 33 + n;
        u32x4 o; o.x = cvtpk(s[0 * 33], s[1 * 33]); o.y = cvtpk(s[2 * 33], s[3 * 33]); o.z = cvtpk(s[4 * 33], s[5 * 33]); o.w = cvtpk(s[6 * 33], s[7 * 33]);
        *(u32x4*)(WT + (size_t)dst_row<MODE>(n0 + n) * K + k0 + 8 * c) = o; }
    LDS_WAIT(); asm volatile("" ::: "memory");
}
template <int NR> __device__ __forceinline__ void rms_rows_to_bf16(const float* xrow, const float* g, bf16_t* orow, size_t rstride, int lane) {
    f32x4 v[NR][4];
#pragma unroll
    for (int r = 0; r < NR; ++r)
#pragma unroll
        for (int j = 0; j < 4; ++j) v[r][j] = ((const f32x4*)(xrow + r * rstride) + lane)[64 * j];
    const f32x4* gr = (const f32x4*)g + lane;
    f32x4 gv[4];
#pragma unroll
    for (int j = 0; j < 4; ++j) gv[j] = gr[64 * j];
#pragma unroll
    for (int r = 0; r < NR; ++r) {
        float s = 0.f;
#pragma unroll
        for (int j = 0; j < 4; ++j) s += (v[r][j][0] * v[r][j][0] + v[r][j][1] * v[r][j][1]) + (v[r][j][2] * v[r][j][2] + v[r][j][3] * v[r][j][3]);
        const float rstd = rsqrtf(wave_sum(s) * (1.f / D) + EPS);
        u32x2* o8 = (u32x2*)(orow + r * rstride) + lane;
#pragma unroll
        for (int j = 0; j < 4; ++j) { const f32x4 y = v[r][j] * rstd * gv[j]; u32x2 w; w.x = cvtpk(y[0], y[1]); w.y = cvtpk(y[2], y[3]); o8[64 * j] = w; }
    }
}

struct NoMid { __device__ __forceinline__ void operator()() const {} };
__device__ __forceinline__ float max3f(float a, float b, float c) { return fmaxf(fmaxf(a, b), c); }
template <int NS, int NT, int KG, bool CINIT, bool MASK, class Mid>
__device__ __forceinline__ void flash_tile(const LAS unsigned char* Ks, int kpitch, const LAS unsigned char* Vs, int vpitch, const bf16x8 (&qf)[NS], f32x16 (&o)[NT],
                                           f32x16& negm, float& mref, float& lrun, bool first, int r32, int hi, bool domask, int qrel, int krel, const Mid& mid) {
    f32x16 p0, p1;
    const LAS unsigned char* k0 = Ks + r32 * kpitch + hi * 16; const LAS unsigned char* k1 = k0 + 32 * kpitch;
    if (CINIT) { p0 = negm; p1 = negm; }
    else {
#pragma unroll
        for (int r = 0; r < 16; ++r) { p0[r] = 0.f; p1[r] = 0.f; }
    }
#pragma unroll
    for (int g0 = 0; g0 < NS; g0 += KG) {
        bf16x8 ka[KG], kb2[KG];
#pragma unroll
        for (int s = 0; s < KG; ++s) { ka[s] = *(const LAS bf16x8*)(k0 + (g0 + s) * 32); kb2[s] = *(const LAS bf16x8*)(k1 + (g0 + s) * 32); }
        __builtin_amdgcn_sched_barrier(0);
#pragma unroll
        for (int s = 0; s < KG; ++s) { p0 = MFMA32(ka[s], qf[g0 + s], p0); p1 = MFMA32(kb2[s], qf[g0 + s], p1); }
        __builtin_amdgcn_sched_barrier(0);
    }
    if (!CINIT) {
#pragma unroll
        for (int r = 0; r < 16; ++r) { p0[r] -= mref; p1[r] -= mref; }
    }
    if (MASK) {
#pragma unroll
        for (int r = 0; r < 16; ++r) { const int kv = krel + crow(r, hi); if (kv > qrel) p0[r] = -1e30f; if (kv + 32 > qrel) p1[r] = -1e30f; }
    }
    float ma = max3f(p0[0], p0[1], p1[0]), mb = max3f(p0[2], p0[3], p1[1]); ma = max3f(ma, p1[2], p1[3]);
#pragma unroll
    for (int r = 4; r < 16; r += 4) { ma = max3f(ma, p0[r], p0[r + 1]); mb = max3f(mb, p0[r + 2], p0[r + 3]); ma = max3f(ma, p1[r], p1[r + 1]); mb = max3f(mb, p1[r + 2], p1[r + 3]); }
    const float mx = xhalf_max(fmaxf(ma, mb));
    if (first || __any(mx > 8.0f)) {
        const float dl = first ? mx : fmaxf(mx, 0.f);
        mref += dl;
#pragma unroll
        for (int r = 0; r < 16; ++r) { p0[r] -= dl; p1[r] -= dl; if (CINIT) negm[r] = -mref; }
        const float alpha = __builtin_amdgcn_exp2f(-dl);
        lrun *= alpha;
        if (!first) {
#pragma unroll
            for (int t = 0; t < NT; ++t)
#pragma unroll
                for (int r = 0; r < 16; ++r) o[t][r] *= alpha;
        }
    }
    float rs0 = 0.f, rs1 = 0.f;
#pragma unroll
    for (int r = 0; r < 16; ++r) { p0[r] = __builtin_amdgcn_exp2f(p0[r]); p1[r] = __builtin_amdgcn_exp2f(p1[r]); rs0 += p0[r]; rs1 += p1[r]; }
    lrun += rs0 + rs1;
    bf16x8 pb[4];
#pragma unroll
    for (int ks = 0; ks < 2; ++ks) {
        u32x4 w0, w1;
        w0.x = cvtpk(p0[8 * ks + 0], p0[8 * ks + 1]); w0.y = cvtpk(p0[8 * ks + 2], p0[8 * ks + 3]); w0.z = cvtpk(p0[8 * ks + 4], p0[8 * ks + 5]); w0.w = cvtpk(p0[8 * ks + 6], p0[8 * ks + 7]);
        w1.x = cvtpk(p1[8 * ks + 0], p1[8 * ks + 1]); w1.y = cvtpk(p1[8 * ks + 2], p1[8 * ks + 3]); w1.z = cvtpk(p1[8 * ks + 4], p1[8 * ks + 5]); w1.w = cvtpk(p1[8 * ks + 6], p1[8 * ks + 7]);
        pb[ks] = __builtin_bit_cast(bf16x8, w0); pb[2 + ks] = __builtin_bit_cast(bf16x8, w1);
    }
    mid();
    const LAS unsigned char* vb = Vs + r32 * vpitch + hi * 8;
#pragma unroll
    for (int t = 0; t < NT; ++t) {
        s16x4 lo[4], hh[4];
#pragma unroll
        for (int ks = 0; ks < 4; ++ks) { lo[ks] = *(const LAS s16x4*)(vb + t * 32 * vpitch + ks * 32); hh[ks] = *(const LAS s16x4*)(vb + t * 32 * vpitch + ks * 32 + 16); }
        __builtin_amdgcn_sched_barrier(0);
#pragma unroll
        for (int ks = 0; ks < 4; ++ks) { const bf16x8 a = (bf16x8){lo[ks][0], lo[ks][1], lo[ks][2], lo[ks][3], hh[ks][0], hh[ks][1], hh[ks][2], hh[ks][3]}; o[t] = MFMA32(a, pb[ks], o[t]); }
        __builtin_amdgcn_sched_barrier(0);
    }
}

constexpr int MLA_KP = 208, MLA_VP = 264;
constexpr int MLA_KT = 128 * MLA_KP, MLA_VTB = 64 * MLA_VP, MLA_BUF = MLA_KT + MLA_VTB;
__device__ __forceinline__ void mla_unit(LAS unsigned char* lds, int b, int h, int qb, const bf16_t* QM, const bf16_t* KN, const bf16_t* PROJ, const bf16_t* VT, bf16_t* MIX) {
    const int tid = opaque_tid(), lane = tid & 63, r32 = lane & 31, hi = lane >> 5, wid = __builtin_amdgcn_readfirstlane(tid >> 6);
    const size_t tb = (size_t)b * SEQ;
    const int q0 = qb * 256 + wid * 32;
    bf16x8 qf[6];
    { const bf16_t* qr = QM + (tb + q0 + r32) * 768;
#pragma unroll
      for (int s = 0; s < 4; ++s) qf[s] = *(const bf16x8*)(qr + h * 64 + s * 16 + hi * 8);
#pragma unroll
      for (int s = 0; s < 2; ++s) qf[4 + s] = *(const bf16x8*)(qr + 512 + h * 32 + s * 16 + hi * 8); }
    f32x16 o[2], negm;
#pragma unroll
    for (int r = 0; r < 16; ++r) { o[0][r] = 0.f; o[1][r] = 0.f; negm[r] = 0.f; }
    float mref = 0.f, lrun = 0.f;
    const int NCH = 2 * qb + 2;
    const int kr = tid >> 3, kc = tid & 7;
    const int pr = tid >> 2, pc = tid & 3;
    const int vr = tid >> 4, vc = tid & 15;
    const bf16_t* ksrc = KN + (tb + kr) * 512 + h * 64 + kc * 8;
    const bf16_t* psrc = PROJ + (tb + pr) * NPROJ + 2176 + pc * 8;
    const bf16_t* vsrc = VT + (size_t)(h * 64 + vr) * TP + tb + vc * 8;
    struct Stg { u32x4 k0, k1, pe, v0, v1; };
    Stg sa, sb;
    auto stage_load = [&](Stg& s, int ch) { const size_t ko = (size_t)ch * 128;
        s.k0 = *(const u32x4*)(ksrc + ko * 512); s.k1 = *(const u32x4*)(ksrc + (ko + 64) * 512); s.pe = *(const u32x4*)(psrc + ko * NPROJ);
        s.v0 = *(const u32x4*)(vsrc + ko); s.v1 = *(const u32x4*)(vsrc + (size_t)32 * TP + ko); };
    auto stage_write = [&](const Stg& s, int buf) {
        LAS unsigned char* kb = lds + buf * MLA_BUF; LAS unsigned char* vbp = kb + MLA_KT;
        *(LAS u32x4*)(kb + kr * MLA_KP + kc * 16) = s.k0; *(LAS u32x4*)(kb + (kr + 64) * MLA_KP + kc * 16) = s.k1;
        *(LAS u32x4*)(kb + pr * MLA_KP + 128 + pc * 16) = s.pe;
        { LAS unsigned char* d = vbp + vr * MLA_VP + vc * 16; *(LAS u32x2*)d = (u32x2){s.v0.x, s.v0.y}; *(LAS u32x2*)(d + 8) = (u32x2){s.v0.z, s.v0.w}; }
        { LAS unsigned char* d = vbp + (vr + 32) * MLA_VP + vc * 16; *(LAS u32x2*)d = (u32x2){s.v1.x, s.v1.y}; *(LAS u32x2*)(d + 8) = (u32x2){s.v1.z, s.v1.w}; }
    };
    const int qrel = wid * 32 + r32;
    auto compute = [&](int buf, int ch) {
        const LAS unsigned char* kb = lds + buf * MLA_BUF;
#pragma unroll
        for (int j = 0; j < 2; ++j)
            flash_tile<6, 2, 6, true, false>(kb + j * 64 * MLA_KP, MLA_KP, kb + MLA_KT + j * 128, MLA_VP, qf, o, negm, mref, lrun, ch == 0 && j == 0, r32, hi, false, qrel, 0, NoMid());
    };
    auto compute_band = [&](int buf, int ch) {
        const LAS unsigned char* kb = lds + buf * MLA_BUF;
#pragma unroll
        for (int j = 0; j < 2; ++j) {
            const int krel = ch * 128 + j * 64 - qb * 256;
            if (krel <= wid * 32 + 31)
                flash_tile<6, 2, 6, true, true>(kb + j * 64 * MLA_KP, MLA_KP, kb + MLA_KT + j * 128, MLA_VP, qf, o, negm, mref, lrun, ch == 0 && j == 0, r32, hi, true, qrel, krel, NoMid());
        }
    };
    stage_load(sa, 0); stage_write(sa, 0);
    stage_load(sa, 1);
    __syncthreads();
    for (int ch = 0; ch < NCH - 2; ch += 2) {
        stage_load(sb, ch + 2);
        compute(0, ch);
        stage_write(sa, 1);
        __syncthreads();
        stage_load(sa, ch + 3);
        compute(1, ch + 1);
        stage_write(sb, 0);
        __syncthreads();
    }
    {
        compute_band(0, NCH - 2);
        stage_write(sa, 1);
        __syncthreads();
        compute_band(1, NCH - 1);
        __syncthreads();
    }
    const float inv = 1.f / xhalf_sum(lrun);
    bf16_t* orow = MIX + (tb + q0 + r32) * D + h * 64;
#pragma unroll
    for (int t = 0; t < 2; ++t)
#pragma unroll
        for (int g = 0; g < 4; ++g) { u32x2 w; w.x = cvtpk(o[t][4 * g] * inv, o[t][4 * g + 1] * inv); w.y = cvtpk(o[t][4 * g + 2] * inv, o[t][4 * g + 3] * inv);
            *(u32x2*)(orow + 32 * t + 8 * g + 4 * hi) = w; }
}

constexpr int XA_KP = 528, XA_VP = 136;
constexpr int XA_KT = 64 * XA_KP, XA_VTB = 128 * XA_VP;
__device__ __forceinline__ void xattn_unit(LAS unsigned char* lds, int b, int h, int qb, int dvh, const bf16_t* QX, const bf16_t* KX, const bf16_t* VXT, bf16_t* OX) {
    const int tid = opaque_tid(), lane = tid & 63, r32 = lane & 31, hi = lane >> 5, wid = __builtin_amdgcn_readfirstlane(tid >> 6);
    const size_t tb = (size_t)b * SEQ;
    const int q0 = qb * 256 + wid * 32;
    bf16x8 qf[16];
    { const bf16_t* qr = QX + (tb + q0 + r32) * D + h * 256 + hi * 8;
#pragma unroll
      for (int s = 0; s < 16; ++s) qf[s] = *(const bf16x8*)(qr + s * 16); }
    f32x16 o[4], negm;
#pragma unroll
    for (int t = 0; t < 4; ++t)
#pragma unroll
        for (int r = 0; r < 16; ++r) o[t][r] = 0.f;
#pragma unroll
    for (int r = 0; r < 16; ++r) negm[r] = 0.f;
    float mref = 0.f, lrun = 0.f;
    const bf16_t* kbase = KX + (size_t)(b * 256) * D + h * 256;
    const bf16_t* vbase = VXT + (size_t)(h * 256 + dvh * 128) * D + b * 256;
    u32x4 kreg[4], vreg[2];
    auto stage_load = [&](int kt) {
#pragma unroll
        for (int i = 0; i < 4; ++i) { const int idx = tid + 512 * i, row = idx >> 5, c = idx & 31; kreg[i] = *(const u32x4*)(kbase + (size_t)(kt * 64 + row) * D + c * 8); }
#pragma unroll
        for (int i = 0; i < 2; ++i) { const int idx = tid + 512 * i, dv = idx >> 3, c = idx & 7; vreg[i] = *(const u32x4*)(vbase + (size_t)dv * D + kt * 64 + c * 8); }
    };
    auto stage_write = [&](int buf) {
        LAS unsigned char* kb = lds + buf * (XA_KT + XA_VTB); LAS unsigned char* vbp = kb + XA_KT;
#pragma unroll
        for (int i = 0; i < 4; ++i) { const int idx = tid + 512 * i, row = idx >> 5, c = idx & 31; *(LAS u32x4*)(kb + row * XA_KP + c * 16) = kreg[i]; }
#pragma unroll
        for (int i = 0; i < 2; ++i) { const int idx = tid + 512 * i, dv = idx >> 3, c = idx & 7;
            *(LAS u32x2*)(vbp + dv * XA_VP + c * 16) = (u32x2){vreg[i].x, vreg[i].y}; *(LAS u32x2*)(vbp + dv * XA_VP + c * 16 + 8) = (u32x2){vreg[i].z, vreg[i].w}; }
    };
    stage_load(0); stage_write(0);
    __syncthreads();
    for (int kt = 0; kt < 4; ++kt) {
        const int buf = kt & 1;
        const LAS unsigned char* kb = lds + buf * (XA_KT + XA_VTB);
        auto mid = [&]() { if (kt + 1 < 4) stage_load(kt + 1); };
        flash_tile<16, 4, 4, false, false>(kb, XA_KP, kb + XA_KT, XA_VP, qf, o, negm, mref, lrun, kt == 0, r32, hi, false, 0, 0, mid);
        if (kt + 1 < 4) stage_write(buf ^ 1);
        __syncthreads();
    }
    const float inv = 1.f / xhalf_sum(lrun);
    bf16_t* orow = OX + (tb + q0 + r32) * D + h * 256 + dvh * 128;
#pragma unroll
    for (int t = 0; t < 4; ++t)
#pragma unroll
        for (int g = 0; g < 4; ++g) { u32x2 w; w.x = cvtpk(o[t][4 * g] * inv, o[t][4 * g + 1] * inv); w.y = cvtpk(o[t][4 * g + 2] * inv, o[t][4 * g + 3] * inv);
            *(u32x2*)(orow + 32 * t + 8 * g + 4 * hi) = w; }
}

constexpr int RT_P = 272;
constexpr int RT_PV = 264;
__device__ __forceinline__ float ret_log2g(int h) { return log2f(1.0f - exp2f(-5.0f - (float)h)); }
__device__ __forceinline__ void ret_state_unit(LAS unsigned char* lds, int unit, const bf16_t* PROJ, const bf16_t* RVT, bf16_t* RKVT) {
    const int tid = opaque_tid(), lane = tid & 63, r32 = lane & 31, hi = lane >> 5, wid = __builtin_amdgcn_readfirstlane(tid >> 6);
    const int n = unit & 31, h = (unit >> 5) & 3, b = unit >> 7;
    const size_t t0 = (size_t)b * SEQ + n * 128;
    const float l2g = ret_log2g(h);
    LAS unsigned char* Vs = lds;
    LAS unsigned char* Ks = lds + 128 * RT_P;
#pragma unroll
    for (int i = 0; i < 4; ++i) { const int idx = tid + 512 * i, e = idx >> 4, c = idx & 15;
        *(LAS u32x4*)(Vs + e * RT_P + c * 16) = *(const u32x4*)(RVT + (size_t)(h * 128 + e) * TP + t0 + c * 8); }
#pragma unroll
    for (int i = 0; i < 4; ++i) { const int idx = tid + 512 * i, j = idx >> 4, c = idx & 15;
        const u32x4 v = *(const u32x4*)(PROJ + (t0 + j) * NPROJ + 1152 + h * 128 + c * 8);
        const float z = exp2f((float)(127 - j) * l2g);
        const unsigned w[4] = {v.x, v.y, v.z, v.w};
#pragma unroll
        for (int q = 0; q < 4; ++q) { const float lo = bf2f((unsigned short)(w[q] & 0xffffu)) * z, hh = bf2f((unsigned short)(w[q] >> 16)) * z; const unsigned pk = cvtpk(lo, hh);
            *(LAS unsigned short*)(Ks + (c * 8 + 2 * q) * RT_P + j * 2) = (unsigned short)(pk & 0xffffu); *(LAS unsigned short*)(Ks + (c * 8 + 2 * q + 1) * RT_P + j * 2) = (unsigned short)(pk >> 16); } }
    __syncthreads();
    const int eb = (wid & 3) * 32, db = (wid >> 2) * 64;
    f32x16 acc[2];
#pragma unroll
    for (int t = 0; t < 2; ++t)
#pragma unroll
        for (int r = 0; r < 16; ++r) acc[t][r] = 0.f;
#pragma unroll
    for (int ks = 0; ks < 8; ++ks) {
        const bf16x8 a = *(const LAS bf16x8*)(Vs + (eb + r32) * RT_P + ks * 32 + hi * 16);
#pragma unroll
        for (int t = 0; t < 2; ++t) { const bf16x8 bb = *(const LAS bf16x8*)(Ks + (db + 32 * t + r32) * RT_P + ks * 32 + hi * 16); acc[t] = MFMA32(a, bb, acc[t]); }
    }
    bf16_t* O = RKVT + (size_t)unit * 16384;
#pragma unroll
    for (int t = 0; t < 2; ++t)
#pragma unroll
        for (int r = 0; r < 16; ++r) { const unsigned pk = cvtpk(acc[t][r], 0.f); O[(size_t)(eb + crow(r, hi)) * 128 + db + 32 * t + r32] = (unsigned short)(pk & 0xffffu); }
    __syncthreads();
}
__device__ __forceinline__ void ret_out_unit(LAS unsigned char* lds, int unit, const bf16_t* PROJ, const bf16_t* RVT, const bf16_t* RKVT, const float* g_gn, bf16_t* MIX) {
    const int tid = opaque_tid(), lane = tid & 63, r32 = lane & 31, hi = lane >> 5, wid = __builtin_amdgcn_readfirstlane(tid >> 6);
    const int n = unit & 31, h = (unit >> 5) & 3, b = unit >> 7;
    const size_t t0 = (size_t)b * SEQ + n * 128;
    const float l2g = ret_log2g(h);
    LAS unsigned char* Ks = lds;
    LAS unsigned char* Vs = lds + 128 * RT_P;
    LAS unsigned char* Rs = Vs + 128 * RT_PV;
    LAS float* Xs = (LAS float*)(Rs + 128 * RT_P);
#pragma unroll
    for (int i = 0; i < 4; ++i) { const int idx = tid + 512 * i, j = idx >> 4, c = idx & 15;
        *(LAS u32x4*)(Ks + j * RT_P + c * 16) = *(const u32x4*)(PROJ + (t0 + j) * NPROJ + 1152 + h * 128 + c * 8); }
#pragma unroll
    for (int i = 0; i < 4; ++i) { const int idx = tid + 512 * i, e = idx >> 4, c = idx & 15;
        const u32x4 v = *(const u32x4*)(RVT + (size_t)(h * 128 + e) * TP + t0 + c * 8);
        *(LAS u32x2*)(Vs + e * RT_PV + c * 16) = (u32x2){v.x, v.y}; *(LAS u32x2*)(Vs + e * RT_PV + c * 16 + 8) = (u32x2){v.z, v.w}; }
    {
        const bf16_t* src = RKVT + (size_t)unit * 16384;
#pragma unroll
        for (int i = 0; i < 4; ++i) { const int idx = tid + 512 * i, e = idx >> 4, c = idx & 15; *(LAS u32x4*)(Rs + e * RT_P + c * 16) = *(const u32x4*)(src + idx * 8); }
    }
    const int ib = wid & 3, eh = wid >> 2;
    bf16x8 qf[8];
    { const bf16_t* qr = PROJ + (t0 + ib * 32 + r32) * NPROJ + 640 + h * 128 + hi * 8;
#pragma unroll
      for (int s = 0; s < 8; ++s) qf[s] = *(const bf16x8*)(qr + s * 16); }
    __syncthreads();
    f32x16 oi[2], oc[2];
#pragma unroll
    for (int t = 0; t < 2; ++t)
#pragma unroll
        for (int r = 0; r < 16; ++r) { oi[t][r] = 0.f; oc[t][r] = 0.f; }
#pragma unroll
    for (int s = 0; s < 8; ++s)
#pragma unroll
        for (int t = 0; t < 2; ++t) { const bf16x8 a = *(const LAS bf16x8*)(Rs + (eh * 64 + t * 32 + r32) * RT_P + s * 32 + hi * 16); oc[t] = MFMA32(a, qf[s], oc[t]); }
    for (int jt = 0; jt <= ib; ++jt) {
        f32x16 p;
#pragma unroll
        for (int r = 0; r < 16; ++r) p[r] = 0.f;
#pragma unroll
        for (int s = 0; s < 8; ++s) { const bf16x8 a = *(const LAS bf16x8*)(Ks + (jt * 32 + r32) * RT_P + s * 32 + hi * 16); p = MFMA32(a, qf[s], p); }
        const int dbase = (ib - jt) * 32 + r32;
#pragma unroll
        for (int r = 0; r < 16; ++r) { const int dd = dbase - crow(r, hi); p[r] = dd >= 0 ? p[r] * exp2f((float)dd * l2g) : 0.f; }
        bf16x8 pb[2];
#pragma unroll
        for (int ks = 0; ks < 2; ++ks) { u32x4 w; w.x = cvtpk(p[8 * ks + 0], p[8 * ks + 1]); w.y = cvtpk(p[8 * ks + 2], p[8 * ks + 3]); w.z = cvtpk(p[8 * ks + 4], p[8 * ks + 5]); w.w = cvtpk(p[8 * ks + 6], p[8 * ks + 7]); pb[ks] = __builtin_bit_cast(bf16x8, w); }
#pragma unroll
        for (int t = 0; t < 2; ++t)
#pragma unroll
            for (int ks = 0; ks < 2; ++ks) { const LAS unsigned char* vp = Vs + (eh * 64 + t * 32 + r32) * RT_PV + (jt * 32 + ks * 16) * 2 + hi * 8;
                const s16x4 lo = *(const LAS s16x4*)vp, hh = *(const LAS s16x4*)(vp + 16);
                const bf16x8 a = (bf16x8){lo[0], lo[1], lo[2], lo[3], hh[0], hh[1], hh[2], hh[3]}; oi[t] = MFMA32(a, pb[ks], oi[t]); }
    }
    const float xi = exp2f((float)(ib * 32 + r32 + 1) * l2g);
    float s1 = 0.f, s2 = 0.f;
#pragma unroll
    for (int t = 0; t < 2; ++t)
#pragma unroll
        for (int r = 0; r < 16; ++r) { const float v = oi[t][r] + oc[t][r] * xi; oi[t][r] = v; s1 += v; s2 += v * v; }
    s1 = xhalf_sum(s1); s2 = xhalf_sum(s2);
    if (hi == 0) { Xs[(wid * 32 + r32) * 2] = s1; Xs[(wid * 32 + r32) * 2 + 1] = s2; }
    __syncthreads();
    { const int ow = wid ^ 4; s1 += Xs[(ow * 32 + r32) * 2]; s2 += Xs[(ow * 32 + r32) * 2 + 1]; }
    const float mean = s1 * (1.f / 128.f), var = fmaxf(s2 * (1.f / 128.f) - mean * mean, 0.f), rstd = rsqrtf(var + EPS);
    const size_t trow = t0 + ib * 32 + r32;
    const bf16_t* grow = PROJ + trow * NPROJ + 1664 + h * 128;
    bf16_t* orow = MIX + trow * D + 512 + h * 128;
#pragma unroll
    for (int t = 0; t < 2; ++t)
#pragma unroll
        for (int g = 0; g < 4; ++g) { const int e = eh * 64 + t * 32 + 8 * g + 4 * hi;
            const u32x2 gg = *(const u32x2*)(grow + e); const f32x4 gn = *(const f32x4*)(g_gn + h * 128 + e);
            const float rg[4] = {bf2f((unsigned short)(gg.x & 0xffffu)), bf2f((unsigned short)(gg.x >> 16)), bf2f((unsigned short)(gg.y & 0xffffu)), bf2f((unsigned short)(gg.y >> 16))};
            float y[4];
#pragma unroll
            for (int q = 0; q < 4; ++q) { const float sil = rg[q] / (1.f + __expf(-rg[q])); y[q] = (oi[t][4 * g + q] - mean) * rstd * gn[q] * sil; }
            u32x2 w; w.x = cvtpk(y[0], y[1]); w.y = cvtpk(y[2], y[3]); *(u32x2*)(orow + e) = w; }
    __syncthreads();
}

constexpr int PK_P = 272;
constexpr int PEER_SK = 0, PEER_LST = 2 * 128 * PK_P;
constexpr int PEER_ENT = PEER_LST + NWAVES * 4096;
__device__ __forceinline__ unsigned f_ord(float f) { const unsigned u = __float_as_uint(f); return u ^ ((unsigned)((int)u >> 31) | 0x80000000u); }
__device__ __forceinline__ float f_unord(unsigned k) { return __uint_as_float((k & 0x80000000u) ? (k ^ 0x80000000u) : ~k); }
#define TK_INS(L, x) do { unsigned _x = (x); _Pragma("unroll") for (int _j = 0; _j < 16; ++_j) { const unsigned _h = max(_x, L[_j]); _x = min(_x, L[_j]); L[_j] = _h; } } while (0)
#define TK_CE(a, b) do { const unsigned _hi = max((a), (b)), _lo = min((a), (b)); (a) = _hi; (b) = _lo; } while (0)
__device__ __forceinline__ void tk_sort16(unsigned (&v)[16]) {
#pragma unroll
    for (int k = 2; k <= 16; k <<= 1)
#pragma unroll
        for (int j = k >> 1; j >= 1; j >>= 1)
#pragma unroll
            for (int i = 0; i < 16; ++i) { const int l = i ^ j; if (l > i) { if ((i & k) == 0) TK_CE(v[i], v[l]); else TK_CE(v[l], v[i]); } }
}
__device__ __forceinline__ void tk_merge16(unsigned (&a)[16], const unsigned (&b)[16]) {
#pragma unroll
    for (int i = 0; i < 16; ++i) a[i] = max(a[i], b[15 - i]);
#pragma unroll
    for (int st = 8; st >= 1; st >>= 1)
#pragma unroll
        for (int i = 0; i < 16; ++i) if ((i & st) == 0) TK_CE(a[i], a[i + st]);
}
__device__ __forceinline__ void tk_merge_partner(unsigned (&L)[16], int hi) {
    unsigned M[16];
#pragma unroll
    for (int i = 0; i < 16; ++i) { const unsigned o = xhalf_other(L[15 - i], hi); M[i] = max(L[i], o); }
#pragma unroll
    for (int st = 8; st >= 1; st >>= 1)
#pragma unroll
        for (int i = 0; i < 16; ++i) if ((i & st) == 0) { const unsigned a = max(M[i], M[i + st]), bq = min(M[i], M[i + st]); M[i] = a; M[i + st] = bq; }
#pragma unroll
    for (int i = 0; i < 16; ++i) L[i] = M[i];
}

template <bool RETR_ONLY>
__device__ __forceinline__ void peer_phase(LAS unsigned char* lds, const Params& p, int vcu, int G) {
    const int tid = opaque_tid(), lane = tid & 63, r32 = lane & 31, hi = lane >> 5, wid = __builtin_amdgcn_readfirstlane(tid >> 6);
    const bf16_t* SK = (const bf16_t*)(p.ws + WS_SK); const bf16_t* QP = (const bf16_t*)(p.ws + WS_QP);
    const unsigned char* U8 = p.ws + WS_U8; const float* ssq2 = (const float*)(p.ws + WS_SSQ2); unsigned* EG = (unsigned*)(p.ws + WS_EG); float* WG = (float*)(p.ws + WS_WG);
    for (int idx = tid; idx < 2 * 128 * 16; idx += 512) { const int row = idx >> 4, c = idx & 15; *(LAS u32x4*)(lds + PEER_SK + row * PK_P + c * 16) = *(const u32x4*)(SK + row * 128 + c * 8); }
    __syncthreads();
    LAS unsigned* LST = (LAS unsigned*)(lds + PEER_LST + wid * 4096);
    LAS u32x2* ENT = (LAS u32x2*)(lds + PEER_ENT + wid * 4096);
    for (int grp = vcu * NWAVES + wid; grp < T / 4; grp += G * NWAVES) {
        const int tok0 = grp * 4;
        int lg = lane; asm volatile("" : "+v"(lg));
        const int r32 = lg & 31, hi = lg >> 5;
        const unsigned hi4 = (unsigned)hi << 2;
        {
            const bf16_t* qrow = QP + (size_t)(tok0 + (r32 >> 3)) * 2048 + (r32 & 7) * 256 + hi * 8;
            unsigned LA[16], LB[16];
#pragma unroll
            for (int pp = 0; pp < 2; ++pp) {
                bf16x8 qf[8];
#pragma unroll
                for (int s = 0; s < 8; ++s) qf[s] = *(const bf16x8*)(qrow + pp * 128 + s * 16);
                unsigned L[16];
#pragma unroll
                for (int i = 0; i < 16; ++i) L[i] = 0u;
#pragma unroll
                for (int kt = 0; kt < 4; ++kt) {
                    f32x16 sc;
#pragma unroll
                    for (int r = 0; r < 16; ++r) sc[r] = 0.f;
#pragma unroll
                    for (int s = 0; s < 8; ++s) { const bf16x8 a = *(const LAS bf16x8*)(lds + PEER_SK + (pp * 128 + kt * 32 + r32) * PK_P + s * 32 + hi * 16); sc = MFMA32(a, qf[s], sc); }
                    { unsigned kv[16];
#pragma unroll
                      for (int r = 0; r < 16; ++r) { const unsigned code = 127u - (unsigned)(32 * kt + (r & 3) + 8 * (r >> 2)); kv[r] = ((f_ord(sc[r]) & ~0x7Fu) | code) ^ hi4; }
                      tk_sort16(kv);
                      if (kt == 0) {
#pragma unroll
                          for (int r = 0; r < 16; ++r) L[r] = kv[r];
                      } else tk_merge16(L, kv); }
                }
                tk_merge_partner(L, hi);
#pragma unroll
                for (int i = 0; i < 16; ++i) { if (pp == 0) LA[i] = L[i]; else LB[i] = L[i]; }
            }
#pragma unroll
            for (int i = 0; i < 16; ++i) { LST[i * 32 + r32] = LA[i]; LST[(16 + i) * 32 + r32] = LB[i]; }
            float va[16], vb[16];
#pragma unroll
            for (int i = 0; i < 16; ++i) { va[i] = f_unord(LA[i] & ~0x7Fu); vb[i] = f_unord(LB[i] & ~0x7Fu); }
            unsigned C[16];
#pragma unroll
            for (int j = 0; j < 16; ++j) C[j] = (f_ord(va[0] + vb[j]) & ~0xFFu) | (255u - (unsigned)j);
#pragma unroll
            for (int i = 1; i < 16; ++i)
#pragma unroll
                for (int j = 0; j < 16; ++j) if ((i + 1) * (j + 1) <= 16) { const unsigned code = 255u - (unsigned)(16 * i + j); TK_INS(C, (f_ord(va[i] + vb[j]) & ~0xFFu) | code); }
            LDS_WAIT();
            float bs[16]; unsigned ex[16]; float mx = -1e30f;
#pragma unroll
            for (int k = 0; k < 16; ++k) { const unsigned code = 255u - (C[k] & 0xFFu); const unsigned i = code >> 4, j = code & 15u;
                const unsigned ka = LST[i * 32 + r32], kbq = LST[(16 + j) * 32 + r32];
                bs[k] = f_unord(ka & ~0x7Fu) + f_unord(kbq & ~0x7Fu); ex[k] = (127u - (ka & 0x7Fu)) * 128u + (127u - (kbq & 0x7Fu)); mx = fmaxf(mx, bs[k]); }
            float sum = 0.f;
#pragma unroll
            for (int k = 0; k < 16; ++k) { bs[k] = __expf(bs[k] - mx); sum += bs[k]; }
            const float rinv = 1.f / sum;
            if (hi == 0) {
#pragma unroll
                for (int k = 0; k < 16; ++k) ENT[(r32 >> 3) * 128 + (r32 & 7) * 16 + k] = (u32x2){ex[k], __float_as_uint(bs[k] * rinv)};
            }
            LDS_WAIT();
        }
        if (RETR_ONLY) {
            for (int tk = 0; tk < 4; ++tk) { const int t = tok0 + tk;
                int ln = lane; asm volatile("" : "+v"(ln));
                const u32x2 a0 = ENT[tk * 128 + ln], a1 = ENT[tk * 128 + 64 + ln];
                const int j0 = 16 * (ln & 7) + (ln >> 3), j1 = j0 + 8;
                EG[(size_t)t * 128 + j0] = a0.x; WG[(size_t)t * 128 + j0] = __uint_as_float(a0.y);
                EG[(size_t)t * 128 + j1] = a1.x; WG[(size_t)t * 128 + j1] = __uint_as_float(a1.y); }
            continue;
        }
        for (int tk = 0; tk < 4; ++tk) {
            const int t = tok0 + tk;
            int ln = lane; asm volatile("" : "+v"(ln));
            const bf16_t* hrow = (const bf16_t*)(p.ws + WS_H2B) + (size_t)t * D + ln * 16;
            f32x2 hv[8];
#pragma unroll
            for (int i = 0; i < 2; ++i) { const u32x4 v = *(const u32x4*)(hrow + 8 * i); const unsigned w[4] = {v.x, v.y, v.z, v.w};
#pragma unroll
                for (int q = 0; q < 4; ++q) hv[4 * i + q] = (f32x2){bf2f((unsigned short)(w[q] & 0xffffu)), bf2f((unsigned short)(w[q] >> 16))}; }
            const float rstd2 = rsqrtf(ssq_sum<16>(ssq2 + (size_t)t * 16) * (1.f / D) + EPS);
            EG[(size_t)t * 128 + ln] = ENT[tk * 128 + ln].x; EG[(size_t)t * 128 + 64 + ln] = ENT[tk * 128 + 64 + ln].x;
            u32x4 ua[16], ub[16];
            { const unsigned ex = ENT[tk * 128 + (ln & 15)].x;
#pragma unroll
              for (int k = 0; k < 16; ++k) { const unsigned e = (unsigned)__builtin_amdgcn_readlane((int)ex, k); ua[k] = *(const u32x4*)(U8 + (size_t)e * D + ln * 16); } }
            auto head = [&](u32x4 (&cur)[16], u32x4 (&nxt)[16], int hd) {
                if (hd < 7) { const unsigned ex = ENT[tk * 128 + (hd + 1) * 16 + (ln & 15)].x;
#pragma unroll
                    for (int k = 0; k < 16; ++k) { const unsigned e = (unsigned)__builtin_amdgcn_readlane((int)ex, k); nxt[k] = *(const u32x4*)(U8 + (size_t)e * D + ln * 16); } }
                const float gate = __uint_as_float(ENT[tk * 128 + hd * 16 + ((ln >> 2) & 15)].y);
                float dt[16];
#pragma unroll
                for (int k = 0; k < 16; ++k) { f32x2 a0 = (f32x2){0.f, 0.f}, a1 = (f32x2){0.f, 0.f}; const unsigned w[4] = {cur[k].x, cur[k].y, cur[k].z, cur[k].w};
#pragma unroll
                    for (int q = 0; q < 4; ++q) { const f32x2 lo = __builtin_amdgcn_cvt_pk_f32_fp8((int)w[q], false), h2 = __builtin_amdgcn_cvt_pk_f32_fp8((int)w[q], true);
                        a0 += lo * hv[2 * q]; a1 += h2 * hv[2 * q + 1]; }
                    const f32x2 a = a0 + a1; dt[k] = a[0] + a[1]; if (k & 1) __builtin_amdgcn_sched_barrier(0); }
                float y8[8], y4[4], y2[2], y1;
                { const bool bsel = (ln & 32) != 0;
#pragma unroll
                  for (int k = 0; k < 8; ++k) { const float snd = bsel ? dt[k] : dt[k + 8], kp = bsel ? dt[k + 8] : dt[k]; y8[k] = kp + __shfl_xor(snd, 32); } }
                { const bool bsel = (ln & 16) != 0;
#pragma unroll
                  for (int k = 0; k < 4; ++k) { const float snd = bsel ? y8[k] : y8[k + 4], kp = bsel ? y8[k + 4] : y8[k]; y4[k] = kp + __shfl_xor(snd, 16); } }
                { const bool bsel = (ln & 8) != 0;
#pragma unroll
                  for (int k = 0; k < 2; ++k) { const float snd = bsel ? y4[k] : y4[k + 2], kp = bsel ? y4[k + 2] : y4[k]; y2[k] = kp + __shfl_xor(snd, 8); } }
                { const bool bsel = (ln & 4) != 0; const float snd = bsel ? y2[0] : y2[1], kp = bsel ? y2[1] : y2[0]; y1 = kp + __shfl_xor(snd, 4); }
                y1 += __shfl_xor(y1, 2); y1 += __shfl_xor(y1, 1);
                const float act = y1 * rstd2 * (1.f / U_SCALE);
                const float wgt = gate * gelu_f(act) * (1.f / V_SCALE);
                if ((ln & 3) == 0) WG[(size_t)t * 128 + hd * 16 + ((ln >> 2) & 15)] = wgt;
            };
            for (int hd = 0; hd < 8; hd += 2) { head(ua, ub, hd); head(ub, ua, hd + 1); }
        }
    }
}

__device__ __forceinline__ void peer_v_phase(const Params& p, int vcu, int G) {
    const int tid = opaque_tid(), lane = tid & 63, wid = __builtin_amdgcn_readfirstlane(tid >> 6);
    const unsigned char* V8 = p.ws + WS_V8; const unsigned* EG = (const unsigned*)(p.ws + WS_EG); const float* WG = (const float*)(p.ws + WS_WG);
    for (int grp = vcu * NWAVES + wid; grp < T / 4; grp += G * NWAVES) {
        for (int tk = 0; tk < 4; ++tk) {
            const int t = grp * 4 + tk;
            int ln = lane; asm volatile("" : "+v"(ln));
            const unsigned e0 = EG[(size_t)t * 128 + ln], e1 = EG[(size_t)t * 128 + 64 + ln];
            const float w0 = WG[(size_t)t * 128 + ln], w1 = WG[(size_t)t * 128 + 64 + ln];
            f32x2 ov[8];
#pragma unroll
            for (int i = 0; i < 8; ++i) ov[i] = (f32x2){0.f, 0.f};
            u32x4 va[16], vb[16];
#pragma unroll
            for (int k = 0; k < 16; ++k) { const unsigned e = (unsigned)__builtin_amdgcn_readlane((int)e0, k); va[k] = *(const u32x4*)(V8 + (size_t)e * D + ln * 16); }
            auto head = [&](u32x4 (&cur)[16], u32x4 (&nxt)[16], int hd) {
                if (hd < 7) { const int h1 = hd + 1; const unsigned er = (h1 & 4) ? e1 : e0; const int lb = (h1 & 3) * 16;
#pragma unroll
                    for (int k = 0; k < 16; ++k) { const unsigned e = (unsigned)__builtin_amdgcn_readlane((int)er, lb + k); nxt[k] = *(const u32x4*)(V8 + (size_t)e * D + ln * 16); } }
                const float wr = (hd & 4) ? w1 : w0; const int lb0 = (hd & 3) * 16;
#pragma unroll
                for (int k = 0; k < 16; ++k) { const float wk = __uint_as_float((unsigned)__builtin_amdgcn_readlane((int)__float_as_uint(wr), lb0 + k)); const f32x2 wk2 = (f32x2){wk, wk};
                    const unsigned w[4] = {cur[k].x, cur[k].y, cur[k].z, cur[k].w};
#pragma unroll
                    for (int q = 0; q < 4; ++q) { const f32x2 lo = __builtin_amdgcn_cvt_pk_f32_fp8((int)w[q], false), h2 = __builtin_amdgcn_cvt_pk_f32_fp8((int)w[q], true);
                        ov[2 * q] += wk2 * lo; ov[2 * q + 1] += wk2 * h2; }
                    if (k & 1) __builtin_amdgcn_sched_barrier(0); }
            };
            for (int hd = 0; hd < 8; hd += 2) { head(va, vb, hd); head(vb, va, hd + 1); }
            float* hrow = p.out + (size_t)t * D + ln * 16;
            const bf16_t* hb = (const bf16_t*)(p.ws + WS_H2B) + (size_t)t * D + ln * 16;
            float ss = 0.f; f32x4 h3[4];
#pragma unroll
            for (int q2 = 0; q2 < 2; ++q2) { const u32x4 v = *(const u32x4*)(hb + 8 * q2);
                h3[2 * q2] = (f32x4){bf2f((unsigned short)(v.x & 0xffffu)), bf2f((unsigned short)(v.x >> 16)), bf2f((unsigned short)(v.y & 0xffffu)), bf2f((unsigned short)(v.y >> 16))};
                h3[2 * q2 + 1] = (f32x4){bf2f((unsigned short)(v.z & 0xffffu)), bf2f((unsigned short)(v.z >> 16)), bf2f((unsigned short)(v.w & 0xffffu)), bf2f((unsigned short)(v.w >> 16))}; }
#pragma unroll
            for (int q = 0; q < 4; ++q) { h3[q] = h3[q] + (f32x4){ov[2 * q][0], ov[2 * q][1], ov[2 * q + 1][0], ov[2 * q + 1][1]};
                ss += (h3[q][0] * h3[q][0] + h3[q][1] * h3[q][1]) + (h3[q][2] * h3[q][2] + h3[q][3] * h3[q][3]); }
            const float rstd3 = rsqrtf(wave_sum(ss) * (1.f / D) + EPS);
#pragma unroll
            for (int q = 0; q < 4; ++q) { const f32x4 gf = *(const f32x4*)(p.g_final + ln * 16 + 4 * q); *(f32x4*)(hrow + 4 * q) = h3[q] * rstd3 * gf; }
        }
    }
}

template <bool VSIDE>
__device__ __forceinline__ void peer_slice_tokens(const Params& p, int x, int w0, int nwv, int lane) {
    const unsigned char* TB = p.ws + (VSIDE ? WS_V8 : WS_U8) + (size_t)x * (16384 * 128);
    const unsigned* EG = (const unsigned*)(p.ws + WS_EG); const float* WG = (const float*)(p.ws + WS_WG);
    const bf16_t* H2 = (const bf16_t*)(p.ws + WS_H2B) + 128 * x;
    float* PART = (float*)(p.ws + WS_PART) + (size_t)x * T * 128; float* SSQ3 = (float*)(p.ws + WS_SSQ3);
    int ln = lane; asm volatile("" : "+v"(ln));
    const int r = ln >> 3, c = ln & 7;
    if (w0 >= T) return;
    u32x4 idn[4];
    f32x4 wn[4], wc[4];
    u32x4 hn[2], hc[2];
    u32x4 ra[16], rb[16];
    auto load_meta = [&](int t) {
#pragma unroll
        for (int q = 0; q < 4; ++q) idn[q] = *(const u32x4*)(EG + (size_t)t * 128 + 16 * r + 4 * q);
        if (VSIDE) {
#pragma unroll
            for (int q = 0; q < 4; ++q) wn[q] = *(const f32x4*)(WG + (size_t)t * 128 + 16 * r + 4 * q);
        } else { hn[0] = *(const u32x4*)(H2 + (size_t)t * D + 16 * c); hn[1] = *(const u32x4*)(H2 + (size_t)t * D + 16 * c + 8); }
    };
    auto issue = [&](u32x4 (&buf)[16]) {
#pragma unroll
        for (int q = 0; q < 4; ++q) { const unsigned e4[4] = {idn[q].x, idn[q].y, idn[q].z, idn[q].w};
#pragma unroll
            for (int j = 0; j < 4; ++j) buf[4 * q + j] = *(const u32x4*)(TB + (e4[j] * 128u + 16u * (unsigned)c)); }
    };
    auto compute = [&](u32x4 (&cur)[16], int t) {
        if (!VSIDE) {
            f32x2 hv[8];
#pragma unroll
            for (int i2 = 0; i2 < 2; ++i2) { const unsigned w[4] = {hc[i2].x, hc[i2].y, hc[i2].z, hc[i2].w};
#pragma unroll
                for (int q = 0; q < 4; ++q) hv[4 * i2 + q] = (f32x2){bf2f((unsigned short)(w[q] & 0xffffu)), bf2f((unsigned short)(w[q] >> 16))}; }
            float dt[16];
#pragma unroll
            for (int i = 0; i < 16; ++i) { f32x2 a0 = (f32x2){0.f, 0.f}, a1 = (f32x2){0.f, 0.f}; const unsigned w[4] = {cur[i].x, cur[i].y, cur[i].z, cur[i].w};
#pragma unroll
                for (int q = 0; q < 4; ++q) { const f32x2 lo = __builtin_amdgcn_cvt_pk_f32_fp8((int)w[q], false), h2 = __builtin_amdgcn_cvt_pk_f32_fp8((int)w[q], true);
                    a0 += lo * hv[2 * q]; a1 += h2 * hv[2 * q + 1]; }
                const f32x2 a = a0 + a1; dt[i] = a[0] + a[1]; if (i & 1) __builtin_amdgcn_sched_barrier(0); }
            float y8[8], y4[4], y2[2];
            { const bool bs = (ln & 4) != 0;
#pragma unroll
              for (int k = 0; k < 8; ++k) { const float snd = bs ? dt[k] : dt[k + 8], kp = bs ? dt[k + 8] : dt[k]; y8[k] = kp + shx<4>(snd, ln); } }
            { const bool bs = (ln & 2) != 0;
#pragma unroll
              for (int k = 0; k < 4; ++k) { const float snd = bs ? y8[k] : y8[k + 4], kp = bs ? y8[k + 4] : y8[k]; y4[k] = kp + shx<2>(snd, ln); } }
            { const bool bs = (ln & 1) != 0;
#pragma unroll
              for (int k = 0; k < 2; ++k) { const float snd = bs ? y4[k] : y4[k + 2], kp = bs ? y4[k + 2] : y4[k]; y2[k] = kp + shx<1>(snd, ln); } }
            *(f32x2*)(PART + (size_t)t * 128 + 2 * ln) = (f32x2){y2[0], y2[1]};
        } else {
            f32x2 ov[8];
#pragma unroll
            for (int q = 0; q < 8; ++q) ov[q] = (f32x2){0.f, 0.f};
#pragma unroll
            for (int i = 0; i < 16; ++i) { const float wk = wc[i >> 2][i & 3]; const f32x2 wk2 = (f32x2){wk, wk}; const unsigned w[4] = {cur[i].x, cur[i].y, cur[i].z, cur[i].w};
#pragma unroll
                for (int q = 0; q < 4; ++q) { const f32x2 lo = __builtin_amdgcn_cvt_pk_f32_fp8((int)w[q], false), h2 = __builtin_amdgcn_cvt_pk_f32_fp8((int)w[q], true);
                    ov[2 * q] += wk2 * lo; ov[2 * q + 1] += wk2 * h2; }
                if (i & 1) __builtin_amdgcn_sched_barrier(0); }
            f32x2 z4[4], z2[2], z1;
            { const bool bs = (ln & 32) != 0;
#pragma unroll
              for (int k = 0; k < 4; ++k) { const f32x2 snd = bs ? ov[k] : ov[k + 4], kp = bs ? ov[k + 4] : ov[k]; z4[k] = kp + (f32x2){shx<32>(snd[0], ln), shx<32>(snd[1], ln)}; } }
            { const bool bs = (ln & 16) != 0;
#pragma unroll
              for (int k = 0; k < 2; ++k) { const f32x2 snd = bs ? z4[k] : z4[k + 2], kp = bs ? z4[k + 2] : z4[k]; z2[k] = kp + (f32x2){shx<16>(snd[0], ln), shx<16>(snd[1], ln)}; } }
            { const bool bs = (ln & 8) != 0; const f32x2 snd = bs ? z2[0] : z2[1], kp = bs ? z2[1] : z2[0]; z1 = kp + (f32x2){shx<8>(snd[0], ln), shx<8>(snd[1], ln)}; }
            const int dd = 16 * c + ((ln >> 5) & 1) * 8 + ((ln >> 4) & 1) * 4 + ((ln >> 3) & 1) * 2;
            const unsigned hb = *(const unsigned*)(H2 + (size_t)t * D + dd);
            const f32x2 h3 = (f32x2){bf2f((unsigned short)(hb & 0xffffu)) + z1[0], bf2f((unsigned short)(hb >> 16)) + z1[1]};
            *(f32x2*)(p.out + (size_t)t * D + 128 * x + dd) = h3;
            const float ss = wave_sum_fast(h3[0] * h3[0] + h3[1] * h3[1], ln);
            if (ln == 0) SSQ3[(size_t)t * 8 + x] = ss;
        }
    };
    load_meta(w0);
    issue(ra);
    if (VSIDE) {
#pragma unroll
        for (int q = 0; q < 4; ++q) wc[q] = wn[q];
    } else { hc[0] = hn[0]; hc[1] = hn[1]; }
    if (w0 + nwv < T) load_meta(w0 + nwv);
    for (int t = w0; t < T; t += 2 * nwv) {
        const bool m1 = t + nwv < T, m2 = t + 2 * nwv < T, m3 = t + 3 * nwv < T;
        f32x4 w1[4]; u32x4 h1[2];
        if (m1) { issue(rb);
            if (VSIDE) {
#pragma unroll
                for (int q = 0; q < 4; ++q) w1[q] = wn[q];
            } else { h1[0] = hn[0]; h1[1] = hn[1]; }
            if (m2) load_meta(t + 2 * nwv); }
        compute(ra, t);
        if (!m1) break;
        if (VSIDE) {
#pragma unroll
            for (int q = 0; q < 4; ++q) wc[q] = w1[q];
        } else { hc[0] = h1[0]; hc[1] = h1[1]; }
        if (m2) { issue(ra); }
        f32x4 w2[4]; u32x4 h2x[2];
        if (m2) {
            if (VSIDE) {
#pragma unroll
                for (int q = 0; q < 4; ++q) w2[q] = wn[q];
            } else { h2x[0] = hn[0]; h2x[1] = hn[1]; }
            if (m3) load_meta(t + 3 * nwv); }
        compute(rb, t + nwv);
        if (!m2) break;
        if (VSIDE) {
#pragma unroll
            for (int q = 0; q < 4; ++q) wc[q] = w2[q];
        } else { hc[0] = h2x[0]; hc[1] = h2x[1]; }
    }
}
template <bool VSIDE>
__device__ __forceinline__ void peer_slice_phase(const Params& p, unsigned xcc, int rank, int G, int bx, int wave, int lane) {
    unsigned* ctl = (unsigned*)(p.ws + WS_CTL);
    for (int x = 0; x < 8; ++x) {
        const int cx = (int)__builtin_amdgcn_readfirstlane((int)__hip_atomic_load(ctl + CW_BAR + XB_XCNT(x), __ATOMIC_RELAXED, __HIP_MEMORY_SCOPE_AGENT));
        if (cx != 0 && (int)xcc != x) continue;
        const int nwv = (cx == 0 ? G : cx) * NWAVES, w0 = (cx == 0 ? bx : rank) * NWAVES + wave;
        peer_slice_tokens<VSIDE>(p, x, w0, nwv, lane);
    }
}
__device__ __forceinline__ void peer_combine_phase(const Params& p, int gw, int NGW, int lane) {
    const float* PART = (const float*)(p.ws + WS_PART); float* WG = (float*)(p.ws + WS_WG); const float* ssq2 = (const float*)(p.ws + WS_SSQ2);
    for (int t = gw; t < T; t += NGW) {
        f32x2 s = (f32x2){0.f, 0.f};
#pragma unroll
        for (int x = 0; x < 8; ++x) s += *(const f32x2*)(PART + ((size_t)x * T + t) * 128 + 2 * lane);
        const float rs = rsqrtf(ssq_sum<16>(ssq2 + (size_t)t * 16) * (1.f / D) + EPS) * (1.f / U_SCALE);
        f32x2* wp = (f32x2*)(WG + (size_t)t * 128 + 2 * lane);
        const f32x2 g = *wp;
        *wp = (f32x2){g[0] * gelu_f(s[0] * rs) * (1.f / V_SCALE), g[1] * gelu_f(s[1] * rs) * (1.f / V_SCALE)};
    }
}
__device__ __forceinline__ void peer_final_phase(const Params& p, int gw, int NGW, int lane) {
    const float* SSQ3 = (const float*)(p.ws + WS_SSQ3);
    for (int t = gw; t < T; t += NGW) {
        float* row = p.out + (size_t)t * D + lane * 16;
        f32x4 v[4];
#pragma unroll
        for (int q = 0; q < 4; ++q) v[q] = *(const f32x4*)(row + 4 * q);
        const float rstd3 = rsqrtf(ssq_sum<8>(SSQ3 + (size_t)t * 8) * (1.f / D) + EPS);
#pragma unroll
        for (int q = 0; q < 4; ++q) { const f32x4 gf = *(const f32x4*)(p.g_final + lane * 16 + 4 * q); *(f32x4*)(row + 4 * q) = v[q] * rstd3 * gf; }
    }
}

#ifndef PH_MASK
#define PH_MASK 0xFFFF
#endif
#define PH(k) ((PH_MASK >> (k)) & 1)
#ifdef TPROBE
#define TMARK(k) do { const unsigned long long tn_ = __builtin_amdgcn_s_memrealtime(); if (TPROBE == (k)) { const unsigned long long d_ = tn_ - tprev_; while (__builtin_amdgcn_s_memrealtime() - tn_ < d_) __builtin_amdgcn_s_sleep(8); } tprev_ = __builtin_amdgcn_s_memrealtime(); } while (0)
#else
#define TMARK(k)
#endif
#ifndef PEER_DSLICE
#define PEER_DSLICE 1
#endif
#ifndef GEMM_ALIGN
#define GEMM_ALIGN true
#endif
#ifndef REP_MASK
#define REP_MASK 0
#endif
#if (REP_MASK >> 0) & 1
#define REP_0 for (int rep_ = 0; rep_ < 2; ++rep_)
#else
#define REP_0
#endif
#if (REP_MASK >> 1) & 1
#define REP_1 for (int rep_ = 0; rep_ < 2; ++rep_)
#else
#define REP_1
#endif
#if (REP_MASK >> 2) & 1
#define REP_2 for (int rep_ = 0; rep_ < 2; ++rep_)
#else
#define REP_2
#endif
#if (REP_MASK >> 3) & 1
#define REP_3 for (int rep_ = 0; rep_ < 2; ++rep_)
#else
#define REP_3
#endif
#if (REP_MASK >> 4) & 1
#define REP_4 for (int rep_ = 0; rep_ < 2; ++rep_)
#else
#define REP_4
#endif
#if (REP_MASK >> 5) & 1
#define REP_5 for (int rep_ = 0; rep_ < 2; ++rep_)
#else
#define REP_5
#endif
#if (REP_MASK >> 6) & 1
#define REP_6 for (int rep_ = 0; rep_ < 2; ++rep_)
#else
#define REP_6
#endif
#if (REP_MASK >> 7) & 1
#define REP_7 for (int rep_ = 0; rep_ < 2; ++rep_)
#else
#define REP_7
#endif
#if (REP_MASK >> 8) & 1
#define REP_8 for (int rep_ = 0; rep_ < 2; ++rep_)
#else
#define REP_8
#endif
#if (REP_MASK >> 9) & 1
#define REP_9 for (int rep_ = 0; rep_ < 2; ++rep_)
#else
#define REP_9
#endif
#define REP(k) REP_##k
__global__ void __launch_bounds__(NWAVES * 64, 2) fwd_megakernel(Params p) {
    extern __shared__ __attribute__((aligned(16))) unsigned char lds_raw[];
    LAS unsigned char* lds = (LAS unsigned char*)lds_raw;
    const int tid = threadIdx.x, lane = tid & 63, wave = __builtin_amdgcn_readfirstlane(tid >> 6);
    const int G = gridDim.x; const int bx = blockIdx.x;
    const int vcu = (G % 8 == 0) ? (bx % 8) * (G / 8) + bx / 8 : bx;
    if (p.never) { cg::this_grid().sync(); }
    unsigned char* const ws = p.ws;
    volatile LAS unsigned* MISC = (volatile LAS unsigned*)(lds + LDSCTL_OFF);
    for (int u = tid; u < (LDS_BYTES - LDSCTL_OFF) / 4; u += NWAVES * 64) ((LAS unsigned*)(lds + LDSCTL_OFF))[u] = 0u;
    __syncthreads();
    XcdBarrier bar = xcd_barrier_post((unsigned*)(ws + WS_CTL) + CW_BAR, MISC + 8);
    if (tid == 0) MISC[20] = __hip_atomic_fetch_add((unsigned*)(ws + WS_CTL) + CW_XRANK + 64 * bar.x, 1u, __ATOMIC_RELAXED, __HIP_MEMORY_SCOPE_AGENT);
    const int gw = vcu * NWAVES + wave, NGW = G * NWAVES;
#ifdef TPROBE
    unsigned long long tprev_ = __builtin_amdgcn_s_memrealtime();
#endif

#define WSB(off) ((bf16_t*)(p.ws + (off)))
#define WSF(off) ((float*)(p.ws + (off)))
    REP(0) {
    if (PH(0))
    {
        LAS float* scr = (LAS float*)(lds + wave * 16384);
        constexpr int I_IN = 16 * 85, I_XKV = 16 * 64;
        constexpr int NITEMS = I_IN + I_XKV;
        for (int it = gw; it < NITEMS; it += NGW) {
            int r = it;
            if (r < I_IN) { p0_transpose_item<1>(p.w_in, 1024, 2720, WSB(WS_WIN), nullptr, scr, r, lane); continue; } r -= I_IN;
            p0_transpose_item<0>(p.w_xkv, 1024, 2048, WSB(WS_WXKV), nullptr, scr, r, lane);
        }
        for (int m = gw; m < T / 4; m += NGW) rms_rows_to_bf16<4>(p.x + (size_t)m * D, p.g_mix, WSB(WS_A0) + (size_t)m * D, (size_t)(T / 4) * D, lane);
        for (int m = gw; m < 1024; m += NGW) rms_rows_to_bf16<1>(p.mem + (size_t)m * D, p.g_mem, WSB(WS_MEMN) + (size_t)m * D, 0, lane);
        const int gt = vcu * 512 + tid, NGT = G * 512;
        for (int i = gt; i < 2 * 128 * 128 / 2; i += NGT) { const f32x2 v = *(const f32x2*)(p.sub_keys + 2 * i); ((unsigned*)WSB(WS_SK))[i] = cvtpk(v[0], v[1]); }
        for (int i = gt; i < 96 * 1024 / 8; i += NGT) ((u32x4*)(WSB(WS_WIN) + (size_t)2208 * 1024))[i] = (u32x4){0u, 0u, 0u, 0u};
        for (int i = gt; i < SEQ * 64; i += NGT) { const int s = i >> 6, f = i & 63; const float inv = exp2f(-(float)f * (13.287712379549449f / 64.f)); const float ang = (float)s * inv;
            const double rev = (double)ang * 0.15915494309189535; const float fr = (float)(rev - floor(rev)); WSF(WS_CR)[i] = __builtin_amdgcn_cosf(fr); WSF(WS_SR)[i] = __builtin_amdgcn_sinf(fr); }
        for (int i = gt; i < SEQ * 16; i += NGT) { const int s = i >> 4, f = i & 15; const float inv = exp2f(-(float)f * (13.287712379549449f / 16.f)); const float ang = (float)s * inv;
            const double rev = (double)ang * 0.15915494309189535; const float fr = (float)(rev - floor(rev)); WSF(WS_CM)[i] = __builtin_amdgcn_cosf(fr); WSF(WS_SM)[i] = __builtin_amdgcn_sinf(fr); }
    }
    xcd_barrier(bar);
    TMARK(0);
#ifdef DBL_BAR
    xcd_barrier(bar);
#endif
    }

    REP(1) {
    if (PH(1))
    {
        { pg8::Gemm g{WSB(WS_A0), WSB(WS_WIN), T, NPROJ, 1024, 1024, 1024}; pg8::StaticOrder S; S.init(T, NPROJ, G, bx);
          pg8::EpiProj E{WSB(WS_PROJ), WSF(WS_SSQQ), WSF(WS_SSQKV), WSF(WS_CR), WSF(WS_SR), WSF(WS_CM), WSF(WS_SM)}; pg8::gemm_phase<pg8::EpiProj, pg8::StaticOrder, GEMM_ALIGN>(lds, g, S, E); }
#ifdef DUP_P1MAIN
        { pg8::Gemm g{WSB(WS_A0), WSB(WS_WIN), T, NPROJ, 1024, 1024, 1024}; pg8::StaticOrder S; S.init(T, NPROJ, G, bx);
          pg8::EpiProj E{WSB(WS_PROJ), WSF(WS_SSQQ), WSF(WS_SSQKV), WSF(WS_CR), WSF(WS_SR), WSF(WS_CM), WSF(WS_SM)}; pg8::gemm_phase<pg8::EpiProj, pg8::StaticOrder, GEMM_ALIGN>(lds, g, S, E); }
#endif
        { pg8::Gemm g{WSB(WS_WIN) + (size_t)2304 * 1024, WSB(WS_A0), 512, T, 1024, 1024, 1024}; pg8::StaticOrder S; S.init(512, T, G, (bx - 64 + G) % G);
          pg8::EpiPlain E{WSB(WS_RVT), TP}; pg8::gemm_phase<pg8::EpiPlain, pg8::StaticOrder, GEMM_ALIGN>(lds, g, S, E); }
        { pg8::Gemm g{WSB(WS_MEMN), WSB(WS_WXKV), 1024, 1024, 1024, 1024, 1024}; pg8::StaticOrder S; S.init(1024, 1024, G, (bx - 192 + G) % G);
          pg8::EpiPlain E{WSB(WS_KX), 1024}; pg8::gemm_phase<pg8::EpiPlain, pg8::StaticOrder, GEMM_ALIGN>(lds, g, S, E); }
        { pg8::Gemm g{WSB(WS_WXKV) + (size_t)1024 * 1024, WSB(WS_MEMN), 1024, 1024, 1024, 1024, 1024}; pg8::StaticOrder S; S.init(1024, 1024, G, (bx - 208 + G) % G);
          pg8::EpiPlain E{WSB(WS_VXT), 1024}; pg8::gemm_phase<pg8::EpiPlain, pg8::StaticOrder, GEMM_ALIGN>(lds, g, S, E); }
        {
            const int nd = G >= 64 ? 32 : G, d0 = G - nd;
            if (bx >= d0) {
                LAS float* scr = (LAS float*)(lds + wave * 16384);
                constexpr int I_UQ = 6 * 24, I_UKV = 4 * 32, I_SQ = 16 * 32, I_PQ = 16 * 64;
                constexpr int NITEMS = I_UQ + I_UKV + 3 * I_SQ + I_PQ;
                for (int it = (bx - d0) * NWAVES + wave; it < NITEMS; it += nd * NWAVES) {
                    int r = it;
                    if (r < I_UQ) { p0_transpose_item<2>(p.w_uq, 384, 768, WSB(WS_WUQ), p.g_q_lora, scr, r, lane); continue; } r -= I_UQ;
                    if (r < I_UKV) { p0_transpose_item<3>(p.w_ukv, 256, 1024, WSB(WS_WUKV), p.g_kv_lora, scr, r, lane); continue; } r -= I_UKV;
                    if (r < I_SQ) { p0_transpose_item<0>(p.w_o, 1024, 1024, WSB(WS_WO), nullptr, scr, r, lane); continue; } r -= I_SQ;
                    if (r < I_SQ) { p0_transpose_item<0>(p.w_xq, 1024, 1024, WSB(WS_WXQ), p.g_xattn, scr, r, lane); continue; } r -= I_SQ;
                    if (r < I_SQ) { p0_transpose_item<0>(p.w_xo, 1024, 1024, WSB(WS_WXO), nullptr, scr, r, lane); continue; } r -= I_SQ;
                    p0_transpose_item<0>(p.w_pq, 1024, 2048, WSB(WS_WPQ), p.g_ffn, scr, r, lane);
                }
            }
        }
    }
    xcd_barrier(bar);
    TMARK(1);
#ifdef DBL_BAR
    xcd_barrier(bar);
#endif
    }

    REP(2) {
    if (PH(2))
    {
        { pg8::Gemm g{WSB(WS_PROJ), WSB(WS_WUQ), T, 768, 384, NPROJ, 384}; pg8::StaticOrder S; S.init(T, 768, G, bx);
          pg8::EpiQ E{WSB(WS_QM), WSF(WS_SSQQ), WSF(WS_CM), WSF(WS_SM)}; pg8::gemm_phase<pg8::EpiQ, pg8::StaticOrder, GEMM_ALIGN>(lds, g, S, E); }
        { pg8::Gemm g{WSB(WS_PROJ) + 384, WSB(WS_WUKV), T, 512, 256, NPROJ, 256}; pg8::StaticOrder S; S.init(T, 512, G, (bx - 192 + G) % G);
          pg8::EpiRowScale<8> E{WSB(WS_KN), 512, WSF(WS_SSQKV), 1.f / 256.f, 1.f}; pg8::gemm_phase<pg8::EpiRowScale<8>, pg8::StaticOrder, GEMM_ALIGN>(lds, g, S, E); }
        { pg8::Gemm g{WSB(WS_WUKV) + (size_t)512 * 256, WSB(WS_PROJ) + 384, 512, T, 256, 256, NPROJ}; pg8::StaticOrder S; S.init(512, T, G, (bx - 64 + G) % G);
          pg8::EpiColScale E{WSB(WS_VT), TP, WSF(WS_SSQKV), 1.f / 256.f}; pg8::gemm_phase<pg8::EpiColScale, pg8::StaticOrder, GEMM_ALIGN>(lds, g, S, E); }
        for (int u = vcu; u < 512; u += G) ret_state_unit(lds, u, WSB(WS_PROJ), WSB(WS_RVT), WSB(WS_RKVT));
    }
    xcd_barrier(bar);
    TMARK(2);
#ifdef DBL_BAR
    xcd_barrier(bar);
#endif
    }

    REP(3) {
    if (PH(3))
    {
        unsigned* scan_cnt = (unsigned*)(p.ws + WS_CTL) + CW_QUEUE + 64 * Q3_SLOT;
#if (REP_MASK >> 3) & 1
        if (rep_ == 0)
#endif
        {
            bf16_t* RK = WSB(WS_RKVT);
            for (int e2 = vcu * 512 + tid; e2 < 16 * 8192; e2 += G * 512) {
                const int bh = e2 >> 13, off = e2 & 8191; const float cd = exp2f(128.f * ret_log2g(bh & 3));
                unsigned* base = (unsigned*)(RK + (size_t)bh * 32 * 16384) + off;
                unsigned x[32];
#pragma unroll
                for (int n = 0; n < 32; ++n) x[n] = base[(size_t)n * 8192];
                float r0 = 0.f, r1 = 0.f;
#pragma unroll
                for (int n = 0; n < 32; ++n) { const unsigned o = cvtpk(r0, r1); r0 = r0 * cd + bf2f((unsigned short)(x[n] & 0xffffu)); r1 = r1 * cd + bf2f((unsigned short)(x[n] >> 16)); base[(size_t)n * 8192] = o; }
            }
            asm volatile("s_waitcnt vmcnt(0)" ::: "memory");
            __syncthreads();
            if (tid == 0) { __builtin_amdgcn_fence(__ATOMIC_RELEASE, "agent"); asm volatile("s_waitcnt vmcnt(0)" ::: "memory"); __hip_atomic_fetch_add(scan_cnt, 1u, __ATOMIC_RELAXED, __HIP_MEMORY_SCOPE_AGENT); }
        }
#ifdef REP_MLA
        for (int rr_ = 0; rr_ < REP_MLA; ++rr_)
#endif
        for (int v2 = 2 * vcu; v2 < 512; v2 += (v2 & 1) ? 2 * G - 1 : 1) { const int v = v2 >> 1, bh = v >> 3, s = v & 7;
            mla_unit(lds, bh >> 3, bh & 7, (v2 & 1) ? s : 15 - s, WSB(WS_QM), WSB(WS_KN), WSB(WS_PROJ), WSB(WS_VT), WSB(WS_MIX)); }
#ifdef MLA_BAR
        xcd_barrier(bar);
#endif
        if (tid == 0) { unsigned sp = 0; while (__hip_atomic_load(scan_cnt, __ATOMIC_RELAXED, __HIP_MEMORY_SCOPE_AGENT) < (unsigned)G) { __builtin_amdgcn_s_sleep(2); if (++sp > XB_SPIN_CAP) break; }
            __builtin_amdgcn_fence(__ATOMIC_ACQUIRE, "agent"); asm volatile("s_waitcnt vmcnt(0)" ::: "memory"); }
        __syncthreads();
#ifdef REP_RET
        for (int rr_ = 0; rr_ < 2; ++rr_)
#endif
        for (int u = vcu; u < 512; u += G) ret_out_unit(lds, u, WSB(WS_PROJ), WSB(WS_RVT), WSB(WS_RKVT), p.g_ret_gn, WSB(WS_MIX));
    }
    xcd_barrier(bar);
    TMARK(3);
#ifdef DBL_BAR
    xcd_barrier(bar);
#endif
    }

    REP(4) {
    if (PH(4))
#ifdef REP_P4NB
    for (int nb_ = 0; nb_ < 2; ++nb_)
#endif
    { pg8::Gemm g{WSB(WS_MIX), WSB(WS_WO), T, 1024, 1024, 1024, 1024}; pg8::StaticOrder S; S.init(T, 1024, G, bx);
      pg8::EpiRes E{p.x, nullptr, WSB(WS_H1B), WSF(WS_SSQ1)}; pg8::gemm_phase<pg8::EpiRes, pg8::StaticOrder, GEMM_ALIGN>(lds, g, S, E); }
    xcd_barrier(bar);
    TMARK(4);
#ifdef DBL_BAR
    xcd_barrier(bar);
#endif
    }

    REP(5) {
    if (PH(5))
    { pg8::Gemm g{WSB(WS_H1B), WSB(WS_WXQ), T, 1024, 1024, 1024, 1024}; pg8::StaticOrder S; S.init(T, 1024, G, bx);
      pg8::EpiRowScale<16> E{WSB(WS_QX), 1024, WSF(WS_SSQ1), 1.f / 1024.f, C2_X}; pg8::gemm_phase<pg8::EpiRowScale<16>, pg8::StaticOrder, GEMM_ALIGN>(lds, g, S, E); }
    xcd_barrier(bar);
    TMARK(5);
#ifdef DBL_BAR
    xcd_barrier(bar);
#endif
    }

    REP(6) {
    if (PH(6))
    {
        for (int u = vcu; u < 512; u += G) { const int dvh = u & 1, qb = (u >> 1) & 15, h = (u >> 5) & 3, b = u >> 7; xattn_unit(lds, b, h, qb, dvh, WSB(WS_QX), WSB(WS_KX), WSB(WS_VXT), WSB(WS_OX)); }
        unsigned char* U8 = ws + WS_U8; unsigned char* V8 = ws + WS_V8;
        const f32x4* gf = (const f32x4*)p.g_ffn + lane * 4;
        f32x4 gs[4];
#pragma unroll
        for (int i = 0; i < 4; ++i) gs[i] = gf[i] * U_SCALE;
        for (int e = gw; e < 2 * 16384; e += NGW) {
            const bool isv = e >= 16384; const int row = isv ? e - 16384 : e;
            const f32x4* src = (const f32x4*)((isv ? p.v_exp : p.u_exp) + (size_t)row * D) + lane * 4;
            u32x4 o; unsigned ow[4];
#pragma unroll
            for (int i = 0; i < 4; ++i) { f32x4 v = src[i]; v = isv ? v * V_SCALE : v * gs[i]; int pk = 0; pk = __builtin_amdgcn_cvt_pk_fp8_f32(v[0], v[1], pk, false); pk = __builtin_amdgcn_cvt_pk_fp8_f32(v[2], v[3], pk, true); ow[i] = (unsigned)pk; }
            o.x = ow[0]; o.y = ow[1]; o.z = ow[2]; o.w = ow[3];
            *(u32x4*)((isv ? V8 : U8) + (size_t)(lane >> 3) * (16384 * 128) + (size_t)row * 128 + (lane & 7) * 16) = o;
        }
    }
    xcd_barrier(bar);
    TMARK(6);
#ifdef DBL_BAR
    xcd_barrier(bar);
#endif
    }

    REP(7) {
    if (PH(7))
    { pg8::Gemm g{WSB(WS_OX), WSB(WS_WXO), T, 1024, 1024, 1024, 1024}; pg8::StaticOrder S; S.init(T, 1024, G, bx);
      pg8::EpiRes E{nullptr, WSB(WS_H1B), WSB(WS_H2B), WSF(WS_SSQ2)}; pg8::gemm_phase<pg8::EpiRes, pg8::StaticOrder, GEMM_ALIGN>(lds, g, S, E); }
    xcd_barrier(bar);
    TMARK(7);
#ifdef DBL_BAR
    xcd_barrier(bar);
#endif
    }

    REP(8) {
    if (PH(8))
    { pg8::Gemm g{WSB(WS_H2B), WSB(WS_WPQ), T, 2048, 1024, 1024, 1024}; pg8::StaticOrder S; S.init(T, 2048, G, bx);
      pg8::EpiRowScale<16> E{WSB(WS_QP), 2048, WSF(WS_SSQ2), 1.f / 1024.f, 1.f}; pg8::gemm_phase<pg8::EpiRowScale<16>, pg8::StaticOrder, GEMM_ALIGN>(lds, g, S, E); }
    xcd_barrier(bar);
    TMARK(8);
#ifdef DBL_BAR
    xcd_barrier(bar);
#endif
    }

    REP(9) {
    if (PH(9))
    {
#if PEER_DSLICE
      const int myrank = (int)MISC[20];
      peer_phase<true>(lds, p, vcu, G);
      xcd_barrier(bar);
    TMARK(9);
#ifdef DUP_RETR
      peer_phase<true>(lds, p, vcu, G);
      xcd_barrier(bar);
#endif
      peer_slice_phase<false>(p, bar.x, myrank, G, bx, wave, lane);
      xcd_barrier(bar);
    TMARK(10);
#ifdef DUP_USL
      peer_slice_phase<false>(p, bar.x, myrank, G, bx, wave, lane);
      xcd_barrier(bar);
#endif
      peer_combine_phase(p, gw, NGW, lane);
      xcd_barrier(bar);
    TMARK(11);
      peer_slice_phase<true>(p, bar.x, myrank, G, bx, wave, lane);
      xcd_barrier(bar);
    TMARK(12);
#ifdef DUP_VSL
      peer_slice_phase<true>(p, bar.x, myrank, G, bx, wave, lane);
      xcd_barrier(bar);
#endif
      peer_final_phase(p, gw, NGW, lane);
      TMARK(13);
#else
      peer_phase<false>(lds, p, vcu, G);
      xcd_barrier(bar);
      peer_v_phase(p, vcu, G);
#endif
    }
#if (REP_MASK >> 9) & 1
    xcd_barrier(bar);
#endif
    }
}

extern "C" void kernel_launch(void* const* d_in, const int* in_sizes, int n_in, void* d_out, int out_size, void* d_ws, size_t ws_size, hipStream_t stream) {
    static int grid = 0;
    if (grid == 0) {
        if (n_in != 21 || out_size != T * D || ws_size < WS_END) { fprintf(stderr, "kernel_launch: unexpected shapes (n_in %d out %d ws %zu)\n", n_in, out_size, ws_size); grid = -1; return; }
        int dev = 0, cus = 0, per_cu = 0;
        if (hipGetDevice(&dev) != hipSuccess || hipDeviceGetAttribute(&cus, hipDeviceAttributeMultiprocessorCount, dev) != hipSuccess) { grid = -1; return; }
        if (hipFuncSetAttribute((const void*)fwd_megakernel, hipFuncAttributeMaxDynamicSharedMemorySize, LDS_BYTES) != hipSuccess) { fprintf(stderr, "kernel_launch: hipFuncSetAttribute failed\n"); grid = -1; return; }
        if (hipOccupancyMaxActiveBlocksPerMultiprocessor(&per_cu, (const void*)fwd_megakernel, NWAVES * 64, LDS_BYTES) != hipSuccess || per_cu < 1) { fprintf(stderr, "kernel_launch: occupancy query says %d\n", per_cu); grid = -1; return; }
        (void)hipGetLastError();
        grid = cus;
    }
    if (grid < 0) return;
    (void)hipMemsetAsync((char*)d_ws + WS_CTL, 0, CTL_ZERO_BYTES, stream);
    Params p{};
    const float** pp = (const float**)&p;
    for (int i = 0; i < 21; ++i) pp[i] = (const float*)d_in[i];
    p.out = (float*)d_out; p.ws = (unsigned char*)d_ws; p.never = 0; p.pad = 0;
    void* args[] = {&p};
    hipError_t e = hipLaunchCooperativeKernel((const void*)fwd_megakernel, dim3(grid), dim3(NWAVES * 64), args, LDS_BYTES, stream);
    if (e != hipSuccess) fprintf(stderr, "cooperative launch failed: %s (grid %d)\n", hipGetErrorString(e), grid);
}
```

```cpp
#include <hip/hip_runtime.h>
#include <type_traits>
#include <hip/hip_cooperative_groups.h>
#include <cstdio>
#include <cstdint>
namespace cg = cooperative_groups;

#define LAS __attribute__((address_space(3)))
#define GAS __attribute__((address_space(1)))
typedef unsigned short bf16_t;
typedef short bf16x8 __attribute__((ext_vector_type(8)));
typedef short s16x4 __attribute__((ext_vector_type(4)));
typedef float f32x4 __attribute__((ext_vector_type(4)));
typedef float f32x2 __attribute__((ext_vector_type(2)));
typedef float f32x16 __attribute__((ext_vector_type(16)));
typedef unsigned u32x4 __attribute__((ext_vector_type(4)));
typedef unsigned u32x2 __attribute__((ext_vector_type(2)));
typedef __bf16 bf16x2_t __attribute__((ext_vector_type(2)));

constexpr int T = 16384, D = 1024, SEQ = 4096;
constexpr int NPROJ = 2304;
constexpr int NWIN = 2816;
constexpr float EPS = 1e-6f;
constexpr float LOG2E = 1.4426950408889634f;
constexpr float C2_MLA = 0.10206207261596575f * LOG2E;
constexpr float C2_X = 0.0625f * LOG2E;
constexpr float U_SCALE = 512.f, V_SCALE = 64.f;

constexpr size_t MiB = 1u << 20;
constexpr size_t WS_CTL = 0, CTL_ZERO_BYTES = 1 * MiB;
constexpr size_t WS_SSQQ = 227 * MiB, WS_SSQKV = 228 * MiB, WS_SSQ1 = 229 * MiB, WS_SSQ2 = 230 * MiB;
constexpr size_t WS_CR = 1 * MiB, WS_SR = 2 * MiB, WS_CM = 3 * MiB, WS_SM = 3 * MiB + 256 * 1024;
constexpr size_t WS_WIN = 4 * MiB, WS_WUQ = 10 * MiB, WS_WUKV = 11 * MiB, WS_WO = 12 * MiB, WS_WXQ = 14 * MiB, WS_WXKV = 16 * MiB, WS_WXO = 20 * MiB, WS_WPQ = 22 * MiB, WS_SK = 26 * MiB;
constexpr size_t WS_MEMN = 27 * MiB, WS_KX = 29 * MiB, WS_VXT = 31 * MiB;
constexpr size_t WS_A0 = 33 * MiB, WS_MIX = 33 * MiB, WS_QX = 33 * MiB;
constexpr size_t WS_EG = 33 * MiB, WS_WG = 41 * MiB, WS_SSQ3 = 49 * MiB, WS_PART = 65 * MiB;
constexpr size_t WS_PROJ = 65 * MiB, WS_H1B = 65 * MiB, WS_U8 = 137 * MiB, WS_V8 = 153 * MiB;
constexpr size_t WS_STEP = 145 * MiB, WS_XS8 = 146 * MiB, WS_XH = 201 * MiB, WS_XL = 209 * MiB;
constexpr float U4_STEP = 0.335f, V4_SCALE = 0.49f, X8_CLIP = 6.0f;
constexpr size_t WS_WH = 129 * MiB;
constexpr size_t WS_PSAVE = 162 * MiB;
constexpr size_t WS_H3B = 97 * MiB;
constexpr size_t WS_OX = 97 * MiB, WS_H2B = 169 * MiB, WS_QP = 65 * MiB;
constexpr size_t WS_RVT = 137 * MiB, WS_QM = 154 * MiB, WS_KN = 178 * MiB, WS_VT = 194 * MiB, WS_RKVT = 211 * MiB;
constexpr int TP = T + 64;
constexpr size_t WS_END = 231 * MiB;
constexpr int CW_BAR = 4096;
constexpr int CW_XRANK = 20480;
constexpr int CW_QUEUE = 16384, Q3_SLOT = 0;

constexpr int RING_BYTES = 131072;
constexpr int LDSCTL_OFF = 143360;
constexpr int LDS_BYTES = 147456;
constexpr int NWAVES = 8;

__device__ __forceinline__ unsigned cvtpk(float lo, float hi) { f32x2 v = {lo, hi}; bf16x2_t b = __builtin_convertvector(v, bf16x2_t); return __builtin_bit_cast(unsigned, b); }
__device__ __forceinline__ float bf2f(unsigned short b) { return __uint_as_float(((unsigned)b) << 16); }
__device__ __forceinline__ int crow(int r, int hi) { return (r & 3) + 8 * (r >> 2) + 4 * hi; }
template <int M> __device__ __forceinline__ float shx(float f, int lane) {
    const int v = (int)__float_as_uint(f); int r;
    if (M == 1) r = __builtin_amdgcn_mov_dpp(v, 0xB1, 0xF, 0xF, true);
    else if (M == 2) r = __builtin_amdgcn_mov_dpp(v, 0x4E, 0xF, 0xF, true);
    else if (M == 4) { r = __builtin_amdgcn_update_dpp(v, v, 0x104, 0xF, 0x5, false); r = __builtin_amdgcn_update_dpp(r, v, 0x114, 0xF, 0xA, false); }
    else if (M == 8) r = __builtin_amdgcn_mov_dpp(v, 0x128, 0xF, 0xF, true);
    else if (M == 16) { auto rr = __builtin_amdgcn_permlane16_swap((unsigned)v, (unsigned)v, false, false); r = (int)((lane & 16) ? rr[0] : rr[1]); }
    else { auto rr = __builtin_amdgcn_permlane32_swap((unsigned)v, (unsigned)v, false, false); r = (int)((lane & 32) ? rr[0] : rr[1]); }
    return __uint_as_float((unsigned)r);
}
__device__ __forceinline__ float wave_sum(float v) {
#pragma unroll
    for (int o = 1; o < 64; o <<= 1) v += __shfl_xor(v, o);
    return v;
}
__device__ __forceinline__ float wave_sum_fast(float v, int lane) {
    v += shx<1>(v, lane); v += shx<2>(v, lane); v += shx<4>(v, lane); v += shx<8>(v, lane);
    { auto rr = __builtin_amdgcn_permlane16_swap(__float_as_uint(v), __float_as_uint(v), false, false); v = __uint_as_float(rr[0]) + __uint_as_float(rr[1]); }
    { auto rr = __builtin_amdgcn_permlane32_swap(__float_as_uint(v), __float_as_uint(v), false, false); v = __uint_as_float(rr[0]) + __uint_as_float(rr[1]); }
    return v;
}
__device__ __forceinline__ float xhalf_max(float m) { auto rr = __builtin_amdgcn_permlane32_swap(__float_as_uint(m), __float_as_uint(m), false, false); return fmaxf(__uint_as_float(rr[0]), __uint_as_float(rr[1])); }
__device__ __forceinline__ float xhalf_sum(float m) { auto rr = __builtin_amdgcn_permlane32_swap(__float_as_uint(m), __float_as_uint(m), false, false); return __uint_as_float(rr[0]) + __uint_as_float(rr[1]); }
__device__ __forceinline__ unsigned xhalf_other(unsigned m, int hi) { auto rr = __builtin_amdgcn_permlane32_swap(m, m, false, false); return hi ? rr[0] : rr[1]; }
#define LDS_WAIT() asm volatile("s_waitcnt lgkmcnt(0)" ::: "memory")
template <int NP> __device__ __forceinline__ float ssq_sum(const float* part) {
    float s = 0.f;
#pragma unroll
    for (int i = 0; i < NP / 4; ++i) { const f32x4 v = *(const f32x4*)(part + 4 * i); s += v[0]; s += v[1]; s += v[2]; s += v[3]; }
    return s;
}
__device__ __forceinline__ int opaque_tid() { int t = threadIdx.x; asm volatile("" : "+v"(t)); return t; }
#define MFMA32(a, b, c) __builtin_amdgcn_mfma_f32_32x32x16_bf16((a), (b), (c), 0, 0, 0)
__device__ __forceinline__ float gelu_f(float v) {
    const float av = fabsf(v), t = __builtin_amdgcn_rcpf(av * 0.2316418882f + 1.0f);
    float q = t * 0.5307027145f + (-0.7265760135f); q = q * t + 0.7107068705f; q = q * t + (-0.142248368f); q = q * t + 0.127414796f; q = q * t;
    const float e = __builtin_amdgcn_exp2f((v * v) * (-0.72134752044f));
    const float m = v * (q * e);
    return v < 0.f ? m : v - m;
}

namespace pg8 {
constexpr int BM = 256, BK = 64, HALF = 128, HTB = HALF * BK * 2, STAGE_BYTES = 8 * HTB, NXCD = 8, WGM = 8;
__host__ __device__ __forceinline__ int lds_byte(int r, int c) { const int st = (r >> 4) * 2 + (c >> 5), rr = r & 15, cc = c & 31, ob = rr * 64 + cc * 2; return st * 1024 + (ob ^ (((ob >> 9) & 1) << 5)); }
__host__ __device__ __forceinline__ void stage_rc(int b, int& R, int& C) { const int st = b / 1024, sb = b % 1024, swz = sb ^ (((sb >> 9) & 1) << 5); R = (st >> 1) * 16 + swz / 64; C = (st & 1) * 32 + (swz % 64) / 2; }
__host__ __device__ __forceinline__ int perm32(int rho) { const int n = rho >> 4, i = rho & 15; return 8 * (i >> 2) + 4 * n + (i & 3); }
struct Unit { int pm, pn; };
struct Gemm { const bf16_t* A; const bf16_t* Bt; int M, N, K, lda, ldb; };
struct StaticOrder {
    int nM, nN, nwg, G, c;
    __device__ void init(int M, int N, int G_, int c_) { nM = M / BM; nN = N / BM; nwg = nM * nN; G = G_; c = c_; }
    __device__ bool next(int i, Unit& u) const {
        const long L = (long)i * G + c; if (L >= nwg) return false;
        int wgid = (int)L; { const int q = nwg / NXCD, r = nwg % NXCD, xcd = wgid % NXCD, off = wgid / NXCD; wgid = (xcd < r ? xcd * (q + 1) : r * (q + 1) + (xcd - r) * q) + off; }
        const int nig = WGM * nN, gid = wgid / nig, fm = gid * WGM, gsz = (nM - fm) < WGM ? (nM - fm) : WGM;
        u.pm = fm + ((wgid % nig) % gsz); u.pn = (wgid % nig) / gsz; return true;
    }
};

struct XaOrder {
    int G, c;
    __device__ bool next(int i, Unit& u) const { const int L = i * G + c; if (L >= 256) return false; u.pm = (L >> 6) * 16 + (L & 15); u.pn = (L >> 4) & 3; return true; }
};

template <class Epi, class Sched, bool ALIGN_EPI>
__device__ __forceinline__ void gemm_phase(LAS unsigned char* lds, const Gemm g, const Sched& S, const Epi& E) {
    const int tid = opaque_tid(), wid = __builtin_amdgcn_readfirstlane(tid >> 6), lane = tid & 63, wr = wid >> 2, wc = wid & 3, fr = lane & 15, fq = lane >> 4;
    const int K = g.K, nt = K / BK;
    unsigned voffA[2], voffB[2];
#pragma unroll
    for (int i = 0; i < 2; ++i) { int R, C; stage_rc(tid * 16 + i * 8192, R, C); const int Rb = 64 * (R >> 5) + perm32(R & 31); voffA[i] = (unsigned)(R * g.lda + C) * 2u; voffB[i] = (unsigned)(Rb * g.ldb + C) * 2u; }
    const size_t kstep = (size_t)(BK * 2);
    const size_t hstepA = (size_t)HALF * g.lda * 2, hstepB = (size_t)32 * g.ldb * 2, tstepA = 2 * hstepA, tstepB = (size_t)BM * g.ldb * 2;
    const unsigned ldsw = (unsigned)wid * 1024u;
    const int aoff = lds_byte(wr * 64 + fr, fq * 8), boff = lds_byte(wc * 32 + fr, fq * 8);
#define PG8_SA(b, h) (((b) * 2 + (h)) * HTB)
#define PG8_SB(b, h) ((4 + (b) * 2 + (h)) * HTB)
#define PG8_STAGE(bufoff, gbase, voff) do { _Pragma("unroll") for (int _i = 0; _i < 2; ++_i) \
        __builtin_amdgcn_global_load_lds((const unsigned*)((const char*)(gbase) + (voff)[_i]), (LAS unsigned*)(lds + (bufoff) + ldsw + _i * 8192), 16, 0, 0); } while (0)
#define PG8_LDA(dst, b, h) do { _Pragma("unroll") for (int m = 0; m < 4; ++m) _Pragma("unroll") for (int k = 0; k < 2; ++k) dst[m][k] = *(const LAS bf16x8*)(lds + PG8_SA(b, h) + aoff + m * 2048 + k * 1024); } while (0)
#define PG8_LDB(dst, b, h) do { _Pragma("unroll") for (int n = 0; n < 2; ++n) _Pragma("unroll") for (int k = 0; k < 2; ++k) dst[n][k] = *(const LAS bf16x8*)(lds + PG8_SB(b, h) + boff + n * 2048 + k * 1024); } while (0)
#define PG8_MMA(ai, bj, At, Bt) do { __builtin_amdgcn_s_setprio(1); _Pragma("unroll") for (int m = 0; m < 4; ++m) _Pragma("unroll") for (int n = 0; n < 2; ++n) _Pragma("unroll") for (int k = 0; k < 2; ++k) \
        acc[ai][bj][m][n] = __builtin_amdgcn_mfma_f32_16x16x32_bf16(Bt[n][k], At[m][k], acc[ai][bj][m][n], 0, 0, 0); __builtin_amdgcn_s_setprio(0); } while (0)
#define PG8_WAIT_V(n) asm volatile("s_waitcnt vmcnt(" #n ")" ::: "memory")
#define PG8_WAIT_L(n) asm volatile("s_waitcnt lgkmcnt(" #n ")" ::: "memory")
#define PG8_BAR __builtin_amdgcn_s_barrier()
#define PG8_SCHED __builtin_amdgcn_sched_barrier(0)
    Unit cur, nxt; int ui = 0;
    if (!S.next(0, cur)) return;
    f32x4 acc[2][2][4][2];
#pragma unroll
    for (int a = 0; a < 2; ++a)
#pragma unroll
        for (int b = 0; b < 2; ++b)
#pragma unroll
            for (int m = 0; m < 4; ++m)
#pragma unroll
                for (int n = 0; n < 2; ++n) acc[a][b][m][n] = (f32x4){0.f, 0.f, 0.f, 0.f};
    bf16x8 At[4][2], B0[2][2], B1[2][2];
    const char* cA = (const char*)g.A + (size_t)cur.pm * tstepA; const char* cB = (const char*)g.Bt + (size_t)cur.pn * tstepB;
    PG8_STAGE(PG8_SB(0, 0), cB, voffB); PG8_STAGE(PG8_SB(0, 1), cB + hstepB, voffB); PG8_STAGE(PG8_SA(0, 0), cA, voffA); PG8_STAGE(PG8_SA(0, 1), cA + hstepA, voffA);
    if (wr == 1) PG8_BAR;
    PG8_WAIT_V(2); PG8_BAR;
    PG8_STAGE(PG8_SB(1, 0), cB + kstep, voffB); PG8_STAGE(PG8_SA(1, 0), cA + kstep, voffA); PG8_STAGE(PG8_SB(1, 1), cB + hstepB + kstep, voffB);
    PG8_WAIT_V(6); PG8_BAR;
    for (;;) {
        const bool has_next = S.next(ui + 1, nxt);
        const char* nA = has_next ? (const char*)g.A + (size_t)nxt.pm * tstepA : cA; const char* nB = has_next ? (const char*)g.Bt + (size_t)nxt.pn * tstepB : cB;
#pragma nounroll
        for (int t = 0; t < nt; t += 2) {
            const bool last = (t == nt - 2);
            const char* a1 = cA + (size_t)(t + 1) * kstep;
            const char* a2 = last ? nA : cA + (size_t)(t + 2) * kstep; const char* b2 = last ? nB : cB + (size_t)(t + 2) * kstep;
            const char* a3 = a2 + kstep; const char* b3 = b2 + kstep;
            PG8_LDB(B0, 0, 0); PG8_LDB(B1, 0, 1); PG8_SCHED; PG8_LDA(At, 0, 0); PG8_STAGE(PG8_SA(1, 1), a1 + hstepA, voffA);
            PG8_WAIT_V(8); PG8_WAIT_L(0); PG8_BAR; PG8_MMA(0, 0, At, B0); PG8_MMA(0, 1, At, B1); PG8_BAR; PG8_SCHED;
            PG8_LDA(At, 0, 1); PG8_STAGE(PG8_SB(0, 0), b2, voffB); PG8_STAGE(PG8_SB(0, 1), b2 + hstepB, voffB); PG8_STAGE(PG8_SA(0, 0), a2, voffA);
            PG8_WAIT_V(8); PG8_WAIT_L(0); PG8_BAR; PG8_MMA(1, 0, At, B0); PG8_MMA(1, 1, At, B1); PG8_BAR; PG8_SCHED;
            PG8_LDB(B0, 1, 0); PG8_LDB(B1, 1, 1); PG8_SCHED; PG8_LDA(At, 1, 0); PG8_STAGE(PG8_SA(0, 1), a2 + hstepA, voffA);
            PG8_WAIT_V(8); PG8_WAIT_L(0); PG8_BAR; PG8_MMA(0, 0, At, B0); PG8_MMA(0, 1, At, B1); PG8_BAR; PG8_SCHED;
            PG8_LDA(At, 1, 1); PG8_STAGE(PG8_SB(1, 0), b3, voffB); PG8_STAGE(PG8_SB(1, 1), b3 + hstepB, voffB); PG8_STAGE(PG8_SA(1, 0), a3, voffA);
            PG8_WAIT_V(8); PG8_WAIT_L(0); PG8_BAR; PG8_MMA(1, 0, At, B0); PG8_MMA(1, 1, At, B1); PG8_BAR; PG8_SCHED;
        }
        if constexpr (ALIGN_EPI) { if (wr == 0) PG8_BAR; }
        E(acc, cur, wr, wc, fr, fq);
        if (!has_next) break;
#pragma unroll
        for (int a = 0; a < 2; ++a)
#pragma unroll
            for (int b = 0; b < 2; ++b)
#pragma unroll
                for (int m = 0; m < 4; ++m)
#pragma unroll
                    for (int n = 0; n < 2; ++n) acc[a][b][m][n] = (f32x4){0.f, 0.f, 0.f, 0.f};
        cur = nxt; cA = nA; cB = nB; ++ui;
        if constexpr (ALIGN_EPI) { if (wr == 1) PG8_BAR; }
    }
    PG8_WAIT_V(0);
    if constexpr (!ALIGN_EPI) { if (wr == 0) PG8_BAR; }
    PG8_BAR;
#undef PG8_SA
#undef PG8_SB
#undef PG8_STAGE
#undef PG8_LDA
#undef PG8_LDB
#undef PG8_MMA
#undef PG8_WAIT_V
#undef PG8_WAIT_L
#undef PG8_BAR
#undef PG8_SCHED
}

__device__ __forceinline__ u32x4 pk_bf16x8(f32x4 v0, f32x4 v1) { u32x4 w; w.x = cvtpk(v0[0], v0[1]); w.y = cvtpk(v0[2], v0[3]); w.z = cvtpk(v1[0], v1[1]); w.w = cvtpk(v1[2], v1[3]); return w; }
__device__ __forceinline__ void st_rows16(bf16_t* p0, int ldc, int fr, int fq, u32x4 A, u32x4 B) {
    u32x4 R;
    R.x = (unsigned)__builtin_amdgcn_mov_dpp((int)B.x, 0x128, 0xF, 0xF, true); R.y = (unsigned)__builtin_amdgcn_mov_dpp((int)B.y, 0x128, 0xF, 0xF, true);
    R.z = (unsigned)__builtin_amdgcn_mov_dpp((int)B.z, 0x128, 0xF, 0xF, true); R.w = (unsigned)__builtin_amdgcn_mov_dpp((int)B.w, 0x128, 0xF, 0xF, true);
    const bool low = fr < 8; const int f7 = fr & 7;
    bf16_t* q1 = p0 + (size_t)f7 * ldc + 8 * fq + (low ? 0 : 32);
    bf16_t* q2 = p0 + (size_t)(8 + f7) * ldc + 8 * fq + (low ? 32 : 0);
    *(u32x4*)q1 = low ? A : R;
    *(u32x4*)q2 = low ? R : A;
}
#define EPI_LOOP_AM _Pragma("unroll") for (int ai = 0; ai < 2; ++ai) _Pragma("unroll") for (int m = 0; m < 4; ++m)

struct EpiPlain {
    bf16_t* O; int ldc;
    __device__ __forceinline__ void operator()(const f32x4 (&acc)[2][2][4][2], const Unit& u, int wr, int wc, int fr, int fq) const {
        bf16_t* base = O + (size_t)(u.pm * BM + wr * 64) * ldc + u.pn * BM + wc * 64;
        EPI_LOOP_AM st_rows16(base + (size_t)(ai * HALF + m * 16) * ldc, ldc, fr, fq, pk_bf16x8(acc[ai][0][m][0], acc[ai][0][m][1]), pk_bf16x8(acc[ai][1][m][0], acc[ai][1][m][1]));
    }
};
template <int NP> struct EpiRowScale {
    bf16_t* O; int ldc; const float* ssq; float invn, mul;
    __device__ __forceinline__ void operator()(const f32x4 (&acc)[2][2][4][2], const Unit& u, int wr, int wc, int fr, int fq) const {
        const int row0 = u.pm * BM + wr * 64 + fr;
        bf16_t* base = O + (size_t)(u.pm * BM + wr * 64) * ldc + u.pn * BM + wc * 64;
        EPI_LOOP_AM { const int row = row0 + ai * HALF + m * 16; const float rs = rsqrtf(ssq_sum<NP>(ssq + (size_t)row * 16) * invn + EPS) * mul;
            st_rows16(base + (size_t)(ai * HALF + m * 16) * ldc, ldc, fr, fq, pk_bf16x8(acc[ai][0][m][0] * rs, acc[ai][0][m][1] * rs), pk_bf16x8(acc[ai][1][m][0] * rs, acc[ai][1][m][1] * rs));
            if (m & 1) asm volatile("" ::: "memory"); }
    }
};
struct EpiColScale {
    bf16_t* O; int ldc; const float* ssq; float invn;
    __device__ __forceinline__ void operator()(const f32x4 (&acc)[2][2][4][2], const Unit& u, int wr, int wc, int fr, int fq) const {
        const int col0 = u.pn * BM + wc * 64 + 8 * fq;
        bf16_t* base = O + (size_t)(u.pm * BM + wr * 64) * ldc + u.pn * BM + wc * 64;
        f32x4 rs[2][2];
#pragma unroll
        for (int bj = 0; bj < 2; ++bj) { const float* sp = ssq + (size_t)(col0 + bj * 32) * 16;
#pragma unroll
            for (int n = 0; n < 2; ++n) rs[bj][n] = (f32x4){rsqrtf(ssq_sum<8>(sp + (4 * n) * 16) * invn + EPS), rsqrtf(ssq_sum<8>(sp + (4 * n + 1) * 16) * invn + EPS), rsqrtf(ssq_sum<8>(sp + (4 * n + 2) * 16) * invn + EPS), rsqrtf(ssq_sum<8>(sp + (4 * n + 3) * 16) * invn + EPS)}; }
        EPI_LOOP_AM st_rows16(base + (size_t)(ai * HALF + m * 16) * ldc, ldc, fr, fq, pk_bf16x8(acc[ai][0][m][0] * rs[0][0], acc[ai][0][m][1] * rs[0][1]), pk_bf16x8(acc[ai][1][m][0] * rs[1][0], acc[ai][1][m][1] * rs[1][1]));
    }
};
struct EpiRes {
    const float* basef; const bf16_t* baseb; bf16_t* hb; float* ssq;
    struct Raw { f32x4 f[4]; u32x4 r[2]; };
    __device__ __forceinline__ void operator()(const f32x4 (&acc)[2][2][4][2], const Unit& u, int wr, int wc, int fr, int fq) const {
        const int row0 = u.pm * BM + wr * 64 + fr, col0 = u.pn * BM + wc * 64 + 8 * fq;
        bf16_t* obase = hb + (size_t)(u.pm * BM + wr * 64) * D + u.pn * BM + wc * 64;
        auto load = [&](int it, Raw& w) { const int ai = it >> 2, m = it & 3; const size_t off = (size_t)(row0 + ai * HALF + m * 16) * D + col0;
#pragma unroll
            for (int bj = 0; bj < 2; ++bj) { if (basef) { w.f[2 * bj] = *(const f32x4*)(basef + off + bj * 32); w.f[2 * bj + 1] = *(const f32x4*)(basef + off + bj * 32 + 4); } else w.r[bj] = *(const u32x4*)(baseb + off + bj * 32); } };
        auto proc = [&](int it, const Raw& w) { const int ai = it >> 2, m = it & 3; const int row = row0 + ai * HALF + m * 16; float ss = 0.f; u32x4 pk[2];
#pragma unroll
            for (int bj = 0; bj < 2; ++bj) { f32x4 b0, b1;
                if (basef) { b0 = w.f[2 * bj]; b1 = w.f[2 * bj + 1]; }
                else { const u32x4 r = w.r[bj];
                    b0 = (f32x4){bf2f((unsigned short)(r.x & 0xffffu)), bf2f((unsigned short)(r.x >> 16)), bf2f((unsigned short)(r.y & 0xffffu)), bf2f((unsigned short)(r.y >> 16))};
                    b1 = (f32x4){bf2f((unsigned short)(r.z & 0xffffu)), bf2f((unsigned short)(r.z >> 16)), bf2f((unsigned short)(r.w & 0xffffu)), bf2f((unsigned short)(r.w >> 16))}; }
                const f32x4 h0 = b0 + acc[ai][bj][m][0], h1 = b1 + acc[ai][bj][m][1];
                pk[bj] = pk_bf16x8(h0, h1);
                ss += (h0[0] * h0[0] + h0[1] * h0[1]) + (h0[2] * h0[2] + h0[3] * h0[3]) + (h1[0] * h1[0] + h1[1] * h1[1]) + (h1[2] * h1[2] + h1[3] * h1[3]); }
            st_rows16(obase + (size_t)(ai * HALF + m * 16) * D, D, fr, fq, pk[0], pk[1]);
            { auto r1 = __builtin_amdgcn_permlane16_swap(__float_as_uint(ss), __float_as_uint(ss), false, false); ss = __uint_as_float(r1[0]) + __uint_as_float(r1[1]);
              auto r2 = __builtin_amdgcn_permlane32_swap(__float_as_uint(ss), __float_as_uint(ss), false, false); ss = __uint_as_float(r2[0]) + __uint_as_float(r2[1]); }
            if (fq == 0) ssq[(size_t)row * 16 + u.pn * 4 + wc] = ss; };
        Raw A, B;
        load(0, A); load(1, B);
        asm volatile("" ::: "memory");
#pragma unroll
        for (int it = 0; it < 8; it += 2) {
            proc(it, A); if (it + 2 < 8) load(it + 2, A);
            asm volatile("" ::: "memory");
            proc(it + 1, B); if (it + 3 < 8) load(it + 3, B);
            asm volatile("" ::: "memory"); }
    }
};
struct EpiProj {
    bf16_t* P; float* ssq_q; float* ssq_kv; const float* cr; const float* sr; const float* cm; const float* sm;
    __device__ __forceinline__ void operator()(const f32x4 (&acc)[2][2][4][2], const Unit& u, int wr, int wc, int fr, int fq) const {
        const int row0 = u.pm * BM + wr * 64 + fr;
        const int hb = 2 * u.pn + (wc >> 1);
        if (hb == 17 && (wc & 1) != 0) return;
        const int kind = hb < 3 ? 0 : hb < 5 ? 1 : hb < 9 ? 2 : hb < 13 ? 3 : hb < 17 ? 4 : 5;
        bf16_t* base = P + (size_t)(u.pm * BM + wr * 64) * NPROJ + u.pn * BM + wc * 64;
        EPI_LOOP_AM { const int row = row0 + ai * HALF + m * 16; const int s = row & (SEQ - 1); u32x4 pk[2];
#pragma unroll
            for (int bj = 0; bj < 2; ++bj) { const int g32 = 2 * (wc & 1) + bj;
                f32x4 v0 = acc[ai][bj][m][0], v1 = acc[ai][bj][m][1];
                if (kind <= 1) {
                    float ss = (v0[0] * v0[0] + v0[1] * v0[1]) + (v0[2] * v0[2] + v0[3] * v0[3]) + (v1[0] * v1[0] + v1[1] * v1[1]) + (v1[2] * v1[2] + v1[3] * v1[3]);
                    ss += shx<16>(ss, fq * 16 + fr); ss += shx<32>(ss, fq * 16 + fr);
                    if (fq == 0) { if (kind == 0) ssq_q[(size_t)row * 16 + hb * 4 + g32] = ss; else ssq_kv[(size_t)row * 16 + (hb - 3) * 4 + g32] = ss; }
                } else if (kind == 2 || kind == 3) {
                    const f32x4 c = *(const f32x4*)(cr + (size_t)s * 64 + g32 * 16 + 4 * fq), sn = *(const f32x4*)(sr + (size_t)s * 64 + g32 * 16 + 4 * fq);
                    f32x4 y0 = v0 * c - v1 * sn, y1 = v0 * sn + v1 * c;
                    if (kind == 3) { y0 = y0 * 0.08838834764831845f; y1 = y1 * 0.08838834764831845f; }
                    v0 = y0; v1 = y1;
                } else if (kind == 5 && bj == 0) {
                    const f32x4 c = *(const f32x4*)(cm + (size_t)s * 16 + 4 * fq), sn = *(const f32x4*)(sm + (size_t)s * 16 + 4 * fq);
                    const f32x4 y0 = v0 * c - v1 * sn, y1 = v0 * sn + v1 * c; v0 = y0; v1 = y1;
                }
                pk[bj] = pk_bf16x8(v0, v1); }
            st_rows16(base + (size_t)(ai * HALF + m * 16) * NPROJ, NPROJ, fr, fq, pk[0], pk[1]);
            if (m & 1) asm volatile("" ::: "memory"); }
    }
};
struct EpiQ {
    bf16_t* O; const float* ssq; const float* cm; const float* sm;
    __device__ __forceinline__ void operator()(const f32x4 (&acc)[2][2][4][2], const Unit& u, int wr, int wc, int fr, int fq) const {
        const int row0 = u.pm * BM + wr * 64 + fr;
        bf16_t* base = O + (size_t)(u.pm * BM + wr * 64) * 768 + u.pn * BM + wc * 64;
        EPI_LOOP_AM { const int row = row0 + ai * HALF + m * 16; const int s = row & (SEQ - 1); const float rs = rsqrtf(ssq_sum<12>(ssq + (size_t)row * 16) * (1.f / 384.f) + EPS) * C2_MLA;
            f32x4 c = (f32x4){1.f, 1.f, 1.f, 1.f}, sn = (f32x4){0.f, 0.f, 0.f, 0.f};
            if (u.pn == 2) { c = *(const f32x4*)(cm + (size_t)s * 16 + 4 * fq); sn = *(const f32x4*)(sm + (size_t)s * 16 + 4 * fq); }
            u32x4 pk[2];
#pragma unroll
            for (int bj = 0; bj < 2; ++bj) { const f32x4 v0 = acc[ai][bj][m][0] * rs, v1 = acc[ai][bj][m][1] * rs; pk[bj] = pk_bf16x8(v0 * c - v1 * sn, v0 * sn + v1 * c); }
            st_rows16(base + (size_t)(ai * HALF + m * 16) * 768, 768, fr, fq, pk[0], pk[1]);
            asm volatile("" ::: "memory"); }
    }
};
}

#define XB_TMO      128
#define XB_XCNT(j)  (256  + 64 * (j))
#define XB_XSUB(j)  (1280 + 64 * (j))
#define XB_XGEN(j)  (2304 + 64 * (j))
#define XB_TOP      3328
#define XB_TOPGEN   3392
#define XCD_BAR_WORDS 3456
#define XB_SPIN_CAP (1u << 21)
__device__ __forceinline__ unsigned xb_ld(unsigned* p)              { return __hip_atomic_load(p, __ATOMIC_RELAXED, __HIP_MEMORY_SCOPE_AGENT); }
__device__ __forceinline__ unsigned xb_add(unsigned* p, unsigned v) { return __hip_atomic_fetch_add(p, v, __ATOMIC_RELAXED, __HIP_MEMORY_SCOPE_AGENT); }
__device__ __forceinline__ unsigned xb_xcc_id() { return (unsigned)__builtin_amdgcn_s_getreg((3 << 11) | 20) & 0xFu; }
#define XB_SPIN(cond, bar) do { unsigned _sp = 0; while (cond) { __builtin_amdgcn_s_sleep(1); \
    if ((++_sp & 255u) == 0u) { if (xb_ld(&(bar)[XB_TMO])) break; if (_sp > XB_SPIN_CAP) { atomicAdd(&(bar)[XB_TMO], 1u); break; } } } } while (0)
struct XcdBarrier { unsigned* bar; unsigned x; volatile LAS unsigned* st; };
__device__ __forceinline__ XcdBarrier xcd_barrier_post(unsigned* bar, volatile LAS unsigned* st) {
    XcdBarrier b; b.bar = bar; b.x = xb_xcc_id(); b.st = st;
    if (threadIdx.x == 0) (void)xb_add(&bar[XB_XCNT(b.x)], 1u);
    return b;
}
__device__ __forceinline__ void xcd_barrier_complete(unsigned* bar, unsigned x, unsigned& nloc, unsigned& nx) {
    const unsigned G = gridDim.x * gridDim.y * gridDim.z;
    unsigned sum, cnt, mine, sp = 0u;
    for (;;) {
        sum = 0u; cnt = 0u; mine = 0u;
#pragma unroll
        for (unsigned j = 0; j < 16; ++j) { const unsigned c = xb_ld(&bar[XB_XCNT(j)]); sum += c; cnt += (c > 0u) ? 1u : 0u; mine = (j == x) ? c : mine; }
        if (sum == G) break;
        __builtin_amdgcn_s_sleep(1);
        if ((++sp & 255u) == 0u) { if (xb_ld(&bar[XB_TMO])) break; if (sp > XB_SPIN_CAP) { atomicAdd(&bar[XB_TMO], 1u); break; } }
    }
    nloc = mine > 0u ? mine : 1u; nx = cnt > 0u ? cnt : 1u;
}
__device__ __forceinline__ void xcd_barrier(const XcdBarrier& b) {
    asm volatile("s_waitcnt vmcnt(0)" ::: "memory");
    __syncthreads();
    if (threadIdx.x == 0) {
        unsigned* bar = b.bar;
        __builtin_amdgcn_s_waitcnt(0);
        unsigned nloc = b.st[0], nx = b.st[1];
        if (nloc == 0u) { xcd_barrier_complete(bar, b.x, nloc, nx); b.st[0] = nloc; b.st[1] = nx; }
        const unsigned old = xb_add(&bar[XB_XSUB(b.x)], 1u);
        const unsigned gen = old / nloc;
        if (old + 1u == (gen + 1u) * nloc) {
            __builtin_amdgcn_fence(__ATOMIC_RELEASE, "agent");
            asm volatile("s_waitcnt vmcnt(0)" ::: "memory");
            const unsigned og = xb_add(&bar[XB_TOP], 1u);
            const unsigned tg = og / nx;
            if (og + 1u == (tg + 1u) * nx) xb_add(&bar[XB_TOPGEN], 1u);
            else XB_SPIN(xb_ld(&bar[XB_TOPGEN]) == tg, bar);
            __builtin_amdgcn_fence(__ATOMIC_ACQUIRE, "agent");
            xb_add(&bar[XB_XGEN(b.x)], 1u);
            asm volatile("s_waitcnt vmcnt(0)" ::: "memory");
        } else {
            XB_SPIN(xb_ld(&bar[XB_XGEN(b.x)]) == gen, bar);
            __builtin_amdgcn_fence(__ATOMIC_ACQUIRE, "agent");
            asm volatile("s_waitcnt vmcnt(0)" ::: "memory");
        }
    }
    __syncthreads();
}

struct Params {
    const float *x, *mem, *g_mix, *w_in, *g_q_lora, *w_uq, *g_kv_lora, *w_ukv, *g_ret_gn, *w_o, *g_xattn, *g_mem, *w_xq, *w_xkv, *w_xo, *g_ffn, *w_pq, *sub_keys, *u_exp, *v_exp, *g_final;
    float* out; unsigned char* ws; int never; int pad;
};

__device__ __forceinline__ int rope32(int r, int second) { return 8 * (r >> 2) + 4 * second + (r & 3); }
__device__ __forceinline__ int permret(int i) { return i < 64 ? ((i >> 4) * 32 + rope32(i & 15, 0)) : (((i - 64) >> 4) * 32 + rope32((i - 64) & 15, 1)); }
template <int MODE> __device__ __forceinline__ int dst_row(int c) {
    if (MODE == 1) {
        if (c < 640) return c;
        if (c < 672) { const int r = c - 640; return 2176 + rope32(r & 15, r >> 4); }
        if (c < 1184) { const int cc = c - 672; return 640 + (cc & ~127) + permret(cc & 127); }
        if (c < 1696) { const int cc = c - 1184; return 1152 + (cc & ~127) + permret(cc & 127); }
        if (c < 2208) return 2304 + (c - 1696);
        return 1664 + (c - 2208);
    } else if (MODE == 2) {
        const int h = c / 96, i = c - h * 96; return i < 64 ? h * 64 + i : 512 + h * 32 + rope32((i - 64) & 15, (i - 64) >> 4);
    } else if (MODE == 3) {
        const int h = c >> 7, i = c & 127; return i < 64 ? h * 64 + i : 512 + h * 64 + (i - 64);
    }
    return c;
}
template <int MODE> __device__ __forceinline__ void p0_transpose_item(const float* W, int K, int N, bf16_t* WT, const float* gain, LAS float* scr, int item, int lane) {
    const int nblk = N / 32, kb = item / nblk, nb = item % nblk, k0 = 64 * kb, n0 = 32 * nb;
    float v[32];
#pragma unroll
    for (int i = 0; i < 32; ++i) { const int kk = 2 * i + (lane >> 5); v[i] = W[(size_t)(k0 + kk) * N + n0 + (lane & 31)]; }
    if (gain) {
#pragma unroll
        for (int i = 0; i < 32; ++i) { const int kk = 2 * i + (lane >> 5); v[i] *= gain[k0 + kk]; }
    }
#pragma unroll
    for (int i = 0; i < 32; ++i) { const int kk = 2 * i + (lane >> 5); scr[kk * 33 + (lane & 31)] = v[i]; }
    LDS_WAIT(); asm volatile("" ::: "memory");
    const int c = lane & 7;
#pragma unroll
    for (int j = 0; j < 4; ++j) { const int n = (lane >> 3) + 8 * j; const LAS float* s = scr + (8 * c) * 33 + n;
        u32x4 o; o.x = cvtpk(s[0 * 33], s[1 * 33]); o.y = cvtpk(s[2 * 33], s[3 * 33]); o.z = cvtpk(s[4 * 33], s[5 * 33]); o.w = cvtpk(s[6 * 33], s[7 * 33]);
        *(u32x4*)(WT + (size_t)dst_row<MODE>(n0 + n) * K + k0 + 8 * c) = o; }
    LDS_WAIT(); asm volatile("" ::: "memory");
}
template <int NR> __device__ __forceinline__ void rms_rows_to_bf16(const float* xrow, const float* g, bf16_t* orow, size_t rstride, int lane) {
    f32x4 v[NR][4];
#pragma unroll
    for (int r = 0; r < NR; ++r)
#pragma unroll
        for (int j = 0; j < 4; ++j) v[r][j] = ((const f32x4*)(xrow + r * rstride) + lane)[64 * j];
    const f32x4* gr = (const f32x4*)g + lane;
    f32x4 gv[4];
#pragma unroll
    for (int j = 0; j < 4; ++j) gv[j] = gr[64 * j];
#pragma unroll
    for (int r = 0; r < NR; ++r) {
        float s = 0.f;
#pragma unroll
        for (int j = 0; j < 4; ++j) s += (v[r][j][0] * v[r][j][0] + v[r][j][1] * v[r][j][1]) + (v[r][j][2] * v[r][j][2] + v[r][j][3] * v[r][j][3]);
        const float rstd = rsqrtf(wave_sum_fast(s, lane) * (1.f / D) + EPS);
        u32x2* o8 = (u32x2*)(orow + r * rstride) + lane;
#pragma unroll
        for (int j = 0; j < 4; ++j) { const f32x4 y = v[r][j] * rstd * gv[j]; u32x2 w; w.x = cvtpk(y[0], y[1]); w.y = cvtpk(y[2], y[3]); o8[64 * j] = w; }
    }
}

constexpr int ROWST_P = 144, ROWST_BYTES = 32 * ROWST_P;
__device__ __forceinline__ void rowst_put(LAS unsigned char* wl, int r32, int hi, int t, int g, u32x2 w) { *(LAS u32x2*)(wl + r32 * ROWST_P + (32 * t + 8 * g + 4 * hi) * 2) = w; }
__device__ __forceinline__ void rowst_flush(const LAS unsigned char* wl, bf16_t* g0, size_t ld, int lane) {
    LDS_WAIT();
#pragma unroll
    for (int k = 0; k < 4; ++k) { const int row = 8 * k + (lane >> 3), c16 = lane & 7; const u32x4 v = *(const LAS u32x4*)(wl + row * ROWST_P + c16 * 16); *(u32x4*)(g0 + (size_t)row * ld + c16 * 8) = v; }
    LDS_WAIT();
}

struct NoMid { __device__ __forceinline__ void operator()() const {} };
__device__ __forceinline__ float max3f(float a, float b, float c) { return fmaxf(fmaxf(a, b), c); }
template <int NS, int NT, int KG, bool CINIT, bool MASK, class Mid>
__device__ __forceinline__ void flash_tile(const LAS unsigned char* Ks, int kpitch, const LAS unsigned char* Vs, int vpitch, const bf16x8 (&qf)[NS], f32x16 (&o)[NT],
                                           f32x16& negm, float& mref, float& lrun, bool first, int r32, int hi, bool domask, int qrel, int krel, const Mid& mid, u32x4* psave = nullptr) {
    f32x16 p0, p1;
    const LAS unsigned char* k0 = Ks + r32 * kpitch + hi * 16; const LAS unsigned char* k1 = k0 + 32 * kpitch;
    if (CINIT) { p0 = negm; p1 = negm; }
    else {
#pragma unroll
        for (int r = 0; r < 16; ++r) { p0[r] = 0.f; p1[r] = 0.f; }
    }
#pragma unroll
    for (int g0 = 0; g0 < NS; g0 += KG) {
        bf16x8 ka[KG], kb2[KG];
#pragma unroll
        for (int s = 0; s < KG; ++s) { ka[s] = *(const LAS bf16x8*)(k0 + (g0 + s) * 32); kb2[s] = *(const LAS bf16x8*)(k1 + (g0 + s) * 32); }
        __builtin_amdgcn_sched_barrier(0);
#pragma unroll
        for (int s = 0; s < KG; ++s) { p0 = MFMA32(ka[s], qf[g0 + s], p0); p1 = MFMA32(kb2[s], qf[g0 + s], p1); }
        __builtin_amdgcn_sched_barrier(0);
    }
    if (!CINIT) {
#pragma unroll
        for (int r = 0; r < 16; ++r) { p0[r] -= mref; p1[r] -= mref; }
    }
    if (MASK) {
#pragma unroll
        for (int r = 0; r < 16; ++r) { const int kv = krel + crow(r, hi); if (kv > qrel) p0[r] = -1e30f; if (kv + 32 > qrel) p1[r] = -1e30f; }
    }
    float ma = max3f(p0[0], p0[1], p1[0]), mb = max3f(p0[2], p0[3], p1[1]); ma = max3f(ma, p1[2], p1[3]);
#pragma unroll
    for (int r = 4; r < 16; r += 4) { ma = max3f(ma, p0[r], p0[r + 1]); mb = max3f(mb, p0[r + 2], p0[r + 3]); ma = max3f(ma, p1[r], p1[r + 1]); mb = max3f(mb, p1[r + 2], p1[r + 3]); }
    const float mx = xhalf_max(fmaxf(ma, mb));
    if (first || __any(mx > 8.0f)) {
        const float dl = first ? mx : fmaxf(mx, 0.f);
        mref += dl;
#pragma unroll
        for (int r = 0; r < 16; ++r) { p0[r] -= dl; p1[r] -= dl; if (CINIT) negm[r] = -mref; }
        const float alpha = __builtin_amdgcn_exp2f(-dl);
        lrun *= alpha;
        if (!first) {
#pragma unroll
            for (int t = 0; t < NT; ++t)
#pragma unroll
                for (int r = 0; r < 16; ++r) o[t][r] *= alpha;
        }
    }
    float rs0 = 0.f, rs1 = 0.f;
#pragma unroll
    for (int r = 0; r < 16; ++r) { p0[r] = __builtin_amdgcn_exp2f(p0[r]); p1[r] = __builtin_amdgcn_exp2f(p1[r]); rs0 += p0[r]; rs1 += p1[r]; }
    lrun += rs0 + rs1;
    bf16x8 pb[4];
#pragma unroll
    for (int ks = 0; ks < 2; ++ks) {
        u32x4 w0, w1;
        w0.x = cvtpk(p0[8 * ks + 0], p0[8 * ks + 1]); w0.y = cvtpk(p0[8 * ks + 2], p0[8 * ks + 3]); w0.z = cvtpk(p0[8 * ks + 4], p0[8 * ks + 5]); w0.w = cvtpk(p0[8 * ks + 6], p0[8 * ks + 7]);
        w1.x = cvtpk(p1[8 * ks + 0], p1[8 * ks + 1]); w1.y = cvtpk(p1[8 * ks + 2], p1[8 * ks + 3]); w1.z = cvtpk(p1[8 * ks + 4], p1[8 * ks + 5]); w1.w = cvtpk(p1[8 * ks + 6], p1[8 * ks + 7]);
        pb[ks] = __builtin_bit_cast(bf16x8, w0); pb[2 + ks] = __builtin_bit_cast(bf16x8, w1);
        if (psave) { psave[(ks) * 64 + hi * 32 + r32] = w0; psave[(2 + ks) * 64 + hi * 32 + r32] = w1; }
    }
    mid();
    const LAS unsigned char* vb = Vs + r32 * vpitch + hi * 8;
#pragma unroll
    for (int t = 0; t < NT; ++t) {
        s16x4 lo[4], hh[4];
#pragma unroll
        for (int ks = 0; ks < 4; ++ks) { lo[ks] = *(const LAS s16x4*)(vb + t * 32 * vpitch + ks * 32); hh[ks] = *(const LAS s16x4*)(vb + t * 32 * vpitch + ks * 32 + 16); }
        __builtin_amdgcn_sched_barrier(0);
#pragma unroll
        for (int ks = 0; ks < 4; ++ks) { const bf16x8 a = (bf16x8){lo[ks][0], lo[ks][1], lo[ks][2], lo[ks][3], hh[ks][0], hh[ks][1], hh[ks][2], hh[ks][3]}; o[t] = MFMA32(a, pb[ks], o[t]); }
        __builtin_amdgcn_sched_barrier(0);
    }
}

constexpr int MLA_KP = 208, MLA_VP = 264;
constexpr int MLA_KT = 128 * MLA_KP, MLA_VTB = 64 * MLA_VP, MLA_BUF = MLA_KT + MLA_VTB;
__device__ __forceinline__ void mla_unit(LAS unsigned char* lds, int b, int h, int qb, const bf16_t* QM, const bf16_t* KN, const bf16_t* PROJ, const bf16_t* VT, bf16_t* MIX) {
    const int tid = opaque_tid(), lane = tid & 63, r32 = lane & 31, hi = lane >> 5, wid = __builtin_amdgcn_readfirstlane(tid >> 6);
    const size_t tb = (size_t)b * SEQ;
    const int rbk = wid < 4 ? wid : 11 - wid;
    const int q0 = qb * 256 + rbk * 32;
    bf16x8 qf[6];
    { const bf16_t* qr = QM + (tb + q0 + r32) * 768;
#pragma unroll
      for (int s = 0; s < 4; ++s) qf[s] = *(const bf16x8*)(qr + h * 64 + s * 16 + hi * 8);
#pragma unroll
      for (int s = 0; s < 2; ++s) qf[4 + s] = *(const bf16x8*)(qr + 512 + h * 32 + s * 16 + hi * 8); }
    f32x16 o[2], negm;
#pragma unroll
    for (int r = 0; r < 16; ++r) { o[0][r] = 0.f; o[1][r] = 0.f; negm[r] = 0.f; }
    float mref = 0.f, lrun = 0.f;
    const int NCH = 2 * qb + 2;
    const int kr = tid >> 3, kc = tid & 7;
    const int pr = tid >> 2, pc = tid & 3;
    const int vr = tid >> 4, vc = tid & 15;
    const unsigned koff = (unsigned)(((tb + kr) * 512 + h * 64 + kc * 8) * 2);
    const unsigned poff = (unsigned)(((tb + pr) * NPROJ + 2176 + pc * 8) * 2);
    const unsigned voff = (unsigned)(((size_t)(h * 64 + vr) * TP + tb + vc * 8) * 2);
    struct Stg { u32x4 k0, k1, pe, v0, v1; };
    Stg sa, sb;
    auto stage_load = [&](Stg& s, int ch) { const unsigned ko = (unsigned)ch * 128u;
        s.k0 = *(const u32x4*)((const char*)KN + (koff + ko * 1024u)); s.k1 = *(const u32x4*)((const char*)KN + (koff + (ko + 64u) * 1024u)); s.pe = *(const u32x4*)((const char*)PROJ + (poff + ko * (unsigned)(NPROJ * 2)));
        s.v0 = *(const u32x4*)((const char*)VT + (voff + ko * 2u)); s.v1 = *(const u32x4*)((const char*)VT + (voff + (unsigned)(32 * TP * 2) + ko * 2u)); };
    auto stage_write = [&](const Stg& s, int buf) {
        LAS unsigned char* kb = lds + buf * MLA_BUF; LAS unsigned char* vbp = kb + MLA_KT;
        *(LAS u32x4*)(kb + kr * MLA_KP + kc * 16) = s.k0; *(LAS u32x4*)(kb + (kr + 64) * MLA_KP + kc * 16) = s.k1;
        *(LAS u32x4*)(kb + pr * MLA_KP + 128 + pc * 16) = s.pe;
        { LAS unsigned char* d = vbp + vr * MLA_VP + vc * 16; *(LAS u32x2*)d = (u32x2){s.v0.x, s.v0.y}; *(LAS u32x2*)(d + 8) = (u32x2){s.v0.z, s.v0.w}; }
        { LAS unsigned char* d = vbp + (vr + 32) * MLA_VP + vc * 16; *(LAS u32x2*)d = (u32x2){s.v1.x, s.v1.y}; *(LAS u32x2*)(d + 8) = (u32x2){s.v1.z, s.v1.w}; }
    };
    const int qrel = rbk * 32 + r32;
    auto qk_plain = [&](const LAS unsigned char* Ks, f32x16& p0, f32x16& p1) {
        const LAS unsigned char* k0 = Ks + r32 * MLA_KP + hi * 16; const LAS unsigned char* k1 = k0 + 32 * MLA_KP;
        p0 = negm; p1 = negm;
#pragma unroll
        for (int g = 0; g < 2; ++g) {
            bf16x8 ka[3], kb2[3];
#pragma unroll
            for (int s = 0; s < 3; ++s) { ka[s] = *(const LAS bf16x8*)(k0 + (3 * g + s) * 32); kb2[s] = *(const LAS bf16x8*)(k1 + (3 * g + s) * 32); }
            __builtin_amdgcn_sched_barrier(0);
#pragma unroll
            for (int s = 0; s < 3; ++s) { p0 = MFMA32(ka[s], qf[3 * g + s], p0); p1 = MFMA32(kb2[s], qf[3 * g + s], p1); }
            __builtin_amdgcn_sched_barrier(0);
        }
    };
    auto sm1 = [&](f32x16& p0, f32x16& p1, bool first) {
        float ma = max3f(p0[0], p0[1], p1[0]), mb = max3f(p0[2], p0[3], p1[1]); ma = max3f(ma, p1[2], p1[3]);
#pragma unroll
        for (int r = 4; r < 16; r += 4) { ma = max3f(ma, p0[r], p0[r + 1]); mb = max3f(mb, p0[r + 2], p0[r + 3]); ma = max3f(ma, p1[r], p1[r + 1]); mb = max3f(mb, p1[r + 2], p1[r + 3]); }
        const float mx = xhalf_max(fmaxf(ma, mb));
        if (first || __any(mx > 8.0f)) {
            const float dl = first ? mx : fmaxf(mx, 0.f);
            mref += dl;
#pragma unroll
            for (int r = 0; r < 16; ++r) { p0[r] -= dl; p1[r] -= dl; negm[r] = -mref; }
            const float alpha = __builtin_amdgcn_exp2f(-dl);
            lrun *= alpha;
            if (!first) {
#pragma unroll
                for (int t = 0; t < 2; ++t)
#pragma unroll
                    for (int r = 0; r < 16; ++r) o[t][r] *= alpha;
            }
        }
    };
    auto pack = [&](const f32x16& p0, const f32x16& p1, bf16x8 (&pb)[4]) {
#pragma unroll
        for (int ks = 0; ks < 2; ++ks) {
            u32x4 w0, w1;
            w0.x = cvtpk(p0[8 * ks + 0], p0[8 * ks + 1]); w0.y = cvtpk(p0[8 * ks + 2], p0[8 * ks + 3]); w0.z = cvtpk(p0[8 * ks + 4], p0[8 * ks + 5]); w0.w = cvtpk(p0[8 * ks + 6], p0[8 * ks + 7]);
            w1.x = cvtpk(p1[8 * ks + 0], p1[8 * ks + 1]); w1.y = cvtpk(p1[8 * ks + 2], p1[8 * ks + 3]); w1.z = cvtpk(p1[8 * ks + 4], p1[8 * ks + 5]); w1.w = cvtpk(p1[8 * ks + 6], p1[8 * ks + 7]);
            pb[ks] = __builtin_bit_cast(bf16x8, w0); pb[2 + ks] = __builtin_bit_cast(bf16x8, w1);
        }
    };
    auto sm2 = [&](f32x16& p0, f32x16& p1, bf16x8 (&pb)[4]) {
        float rs0 = 0.f, rs1 = 0.f;
#pragma unroll
        for (int r = 0; r < 16; ++r) { p0[r] = __builtin_amdgcn_exp2f(p0[r]); p1[r] = __builtin_amdgcn_exp2f(p1[r]); rs0 += p0[r]; rs1 += p1[r]; }
        lrun += rs0 + rs1;
        pack(p0, p1, pb);
    };
    auto sm2_qk = [&](f32x16& a0, f32x16& a1, bf16x8 (&pb)[4], const LAS unsigned char* Kn, f32x16& b0, f32x16& b1) {
        const LAS unsigned char* k0 = Kn + r32 * MLA_KP + hi * 16; const LAS unsigned char* k1 = k0 + 32 * MLA_KP;
        b0 = negm; b1 = negm;
        float rs0 = 0.f, rs1 = 0.f;
        bf16x8 ka = *(const LAS bf16x8*)k0, kb2 = *(const LAS bf16x8*)k1;
#pragma unroll
        for (int s = 0; s < 6; ++s) {
            const bf16x8 ca = ka, cb = kb2;
            if (s + 1 < 6) { ka = *(const LAS bf16x8*)(k0 + (s + 1) * 32); kb2 = *(const LAS bf16x8*)(k1 + (s + 1) * 32); }
            b0 = MFMA32(ca, qf[s], b0); b1 = MFMA32(cb, qf[s], b1);
#pragma unroll
            for (int e = 0; e < 3; ++e) { const int r = 3 * s + e; if (r < 16) { a0[r] = __builtin_amdgcn_exp2f(a0[r]); a1[r] = __builtin_amdgcn_exp2f(a1[r]); rs0 += a0[r]; rs1 += a1[r]; } }
            __builtin_amdgcn_sched_barrier(0);
        }
        lrun += rs0 + rs1;
        pack(a0, a1, pb);
    };
    auto pv = [&](const LAS unsigned char* Vs, const bf16x8 (&pb)[4]) {
        const LAS unsigned char* vb = Vs + r32 * MLA_VP + hi * 8;
#pragma unroll
        for (int t = 0; t < 2; ++t) {
            s16x4 lo[4], hh[4];
#pragma unroll
            for (int ks = 0; ks < 4; ++ks) { lo[ks] = *(const LAS s16x4*)(vb + t * 32 * MLA_VP + ks * 32); hh[ks] = *(const LAS s16x4*)(vb + t * 32 * MLA_VP + ks * 32 + 16); }
            __builtin_amdgcn_sched_barrier(0);
#pragma unroll
            for (int ks = 0; ks < 4; ++ks) { const bf16x8 a = (bf16x8){lo[ks][0], lo[ks][1], lo[ks][2], lo[ks][3], hh[ks][0], hh[ks][1], hh[ks][2], hh[ks][3]}; o[t] = MFMA32(a, pb[ks], o[t]); }
            __builtin_amdgcn_sched_barrier(0);
        }
    };
    auto compute = [&](int buf, int ch) {
        const LAS unsigned char* kb = lds + buf * MLA_BUF;
        f32x16 a0, a1, b0, b1; bf16x8 pb[4];
        qk_plain(kb, a0, a1);
        sm1(a0, a1, ch == 0);
        sm2_qk(a0, a1, pb, kb + 64 * MLA_KP, b0, b1);
        pv(kb + MLA_KT, pb);
        sm1(b0, b1, false);
        sm2(b0, b1, pb);
        pv(kb + MLA_KT + 128, pb);
    };
    auto compute_band = [&](int buf, int ch) {
        const LAS unsigned char* kb = lds + buf * MLA_BUF;
#pragma unroll
        for (int j = 0; j < 2; ++j) {
            const int krel = ch * 128 + j * 64 - qb * 256;
            if (krel <= rbk * 32 + 31)
                flash_tile<6, 2, 6, true, true>(kb + j * 64 * MLA_KP, MLA_KP, kb + MLA_KT + j * 128, MLA_VP, qf, o, negm, mref, lrun, ch == 0 && j == 0, r32, hi, true, qrel, krel, NoMid());
        }
    };
    stage_load(sa, 0); stage_write(sa, 0);
    stage_load(sa, 1);
    __syncthreads();
    for (int ch = 0; ch < NCH - 2; ch += 2) {
        stage_load(sb, ch + 2);
        compute(0, ch);
        stage_write(sa, 1);
        __syncthreads();
        stage_load(sa, ch + 3);
        compute(1, ch + 1);
        stage_write(sb, 0);
        __syncthreads();
    }
    {
        compute_band(0, NCH - 2);
        stage_write(sa, 1);
        __syncthreads();
        compute_band(1, NCH - 1);
        __syncthreads();
    }
    const float inv = 1.f / xhalf_sum(lrun);
    LAS unsigned char* wl = lds + 2 * MLA_BUF + wid * ROWST_BYTES;
#pragma unroll
    for (int t = 0; t < 2; ++t)
#pragma unroll
        for (int g = 0; g < 4; ++g) { u32x2 w; w.x = cvtpk(o[t][4 * g] * inv, o[t][4 * g + 1] * inv); w.y = cvtpk(o[t][4 * g + 2] * inv, o[t][4 * g + 3] * inv); rowst_put(wl, r32, hi, t, g, w); }
    rowst_flush(wl, MIX + (tb + q0) * D + h * 64, D, lane);
}

constexpr int XA_KP = 528, XA_VP = 136;
constexpr int XA_KT = 64 * XA_KP, XA_VTB = 128 * XA_VP;
__device__ __forceinline__ void xattn_unit(LAS unsigned char* lds, int b, int h, int qb, const bf16_t* QX, const bf16_t* KX, const bf16_t* VXT, bf16_t* OX, u32x4* PS) {
    const int wid = __builtin_amdgcn_readfirstlane(opaque_tid() >> 6);
    const size_t tb = (size_t)b * SEQ;
    const int q0 = qb * 256 + wid * 32;
    const bf16_t* kbase = KX + (size_t)(b * 256) * D + h * 256;
    u32x4* ps = PS + (size_t)wid * (4 * 4 * 64);
    float mr[4], inv;
    {
        const int tid = opaque_tid(), lane = tid & 63, r32 = lane & 31, hi = lane >> 5;
        bf16x8 qf[16];
        { const bf16_t* qr = QX + (tb + q0 + r32) * D + h * 256 + hi * 8;
#pragma unroll
          for (int s = 0; s < 16; ++s) qf[s] = *(const bf16x8*)(qr + s * 16); }
        f32x16 o[4], negm;
#pragma unroll
        for (int t = 0; t < 4; ++t)
#pragma unroll
            for (int r = 0; r < 16; ++r) o[t][r] = 0.f;
#pragma unroll
        for (int r = 0; r < 16; ++r) negm[r] = 0.f;
        float mref = 0.f, lrun = 0.f;
        const bf16_t* vbase = VXT + (size_t)(h * 256) * D + b * 256;
        u32x4 kreg[4], vreg[2];
        auto stage_load = [&](int kt) {
#pragma unroll
            for (int i = 0; i < 4; ++i) { const int idx = tid + 512 * i, row = idx >> 5, c = idx & 31; kreg[i] = *(const u32x4*)(kbase + (size_t)(kt * 64 + row) * D + c * 8); }
#pragma unroll
            for (int i = 0; i < 2; ++i) { const int idx = tid + 512 * i, dv = idx >> 3, c = idx & 7; vreg[i] = *(const u32x4*)(vbase + (size_t)dv * D + kt * 64 + c * 8); }
        };
        auto stage_write = [&](int buf) {
            LAS unsigned char* kb = lds + buf * (XA_KT + XA_VTB); LAS unsigned char* vbp = kb + XA_KT;
#pragma unroll
            for (int i = 0; i < 4; ++i) { const int idx = tid + 512 * i, row = idx >> 5, c = idx & 31; *(LAS u32x4*)(kb + row * XA_KP + c * 16) = kreg[i]; }
#pragma unroll
            for (int i = 0; i < 2; ++i) { const int idx = tid + 512 * i, dv = idx >> 3, c = idx & 7;
                *(LAS u32x2*)(vbp + dv * XA_VP + c * 16) = (u32x2){vreg[i].x, vreg[i].y}; *(LAS u32x2*)(vbp + dv * XA_VP + c * 16 + 8) = (u32x2){vreg[i].z, vreg[i].w}; }
        };
        stage_load(0); stage_write(0);
        __syncthreads();
#pragma unroll
        for (int kt = 0; kt < 4; ++kt) {
            const int buf = kt & 1;
            const LAS unsigned char* kb = lds + buf * (XA_KT + XA_VTB);
            auto mid = [&]() { if (kt + 1 < 4) stage_load(kt + 1); };
            flash_tile<16, 4, 4, false, false>(kb, XA_KP, kb + XA_KT, XA_VP, qf, o, negm, mref, lrun, kt == 0, r32, hi, false, 0, 0, mid, ps + kt * 256);
            mr[kt] = mref;
            if (kt + 1 < 4) stage_write(buf ^ 1);
            __syncthreads();
        }
        inv = 1.f / xhalf_sum(lrun);
        LAS unsigned char* wl = lds + 2 * (XA_KT + XA_VTB) + wid * ROWST_BYTES;
#pragma unroll
        for (int th = 0; th < 2; ++th) {
#pragma unroll
            for (int t = 0; t < 2; ++t)
#pragma unroll
                for (int g = 0; g < 4; ++g) { const int tt = 2 * th + t; u32x2 w; w.x = cvtpk(o[tt][4 * g] * inv, o[tt][4 * g + 1] * inv); w.y = cvtpk(o[tt][4 * g + 2] * inv, o[tt][4 * g + 3] * inv); rowst_put(wl, r32, hi, t, g, w); }
            rowst_flush(wl, OX + (tb + q0) * D + h * 256 + th * 64, D, lane); }
    }
    {
        const int tid = opaque_tid(), lane = tid & 63, r32 = lane & 31, hi = lane >> 5;
        f32x16 o[4];
#pragma unroll
        for (int t = 0; t < 4; ++t)
#pragma unroll
            for (int r = 0; r < 16; ++r) o[t][r] = 0.f;
        const bf16_t* vbase = VXT + (size_t)(h * 256 + 128) * D + b * 256;
        u32x4 vreg[2], pn[4];
        auto stage_load = [&](int kt) {
#pragma unroll
            for (int i = 0; i < 2; ++i) { const int idx = tid + 512 * i, dv = idx >> 3, c = idx & 7; vreg[i] = *(const u32x4*)(vbase + (size_t)dv * D + kt * 64 + c * 8); }
        };
        auto stage_write = [&](int buf) {
            LAS unsigned char* vbp = lds + buf * (XA_KT + XA_VTB) + XA_KT;
#pragma unroll
            for (int i = 0; i < 2; ++i) { const int idx = tid + 512 * i, dv = idx >> 3, c = idx & 7;
                *(LAS u32x2*)(vbp + dv * XA_VP + c * 16) = (u32x2){vreg[i].x, vreg[i].y}; *(LAS u32x2*)(vbp + dv * XA_VP + c * 16 + 8) = (u32x2){vreg[i].z, vreg[i].w}; }
        };
        auto pload = [&](int kt) {
#pragma unroll
            for (int k = 0; k < 4; ++k) pn[k] = ps[kt * 256 + k * 64 + hi * 32 + r32]; };
        asm volatile("s_waitcnt vmcnt(0)" ::: "memory");
        stage_load(0); pload(0); stage_write(0);
        __syncthreads();
#pragma unroll
        for (int kt = 0; kt < 4; ++kt) {
            const int buf = kt & 1;
            bf16x8 pb[4];
#pragma unroll
            for (int k = 0; k < 4; ++k) pb[k] = __builtin_bit_cast(bf16x8, pn[k]);
            if (kt + 1 < 4) { stage_load(kt + 1); pload(kt + 1); }
            if (kt > 0) { const float gsc = __builtin_amdgcn_exp2f(mr[kt - 1] - mr[kt]);
                if (__any(gsc != 1.f)) {
#pragma unroll
                    for (int t = 0; t < 4; ++t)
#pragma unroll
                        for (int r = 0; r < 16; ++r) o[t][r] *= gsc; } }
            const LAS unsigned char* vb = lds + buf * (XA_KT + XA_VTB) + XA_KT + r32 * XA_VP + hi * 8;
#pragma unroll
            for (int t = 0; t < 4; ++t) {
                s16x4 lo[4], hh[4];
#pragma unroll
                for (int ks = 0; ks < 4; ++ks) { lo[ks] = *(const LAS s16x4*)(vb + t * 32 * XA_VP + ks * 32); hh[ks] = *(const LAS s16x4*)(vb + t * 32 * XA_VP + ks * 32 + 16); }
                __builtin_amdgcn_sched_barrier(0);
#pragma unroll
                for (int ks = 0; ks < 4; ++ks) { const bf16x8 a = (bf16x8){lo[ks][0], lo[ks][1], lo[ks][2], lo[ks][3], hh[ks][0], hh[ks][1], hh[ks][2], hh[ks][3]}; o[t] = MFMA32(a, pb[ks], o[t]); }
                __builtin_amdgcn_sched_barrier(0);
            }
            if (kt + 1 < 4) stage_write(buf ^ 1);
            __syncthreads();
        }
        LAS unsigned char* wl = lds + 2 * (XA_KT + XA_VTB) + wid * ROWST_BYTES;
#pragma unroll
        for (int th = 0; th < 2; ++th) {
#pragma unroll
            for (int t = 0; t < 2; ++t)
#pragma unroll
                for (int g = 0; g < 4; ++g) { const int tt = 2 * th + t; u32x2 w; w.x = cvtpk(o[tt][4 * g] * inv, o[tt][4 * g + 1] * inv); w.y = cvtpk(o[tt][4 * g + 2] * inv, o[tt][4 * g + 3] * inv); rowst_put(wl, r32, hi, t, g, w); }
            rowst_flush(wl, OX + (tb + q0) * D + h * 256 + 128 + th * 64, D, lane); }
    }
}

constexpr int RT_P = 272;
constexpr int RT_PV = 264;
__device__ __forceinline__ float ret_log2g(int h) { return log2f(1.0f - exp2f(-5.0f - (float)h)); }
__device__ __forceinline__ void ret_state_unit(LAS unsigned char* lds, int unit, const bf16_t* PROJ, const bf16_t* RVT, bf16_t* RKVT) {
    const int tid = opaque_tid(), lane = tid & 63, r32 = lane & 31, hi = lane >> 5, wid = __builtin_amdgcn_readfirstlane(tid >> 6);
    const int n = unit & 31, h = (unit >> 5) & 3, b = unit >> 7;
    const size_t t0 = (size_t)b * SEQ + n * 128;
    const float l2g = ret_log2g(h);
    LAS unsigned char* Vs = lds;
    LAS unsigned char* Ks = lds + 128 * RT_P;
#pragma unroll
    for (int i = 0; i < 4; ++i) { const int idx = tid + 512 * i, e = idx >> 4, c = idx & 15;
        *(LAS u32x4*)(Vs + e * RT_P + c * 16) = *(const u32x4*)(RVT + (size_t)(h * 128 + e) * TP + t0 + c * 8); }
#pragma unroll
    for (int i = 0; i < 4; ++i) { const int idx = tid + 512 * i, j = idx >> 4, c = idx & 15;
        const u32x4 v = *(const u32x4*)(PROJ + (t0 + j) * NPROJ + 1152 + h * 128 + c * 8);
        const float z = exp2f((float)(127 - j) * l2g);
        const unsigned w[4] = {v.x, v.y, v.z, v.w}; unsigned pk[4];
#pragma unroll
        for (int q = 0; q < 4; ++q) pk[q] = cvtpk(bf2f((unsigned short)(w[q] & 0xffffu)) * z, bf2f((unsigned short)(w[q] >> 16)) * z);
        *(LAS u32x4*)(Ks + j * RT_P + c * 16) = (u32x4){pk[0], pk[1], pk[2], pk[3]}; }
    __syncthreads();
    const int eb = (wid & 3) * 32, db = (wid >> 2) * 64;
    f32x16 acc[2];
#pragma unroll
    for (int t = 0; t < 2; ++t)
#pragma unroll
        for (int r = 0; r < 16; ++r) acc[t][r] = 0.f;
#pragma unroll
    for (int ks = 0; ks < 8; ++ks) {
        const bf16x8 a = *(const LAS bf16x8*)(Vs + (eb + r32) * RT_P + ks * 32 + hi * 16);
#pragma unroll
        for (int t = 0; t < 2; ++t) {
            const int i16 = r32 & 15, qq = i16 >> 2, pp = i16 & 3;
            const LAS unsigned char* tp = Ks + (16 * ks + 8 * hi + qq) * RT_P + (db + 32 * t + 16 * (r32 >> 4) + 4 * pp) * 2;
            typedef short v4i16_t __attribute__((ext_vector_type(4)));
            const s16x4 lo = __builtin_bit_cast(s16x4, __builtin_amdgcn_ds_read_tr16_b64_v4i16((__attribute__((address_space(3))) v4i16_t*)tp));
            const s16x4 hh = __builtin_bit_cast(s16x4, __builtin_amdgcn_ds_read_tr16_b64_v4i16((__attribute__((address_space(3))) v4i16_t*)(tp + 4 * RT_P)));
            const bf16x8 bb = (bf16x8){lo[0], lo[1], lo[2], lo[3], hh[0], hh[1], hh[2], hh[3]};
            acc[t] = MFMA32(bb, a, acc[t]); }
    }
    LAS unsigned char* wl = Ks + 128 * RT_P + wid * ROWST_BYTES;
#pragma unroll
    for (int t = 0; t < 2; ++t)
#pragma unroll
        for (int g = 0; g < 4; ++g) { u32x2 w; w.x = cvtpk(acc[t][4 * g], acc[t][4 * g + 1]); w.y = cvtpk(acc[t][4 * g + 2], acc[t][4 * g + 3]); rowst_put(wl, r32, hi, t, g, w); }
    rowst_flush(wl, RKVT + (size_t)unit * 16384 + (size_t)eb * 128 + db, 128, lane);
    __syncthreads();
}
__device__ __forceinline__ void ret_out_unit(LAS unsigned char* lds, int unit, const bf16_t* PROJ, const bf16_t* RVT, const bf16_t* RKVT, const float* g_gn, bf16_t* MIX) {
    const int tid = opaque_tid(), lane = tid & 63, r32 = lane & 31, hi = lane >> 5, wid = __builtin_amdgcn_readfirstlane(tid >> 6);
    const int n = unit & 31, h = (unit >> 5) & 3, b = unit >> 7;
    const size_t t0 = (size_t)b * SEQ + n * 128;
    const float l2g = ret_log2g(h);
    LAS unsigned char* Ks = lds;
    LAS unsigned char* Vs = lds + 128 * RT_P;
    LAS unsigned char* Rs = Vs + 128 * RT_PV;
    LAS float* Xs = (LAS float*)(Rs + 128 * RT_P);
#pragma unroll
    for (int i = 0; i < 4; ++i) { const int idx = tid + 512 * i, j = idx >> 4, c = idx & 15;
        *(LAS u32x4*)(Ks + j * RT_P + c * 16) = *(const u32x4*)(PROJ + (t0 + j) * NPROJ + 1152 + h * 128 + c * 8); }
#pragma unroll
    for (int i = 0; i < 4; ++i) { const int idx = tid + 512 * i, e = idx >> 4, c = idx & 15;
        const u32x4 v = *(const u32x4*)(RVT + (size_t)(h * 128 + e) * TP + t0 + c * 8);
        *(LAS u32x2*)(Vs + e * RT_PV + c * 16) = (u32x2){v.x, v.y}; *(LAS u32x2*)(Vs + e * RT_PV + c * 16 + 8) = (u32x2){v.z, v.w}; }
    {
        const bf16_t* src = RKVT + (size_t)unit * 16384;
#pragma unroll
        for (int i = 0; i < 4; ++i) { const int idx = tid + 512 * i, e = idx >> 4, c = idx & 15; *(LAS u32x4*)(Rs + e * RT_P + c * 16) = *(const u32x4*)(src + idx * 8); }
    }
    const int ib = wid & 3, eh = wid >> 2;
    LAS unsigned char* wl = (LAS unsigned char*)(Xs + 8 * 32 * 2) + wid * ROWST_BYTES;
    {   const bf16_t* gsrc = PROJ + (t0 + ib * 32) * NPROJ + 1664 + h * 128 + eh * 64;
#pragma unroll
        for (int k = 0; k < 4; ++k) { const int row = 8 * k + (lane >> 3), c16 = lane & 7; *(LAS u32x4*)(wl + row * ROWST_P + c16 * 16) = *(const u32x4*)(gsrc + (size_t)row * NPROJ + c16 * 8); } }
    bf16x8 qf[8];
    { const bf16_t* qr = PROJ + (t0 + ib * 32 + r32) * NPROJ + 640 + h * 128 + hi * 8;
#pragma unroll
      for (int s = 0; s < 8; ++s) qf[s] = *(const bf16x8*)(qr + s * 16); }
    __syncthreads();
    f32x16 oi[2], oc[2];
#pragma unroll
    for (int t = 0; t < 2; ++t)
#pragma unroll
        for (int r = 0; r < 16; ++r) { oi[t][r] = 0.f; oc[t][r] = 0.f; }
#pragma unroll
    for (int s = 0; s < 8; ++s)
#pragma unroll
        for (int t = 0; t < 2; ++t) { const bf16x8 a = *(const LAS bf16x8*)(Rs + (eh * 64 + t * 32 + r32) * RT_P + s * 32 + hi * 16); oc[t] = MFMA32(a, qf[s], oc[t]); }
    for (int jt = 0; jt <= ib; ++jt) {
        f32x16 p;
#pragma unroll
        for (int r = 0; r < 16; ++r) p[r] = 0.f;
#pragma unroll
        for (int s = 0; s < 8; ++s) { const bf16x8 a = *(const LAS bf16x8*)(Ks + (jt * 32 + r32) * RT_P + s * 32 + hi * 16); p = MFMA32(a, qf[s], p); }
        const int dbase = (ib - jt) * 32 + r32;
#pragma unroll
        for (int r = 0; r < 16; ++r) { const int dd = dbase - crow(r, hi); p[r] = dd >= 0 ? p[r] * exp2f((float)dd * l2g) : 0.f; }
        bf16x8 pb[2];
#pragma unroll
        for (int ks = 0; ks < 2; ++ks) { u32x4 w; w.x = cvtpk(p[8 * ks + 0], p[8 * ks + 1]); w.y = cvtpk(p[8 * ks + 2], p[8 * ks + 3]); w.z = cvtpk(p[8 * ks + 4], p[8 * ks + 5]); w.w = cvtpk(p[8 * ks + 6], p[8 * ks + 7]); pb[ks] = __builtin_bit_cast(bf16x8, w); }
#pragma unroll
        for (int t = 0; t < 2; ++t)
#pragma unroll
            for (int ks = 0; ks < 2; ++ks) { const LAS unsigned char* vp = Vs + (eh * 64 + t * 32 + r32) * RT_PV + (jt * 32 + ks * 16) * 2 + hi * 8;
                const s16x4 lo = *(const LAS s16x4*)vp, hh = *(const LAS s16x4*)(vp + 16);
                const bf16x8 a = (bf16x8){lo[0], lo[1], lo[2], lo[3], hh[0], hh[1], hh[2], hh[3]}; oi[t] = MFMA32(a, pb[ks], oi[t]); }
    }
    const float xi = exp2f((float)(ib * 32 + r32 + 1) * l2g);
    float s1 = 0.f, s2 = 0.f;
#pragma unroll
    for (int t = 0; t < 2; ++t)
#pragma unroll
        for (int r = 0; r < 16; ++r) { const float v = oi[t][r] + oc[t][r] * xi; oi[t][r] = v; s1 += v; s2 += v * v; }
    s1 = xhalf_sum(s1); s2 = xhalf_sum(s2);
    if (hi == 0) { Xs[(wid * 32 + r32) * 2] = s1; Xs[(wid * 32 + r32) * 2 + 1] = s2; }
    __syncthreads();
    { const int ow = wid ^ 4; s1 += Xs[(ow * 32 + r32) * 2]; s2 += Xs[(ow * 32 + r32) * 2 + 1]; }
    const float mean = s1 * (1.f / 128.f), var = fmaxf(s2 * (1.f / 128.f) - mean * mean, 0.f), rstd = rsqrtf(var + EPS);
    u32x2 ggv[2][4];
#pragma unroll
    for (int t = 0; t < 2; ++t)
#pragma unroll
        for (int g = 0; g < 4; ++g) ggv[t][g] = *(const LAS u32x2*)(wl + r32 * ROWST_P + (32 * t + 8 * g + 4 * hi) * 2);
    LDS_WAIT();
#pragma unroll
    for (int t = 0; t < 2; ++t)
#pragma unroll
        for (int g = 0; g < 4; ++g) { const int e = eh * 64 + t * 32 + 8 * g + 4 * hi;
            const u32x2 gg = ggv[t][g]; const f32x4 gn = *(const f32x4*)(g_gn + h * 128 + e);
            const float rg[4] = {bf2f((unsigned short)(gg.x & 0xffffu)), bf2f((unsigned short)(gg.x >> 16)), bf2f((unsigned short)(gg.y & 0xffffu)), bf2f((unsigned short)(gg.y >> 16))};
            float y[4];
#pragma unroll
            for (int q = 0; q < 4; ++q) { const float sil = rg[q] / (1.f + __expf(-rg[q])); y[q] = (oi[t][4 * g + q] - mean) * rstd * gn[q] * sil; }
            u32x2 w; w.x = cvtpk(y[0], y[1]); w.y = cvtpk(y[2], y[3]); rowst_put(wl, r32, hi, t, g, w); }
    rowst_flush(wl, MIX + (t0 + ib * 32) * D + 512 + h * 128 + eh * 64, D, lane);
    __syncthreads();
}

constexpr int PK_P = 272;
constexpr int PEER_SK = 0, PEER_LST = 2 * 128 * PK_P;
constexpr int PEER_ENT = PEER_LST + NWAVES * 4096;
__device__ __forceinline__ unsigned f_ord(float f) { const unsigned u = __float_as_uint(f); return u ^ ((unsigned)((int)u >> 31) | 0x80000000u); }
__device__ __forceinline__ float f_unord(unsigned k) { return __uint_as_float((k & 0x80000000u) ? (k ^ 0x80000000u) : ~k); }
#define TK_INS(L, x) do { unsigned _x = (x); _Pragma("unroll") for (int _j = 0; _j < 16; ++_j) { const unsigned _h = max(_x, L[_j]); _x = min(_x, L[_j]); L[_j] = _h; } } while (0)
__device__ __forceinline__ unsigned umed3(unsigned a, unsigned b, unsigned c) { return max(min(a, b), min(max(a, b), c)); }
#define TK_CE(a, b) do { const unsigned _hi = max((a), (b)), _lo = min((a), (b)); (a) = _hi; (b) = _lo; } while (0)
__device__ __forceinline__ void tk_sort16(unsigned (&v)[16]) {
#define TK_L(a, b) TK_CE(v[a], v[b])
    TK_L(0,13); TK_L(1,12); TK_L(2,15); TK_L(3,14); TK_L(4,8); TK_L(5,6); TK_L(7,11); TK_L(9,10);
    TK_L(0,5); TK_L(1,7); TK_L(2,9); TK_L(3,4); TK_L(6,13); TK_L(8,14); TK_L(10,15); TK_L(11,12);
    TK_L(0,1); TK_L(2,3); TK_L(4,5); TK_L(6,8); TK_L(7,9); TK_L(10,11); TK_L(12,13); TK_L(14,15);
    TK_L(0,2); TK_L(1,3); TK_L(4,10); TK_L(5,11); TK_L(6,7); TK_L(8,9); TK_L(12,14); TK_L(13,15);
    TK_L(1,2); TK_L(3,12); TK_L(4,6); TK_L(5,7); TK_L(8,10); TK_L(9,11); TK_L(13,14);
    TK_L(1,4); TK_L(2,6); TK_L(5,8); TK_L(7,10); TK_L(9,13); TK_L(11,14);
    TK_L(2,4); TK_L(3,6); TK_L(9,12); TK_L(11,13);
    TK_L(3,5); TK_L(6,8); TK_L(7,9); TK_L(10,12);
    TK_L(3,4); TK_L(5,6); TK_L(7,8); TK_L(9,10); TK_L(11,12);
    TK_L(6,7); TK_L(8,9);
#undef TK_L
}
__device__ __forceinline__ void tk_merge16(unsigned (&a)[16], const unsigned (&b)[16]) {
#pragma unroll
    for (int i = 0; i < 16; ++i) a[i] = max(a[i], b[15 - i]);
#pragma unroll
    for (int st = 8; st >= 1; st >>= 1)
#pragma unroll
        for (int i = 0; i < 16; ++i) if ((i & st) == 0) TK_CE(a[i], a[i + st]);
}
__device__ __forceinline__ void tk_merge_partner(unsigned (&L)[16], int hi) {
    unsigned M[16];
#pragma unroll
    for (int i = 0; i < 16; ++i) { const unsigned o = xhalf_other(L[15 - i], hi); M[i] = max(L[i], o); }
#pragma unroll
    for (int st = 8; st >= 1; st >>= 1)
#pragma unroll
        for (int i = 0; i < 16; ++i) if ((i & st) == 0) { const unsigned a = max(M[i], M[i + st]), bq = min(M[i], M[i + st]); M[i] = a; M[i + st] = bq; }
#pragma unroll
    for (int i = 0; i < 16; ++i) L[i] = M[i];
}

template <bool RETR_ONLY>
__device__ __forceinline__ void peer_phase(LAS unsigned char* lds, const Params& p, int vcu, int G) {
    const int tid = opaque_tid(), lane = tid & 63, r32 = lane & 31, hi = lane >> 5, wid = __builtin_amdgcn_readfirstlane(tid >> 6);
    const bf16_t* SK = (const bf16_t*)(p.ws + WS_SK); const bf16_t* QP = (const bf16_t*)(p.ws + WS_QP);
    const unsigned char* U8 = p.ws + WS_U8; const float* ssq2 = (const float*)(p.ws + WS_SSQ2); unsigned* EG = (unsigned*)(p.ws + WS_EG); float* WG = (float*)(p.ws + WS_WG);
    for (int idx = tid; idx < 2 * 128 * 16; idx += 512) { const int row = idx >> 4, c = idx & 15; *(LAS u32x4*)(lds + PEER_SK + row * PK_P + c * 16) = *(const u32x4*)(SK + row * 128 + c * 8); }
    __syncthreads();
    if (RETR_ONLY) {
        const int gwv = vcu * NWAVES + wid, ngw = G * NWAVES;
        for (int t0 = gwv; t0 < T; t0 += 4 * ngw) {
            u32x4 hv[4][2]; float inv[4];
#pragma unroll
            for (int j = 0; j < 4; ++j) { const int t = t0 + j * ngw; if (t < T) { const bf16_t* hrow = (const bf16_t*)(p.ws + WS_H2B) + (size_t)t * D + lane * 16;
                hv[j][0] = *(const u32x4*)hrow; hv[j][1] = *(const u32x4*)(hrow + 8); inv[j] = rsqrtf(ssq_sum<16>(ssq2 + (size_t)t * 16) * (1.f / D) + EPS) * (119.f / X8_CLIP); } }
#pragma unroll
            for (int j = 0; j < 4; ++j) { const int t = t0 + j * ngw; if (t < T) {
                unsigned xh[2] = {0u, 0u}, xl[2] = {0u, 0u};
#pragma unroll
                for (int i = 0; i < 2; ++i) { const unsigned w[4] = {hv[j][i].x, hv[j][i].y, hv[j][i].z, hv[j][i].w};
#pragma unroll
                    for (int q = 0; q < 4; ++q)
#pragma unroll
                        for (int hh = 0; hh < 2; ++hh) { const float f = __uint_as_float(hh ? (w[q] & 0xffff0000u) : (w[q] << 16)) * inv[j];
                            const unsigned bits = __float_as_uint(__builtin_amdgcn_fmed3f(f, -120.f, 119.f) + 12582912.f);
                            xl[i] |= (bits & 15u) << (4 * (2 * q + hh)); xh[i] |= (((bits + 8u) >> 4) & 15u) << (4 * (2 * q + hh)); } }
                int xs = 0;
#pragma unroll
                for (int i = 0; i < 2; ++i) { xs += 16 * __builtin_amdgcn_sdot8((int)xh[i], 0x11111111, 0, false) + __builtin_amdgcn_sdot8((int)xl[i], 0x11111111, 0, false); }
                *(u32x2*)(p.ws + WS_XH + (size_t)t * 512 + lane * 8) = (u32x2){xh[0], xh[1]}; *(u32x2*)(p.ws + WS_XL + (size_t)t * 512 + lane * 8) = (u32x2){xl[0], xl[1]};
                const float xsf = wave_sum_fast((float)xs, lane);
                if (lane == 0) ((float*)(p.ws + WS_XS8))[t] = xsf; } }
        }
    }
    LAS unsigned* LST = (LAS unsigned*)(lds + PEER_LST + wid * 4096);
    LAS u32x2* ENT = (LAS u32x2*)(lds + PEER_ENT + wid * 4096);
    for (int grp = vcu * NWAVES + wid; grp < T / 4; grp += G * NWAVES) {
        const int tok0 = grp * 4;
        int lg = lane; asm volatile("" : "+v"(lg));
        const int r32 = lg & 31, hi = lg >> 5;
        const unsigned hi4 = (unsigned)hi << 2;
        {
            const bf16_t* qrow = QP + (size_t)(tok0 + (r32 >> 3)) * 2048 + (r32 & 7) * 256 + hi * 8;
            unsigned LA[16], LB[16];
#pragma unroll
            for (int pp = 0; pp < 2; ++pp) {
                bf16x8 qf[8];
#pragma unroll
                for (int s = 0; s < 8; ++s) qf[s] = *(const bf16x8*)(qrow + pp * 128 + s * 16);
                unsigned L[16];
#pragma unroll
                for (int i = 0; i < 16; ++i) L[i] = 0u;
#pragma unroll
                for (int kt = 0; kt < 4; ++kt) {
                    f32x16 sc;
#pragma unroll
                    for (int r = 0; r < 16; ++r) sc[r] = 0.f;
#pragma unroll
                    for (int s = 0; s < 8; ++s) { const bf16x8 a = *(const LAS bf16x8*)(lds + PEER_SK + (pp * 128 + kt * 32 + r32) * PK_P + s * 32 + hi * 16); sc = MFMA32(a, qf[s], sc); }
                    { unsigned kv[16];
#pragma unroll
                      for (int r = 0; r < 16; ++r) { const unsigned code = 127u - (unsigned)(32 * kt + (r & 3) + 8 * (r >> 2)); kv[r] = ((f_ord(sc[r]) & ~0x7Fu) | code) ^ hi4; }
                      tk_sort16(kv);
                      if (kt == 0) {
#pragma unroll
                          for (int r = 0; r < 16; ++r) L[r] = kv[r];
                      } else tk_merge16(L, kv); }
                }
                tk_merge_partner(L, hi);
#pragma unroll
                for (int i = 0; i < 16; ++i) { if (pp == 0) LA[i] = L[i]; else LB[i] = L[i]; }
            }
#pragma unroll
            for (int i = 0; i < 16; ++i) { LST[i * 32 + r32] = LA[i]; LST[(16 + i) * 32 + r32] = LB[i]; }
            float va[16], vb[16];
#pragma unroll
            for (int i = 0; i < 16; ++i) { va[i] = f_unord(LA[i] & ~0x7Fu); vb[i] = f_unord(LB[i] & ~0x7Fu); }
            unsigned C[16];
#pragma unroll
            for (int j = 0; j < 16; ++j) C[j] = (f_ord(va[0] + vb[j]) & ~0xFFu) | (255u - (unsigned)j);
#pragma unroll
            for (int i = 1; i < 16; ++i)
#pragma unroll
                for (int j = 0; j < 16; ++j) if ((i + 1) * (j + 1) <= 16) { const unsigned code = 255u - (unsigned)(16 * i + j); const unsigned x = (f_ord(va[i] + vb[j]) & ~0xFFu) | code;
                    constexpr int dummy_ = 0; (void)dummy_; const int r0 = (i + 1) * (j + 1) - 1;
#pragma unroll
                    for (int r = 15; r > r0; --r) C[r] = umed3(C[r - 1], C[r], x);
                    C[r0] = max(C[r0], x); }
            LDS_WAIT();
            float bs[16]; unsigned ex[16]; float mx = -1e30f;
#pragma unroll
            for (int k = 0; k < 16; ++k) { const unsigned code = 255u - (C[k] & 0xFFu); const unsigned i = code >> 4, j = code & 15u;
                const unsigned ka = LST[i * 32 + r32], kbq = LST[(16 + j) * 32 + r32];
                bs[k] = f_unord(ka & ~0x7Fu) + f_unord(kbq & ~0x7Fu); ex[k] = (127u - (ka & 0x7Fu)) * 128u + (127u - (kbq & 0x7Fu)); mx = fmaxf(mx, bs[k]); }
            float sum = 0.f;
#pragma unroll
            for (int k = 0; k < 16; ++k) { bs[k] = __expf(bs[k] - mx); sum += bs[k]; }
            const float rinv = 1.f / sum;
            if (hi == 0) {
#pragma unroll
                for (int k = 0; k < 16; ++k) ENT[(r32 >> 3) * 128 + (r32 & 7) * 16 + k] = (u32x2){ex[k], __float_as_uint(bs[k] * rinv)};
            }
            LDS_WAIT();
        }
        if (RETR_ONLY) {
            for (int tk = 0; tk < 4; ++tk) { const int t = tok0 + tk;
                int ln = lane; asm volatile("" : "+v"(ln));
                const int e0 = 16 * (ln & 7) + (ln >> 3);
                const u32x2 a0 = ENT[tk * 128 + e0], a1 = ENT[tk * 128 + e0 + 8];
                *(u32x2*)(EG + (size_t)t * 128 + 2 * ln) = (u32x2){a0.x, a1.x}; *(f32x2*)(WG + (size_t)t * 128 + 2 * ln) = (f32x2){__uint_as_float(a0.y), __uint_as_float(a1.y)}; }
            continue;
        }
        for (int tk = 0; tk < 4; ++tk) {
            const int t = tok0 + tk;
            int ln = lane; asm volatile("" : "+v"(ln));
            const bf16_t* hrow = (const bf16_t*)(p.ws + WS_H2B) + (size_t)t * D + ln * 16;
            f32x2 hv[8];
#pragma unroll
            for (int i = 0; i < 2; ++i) { const u32x4 v = *(const u32x4*)(hrow + 8 * i); const unsigned w[4] = {v.x, v.y, v.z, v.w};
#pragma unroll
                for (int q = 0; q < 4; ++q) hv[4 * i + q] = (f32x2){bf2f((unsigned short)(w[q] & 0xffffu)), bf2f((unsigned short)(w[q] >> 16))}; }
            const float rstd2 = rsqrtf(ssq_sum<16>(ssq2 + (size_t)t * 16) * (1.f / D) + EPS);
            EG[(size_t)t * 128 + ln] = ENT[tk * 128 + ln].x; EG[(size_t)t * 128 + 64 + ln] = ENT[tk * 128 + 64 + ln].x;
            u32x4 ua[16], ub[16];
            { const unsigned ex = ENT[tk * 128 + (ln & 15)].x;
#pragma unroll
              for (int k = 0; k < 16; ++k) { const unsigned e = (unsigned)__builtin_amdgcn_readlane((int)ex, k); ua[k] = *(const u32x4*)(U8 + (size_t)e * D + ln * 16); } }
            auto head = [&](u32x4 (&cur)[16], u32x4 (&nxt)[16], int hd) {
                if (hd < 7) { const unsigned ex = ENT[tk * 128 + (hd + 1) * 16 + (ln & 15)].x;
#pragma unroll
                    for (int k = 0; k < 16; ++k) { const unsigned e = (unsigned)__builtin_amdgcn_readlane((int)ex, k); nxt[k] = *(const u32x4*)(U8 + (size_t)e * D + ln * 16); } }
                const float gate = __uint_as_float(ENT[tk * 128 + hd * 16 + ((ln >> 2) & 15)].y);
                float dt[16];
#pragma unroll
                for (int k = 0; k < 16; ++k) { f32x2 a0 = (f32x2){0.f, 0.f}, a1 = (f32x2){0.f, 0.f}; const unsigned w[4] = {cur[k].x, cur[k].y, cur[k].z, cur[k].w};
#pragma unroll
                    for (int q = 0; q < 4; ++q) { const f32x2 lo = __builtin_amdgcn_cvt_pk_f32_fp8((int)w[q], false), h2 = __builtin_amdgcn_cvt_pk_f32_fp8((int)w[q], true);
                        a0 += lo * hv[2 * q]; a1 += h2 * hv[2 * q + 1]; }
                    const f32x2 a = a0 + a1; dt[k] = a[0] + a[1]; if (k & 1) __builtin_amdgcn_sched_barrier(0); }
                float y8[8], y4[4], y2[2], y1;
                { const bool bsel = (ln & 32) != 0;
#pragma unroll
                  for (int k = 0; k < 8; ++k) { const float snd = bsel ? dt[k] : dt[k + 8], kp = bsel ? dt[k + 8] : dt[k]; y8[k] = kp + __shfl_xor(snd, 32); } }
                { const bool bsel = (ln & 16) != 0;
#pragma unroll
                  for (int k = 0; k < 4; ++k) { const float snd = bsel ? y8[k] : y8[k + 4], kp = bsel ? y8[k + 4] : y8[k]; y4[k] = kp + __shfl_xor(snd, 16); } }
                { const bool bsel = (ln & 8) != 0;
#pragma unroll
                  for (int k = 0; k < 2; ++k) { const float snd = bsel ? y4[k] : y4[k + 2], kp = bsel ? y4[k + 2] : y4[k]; y2[k] = kp + __shfl_xor(snd, 8); } }
                { const bool bsel = (ln & 4) != 0; const float snd = bsel ? y2[0] : y2[1], kp = bsel ? y2[1] : y2[0]; y1 = kp + __shfl_xor(snd, 4); }
                y1 += __shfl_xor(y1, 2); y1 += __shfl_xor(y1, 1);
                const float act = y1 * rstd2 * (1.f / U_SCALE);
                const float wgt = gate * gelu_f(act) * (1.f / V_SCALE);
                if ((ln & 3) == 0) WG[(size_t)t * 128 + hd * 16 + ((ln >> 2) & 15)] = wgt;
            };
            for (int hd = 0; hd < 8; hd += 2) { head(ua, ub, hd); head(ub, ua, hd + 1); }
        }
    }
}

__device__ __forceinline__ void peer_v_phase(const Params& p, int vcu, int G) {
    const int tid = opaque_tid(), lane = tid & 63, wid = __builtin_amdgcn_readfirstlane(tid >> 6);
    const unsigned char* V8 = p.ws + WS_V8; const unsigned* EG = (const unsigned*)(p.ws + WS_EG); const float* WG = (const float*)(p.ws + WS_WG);
    for (int grp = vcu * NWAVES + wid; grp < T / 4; grp += G * NWAVES) {
        for (int tk = 0; tk < 4; ++tk) {
            const int t = grp * 4 + tk;
            int ln = lane; asm volatile("" : "+v"(ln));
            const unsigned e0 = EG[(size_t)t * 128 + ln], e1 = EG[(size_t)t * 128 + 64 + ln];
            const float w0 = WG[(size_t)t * 128 + ln], w1 = WG[(size_t)t * 128 + 64 + ln];
            f32x2 ov[8];
#pragma unroll
            for (int i = 0; i < 8; ++i) ov[i] = (f32x2){0.f, 0.f};
            u32x4 va[16], vb[16];
#pragma unroll
            for (int k = 0; k < 16; ++k) { const unsigned e = (unsigned)__builtin_amdgcn_readlane((int)e0, k); va[k] = *(const u32x4*)(V8 + (size_t)e * D + ln * 16); }
            auto head = [&](u32x4 (&cur)[16], u32x4 (&nxt)[16], int hd) {
                if (hd < 7) { const int h1 = hd + 1; const unsigned er = (h1 & 4) ? e1 : e0; const int lb = (h1 & 3) * 16;
#pragma unroll
                    for (int k = 0; k < 16; ++k) { const unsigned e = (unsigned)__builtin_amdgcn_readlane((int)er, lb + k); nxt[k] = *(const u32x4*)(V8 + (size_t)e * D + ln * 16); } }
                const float wr = (hd & 4) ? w1 : w0; const int lb0 = (hd & 3) * 16;
#pragma unroll
                for (int k = 0; k < 16; ++k) { const float wk = __uint_as_float((unsigned)__builtin_amdgcn_readlane((int)__float_as_uint(wr), lb0 + k)); const f32x2 wk2 = (f32x2){wk, wk};
                    const unsigned w[4] = {cur[k].x, cur[k].y, cur[k].z, cur[k].w};
#pragma unroll
                    for (int q = 0; q < 4; ++q) { const f32x2 lo = __builtin_amdgcn_cvt_pk_f32_fp8((int)w[q], false), h2 = __builtin_amdgcn_cvt_pk_f32_fp8((int)w[q], true);
                        ov[2 * q] += wk2 * lo; ov[2 * q + 1] += wk2 * h2; }
                    if (k & 1) __builtin_amdgcn_sched_barrier(0); }
            };
            for (int hd = 0; hd < 8; hd += 2) { head(va, vb, hd); head(vb, va, hd + 1); }
            float* hrow = p.out + (size_t)t * D + ln * 16;
            const bf16_t* hb = (const bf16_t*)(p.ws + WS_H2B) + (size_t)t * D + ln * 16;
            float ss = 0.f; f32x4 h3[4];
#pragma unroll
            for (int q2 = 0; q2 < 2; ++q2) { const u32x4 v = *(const u32x4*)(hb + 8 * q2);
                h3[2 * q2] = (f32x4){bf2f((unsigned short)(v.x & 0xffffu)), bf2f((unsigned short)(v.x >> 16)), bf2f((unsigned short)(v.y & 0xffffu)), bf2f((unsigned short)(v.y >> 16))};
                h3[2 * q2 + 1] = (f32x4){bf2f((unsigned short)(v.z & 0xffffu)), bf2f((unsigned short)(v.z >> 16)), bf2f((unsigned short)(v.w & 0xffffu)), bf2f((unsigned short)(v.w >> 16))}; }
#pragma unroll
            for (int q = 0; q < 4; ++q) { h3[q] = h3[q] + (f32x4){ov[2 * q][0], ov[2 * q][1], ov[2 * q + 1][0], ov[2 * q + 1][1]};
                ss += (h3[q][0] * h3[q][0] + h3[q][1] * h3[q][1]) + (h3[q][2] * h3[q][2] + h3[q][3] * h3[q][3]); }
            const float rstd3 = rsqrtf(wave_sum(ss) * (1.f / D) + EPS);
#pragma unroll
            for (int q = 0; q < 4; ++q) { const f32x4 gf = *(const f32x4*)(p.g_final + ln * 16 + 4 * q); *(f32x4*)(hrow + 4 * q) = h3[q] * rstd3 * gf; }
        }
    }
}

template <bool VSIDE>
__device__ __forceinline__ void peer_slice_tokens(const Params& p, int x, int w0, int nwv, int lane) {
    const int s = x >> 1, hx = x & 1;
    const unsigned char* TB = p.ws + (VSIDE ? WS_V8 : WS_U8) + (size_t)s * (16384 * 128);
    const unsigned* EG = (const unsigned*)(p.ws + WS_EG); const unsigned short* WH = (const unsigned short*)(p.ws + WS_WH);
    const bf16_t* H2 = (const bf16_t*)(p.ws + WS_H2B) + 256 * s;
    const unsigned char* XH = p.ws + WS_XH + 128 * s; const unsigned char* XL = p.ws + WS_XL + 128 * s;
    unsigned* PART = (unsigned*)(p.ws + WS_PART) + (size_t)s * T * 64; float* SSQ3 = (float*)(p.ws + WS_SSQ3);
    int ln = lane; asm volatile("" : "+v"(ln));
    const int r = ln >> 3, c = ln & 7;
    constexpr int TH = T / 2;
    if (w0 >= TH) return;
    u32x4 idn[4];
    u32x4 wa[2], wb[2];
    u32x4 ha[2], hb2[2];
    u32x4 ra[16], rb[16];
    auto load_ids = [&](int k) { const int t = 2 * k + hx;
#pragma unroll
        for (int q = 0; q < 4; ++q) idn[q] = *(const u32x4*)(EG + (size_t)t * 128 + 16 * r + 4 * q);
    };
    auto issue = [&](u32x4 (&buf)[16], u32x4 (&wq)[2], u32x4 (&hq)[2], int k) {
        const int t = 2 * k + hx;
#pragma unroll
        for (int q = 0; q < 4; ++q) { const unsigned e4[4] = {idn[q].x, idn[q].y, idn[q].z, idn[q].w};
#pragma unroll
            for (int j = 0; j < 4; ++j) buf[4 * q + j] = *(const u32x4*)(TB + (e4[j] * 128u + 16u * (unsigned)c)); }
        if (VSIDE) { wq[0] = *(const u32x4*)(WH + (size_t)t * 128 + 16 * r); wq[1] = *(const u32x4*)(WH + (size_t)t * 128 + 16 * r + 8);
        } else { hq[0] = *(const u32x4*)(XH + (size_t)t * 512 + 16 * c); hq[1] = *(const u32x4*)(XL + (size_t)t * 512 + 16 * c); }
    };
    auto compute = [&](u32x4 (&cur)[16], u32x4 (&wc)[2], u32x4 (&hc)[2], int k) { const int t = 2 * k + hx;
        if (!VSIDE) {
            int dt[16];
#pragma unroll
            for (int i = 0; i < 16; ++i) {
                int ah = __builtin_amdgcn_sdot8((int)cur[i].x, (int)hc[0].x, 0, false), al = __builtin_amdgcn_sdot8((int)cur[i].x, (int)hc[1].x, 0, false);
                ah = __builtin_amdgcn_sdot8((int)cur[i].y, (int)hc[0].y, ah, false); al = __builtin_amdgcn_sdot8((int)cur[i].y, (int)hc[1].y, al, false);
                ah = __builtin_amdgcn_sdot8((int)cur[i].z, (int)hc[0].z, ah, false); al = __builtin_amdgcn_sdot8((int)cur[i].z, (int)hc[1].z, al, false);
                ah = __builtin_amdgcn_sdot8((int)cur[i].w, (int)hc[0].w, ah, false); al = __builtin_amdgcn_sdot8((int)cur[i].w, (int)hc[1].w, al, false);
                dt[i] = 16 * ah + al; if (i & 1) __builtin_amdgcn_sched_barrier(0); }
            int y8[8], y4[4], y2[2];
            { const bool bs = (ln & 4) != 0;
#pragma unroll
              for (int k2 = 0; k2 < 8; ++k2) { const int snd = bs ? dt[k2] : dt[k2 + 8], kp = bs ? dt[k2 + 8] : dt[k2]; y8[k2] = kp + (int)__float_as_uint(shx<4>(__uint_as_float((unsigned)snd), ln)); } }
            { const bool bs = (ln & 2) != 0;
#pragma unroll
              for (int k2 = 0; k2 < 4; ++k2) { const int snd = bs ? y8[k2] : y8[k2 + 4], kp = bs ? y8[k2 + 4] : y8[k2]; y4[k2] = kp + (int)__float_as_uint(shx<2>(__uint_as_float((unsigned)snd), ln)); } }
            { const bool bs = (ln & 1) != 0;
#pragma unroll
              for (int k2 = 0; k2 < 2; ++k2) { const int snd = bs ? y4[k2] : y4[k2 + 2], kp = bs ? y4[k2 + 2] : y4[k2]; y2[k2] = kp + (int)__float_as_uint(shx<1>(__uint_as_float((unsigned)snd), ln)); } }
            PART[(size_t)t * 64 + ln] = cvtpk((float)y2[0], (float)y2[1]);
        } else {
            typedef _Float16 f16x2 __attribute__((ext_vector_type(2)));
            f16x2 ov[16];
#pragma unroll
            for (int q = 0; q < 16; ++q) ov[q] = (f16x2){(_Float16)0.f, (_Float16)0.f};
            const unsigned wpk[8] = {wc[0].x, wc[0].y, wc[0].z, wc[0].w, wc[1].x, wc[1].y, wc[1].z, wc[1].w};
#pragma unroll
            for (int i = 0; i < 16; ++i) { const f16x2 wpair = __builtin_bit_cast(f16x2, wpk[i >> 1]); const _Float16 wh = wpair[i & 1]; const f16x2 wk2 = (f16x2){wh, wh}; const unsigned w[4] = {cur[i].x, cur[i].y, cur[i].z, cur[i].w};
#pragma unroll
                for (int q = 0; q < 4; ++q) {
                    const f16x2 f0 = __builtin_amdgcn_cvt_scalef32_pk_f16_fp4(w[q], 1.0f, 0), f1 = __builtin_amdgcn_cvt_scalef32_pk_f16_fp4(w[q], 1.0f, 1);
                    const f16x2 f2 = __builtin_amdgcn_cvt_scalef32_pk_f16_fp4(w[q], 1.0f, 2), f3 = __builtin_amdgcn_cvt_scalef32_pk_f16_fp4(w[q], 1.0f, 3);
                    ov[4 * q + 0] += wk2 * f0; ov[4 * q + 1] += wk2 * f1; ov[4 * q + 2] += wk2 * f2; ov[4 * q + 3] += wk2 * f3; }
                if (i & 1) __builtin_amdgcn_sched_barrier(0); }
            auto shp = [&](f16x2 v, auto tag) { return __builtin_bit_cast(f16x2, shx<decltype(tag)::value>(__builtin_bit_cast(float, v), ln)); };
            f16x2 y8[8], y4[4], y2[2];
#pragma unroll
            for (int k2 = 0; k2 < 8; ++k2) { auto rr = __builtin_amdgcn_permlane32_swap(__builtin_bit_cast(unsigned, ov[k2]), __builtin_bit_cast(unsigned, ov[k2 + 8]), false, false);
                y8[k2] = __builtin_bit_cast(f16x2, (unsigned)rr[0]) + __builtin_bit_cast(f16x2, (unsigned)rr[1]); }
#pragma unroll
            for (int k2 = 0; k2 < 4; ++k2) { auto rr = __builtin_amdgcn_permlane16_swap(__builtin_bit_cast(unsigned, y8[k2]), __builtin_bit_cast(unsigned, y8[k2 + 4]), false, false);
                y4[k2] = __builtin_bit_cast(f16x2, (unsigned)rr[0]) + __builtin_bit_cast(f16x2, (unsigned)rr[1]); }
            { const bool bs = (ln & 8) != 0;
#pragma unroll
              for (int k2 = 0; k2 < 2; ++k2) { const f16x2 snd = bs ? y4[k2] : y4[k2 + 2], kp = bs ? y4[k2 + 2] : y4[k2]; y2[k2] = kp + shp(snd, std::integral_constant<int, 8>()); } }
            const f32x2 z2[2] = {(f32x2){(float)y2[0][0], (float)y2[0][1]}, (f32x2){(float)y2[1][0], (float)y2[1][1]}};
            const int dd = 32 * c + ((ln >> 5) & 1) * 16 + ((ln >> 4) & 1) * 8 + ((ln >> 3) & 1) * 4;
            const u32x2 hb = *(const u32x2*)(H2 + (size_t)t * D + dd);
            const f32x4 h3 = (f32x4){bf2f((unsigned short)(hb.x & 0xffffu)) + z2[0][0], bf2f((unsigned short)(hb.x >> 16)) + z2[0][1], bf2f((unsigned short)(hb.y & 0xffffu)) + z2[1][0], bf2f((unsigned short)(hb.y >> 16)) + z2[1][1]};
            { u32x2 pk; pk.x = cvtpk(h3[0], h3[1]); pk.y = cvtpk(h3[2], h3[3]); *(u32x2*)((bf16_t*)(p.ws + WS_H3B) + (size_t)t * D + 256 * s + dd) = pk; }
            const float ss = wave_sum_fast((h3[0] * h3[0] + h3[1] * h3[1]) + (h3[2] * h3[2] + h3[3] * h3[3]), ln);
            if (ln == 0) SSQ3[(size_t)t * 4 + s] = ss;
        }
    };
    load_ids(w0);
    issue(ra, wa, ha, w0);
    if (w0 + nwv < TH) load_ids(w0 + nwv);
    for (int t = w0; t < TH; t += 2 * nwv) {
        const bool m1 = t + nwv < TH, m2 = t + 2 * nwv < TH, m3 = t + 3 * nwv < TH;
        if (m1) { issue(rb, wb, hb2, t + nwv); if (m2) load_ids(t + 2 * nwv); }
        compute(ra, wa, ha, t);
        if (!m1) break;
        if (m2) { issue(ra, wa, ha, t + 2 * nwv); if (m3) load_ids(t + 3 * nwv); }
        compute(rb, wb, hb2, t + nwv);
        if (!m2) break;
    }
}
template <bool VSIDE>
__device__ __forceinline__ void peer_slice_phase(const Params& p, unsigned xcc, int rank, int G, int bx, int wave, int lane) {
    unsigned* ctl = (unsigned*)(p.ws + WS_CTL);
    for (int x = 0; x < 8; ++x) {
        const int cx = (int)__builtin_amdgcn_readfirstlane((int)__hip_atomic_load(ctl + CW_BAR + XB_XCNT(x), __ATOMIC_RELAXED, __HIP_MEMORY_SCOPE_AGENT));
        if (cx != 0 && (int)xcc != x) continue;
        const int nwv = (cx == 0 ? G : cx) * NWAVES, w0 = (cx == 0 ? bx : rank) * NWAVES + wave;
        peer_slice_tokens<VSIDE>(p, x, w0, nwv, lane);
    }
}
__device__ __forceinline__ void peer_combine_phase(const Params& p, int gw, int NGW, int lane) {
    const unsigned* PART = (const unsigned*)(p.ws + WS_PART); const float* WG = (const float*)(p.ws + WS_WG); unsigned* WH = (unsigned*)(p.ws + WS_WH); const unsigned* EG = (const unsigned*)(p.ws + WS_EG);
    const float* STEP = (const float*)(p.ws + WS_STEP); const float* XS8 = (const float*)(p.ws + WS_XS8);
    for (int t = gw; t < T; t += NGW) {
        f32x2 sm = (f32x2){0.f, 0.f};
#pragma unroll
        for (int x = 0; x < 4; ++x) { const unsigned pw = PART[((size_t)x * T + t) * 64 + lane]; sm += (f32x2){bf2f((unsigned short)(pw & 0xffffu)), bf2f((unsigned short)(pw >> 16))}; }
        const u32x2 e2 = *(const u32x2*)(EG + (size_t)t * 128 + 2 * lane);
        const f32x2 st0 = *(const f32x2*)(STEP + 2 * (size_t)e2.x), st1 = *(const f32x2*)(STEP + 2 * (size_t)e2.y);
        const float kh = 0.5f * XS8[t];
        const f32x2 g = *(const f32x2*)(WG + (size_t)t * 128 + 2 * lane);
        typedef _Float16 f16x2 __attribute__((ext_vector_type(2)));
        const f16x2 wv = (f16x2){(_Float16)(g[0] * gelu_f((sm[0] + kh) * (st0[0] * (X8_CLIP / 119.f))) * st0[1]), (_Float16)(g[1] * gelu_f((sm[1] + kh) * (st1[0] * (X8_CLIP / 119.f))) * st1[1])};
        WH[(size_t)t * 64 + lane] = __builtin_bit_cast(unsigned, wv);
    }
}
__device__ __forceinline__ void peer_final_phase(const Params& p, int gw, int NGW, int lane_) {
    int lane = lane_; asm volatile("" : "+v"(lane));
    const float* SSQ3 = (const float*)(p.ws + WS_SSQ3); const bf16_t* H3 = (const bf16_t*)(p.ws + WS_H3B);
    f32x4 gf[4];
#pragma unroll
    for (int q = 0; q < 4; ++q) gf[q] = *(const f32x4*)(p.g_final + 256 * q + 4 * lane);
    for (int t = gw; t < T; t += 2 * NGW) {
        const int t2 = t + NGW; const bool has2 = t2 < T;
        u32x2 a[4], b[4];
#pragma unroll
        for (int q = 0; q < 4; ++q) a[q] = *(const u32x2*)(H3 + (size_t)t * D + 256 * q + 4 * lane);
        if (has2) {
#pragma unroll
            for (int q = 0; q < 4; ++q) b[q] = *(const u32x2*)(H3 + (size_t)t2 * D + 256 * q + 4 * lane); }
        const float r1 = rsqrtf(ssq_sum<4>(SSQ3 + (size_t)t * 4) * (1.f / D) + EPS), r2 = has2 ? rsqrtf(ssq_sum<4>(SSQ3 + (size_t)t2 * 4) * (1.f / D) + EPS) : 0.f;
        auto emit = [&](const u32x2 (&v)[4], float rs, int tt) { float* row = p.out + (size_t)tt * D + 4 * lane;
#pragma unroll
            for (int q = 0; q < 4; ++q) { const f32x4 h = (f32x4){bf2f((unsigned short)(v[q].x & 0xffffu)), bf2f((unsigned short)(v[q].x >> 16)), bf2f((unsigned short)(v[q].y & 0xffffu)), bf2f((unsigned short)(v[q].y >> 16))};
                *(f32x4*)(row + 256 * q) = h * rs * gf[q]; } };
        emit(a, r1, t);
        if (has2) emit(b, r2, t2);
    }
}

#ifndef PH_MASK
#define PH_MASK 0xFFFF
#endif
#define PH(k) ((PH_MASK >> (k)) & 1)
#ifdef TPROBE
#define TMARK(k) do { const unsigned long long tn_ = __builtin_amdgcn_s_memrealtime(); if (TPROBE == (k)) { const unsigned long long d_ = tn_ - tprev_; while (__builtin_amdgcn_s_memrealtime() - tn_ < d_) __builtin_amdgcn_s_sleep(8); } tprev_ = __builtin_amdgcn_s_memrealtime(); } while (0)
#else
#define TMARK(k)
#endif
#ifndef PEER_DSLICE
#define PEER_DSLICE 1
#endif
#ifndef GEMM_ALIGN
#define GEMM_ALIGN true
#endif
#ifndef REP_MASK
#define REP_MASK 0
#endif
#if (REP_MASK >> 0) & 1
#define REP_0 for (int rep_ = 0; rep_ < 2; ++rep_)
#else
#define REP_0
#endif
#if (REP_MASK >> 1) & 1
#define REP_1 for (int rep_ = 0; rep_ < 2; ++rep_)
#else
#define REP_1
#endif
#if (REP_MASK >> 2) & 1
#define REP_2 for (int rep_ = 0; rep_ < 2; ++rep_)
#else
#define REP_2
#endif
#if (REP_MASK >> 3) & 1
#define REP_3 for (int rep_ = 0; rep_ < 2; ++rep_)
#else
#define REP_3
#endif
#if (REP_MASK >> 4) & 1
#define REP_4 for (int rep_ = 0; rep_ < 2; ++rep_)
#else
#define REP_4
#endif
#if (REP_MASK >> 5) & 1
#define REP_5 for (int rep_ = 0; rep_ < 2; ++rep_)
#else
#define REP_5
#endif
#if (REP_MASK >> 6) & 1
#define REP_6 for (int rep_ = 0; rep_ < 2; ++rep_)
#else
#define REP_6
#endif
#if (REP_MASK >> 7) & 1
#define REP_7 for (int rep_ = 0; rep_ < 2; ++rep_)
#else
#define REP_7
#endif
#if (REP_MASK >> 8) & 1
#define REP_8 for (int rep_ = 0; rep_ < 2; ++rep_)
#else
#define REP_8
#endif
#if (REP_MASK >> 9) & 1
#define REP_9 for (int rep_ = 0; rep_ < 2; ++rep_)
#else
#define REP_9
#endif
#define REP(k) REP_##k
__global__ void __launch_bounds__(NWAVES * 64, 2) fwd_megakernel(Params p) {
    extern __shared__ __attribute__((aligned(16))) unsigned char lds_raw[];
    LAS unsigned char* lds = (LAS unsigned char*)lds_raw;
    const int tid = threadIdx.x, lane = tid & 63, wave = __builtin_amdgcn_readfirstlane(tid >> 6);
    const int G = gridDim.x; const int bx = blockIdx.x;
    const int vcu = (G % 8 == 0) ? (bx % 8) * (G / 8) + bx / 8 : bx;
    if (p.never) { cg::this_grid().sync(); }
    unsigned char* const ws = p.ws;
    volatile LAS unsigned* MISC = (volatile LAS unsigned*)(lds + LDSCTL_OFF);
    for (int u = tid; u < (LDS_BYTES - LDSCTL_OFF) / 4; u += NWAVES * 64) ((LAS unsigned*)(lds + LDSCTL_OFF))[u] = 0u;
    __syncthreads();
    XcdBarrier bar = xcd_barrier_post((unsigned*)(ws + WS_CTL) + CW_BAR, MISC + 8);
    if (tid == 0) MISC[20] = __hip_atomic_fetch_add((unsigned*)(ws + WS_CTL) + CW_XRANK + 64 * bar.x, 1u, __ATOMIC_RELAXED, __HIP_MEMORY_SCOPE_AGENT);
    const int gw = vcu * NWAVES + wave, NGW = G * NWAVES;
#ifdef TPROBE
    unsigned long long tprev_ = __builtin_amdgcn_s_memrealtime();
#endif

#define WSB(off) ((bf16_t*)(p.ws + (off)))
#define WSF(off) ((float*)(p.ws + (off)))
    REP(0) {
    if (PH(0))
    {
        LAS float* scr = (LAS float*)(lds + wave * 16384);
        constexpr int I_IN = 16 * 85, I_XKV = 16 * 64;
        constexpr int NITEMS = I_IN + I_XKV;
        for (int it = gw; it < NITEMS; it += NGW) {
            int r = it;
            if (r < I_IN) { p0_transpose_item<1>(p.w_in, 1024, 2720, WSB(WS_WIN), nullptr, scr, r, lane); continue; } r -= I_IN;
            p0_transpose_item<0>(p.w_xkv, 1024, 2048, WSB(WS_WXKV), nullptr, scr, r, lane);
        }
        for (int m = gw; m < T / 4; m += NGW) rms_rows_to_bf16<4>(p.x + (size_t)m * D, p.g_mix, WSB(WS_A0) + (size_t)m * D, (size_t)(T / 4) * D, lane);
        for (int m = gw; m < 1024; m += NGW) rms_rows_to_bf16<1>(p.mem + (size_t)m * D, p.g_mem, WSB(WS_MEMN) + (size_t)m * D, 0, lane);
        const int gt = vcu * 512 + tid, NGT = G * 512;
        for (int i = gt; i < 2 * 128 * 128 / 2; i += NGT) { const f32x2 v = *(const f32x2*)(p.sub_keys + 2 * i); ((unsigned*)WSB(WS_SK))[i] = cvtpk(v[0], v[1]); }
        for (int i = gt; i < 96 * 1024 / 8; i += NGT) ((u32x4*)(WSB(WS_WIN) + (size_t)2208 * 1024))[i] = (u32x4){0u, 0u, 0u, 0u};
        for (int i = gt; i < SEQ * 64; i += NGT) { const int s = i >> 6, f = i & 63; const float inv = exp2f(-(float)f * (13.287712379549449f / 64.f)); const float ang = (float)s * inv;
            const double rev = (double)ang * 0.15915494309189535; const float fr = (float)(rev - floor(rev)); WSF(WS_CR)[i] = __builtin_amdgcn_cosf(fr); WSF(WS_SR)[i] = __builtin_amdgcn_sinf(fr); }
        for (int i = gt; i < SEQ * 16; i += NGT) { const int s = i >> 4, f = i & 15; const float inv = exp2f(-(float)f * (13.287712379549449f / 16.f)); const float ang = (float)s * inv;
            const double rev = (double)ang * 0.15915494309189535; const float fr = (float)(rev - floor(rev)); WSF(WS_CM)[i] = __builtin_amdgcn_cosf(fr); WSF(WS_SM)[i] = __builtin_amdgcn_sinf(fr); }
    }
    xcd_barrier(bar);
    TMARK(0);
#ifdef DBL_BAR
    xcd_barrier(bar);
#endif
    }

    REP(1) {
    if (PH(1))
    {
        { pg8::Gemm g{WSB(WS_A0), WSB(WS_WIN), T, NPROJ, 1024, 1024, 1024}; pg8::StaticOrder S; S.init(T, NPROJ, G, bx);
          pg8::EpiProj E{WSB(WS_PROJ), WSF(WS_SSQQ), WSF(WS_SSQKV), WSF(WS_CR), WSF(WS_SR), WSF(WS_CM), WSF(WS_SM)}; pg8::gemm_phase<pg8::EpiProj, pg8::StaticOrder, GEMM_ALIGN>(lds, g, S, E); }
#ifdef DUP_P1MAIN
        { pg8::Gemm g{WSB(WS_A0), WSB(WS_WIN), T, NPROJ, 1024, 1024, 1024}; pg8::StaticOrder S; S.init(T, NPROJ, G, bx);
          pg8::EpiProj E{WSB(WS_PROJ), WSF(WS_SSQQ), WSF(WS_SSQKV), WSF(WS_CR), WSF(WS_SR), WSF(WS_CM), WSF(WS_SM)}; pg8::gemm_phase<pg8::EpiProj, pg8::StaticOrder, GEMM_ALIGN>(lds, g, S, E); }
#endif
        { pg8::Gemm g{WSB(WS_WIN) + (size_t)2304 * 1024, WSB(WS_A0), 512, T, 1024, 1024, 1024}; pg8::StaticOrder S; S.init(512, T, G, (bx - 64 + G) % G);
          pg8::EpiPlain E{WSB(WS_RVT), TP}; pg8::gemm_phase<pg8::EpiPlain, pg8::StaticOrder, GEMM_ALIGN>(lds, g, S, E); }
        { pg8::Gemm g{WSB(WS_MEMN), WSB(WS_WXKV), 1024, 1024, 1024, 1024, 1024}; pg8::StaticOrder S; S.init(1024, 1024, G, (bx - 192 + G) % G);
          pg8::EpiPlain E{WSB(WS_KX), 1024}; pg8::gemm_phase<pg8::EpiPlain, pg8::StaticOrder, GEMM_ALIGN>(lds, g, S, E); }
        { pg8::Gemm g{WSB(WS_WXKV) + (size_t)1024 * 1024, WSB(WS_MEMN), 1024, 1024, 1024, 1024, 1024}; pg8::StaticOrder S; S.init(1024, 1024, G, (bx - 208 + G) % G);
          pg8::EpiPlain E{WSB(WS_VXT), 1024}; pg8::gemm_phase<pg8::EpiPlain, pg8::StaticOrder, GEMM_ALIGN>(lds, g, S, E); }
        {
            const int nd = G >= 64 ? 32 : G, d0 = G - nd;
            if (bx >= d0) {
                LAS float* scr = (LAS float*)(lds + wave * 16384);
                constexpr int I_UQ = 6 * 24, I_UKV = 4 * 32;
                constexpr int NITEMS = I_UQ + I_UKV;
                for (int it = (bx - d0) * NWAVES + wave; it < NITEMS; it += nd * NWAVES) {
                    int r = it;
                    if (r < I_UQ) { p0_transpose_item<2>(p.w_uq, 384, 768, WSB(WS_WUQ), p.g_q_lora, scr, r, lane); continue; } r -= I_UQ;
                    p0_transpose_item<3>(p.w_ukv, 256, 1024, WSB(WS_WUKV), p.g_kv_lora, scr, r, lane);
                }
            }
        }
    }
    xcd_barrier(bar);
    TMARK(1);
#ifdef DBL_BAR
    xcd_barrier(bar);
#endif
    }

    REP(2) {
    if (PH(2))
    {
        { pg8::Gemm g{WSB(WS_PROJ), WSB(WS_WUQ), T, 768, 384, NPROJ, 384}; pg8::StaticOrder S; S.init(T, 768, G, bx);
          pg8::EpiQ E{WSB(WS_QM), WSF(WS_SSQQ), WSF(WS_CM), WSF(WS_SM)}; pg8::gemm_phase<pg8::EpiQ, pg8::StaticOrder, GEMM_ALIGN>(lds, g, S, E); }
        { pg8::Gemm g{WSB(WS_PROJ) + 384, WSB(WS_WUKV), T, 512, 256, NPROJ, 256}; pg8::StaticOrder S; S.init(T, 512, G, (bx - 192 + G) % G);
          pg8::EpiRowScale<8> E{WSB(WS_KN), 512, WSF(WS_SSQKV), 1.f / 256.f, 1.f}; pg8::gemm_phase<pg8::EpiRowScale<8>, pg8::StaticOrder, GEMM_ALIGN>(lds, g, S, E); }
        { pg8::Gemm g{WSB(WS_WUKV) + (size_t)512 * 256, WSB(WS_PROJ) + 384, 512, T, 256, 256, NPROJ}; pg8::StaticOrder S; S.init(512, T, G, (bx - 64 + G) % G);
          pg8::EpiColScale E{WSB(WS_VT), TP, WSF(WS_SSQKV), 1.f / 256.f}; pg8::gemm_phase<pg8::EpiColScale, pg8::StaticOrder, GEMM_ALIGN>(lds, g, S, E); }
        {
            const int nd = G >= 256 ? 64 : G, d0 = G - nd;
            if (bx >= d0) {
                LAS float* scr = (LAS float*)(lds + wave * 16384);
                constexpr int I_SQ = 16 * 32, I_PQ = 16 * 64;
                constexpr int NITEMS = 3 * I_SQ + I_PQ;
                for (int it = (bx - d0) * NWAVES + wave; it < NITEMS; it += nd * NWAVES) {
                    int r = it;
                    if (r < I_SQ) { p0_transpose_item<0>(p.w_o, 1024, 1024, WSB(WS_WO), nullptr, scr, r, lane); continue; } r -= I_SQ;
                    if (r < I_SQ) { p0_transpose_item<0>(p.w_xq, 1024, 1024, WSB(WS_WXQ), p.g_xattn, scr, r, lane); continue; } r -= I_SQ;
                    if (r < I_SQ) { p0_transpose_item<0>(p.w_xo, 1024, 1024, WSB(WS_WXO), nullptr, scr, r, lane); continue; } r -= I_SQ;
                    p0_transpose_item<0>(p.w_pq, 1024, 2048, WSB(WS_WPQ), p.g_ffn, scr, r, lane);
                }
                __syncthreads();
            }
        }
        for (int u = vcu; u < 512; u += G) ret_state_unit(lds, u, WSB(WS_PROJ), WSB(WS_RVT), WSB(WS_RKVT));
    }
    xcd_barrier(bar);
    TMARK(2);
#ifdef DBL_BAR
    xcd_barrier(bar);
#endif
    }

    REP(3) {
    if (PH(3))
    {
        unsigned* scan_cnt = (unsigned*)(p.ws + WS_CTL) + CW_QUEUE + 64 * Q3_SLOT;
#if (REP_MASK >> 3) & 1
        if (rep_ == 0)
#endif
        {
            bf16_t* RK = WSB(WS_RKVT);
            for (int e2 = vcu * 512 + tid; e2 < 16 * 8192; e2 += G * 512) {
                const int bh = e2 >> 13, off = e2 & 8191; const float cd = exp2f(128.f * ret_log2g(bh & 3));
                unsigned* base = (unsigned*)(RK + (size_t)bh * 32 * 16384) + off;
                unsigned x[32];
#pragma unroll
                for (int n = 0; n < 32; ++n) x[n] = base[(size_t)n * 8192];
                float r0 = 0.f, r1 = 0.f;
#pragma unroll
                for (int n = 0; n < 32; ++n) { const unsigned o = cvtpk(r0, r1); r0 = r0 * cd + bf2f((unsigned short)(x[n] & 0xffffu)); r1 = r1 * cd + bf2f((unsigned short)(x[n] >> 16)); base[(size_t)n * 8192] = o; }
            }
            asm volatile("s_waitcnt vmcnt(0)" ::: "memory");
            __syncthreads();
            if (tid == 0) { __builtin_amdgcn_fence(__ATOMIC_RELEASE, "agent"); asm volatile("s_waitcnt vmcnt(0)" ::: "memory"); __hip_atomic_fetch_add(scan_cnt, 1u, __ATOMIC_RELAXED, __HIP_MEMORY_SCOPE_AGENT); }
        }
#ifdef REP_MLA
        for (int rr_ = 0; rr_ < REP_MLA; ++rr_)
#endif
        for (int v2 = 2 * vcu; v2 < 512; v2 += (v2 & 1) ? 2 * G - 1 : 1) { const int v = v2 >> 1, bh = v >> 3, s = v & 7;
            mla_unit(lds, bh >> 3, bh & 7, (v2 & 1) ? s : 15 - s, WSB(WS_QM), WSB(WS_KN), WSB(WS_PROJ), WSB(WS_VT), WSB(WS_MIX)); }
#ifdef MLA_BAR
        xcd_barrier(bar);
#endif
        if (tid == 0) { unsigned sp = 0; while (__hip_atomic_load(scan_cnt, __ATOMIC_RELAXED, __HIP_MEMORY_SCOPE_AGENT) < (unsigned)G) { __builtin_amdgcn_s_sleep(2); if (++sp > XB_SPIN_CAP) break; }
            __builtin_amdgcn_fence(__ATOMIC_ACQUIRE, "agent"); asm volatile("s_waitcnt vmcnt(0)" ::: "memory"); }
        __syncthreads();
#ifdef REP_RET
        for (int rr_ = 0; rr_ < 2; ++rr_)
#endif
        for (int u = vcu; u < 512; u += G) ret_out_unit(lds, u, WSB(WS_PROJ), WSB(WS_RVT), WSB(WS_RKVT), p.g_ret_gn, WSB(WS_MIX));
    }
    xcd_barrier(bar);
    TMARK(3);
#ifdef DBL_BAR
    xcd_barrier(bar);
#endif
    }

    REP(4) {
    if (PH(4))
#ifdef REP_P4NB
    for (int nb_ = 0; nb_ < 2; ++nb_)
#endif
    { pg8::Gemm g{WSB(WS_MIX), WSB(WS_WO), T, 1024, 1024, 1024, 1024}; pg8::StaticOrder S; S.init(T, 1024, G, bx);
      pg8::EpiRes E{p.x, nullptr, WSB(WS_H1B), WSF(WS_SSQ1)}; pg8::gemm_phase<pg8::EpiRes, pg8::StaticOrder, GEMM_ALIGN>(lds, g, S, E); }
    xcd_barrier(bar);
    TMARK(4);
#ifdef DBL_BAR
    xcd_barrier(bar);
#endif
    }

    REP(5) {
    if (PH(5))
    { }
    TMARK(5);
#ifdef DBL_BAR
    xcd_barrier(bar);
#endif
    }

    REP(6) {
    if (PH(6))
    {
        auto xattn_job = [&]() { for (int u = vcu; u < 256; u += G) { const int qb = u & 15, h = (u >> 4) & 3, b = u >> 6; xattn_unit(lds, b, h, qb, WSB(WS_QX), WSB(WS_KX), WSB(WS_VXT), WSB(WS_OX), (u32x4*)(p.ws + WS_PSAVE) + (size_t)u * (NWAVES * 4 * 4 * 64)); } };
        auto convert_job = [&]() {
            unsigned char* U4 = ws + WS_U8; unsigned char* V4 = ws + WS_V8; float* STEP = (float*)(ws + WS_STEP);
            const f32x4* gf = (const f32x4*)p.g_ffn + lane * 4;
            f32x4 gs[4];
#pragma unroll
            for (int i = 0; i < 4; ++i) gs[i] = gf[i];
            auto ldrow = [&](int e, f32x4 (&v)[4]) { const bool isv = e >= 16384; const int row = isv ? e - 16384 : e;
                const f32x4* src = (const f32x4*)((isv ? p.v_exp : p.u_exp) + (size_t)row * D) + lane * 4;
#pragma unroll
                for (int i = 0; i < 4; ++i) v[i] = src[i]; };
            auto emit = [&](int e, const f32x4 (&vin)[4]) {
                const bool isv = e >= 16384; const int row = isv ? e - 16384 : e;
                f32x4 v[4]; float ss = 0.f;
#pragma unroll
                for (int i = 0; i < 4; ++i) { v[i] = isv ? vin[i] : vin[i] * gs[i]; ss += (v[i][0] * v[i][0] + v[i][1] * v[i][1]) + (v[i][2] * v[i][2] + v[i][3] * v[i][3]); }
                const float rms = sqrtf(wave_sum_fast(ss, lane) * (1.f / D));
                const float sc = fmaxf(rms * (isv ? V4_SCALE : U4_STEP), 1e-30f), inv = 1.f / sc;
                unsigned ow[2] = {0u, 0u};
                if (isv) {
#pragma unroll
                    for (int i = 0; i < 4; ++i) { const f32x4 a = v[i] * inv;
                        const float a0 = fminf(fmaxf(a[0], -6.f), 6.f), a1 = fminf(fmaxf(a[1], -6.f), 6.f), a2 = fminf(fmaxf(a[2], -6.f), 6.f), a3 = fminf(fmaxf(a[3], -6.f), 6.f);
                        if (i & 1) { ow[i >> 1] = __builtin_amdgcn_cvt_scalef32_pk_fp4_f32(ow[i >> 1], a0, a1, 1.0f, 2); ow[i >> 1] = __builtin_amdgcn_cvt_scalef32_pk_fp4_f32(ow[i >> 1], a2, a3, 1.0f, 3); }
                        else { ow[i >> 1] = __builtin_amdgcn_cvt_scalef32_pk_fp4_f32(ow[i >> 1], a0, a1, 1.0f, 0); ow[i >> 1] = __builtin_amdgcn_cvt_scalef32_pk_fp4_f32(ow[i >> 1], a2, a3, 1.0f, 1); } }
                } else {
#pragma unroll
                    for (int i = 0; i < 4; ++i)
#pragma unroll
                        for (int q = 0; q < 4; ++q) { const int n = 4 * i + q; const int qv = (int)floorf(fminf(fmaxf(v[i][q] * inv, -8.f), 7.5f)); ow[n >> 3] |= (unsigned)(qv & 15) << (4 * (n & 7)); }
                }
                *(u32x2*)((isv ? V4 : U4) + (size_t)(lane >> 4) * (16384 * 128) + (size_t)row * 128 + (lane & 15) * 8) = (u32x2){ow[0], ow[1]};
                if (lane == 0) STEP[2 * row + (isv ? 1 : 0)] = sc;
            };
            constexpr int NR = 2 * 16384;
            f32x4 ra_[4], rb_[4], rc_[4];
            if (gw < NR) ldrow(gw, ra_);
            if (gw + NGW < NR) ldrow(gw + NGW, rb_);
            for (int e = gw; e < NR; e += 3 * NGW) {
                if (e + 2 * NGW < NR) ldrow(e + 2 * NGW, rc_);
                emit(e, ra_);
                if (e + NGW >= NR) break;
                if (e + 3 * NGW < NR) ldrow(e + 3 * NGW, ra_);
                emit(e + NGW, rb_);
                if (e + 2 * NGW >= NR) break;
                if (e + 4 * NGW < NR) ldrow(e + 4 * NGW, rb_);
                emit(e + 2 * NGW, rc_);
            }
        };
        auto qproj_job = [&]() {
            { pg8::Gemm g{WSB(WS_H1B), WSB(WS_WXQ), T, 1024, 1024, 1024, 1024}; pg8::XaOrder S{G, vcu};
              pg8::EpiRowScale<16> E{WSB(WS_QX), 1024, WSF(WS_SSQ1), 1.f / 1024.f, C2_X}; pg8::gemm_phase<pg8::EpiRowScale<16>, pg8::XaOrder, GEMM_ALIGN>(lds, g, S, E); }
            asm volatile("s_waitcnt vmcnt(0)" ::: "memory");
            __builtin_amdgcn_fence(__ATOMIC_RELEASE, "workgroup");
            __syncthreads();
            __builtin_amdgcn_fence(__ATOMIC_ACQUIRE, "workgroup");
        };
        const int ord = (bx >> 3) % 3;
        if (ord == 2) convert_job();
        qproj_job();
        if (ord == 1) convert_job();
        xattn_job();
        if (ord == 0) convert_job();
    }
    xcd_barrier(bar);
    TMARK(6);
#ifdef DBL_BAR
    xcd_barrier(bar);
#endif
    }

    REP(7) {
    if (PH(7))
    { pg8::Gemm g{WSB(WS_OX), WSB(WS_WXO), T, 1024, 1024, 1024, 1024}; pg8::StaticOrder S; S.init(T, 1024, G, bx);
      pg8::EpiRes E{nullptr, WSB(WS_H1B), WSB(WS_H2B), WSF(WS_SSQ2)}; pg8::gemm_phase<pg8::EpiRes, pg8::StaticOrder, GEMM_ALIGN>(lds, g, S, E); }
    xcd_barrier(bar);
    TMARK(7);
#ifdef DBL_BAR
    xcd_barrier(bar);
#endif
    }

    REP(8) {
    if (PH(8))
    { pg8::Gemm g{WSB(WS_H2B), WSB(WS_WPQ), T, 2048, 1024, 1024, 1024}; pg8::StaticOrder S; S.init(T, 2048, G, bx);
      pg8::EpiRowScale<16> E{WSB(WS_QP), 2048, WSF(WS_SSQ2), 1.f / 1024.f, 1.f}; pg8::gemm_phase<pg8::EpiRowScale<16>, pg8::StaticOrder, GEMM_ALIGN>(lds, g, S, E); }
    xcd_barrier(bar);
    TMARK(8);
#ifdef DBL_BAR
    xcd_barrier(bar);
#endif
    }

    REP(9) {
    if (PH(9))
    {
#if PEER_DSLICE
      const int myrank = (int)MISC[20];
      peer_phase<true>(lds, p, vcu, G);
      xcd_barrier(bar);
    TMARK(9);
#ifdef DUP_RETR
      peer_phase<true>(lds, p, vcu, G);
      xcd_barrier(bar);
#endif
      peer_slice_phase<false>(p, bar.x, myrank, G, bx, wave, lane);
      xcd_barrier(bar);
    TMARK(10);
#ifdef DUP_USL
      peer_slice_phase<false>(p, bar.x, myrank, G, bx, wave, lane);
      xcd_barrier(bar);
#endif
      peer_combine_phase(p, gw, NGW, lane);
      xcd_barrier(bar);
    TMARK(11);
      peer_slice_phase<true>(p, bar.x, myrank, G, bx, wave, lane);
      xcd_barrier(bar);
    TMARK(12);
#ifdef DUP_VSL
      peer_slice_phase<true>(p, bar.x, myrank, G, bx, wave, lane);
      xcd_barrier(bar);
#endif
      peer_final_phase(p, gw, NGW, lane);
      TMARK(13);
#else
      peer_phase<false>(lds, p, vcu, G);
      xcd_barrier(bar);
      peer_v_phase(p, vcu, G);
#endif
    }
#if (REP_MASK >> 9) & 1
    xcd_barrier(bar);
#endif
    }
}

extern "C" void kernel_launch(void* const* d_in, const int* in_sizes, int n_in, void* d_out, int out_size, void* d_ws, size_t ws_size, hipStream_t stream) {
    static int grid = 0;
    if (grid == 0) {
        if (n_in != 21 || out_size != T * D || ws_size < WS_END) { fprintf(stderr, "kernel_launch: unexpected shapes (n_in %d out %d ws %zu)\n", n_in, out_size, ws_size); grid = -1; return; }
        int dev = 0, cus = 0, per_cu = 0;
        if (hipGetDevice(&dev) != hipSuccess || hipDeviceGetAttribute(&cus, hipDeviceAttributeMultiprocessorCount, dev) != hipSuccess) { grid = -1; return; }
        if (hipFuncSetAttribute((const void*)fwd_megakernel, hipFuncAttributeMaxDynamicSharedMemorySize, LDS_BYTES) != hipSuccess) { fprintf(stderr, "kernel_launch: hipFuncSetAttribute failed\n"); grid = -1; return; }
        if (hipOccupancyMaxActiveBlocksPerMultiprocessor(&per_cu, (const void*)fwd_megakernel, NWAVES * 64, LDS_BYTES) != hipSuccess || per_cu < 1) { fprintf(stderr, "kernel_launch: occupancy query says %d\n", per_cu); grid = -1; return; }
        (void)hipGetLastError();
        grid = cus;
    }
    if (grid < 0) return;
    (void)hipMemsetAsync((char*)d_ws + WS_CTL, 0, CTL_ZERO_BYTES, stream);
    Params p{};
    const float** pp = (const float**)&p;
    for (int i = 0; i < 21; ++i) pp[i] = (const float*)d_in[i];
    p.out = (float*)d_out; p.ws = (unsigned char*)d_ws; p.never = 0; p.pad = 0;
    void* args[] = {&p};
    hipError_t e = hipLaunchCooperativeKernel((const void*)fwd_megakernel, dim3(grid), dim3(NWAVES * 64), args, LDS_BYTES, stream);
    if (e != hipSuccess) fprintf(stderr, "cooperative launch failed: %s (grid %d)\n", hipGetErrorString(e), grid);
}
```
